# Optimizing an MI355X kernel written in HIP

```python
import jax, jax.numpy as jnp
from jax import lax
import numpy as np

D_MODEL = 1024
BATCH = 2
SEQ = 8192
DEPTH = 1

MEM_LEN = 256

NSA_HEADS = 8
NSA_HEAD_DIM = 64
NSA_KV_GROUPS = 2
NSA_HEADS_PER_GROUP = NSA_HEADS // NSA_KV_GROUPS
NSA_WIDTH = NSA_HEADS * NSA_HEAD_DIM
KV_WIDTH = NSA_KV_GROUPS * NSA_HEAD_DIM
NSA_GATE_WIDTH = NSA_HEADS * 3
CMP_BLOCK = 32
CMP_STRIDE = 16
CMP_HIDDEN = 256
SLC_BLOCK = 64
SLC_TOPN = 16
WINDOW = 512
Q_BLOCK = 128
FORCE_BONUS = 1e4

GMLP_WIDTH = 512
GMLP_GROUPS = 4
GMLP_GROUP_DIM = GMLP_WIDTH // GMLP_GROUPS
GMLP_CHUNK = 128

N_BRANCHES = 2
IN_SPLITS = (NSA_WIDTH, KV_WIDTH, KV_WIDTH, KV_WIDTH, KV_WIDTH, KV_WIDTH, KV_WIDTH,
             NSA_GATE_WIDTH, GMLP_WIDTH, GMLP_WIDTH, N_BRANCHES * D_MODEL)
IN_PROJ_WIDTH = NSA_WIDTH + 6 * KV_WIDTH + NSA_GATE_WIDTH + 2 * GMLP_WIDTH + N_BRANCHES * D_MODEL

XATTN_HEADS = 4
XATTN_HEAD_DIM = D_MODEL // XATTN_HEADS

PEER_HEADS = 8
PEER_KEYS = 128
PEER_EXPERTS = PEER_KEYS * PEER_KEYS
PEER_QUERY_DIM = 256
PEER_HALF = PEER_QUERY_DIM // 2
PEER_TOPK = 16
PEER_TOKEN_CHUNK = 128

NORM_EPS = 1e-6
NEG_INF = -1e30
TINY = 1e-30

kernel_name = "hybrid_nsa_gmlp_peer_block"


def rms_norm(x, g):
    xf = x.astype(jnp.float32)
    y = xf * lax.rsqrt(jnp.mean(xf * xf, axis=-1, keepdims=True) + NORM_EPS)
    return (y * g.astype(jnp.float32)).astype(x.dtype)


def masked_softmax(s, mask):
    s = jnp.where(mask, s.astype(jnp.float32), NEG_INF)
    m = jnp.max(s, axis=-1, keepdims=True)
    p = jnp.where(mask, jnp.exp(s - m), 0.0)
    return p / jnp.maximum(jnp.sum(p, axis=-1, keepdims=True), TINY)


def gelu(x):
    return jax.nn.gelu(x, approximate=False)


def compress_tokens(tok, pe, w1, b1, w2):
    B, S, G, dk = tok.shape
    r = CMP_BLOCK // CMP_STRIDE
    n_chunks = S // CMP_STRIDE
    n_cmp = n_chunks - r + 1
    chunks = tok.reshape(B, n_chunks, CMP_STRIDE, G, dk)
    blocks = jnp.concatenate([chunks[:, j:j + n_cmp] for j in range(r)], axis=2)
    blocks = blocks + pe[None, None, :, None, :]
    flat = blocks.transpose(0, 1, 3, 2, 4).reshape(B, n_cmp, G, CMP_BLOCK * dk)
    return gelu(flat @ w1 + b1) @ w2


def nsa_attention(q, kc, vc, ks, vs, kw, vw, gates,
                  cmp_pe_k, cmp_w1_k, cmp_b1_k, cmp_w2_k,
                  cmp_pe_v, cmp_w1_v, cmp_b1_v, cmp_w2_v):
    B, S, G, R, dk = q.shape
    scale = dk ** -0.5
    k_cmp = compress_tokens(kc, cmp_pe_k, cmp_w1_k, cmp_b1_k, cmp_w2_k)
    v_cmp = compress_tokens(vc, cmp_pe_v, cmp_w1_v, cmp_b1_v, cmp_w2_v)
    n_cmp = k_cmp.shape[1]
    n_slc = S // SLC_BLOCK
    n_sel = min(SLC_TOPN, n_slc)
    n_qblk = S // Q_BLOCK

    k_blocks = ks.reshape(B, n_slc, SLC_BLOCK, G, dk).transpose(0, 3, 1, 2, 4)
    v_blocks = vs.reshape(B, n_slc, SLC_BLOCK, G, dk).transpose(0, 3, 1, 2, 4)
    pad = ((0, 0), (WINDOW, 0), (0, 0), (0, 0))
    kw_pad = jnp.pad(kw, pad)
    vw_pad = jnp.pad(vw, pad)

    c_start = jnp.arange(n_cmp) * CMP_STRIDE
    j_start = jnp.arange(n_slc) * SLC_BLOCK
    ov = jnp.clip(jnp.minimum(c_start[:, None] + CMP_BLOCK, j_start[None, :] + SLC_BLOCK)
                  - jnp.maximum(c_start[:, None], j_start[None, :]), 0, None)
    overlap = ov.astype(jnp.float32) / CMP_BLOCK
    cmp_end = c_start + CMP_BLOCK - 1
    blk = jnp.arange(n_slc)
    b_ix = jnp.arange(B)[:, None, None, None]
    g_ix = jnp.arange(G)[None, :, None, None]

    def one_block(i):
        q0 = i * Q_BLOCK
        qb = lax.dynamic_slice_in_dim(q, q0, Q_BLOCK, axis=1)
        gb = lax.dynamic_slice_in_dim(gates, q0, Q_BLOCK, axis=1)
        t = q0 + jnp.arange(Q_BLOCK)

        s_c = jnp.einsum('bqgrd,bcgd->bgrqc', qb, k_cmp) * scale
        mask_c = cmp_end[None, :] <= t[:, None]
        p_c = masked_softmax(s_c, mask_c)
        o_c = jnp.einsum('bgrqc,bcgd->bqgrd', p_c.astype(v_cmp.dtype), v_cmp)

        imp = jnp.einsum('bgrqc,cj->bgqj', p_c, overlap)
        allowed = blk[None, :] * SLC_BLOCK <= t[:, None]
        cur = (t // SLC_BLOCK)[:, None]
        forced = (blk[None, :] == 0) | (blk[None, :] == cur) | (blk[None, :] == cur - 1)
        score = jnp.where(forced & allowed, FORCE_BONUS, jnp.where(allowed, imp, NEG_INF))
        top_score, idx = lax.top_k(score, n_sel)
        valid_blk = top_score > 0.5 * NEG_INF

        kb = k_blocks[b_ix, g_ix, idx]
        vb = v_blocks[b_ix, g_ix, idx]
        n_tok = n_sel * SLC_BLOCK
        s_s = jnp.einsum('bqgrd,bgqnkd->bgrqnk', qb, kb) * scale
        tok_pos = idx[..., None] * SLC_BLOCK + jnp.arange(SLC_BLOCK)
        mask_s = valid_blk[..., None] & (tok_pos <= t[None, None, :, None, None])
        p_s = masked_softmax(s_s.reshape(B, G, R, Q_BLOCK, n_tok),
                             mask_s.reshape(B, G, 1, Q_BLOCK, n_tok))
        o_s = jnp.einsum('bgrqm,bgqmd->bqgrd', p_s.astype(vb.dtype),
                         vb.reshape(B, G, Q_BLOCK, n_tok, dk))

        kwb = lax.dynamic_slice_in_dim(kw_pad, q0, Q_BLOCK + WINDOW, axis=1)
        vwb = lax.dynamic_slice_in_dim(vw_pad, q0, Q_BLOCK + WINDOW, axis=1)
        s_pos = q0 - WINDOW + jnp.arange(Q_BLOCK + WINDOW)
        diff = t[:, None] - s_pos[None, :]
        mask_w = (s_pos >= 0)[None, :] & (diff >= 0) & (diff < WINDOW)
        s_w = jnp.einsum('bqgrd,bkgd->bgrqk', qb, kwb) * scale
        p_w = masked_softmax(s_w, mask_w)
        o_w = jnp.einsum('bgrqk,bkgd->bqgrd', p_w.astype(vwb.dtype), vwb)

        return gb[..., 0:1] * o_c + gb[..., 1:2] * o_s + gb[..., 2:3] * o_w

    out = lax.map(one_block, jnp.arange(n_qblk))
    return out.transpose(1, 0, 2, 3, 4, 5).reshape(B, S, G * R * dk)


def chunked_gmlp(u_raw, v_raw, ln_g, ln_b, ws, bs):
    B, S, W = u_raw.shape
    u = gelu(u_raw)
    v = gelu(v_raw).astype(jnp.float32)
    mu = jnp.mean(v, axis=-1, keepdims=True)
    var = jnp.mean(jnp.square(v - mu), axis=-1, keepdims=True)
    v = ((v - mu) * lax.rsqrt(var + NORM_EPS) * ln_g + ln_b).astype(u.dtype)
    v = v.reshape(B, S // GMLP_CHUNK, GMLP_CHUNK, GMLP_GROUPS, GMLP_GROUP_DIM)
    causal = jnp.tril(jnp.ones((GMLP_CHUNK, GMLP_CHUNK), dtype=ws.dtype))
    s = jnp.einsum('gts,bcsgd->bctgd', ws * causal, v) + bs.T[None, None, :, :, None]
    return u * s.reshape(B, S, W)


def memory_cross_attention(hn, mn, w_xq, w_xkv, w_xo):
    B, S, D = hn.shape
    M = mn.shape[1]
    q = (hn @ w_xq).reshape(B, S, XATTN_HEADS, XATTN_HEAD_DIM)
    k, v = jnp.split(mn @ w_xkv, 2, axis=-1)
    k = k.reshape(B, M, XATTN_HEADS, XATTN_HEAD_DIM)
    v = v.reshape(B, M, XATTN_HEADS, XATTN_HEAD_DIM)
    s = jnp.einsum('bshd,bmhd->bhsm', q, k) * (XATTN_HEAD_DIM ** -0.5)
    p = jax.nn.softmax(s.astype(jnp.float32), axis=-1).astype(v.dtype)
    o = jnp.einsum('bhsm,bmhd->bshd', p, v).reshape(B, S, D)
    return o @ w_xo


def peer_ffn(hn, w_peer_q, sub_keys, peer_u, peer_v):
    B, S, D = hn.shape
    q = (hn @ w_peer_q).reshape(B, S, PEER_HEADS, 2, PEER_HALF)
    sc = jnp.einsum('bshpd,hpkd->bshpk', q, sub_keys).astype(jnp.float32)
    half_s, half_i = lax.top_k(sc, PEER_TOPK)
    cand_s = half_s[..., 0, :, None] + half_s[..., 1, None, :]
    cand_i = half_i[..., 0, :, None] * PEER_KEYS + half_i[..., 1, None, :]
    cand_s = cand_s.reshape(B, S, PEER_HEADS, PEER_TOPK * PEER_TOPK)
    cand_i = cand_i.reshape(B, S, PEER_HEADS, PEER_TOPK * PEER_TOPK)
    best_s, pos = lax.top_k(cand_s, PEER_TOPK)
    expert = jnp.take_along_axis(cand_i, pos, axis=-1)
    gate = jax.nn.softmax(best_s, axis=-1).astype(hn.dtype)

    n_e = PEER_HEADS * PEER_TOPK
    n_chunk = S // PEER_TOKEN_CHUNK
    def to_chunks(a):
        return jnp.moveaxis(a.reshape(B, n_chunk, PEER_TOKEN_CHUNK, *a.shape[2:]), 1, 0)
    xs = to_chunks(hn)
    es = to_chunks(expert.reshape(B, S, n_e))
    gs = to_chunks(gate.reshape(B, S, n_e))

    def one_chunk(args):
        xc, ec, gc = args
        u = peer_u[ec]
        a = gelu(jnp.einsum('btd,bted->bte', xc, u))
        return jnp.einsum('bte,bted->btd', gc * a, peer_v[ec])

    out = lax.map(one_chunk, (xs, es, gs))
    return jnp.moveaxis(out, 0, 1).reshape(B, S, D)


def setup_inputs(seed: int = 0) -> dict:
    key = jax.random.key(seed)
    ks = jax.random.split(key, 32)
    f32 = jnp.float32
    D = D_MODEL
    dk = NSA_HEAD_DIM

    def nrm(k, shape, scale):
        return jax.random.normal(k, shape, f32) * scale

    def gain(k, n):
        return 1.0 + 0.02 * jax.random.normal(k, (n,), f32)

    return {
        "x": nrm(ks[0], (BATCH, SEQ, D), 1.0),
        "mem": nrm(ks[1], (BATCH, MEM_LEN, D), 1.0),
        "g_mix": gain(ks[2], D),
        "w_in": nrm(ks[3], (D, IN_PROJ_WIDTH), D ** -0.5),
        "cmp_pe_k": nrm(ks[4], (CMP_BLOCK, dk), 0.02),
        "cmp_w1_k": nrm(ks[5], (CMP_BLOCK * dk, CMP_HIDDEN), (CMP_BLOCK * dk) ** -0.5),
        "cmp_b1_k": nrm(ks[6], (CMP_HIDDEN,), 0.01),
        "cmp_w2_k": nrm(ks[7], (CMP_HIDDEN, dk), CMP_HIDDEN ** -0.5),
        "cmp_pe_v": nrm(ks[8], (CMP_BLOCK, dk), 0.02),
        "cmp_w1_v": nrm(ks[9], (CMP_BLOCK * dk, CMP_HIDDEN), (CMP_BLOCK * dk) ** -0.5),
        "cmp_b1_v": nrm(ks[10], (CMP_HIDDEN,), 0.01),
        "cmp_w2_v": nrm(ks[11], (CMP_HIDDEN, dk), CMP_HIDDEN ** -0.5),
        "gmlp_ln_g": gain(ks[12], GMLP_WIDTH),
        "gmlp_ln_b": nrm(ks[13], (GMLP_WIDTH,), 0.01),
        "gmlp_ws": nrm(ks[14], (GMLP_GROUPS, GMLP_CHUNK, GMLP_CHUNK), GMLP_CHUNK ** -0.5),
        "gmlp_bs": 1.0 + 0.1 * jax.random.normal(ks[15], (GMLP_GROUPS, GMLP_CHUNK), f32),
        "w_nsa_out": nrm(ks[16], (NSA_WIDTH, D), NSA_WIDTH ** -0.5),
        "w_gmlp_out": nrm(ks[17], (GMLP_WIDTH, D), GMLP_WIDTH ** -0.5),
        "w_mix_out": nrm(ks[18], (D, D), D ** -0.5),
        "g_xattn": gain(ks[19], D),
        "g_mem": gain(ks[20], D),
        "w_xq": nrm(ks[21], (D, D), D ** -0.5),
        "w_xkv": nrm(ks[22], (D, 2 * D), D ** -0.5),
        "w_xo": nrm(ks[23], (D, D), D ** -0.5),
        "g_peer": gain(ks[24], D),
        "w_peer_q": nrm(ks[25], (D, PEER_HEADS * PEER_QUERY_DIM), D ** -0.5),
        "peer_sub_keys": nrm(ks[26], (PEER_HEADS, 2, PEER_KEYS, PEER_HALF), PEER_HALF ** -0.5),
        "peer_u": nrm(ks[27], (PEER_EXPERTS, D), D ** -0.5),
        "peer_v": nrm(ks[28], (PEER_EXPERTS, D), (PEER_HEADS * PEER_TOPK) ** -0.5),
        "g_final": gain(ks[29], D),
    }


def reference(x, mem, g_mix, w_in,
              cmp_pe_k, cmp_w1_k, cmp_b1_k, cmp_w2_k,
              cmp_pe_v, cmp_w1_v, cmp_b1_v, cmp_w2_v,
              gmlp_ln_g, gmlp_ln_b, gmlp_ws, gmlp_bs,
              w_nsa_out, w_gmlp_out, w_mix_out,
              g_xattn, g_mem, w_xq, w_xkv, w_xo,
              g_peer, w_peer_q, peer_sub_keys, peer_u, peer_v,
              g_final):
    B, S, D = x.shape
    G, R, dk = NSA_KV_GROUPS, NSA_HEADS_PER_GROUP, NSA_HEAD_DIM
    split_points = [int(p) for p in np.cumsum(IN_SPLITS)[:-1]]
    h = x
    for _ in range(DEPTH):
        hn = rms_norm(h, g_mix)
        proj = hn @ w_in
        (q, kc, vc, ks_, vs_, kw, vw, nsa_gate_raw,
         u_raw, v_raw, merge_raw) = jnp.split(proj, split_points, axis=-1)
        q = q.reshape(B, S, G, R, dk)
        kc, vc, ks_, vs_, kw, vw = [a.reshape(B, S, G, dk) for a in (kc, vc, ks_, vs_, kw, vw)]
        nsa_gates = jax.nn.sigmoid(nsa_gate_raw).reshape(B, S, G, R, 3)
        o_nsa = nsa_attention(q, kc, vc, ks_, vs_, kw, vw, nsa_gates,
                              cmp_pe_k, cmp_w1_k, cmp_b1_k, cmp_w2_k,
                              cmp_pe_v, cmp_w1_v, cmp_b1_v, cmp_w2_v)
        o_gmlp = chunked_gmlp(u_raw, v_raw, gmlp_ln_g, gmlp_ln_b, gmlp_ws, gmlp_bs)
        mg = jax.nn.sigmoid(merge_raw).reshape(B, S, N_BRANCHES, D)
        y = mg[:, :, 0] * (o_nsa @ w_nsa_out) + mg[:, :, 1] * (o_gmlp @ w_gmlp_out)
        h = h + y @ w_mix_out
        h = h + memory_cross_attention(rms_norm(h, g_xattn), rms_norm(mem, g_mem),
                                       w_xq, w_xkv, w_xo)
        h = h + peer_ffn(rms_norm(h, g_peer), w_peer_q, peer_sub_keys, peer_u, peer_v)
    return rms_norm(h, g_final)
```

```cpp
#include <hip/hip_runtime.h>
#include <hip/hip_cooperative_groups.h>
#include <cstdio>
#include <cstdint>
namespace cg = cooperative_groups;

typedef unsigned short bf16_t;
typedef short bf16x8 __attribute__((ext_vector_type(8)));
typedef float f32x4 __attribute__((ext_vector_type(4)));
#define DEVI __device__ __forceinline__

constexpr int NTHREADS = 512;
constexpr int LDS_BYTES = 140 * 1024;

constexpr size_t O_BAR  = 0;
constexpr size_t O_WIN  = 16384;
constexpr size_t O_W1K  = O_WIN  + 4480ull * 1024 * 2;
constexpr size_t O_W1V  = O_W1K  + 256ull * 2048 * 2;
constexpr size_t O_WNSA = O_W1V  + 256ull * 2048 * 2;
constexpr size_t O_WGM  = O_WNSA + 1024ull * 512 * 2;
constexpr size_t O_WMIX = O_WGM  + 1024ull * 512 * 2;
constexpr size_t O_WXQ  = O_WMIX + 1024ull * 1024 * 2;
constexpr size_t O_WXKV = O_WXQ  + 1024ull * 1024 * 2;
constexpr size_t O_WXO  = O_WXKV + 2048ull * 1024 * 2;
constexpr size_t O_WPQ  = O_WXO  + 1024ull * 1024 * 2;
constexpr size_t O_B1   = O_WPQ  + 2048ull * 1024 * 2;
constexpr size_t O_HN   = O_B1   + 2048;
constexpr size_t O_MN   = O_HN   + 16384ull * 1024 * 2;
constexpr size_t O_KVX  = O_MN   + 512ull * 1024 * 2;
constexpr size_t O_GATES= O_KVX  + 512ull * 2048 * 2;
constexpr size_t O_HID  = O_GATES+ 16384ull * 24 * 4;
constexpr size_t O_CMP  = O_HID  + 2ull * 2048 * 256 * 4;
constexpr size_t O_Q    = O_CMP  + 2ull * 4 * 512 * 64 * 4;
constexpr size_t O_KV6  = O_Q    + 16384ull * 512 * 2;
constexpr size_t O_U    = O_KV6  + 6ull * 16384 * 128 * 2;
constexpr size_t O_VG   = O_U    + 16384ull * 512 * 2;
constexpr size_t O_MG   = O_VG   + 16384ull * 512 * 2;
constexpr size_t O_ONSA = O_MG   + 16384ull * 2048 * 2;
constexpr size_t O_OGM  = O_ONSA + 16384ull * 512 * 2;
constexpr size_t O_END  = O_OGM  + 16384ull * 512 * 2;
constexpr size_t O_Y    = O_Q;
constexpr size_t O_QX   = O_U;
constexpr size_t O_OX   = O_ONSA;
constexpr size_t O_QP   = O_MG;
constexpr size_t O_HS   = O_Q;
constexpr size_t O_HI   = O_Q + 16384ull * 256 * 4;
constexpr size_t O_EX   = O_U;
static_assert(O_END <= 256ull * 1024 * 1024, "workspace too large");

struct Params {
    const float *x, *mem, *g_mix, *w_in, *pe_k, *w1_k, *b1_k, *w2_k, *pe_v, *w1_v, *b1_v, *w2_v, *ln_g, *ln_b, *gws, *gbs,
        *w_nsa_out, *w_gmlp_out, *w_mix_out, *g_xattn, *g_mem, *w_xq, *w_xkv, *w_xo, *g_peer, *w_peer_q, *sub_keys, *peer_u, *peer_v, *g_final;
    float* out;
    unsigned char* ws;
};

DEVI bf16_t f2bf(float f) { unsigned u = __float_as_uint(f); u += 0x7fffu + ((u >> 16) & 1u); return (bf16_t)(u >> 16); }
DEVI float bf2f(bf16_t h) { return __uint_as_float(((unsigned)h) << 16); }
DEVI float tof(float v) { return v; }
DEVI float tof(bf16_t v) { return bf2f(v); }
DEVI float wave_sum(float v) { for (int o = 32; o > 0; o >>= 1) v += __shfl_xor(v, o); return v; }
DEVI float wave_max(float v) { for (int o = 32; o > 0; o >>= 1) v = fmaxf(v, __shfl_xor(v, o)); return v; }
DEVI float gelu_f(float x) { return 0.5f * x * (1.0f + erff(x * 0.70710678118654752f)); }
DEVI float sigmoid_f(float x) { return 1.0f / (1.0f + expf(-x)); }
DEVI void wave_argmax(float& v, int& idx) {
    for (int o = 32; o > 0; o >>= 1) {
        const float ov = __shfl_xor(v, o); const int oi = __shfl_xor(idx, o);
        const bool take = (ov > v) || (ov == v && oi < idx);
        v = take ? ov : v; idx = take ? oi : idx;
    }
}
DEVI void lds_fence() { asm volatile("s_waitcnt lgkmcnt(0)" ::: "memory"); }
DEVI void load8(const float* p, float (&f)[8]) { const float4 a = *(const float4*)p, b = *(const float4*)(p + 4); f[0]=a.x; f[1]=a.y; f[2]=a.z; f[3]=a.w; f[4]=b.x; f[5]=b.y; f[6]=b.z; f[7]=b.w; }
DEVI void load8(const bf16_t* p, float (&f)[8]) { const uint4 a = *(const uint4*)p;
    f[0] = __uint_as_float(a.x << 16); f[1] = __uint_as_float(a.x & 0xffff0000u); f[2] = __uint_as_float(a.y << 16); f[3] = __uint_as_float(a.y & 0xffff0000u);
    f[4] = __uint_as_float(a.z << 16); f[5] = __uint_as_float(a.z & 0xffff0000u); f[6] = __uint_as_float(a.w << 16); f[7] = __uint_as_float(a.w & 0xffff0000u); }

template <class CMap>
DEVI void transpose_tile(const float* src, int srcN, bf16_t* dst, int K, int tl, CMap cmap, float* tile) {
    const int nkt = K / 64, kt = tl % nkt, nt = tl / nkt, k0 = kt * 64, n0 = nt * 64;
    const int tx = threadIdx.x & 63, ty = threadIdx.x >> 6;
    const int sc = cmap(n0 + tx);
#pragma unroll
    for (int i = 0; i < 8; ++i) { const int k = k0 + ty + 8 * i; tile[(ty + 8 * i) * 65 + tx] = sc >= 0 ? src[(size_t)k * srcN + sc] : 0.f; }
    __syncthreads();
#pragma unroll
    for (int i = 0; i < 8; ++i) { const int n = n0 + ty + 8 * i; dst[(size_t)n * K + k0 + tx] = f2bf(tile[tx * 65 + ty + 8 * i]); }
    __syncthreads();
}
struct IdMap { DEVI int operator()(int n) const { return n; } };
struct WinMap { DEVI int operator()(int n) const { return n < 1280 ? n : (n < 4352 ? n + 24 : (n < 4376 ? n - 4352 + 1280 : -1)); } };

DEVI void rmsnorm_row_bf16(const float* xrow, const float* g, bf16_t* dst, int lane) {
    float4 v[4]; float ss = 0.f;
#pragma unroll
    for (int i = 0; i < 4; ++i) { v[i] = ((const float4*)xrow)[lane + 64 * i]; ss += v[i].x * v[i].x + v[i].y * v[i].y + v[i].z * v[i].z + v[i].w * v[i].w; }
    ss = wave_sum(ss);
    const float r = rsqrtf(ss * (1.0f / 1024.0f) + 1e-6f);
#pragma unroll
    for (int i = 0; i < 4; ++i) {
        const float4 gg = ((const float4*)g)[lane + 64 * i];
        uint2 w; w.x = (unsigned)f2bf(v[i].x * r * gg.x) | ((unsigned)f2bf(v[i].y * r * gg.y) << 16); w.y = (unsigned)f2bf(v[i].z * r * gg.z) | ((unsigned)f2bf(v[i].w * r * gg.w) << 16);
        ((uint2*)dst)[lane + 64 * i] = w;
    }
}

constexpr int G_LD = 72;
template <class AF>
DEVI void gemm_tile(f32x4 (&acc)[4][2], AF af, int m0, const bf16_t* Bt, int ldb, int K, bf16_t* As, bf16_t* Bs) {
    const int tid = threadIdx.x, lane = tid & 63, wave = tid >> 6, wm = wave >> 2, wn = wave & 3;
    const int r0 = tid >> 3, kc = (tid & 7) * 8;
    uint4 ra0, ra1, rb0, rb1;
    ra0 = *(const uint4*)af(m0 + r0, kc); ra1 = *(const uint4*)af(m0 + r0 + 64, kc);
    rb0 = *(const uint4*)(Bt + (size_t)r0 * ldb + kc); rb1 = *(const uint4*)(Bt + (size_t)(r0 + 64) * ldb + kc);
    for (int k0 = 0; k0 < K; k0 += 64) {
        __syncthreads();
        *(uint4*)(As + r0 * G_LD + kc) = ra0; *(uint4*)(As + (r0 + 64) * G_LD + kc) = ra1;
        *(uint4*)(Bs + r0 * G_LD + kc) = rb0; *(uint4*)(Bs + (r0 + 64) * G_LD + kc) = rb1;
        __syncthreads();
        if (k0 + 64 < K) {
            const int kn = k0 + 64 + kc;
            ra0 = *(const uint4*)af(m0 + r0, kn); ra1 = *(const uint4*)af(m0 + r0 + 64, kn);
            rb0 = *(const uint4*)(Bt + (size_t)r0 * ldb + kn); rb1 = *(const uint4*)(Bt + (size_t)(r0 + 64) * ldb + kn);
        }
#pragma unroll
        for (int ks = 0; ks < 2; ++ks) {
            bf16x8 af_[4], bf_[2];
#pragma unroll
            for (int i = 0; i < 4; ++i) af_[i] = *(const bf16x8*)(As + (wm * 64 + i * 16 + (lane & 15)) * G_LD + ks * 32 + (lane >> 4) * 8);
#pragma unroll
            for (int j = 0; j < 2; ++j) bf_[j] = *(const bf16x8*)(Bs + (wn * 32 + j * 16 + (lane & 15)) * G_LD + ks * 32 + (lane >> 4) * 8);
#pragma unroll
            for (int i = 0; i < 4; ++i)
#pragma unroll
                for (int j = 0; j < 2; ++j) acc[i][j] = __builtin_amdgcn_mfma_f32_16x16x32_bf16(bf_[j], af_[i], acc[i][j], 0, 0, 0);
        }
    }
}
struct RowMajorA { const bf16_t* A; int lda; DEVI const bf16_t* operator()(int row, int k) const { return A + (size_t)row * lda + k; } };
struct CmpA { const bf16_t* KC;
    DEVI const bf16_t* operator()(int row, int k) const { const int rr = row < 2044 ? row : 2043; const int b = rr / 1022, rem = rr - b * 1022, c = rem >> 1, g = rem & 1;
        return KC + ((size_t)(b * 8192 + 16 * c + (k >> 6)) * 128 + g * 64 + (k & 63)); } };

template <class AF, class Epi>
DEVI void gemm_run(AF af, const bf16_t* Bt, int K, int MT, int NT, Epi epi, unsigned char* smem, int bid, int nb) {
    bf16_t* As = (bf16_t*)smem; bf16_t* Bs = As + 128 * G_LD;
    const int lane = threadIdx.x & 63, wave = threadIdx.x >> 6, wm = wave >> 2, wn = wave & 3;
    for (int t = bid; t < MT * NT; t += nb) {
        const int mt = t / NT, nt = t % NT;
        f32x4 acc[4][2];
#pragma unroll
        for (int i = 0; i < 4; ++i)
#pragma unroll
            for (int j = 0; j < 2; ++j) acc[i][j] = (f32x4){0.f, 0.f, 0.f, 0.f};
        gemm_tile(acc, af, mt * 128, Bt + (size_t)nt * 128 * K, K, K, As, Bs);
#pragma unroll
        for (int i = 0; i < 4; ++i)
#pragma unroll
            for (int j = 0; j < 2; ++j) epi(mt * 128 + wm * 64 + i * 16 + (lane & 15), nt * 128 + wn * 32 + j * 16 + (lane >> 4) * 4, acc[i][j]);
    }
}
DEVI void store_bf16x4(bf16_t* p, float a, float b, float c, float d) { uint2 w; w.x = (unsigned)f2bf(a) | ((unsigned)f2bf(b) << 16); w.y = (unsigned)f2bf(c) | ((unsigned)f2bf(d) << 16); *(uint2*)p = w; }

template <int DH, int R, int NCH, bool PSUM, typename KT, class RowF>
DEVI void attend(const float* qs, float* pl, float* psum, const KT* Kb, const KT* Vb, size_t stride, RowF rowf, float (&o)[R][DH / 64], int lane) {
    float m[R], l[R];
#pragma unroll
    for (int r = 0; r < R; ++r) { m[r] = -1e30f; l[r] = 0.f; }
#pragma unroll 1
    for (int i = 0; i < NCH; ++i) {
        bool valid; const long row = rowf(i, lane, valid);
        if (__ballot(valid) == 0ull) continue;
        const KT* kp = Kb + (size_t)row * stride;
        float a[R];
#pragma unroll
        for (int r = 0; r < R; ++r) a[r] = 0.f;
#pragma unroll 2
        for (int d0 = 0; d0 < DH; d0 += 8) {
            float kf[8]; load8(kp + d0, kf);
#pragma unroll
            for (int r = 0; r < R; ++r) {
                const float4 q0 = *(const float4*)(qs + r * DH + d0), q1 = *(const float4*)(qs + r * DH + d0 + 4);
                a[r] += kf[0] * q0.x + kf[1] * q0.y + kf[2] * q0.z + kf[3] * q0.w + kf[4] * q1.x + kf[5] * q1.y + kf[6] * q1.z + kf[7] * q1.w;
            }
        }
#pragma unroll
        for (int r = 0; r < R; ++r) {
            const float sv = valid ? a[r] : -1e30f;
            const float mn = fmaxf(m[r], wave_max(sv));
            const float pe = valid ? expf(sv - mn) : 0.f;
            l[r] = l[r] * expf(m[r] - mn) + wave_sum(pe);
            m[r] = mn;
        }
    }
    float inv[R];
#pragma unroll
    for (int r = 0; r < R; ++r) inv[r] = 1.0f / fmaxf(l[r], 1e-30f);
#pragma unroll 1
    for (int i = 0; i < NCH; ++i) {
        bool valid; const long row = rowf(i, lane, valid);
        const bool any = __ballot(valid) != 0ull;
        float a[R];
#pragma unroll
        for (int r = 0; r < R; ++r) a[r] = 0.f;
        if (any) {
            const KT* kp = Kb + (size_t)row * stride;
#pragma unroll 2
            for (int d0 = 0; d0 < DH; d0 += 8) {
                float kf[8]; load8(kp + d0, kf);
#pragma unroll
                for (int r = 0; r < R; ++r) {
                    const float4 q0 = *(const float4*)(qs + r * DH + d0), q1 = *(const float4*)(qs + r * DH + d0 + 4);
                    a[r] += kf[0] * q0.x + kf[1] * q0.y + kf[2] * q0.z + kf[3] * q0.w + kf[4] * q1.x + kf[5] * q1.y + kf[6] * q1.z + kf[7] * q1.w;
                }
            }
        }
        float ps = 0.f;
#pragma unroll
        for (int r = 0; r < R; ++r) { const float pv = valid ? expf(a[r] - m[r]) * inv[r] : 0.f; pl[r * 64 + lane] = pv; ps += pv; }
        if (PSUM) psum[i * 64 + lane] = ps;
        lds_fence();
        if (any) {
#pragma unroll 2
            for (int key = 0; key < 64; ++key) {
                bool dummy; const long vrow = rowf(i, key, dummy);
                const KT* vp = Vb + (size_t)vrow * stride;
                float pr[R];
#pragma unroll
                for (int r = 0; r < R; ++r) pr[r] = pl[r * 64 + key];
#pragma unroll
                for (int j = 0; j < DH / 64; ++j) { const float v = tof(vp[lane + 64 * j]);
#pragma unroll
                    for (int r = 0; r < R; ++r) o[r][j] += pr[r] * v; }
            }
        }
        lds_fence();
    }
}

__global__ void __launch_bounds__(NTHREADS) fwd_mega(Params p) {
    extern __shared__ __attribute__((aligned(16))) unsigned char smem[];
    cg::grid_group grid = cg::this_grid();
    const int bid = blockIdx.x, nb = gridDim.x, tid = threadIdx.x, lane = tid & 63, wave = tid >> 6;
    unsigned char* ws = p.ws;
    bf16_t* WIN = (bf16_t*)(ws + O_WIN); bf16_t* W1K = (bf16_t*)(ws + O_W1K); bf16_t* W1V = (bf16_t*)(ws + O_W1V);
    bf16_t* WNSA = (bf16_t*)(ws + O_WNSA); bf16_t* WGM = (bf16_t*)(ws + O_WGM); bf16_t* WMIX = (bf16_t*)(ws + O_WMIX);
    bf16_t* WXQ = (bf16_t*)(ws + O_WXQ); bf16_t* WXKV = (bf16_t*)(ws + O_WXKV); bf16_t* WXO = (bf16_t*)(ws + O_WXO); bf16_t* WPQ = (bf16_t*)(ws + O_WPQ);
    float* B1F = (float*)(ws + O_B1);
    bf16_t* HN = (bf16_t*)(ws + O_HN); bf16_t* MN = (bf16_t*)(ws + O_MN); bf16_t* KVX = (bf16_t*)(ws + O_KVX);
    float* GATES = (float*)(ws + O_GATES); float* HID = (float*)(ws + O_HID); float* CMP = (float*)(ws + O_CMP);
    bf16_t* Q = (bf16_t*)(ws + O_Q); bf16_t* KV6 = (bf16_t*)(ws + O_KV6); bf16_t* U = (bf16_t*)(ws + O_U); bf16_t* VG = (bf16_t*)(ws + O_VG);
    bf16_t* MG = (bf16_t*)(ws + O_MG); bf16_t* ONSA = (bf16_t*)(ws + O_ONSA); bf16_t* OGM = (bf16_t*)(ws + O_OGM);
    bf16_t* Y = (bf16_t*)(ws + O_Y); bf16_t* QX = (bf16_t*)(ws + O_QX); bf16_t* OX = (bf16_t*)(ws + O_OX); bf16_t* QP = (bf16_t*)(ws + O_QP);
    float* HS = (float*)(ws + O_HS); int* HI = (int*)(ws + O_HI);
    float* OUT = p.out;

    {
        float* tile = (float*)smem;
        for (int j = bid; j < 3424; j += nb) {
            int t = j;
            if (t < 1120) { transpose_tile(p.w_in, 4376, WIN, 1024, t, WinMap(), tile); continue; } t -= 1120;
            if (t < 128) { transpose_tile(p.w1_k, 256, W1K, 2048, t, IdMap(), tile); continue; } t -= 128;
            if (t < 128) { transpose_tile(p.w1_v, 256, W1V, 2048, t, IdMap(), tile); continue; } t -= 128;
            if (t < 128) { transpose_tile(p.w_nsa_out, 1024, WNSA, 512, t, IdMap(), tile); continue; } t -= 128;
            if (t < 128) { transpose_tile(p.w_gmlp_out, 1024, WGM, 512, t, IdMap(), tile); continue; } t -= 128;
            if (t < 256) { transpose_tile(p.w_mix_out, 1024, WMIX, 1024, t, IdMap(), tile); continue; } t -= 256;
            if (t < 256) { transpose_tile(p.w_xq, 1024, WXQ, 1024, t, IdMap(), tile); continue; } t -= 256;
            if (t < 512) { transpose_tile(p.w_xkv, 2048, WXKV, 1024, t, IdMap(), tile); continue; } t -= 512;
            if (t < 256) { transpose_tile(p.w_xo, 1024, WXO, 1024, t, IdMap(), tile); continue; } t -= 256;
            transpose_tile(p.w_peer_q, 2048, WPQ, 1024, t, IdMap(), tile);
        }
        for (int r = bid * 8 + wave; r < 16384 + 512; r += nb * 8) {
            if (r < 16384) rmsnorm_row_bf16(p.x + (size_t)r * 1024, p.g_mix, HN + (size_t)r * 1024, lane);
            else rmsnorm_row_bf16(p.mem + (size_t)(r - 16384) * 1024, p.g_mem, MN + (size_t)(r - 16384) * 1024, lane);
        }
        if (bid == nb - 1) {
            const int kv = tid >> 8, n = tid & 255;
            const float* pe = kv ? p.pe_v : p.pe_k; const float* w1 = kv ? p.w1_v : p.w1_k; const float* b1 = kv ? p.b1_v : p.b1_k;
            float a = b1[n];
            for (int k = 0; k < 2048; ++k) a += pe[k] * w1[(size_t)k * 256 + n];
            B1F[kv * 256 + n] = a;
        }
    }
    grid.sync();

    {
        auto epi = [&](int r, int c, const f32x4& v) {
            if (c < 512) store_bf16x4(Q + (size_t)r * 512 + c, v[0] * 0.125f, v[1] * 0.125f, v[2] * 0.125f, v[3] * 0.125f);
            else if (c < 1280) { const int w = (c - 512) >> 7, cc = (c - 512) & 127; store_bf16x4(KV6 + ((size_t)w * 16384 + r) * 128 + cc, v[0], v[1], v[2], v[3]); }
            else if (c < 1792) store_bf16x4(U + (size_t)r * 512 + (c - 1280), gelu_f(v[0]), gelu_f(v[1]), gelu_f(v[2]), gelu_f(v[3]));
            else if (c < 2304) store_bf16x4(VG + (size_t)r * 512 + (c - 1792), gelu_f(v[0]), gelu_f(v[1]), gelu_f(v[2]), gelu_f(v[3]));
            else if (c < 4352) store_bf16x4(MG + (size_t)r * 2048 + (c - 2304), sigmoid_f(v[0]), sigmoid_f(v[1]), sigmoid_f(v[2]), sigmoid_f(v[3]));
            else if (c < 4376) { float* gp = GATES + (size_t)r * 24 + (c - 4352); gp[0] = sigmoid_f(v[0]); gp[1] = sigmoid_f(v[1]); gp[2] = sigmoid_f(v[2]); gp[3] = sigmoid_f(v[3]); }
        };
        gemm_run(RowMajorA{HN, 1024}, WIN, 1024, 128, 35, epi, smem, bid, nb);
        auto epi2 = [&](int r, int c, const f32x4& v) { store_bf16x4(KVX + (size_t)r * 2048 + c, v[0], v[1], v[2], v[3]); };
        gemm_run(RowMajorA{MN, 1024}, WXKV, 1024, 4, 16, epi2, smem, bid, nb);
    }
    grid.sync();

    {
        for (int task = bid; task < 192; task += nb) {
            if (task < 64) {
                const int kv = task >> 5, t = task & 31, mt = t >> 1, nt = t & 1;
                bf16_t* As = (bf16_t*)smem; bf16_t* Bs = As + 128 * G_LD;
                const int wm = wave >> 2, wn = wave & 3;
                f32x4 acc[4][2];
#pragma unroll
                for (int i = 0; i < 4; ++i)
#pragma unroll
                    for (int j = 0; j < 2; ++j) acc[i][j] = (f32x4){0.f, 0.f, 0.f, 0.f};
                gemm_tile(acc, CmpA{KV6 + (size_t)kv * 16384 * 128}, mt * 128, (kv ? W1V : W1K) + (size_t)nt * 128 * 2048, 2048, 2048, As, Bs);
#pragma unroll
                for (int i = 0; i < 4; ++i)
#pragma unroll
                    for (int j = 0; j < 2; ++j) {
                        const int r = mt * 128 + wm * 64 + i * 16 + (lane & 15), c = nt * 128 + wn * 32 + j * 16 + (lane >> 4) * 4;
                        if (r < 2044) { float* hp = HID + ((size_t)kv * 2048 + r) * 256 + c; const float* bb = B1F + kv * 256 + c;
                            hp[0] = gelu_f(acc[i][j][0] + bb[0]); hp[1] = gelu_f(acc[i][j][1] + bb[1]); hp[2] = gelu_f(acc[i][j][2] + bb[2]); hp[3] = gelu_f(acc[i][j][3] + bb[3]); }
                    }
                __syncthreads();
            } else {
                const int ch = task - 64;
                const size_t row0 = (size_t)ch * 128;
                float* vl = (float*)smem;
                float* wl = vl + 128 * 128;
                float* st = wl + 128 * 128;
                for (int r = wave; r < 128; r += 8) {
                    float f[8]; load8(VG + (row0 + r) * 512 + lane * 8, f);
                    float s1 = 0.f;
#pragma unroll
                    for (int e = 0; e < 8; ++e) s1 += f[e];
                    s1 = wave_sum(s1); const float mu = s1 * (1.0f / 512.0f);
                    float s2 = 0.f;
#pragma unroll
                    for (int e = 0; e < 8; ++e) s2 += (f[e] - mu) * (f[e] - mu);
                    s2 = wave_sum(s2);
                    if (lane == 0) { st[r * 2] = mu; st[r * 2 + 1] = rsqrtf(s2 * (1.0f / 512.0f) + 1e-6f); }
                }
                __syncthreads();
                for (int g = 0; g < 4; ++g) {
                    for (int idx = tid; idx < 128 * 128; idx += NTHREADS) {
                        const int s_ = idx >> 7, d = idx & 127, chn = g * 128 + d;
                        vl[idx] = (bf2f(VG[(row0 + s_) * 512 + chn]) - st[s_ * 2]) * st[s_ * 2 + 1] * p.ln_g[chn] + p.ln_b[chn];
                        wl[idx] = p.gws[(size_t)g * 16384 + idx];
                    }
                    __syncthreads();
                    const int d = tid & 127, tg = tid >> 7;
                    for (int i = 0; i < 32; ++i) {
                        const int t = tg + 4 * i;
                        float a = 0.f;
                        for (int s_ = 0; s_ <= t; ++s_) a += wl[t * 128 + s_] * vl[s_ * 128 + d];
                        a += p.gbs[g * 128 + t];
                        const size_t o = (row0 + t) * 512 + g * 128 + d;
                        OGM[o] = f2bf(bf2f(U[o]) * a);
                    }
                    __syncthreads();
                }
            }
        }
    }
    grid.sync();

    {
        for (int idx = bid * NTHREADS + tid; idx < 2 * 2044 * 64; idx += nb * NTHREADS) {
            const int kv = idx / (2044 * 64), rem = idx - kv * (2044 * 64), r = rem >> 6, n = rem & 63;
            const float* hp = HID + ((size_t)kv * 2048 + r) * 256; const float* w2 = kv ? p.w2_v : p.w2_k;
            float a = 0.f;
            for (int j = 0; j < 256; ++j) a += hp[j] * w2[j * 64 + n];
            const int b = r / 1022, rr = r - b * 1022, c = rr >> 1, g = rr & 1;
            CMP[(((size_t)kv * 4 + b * 2 + g) * 512 + c) * 64 + n] = a;
        }
    }
    grid.sync();

    {
        float* qs = (float*)smem + wave * 1024; float* pl = qs + 256; float* psum = qs + 512;
        const bf16_t* KS = KV6 + 2ull * 16384 * 128; const bf16_t* VS = KV6 + 3ull * 16384 * 128;
        const bf16_t* KW = KV6 + 4ull * 16384 * 128; const bf16_t* VW = KV6 + 5ull * 16384 * 128;
        for (int task = bid * 8 + wave; task < 32768; task += nb * 8) {
            const int g = task & 1, bt = task >> 1, b = bt >> 13, t = bt & 8191;
#pragma unroll
            for (int r = 0; r < 4; ++r) qs[r * 64 + lane] = bf2f(Q[(size_t)bt * 512 + g * 256 + r * 64 + lane]);
            lds_fence();
            const int ncv = t >= 31 ? ((t - 31) >> 4) + 1 : 0;
            float oc[4][1] = {{0.f}, {0.f}, {0.f}, {0.f}};
            {
                const float* Kc = CMP + ((size_t)0 * 4 + b * 2 + g) * 512 * 64; const float* Vc = CMP + ((size_t)1 * 4 + b * 2 + g) * 512 * 64;
                auto rowf = [&](int i, int key, bool& valid) -> long { const int c = i * 64 + key; valid = c < ncv; return c < 510 ? c : 510; };
                attend<64, 4, 8, true, float>(qs, pl, psum, Kc, Vc, 64, rowf, oc, lane);
            }
            const int cur = t >> 6;
            float sc0, sc1;
            {
                const int j0 = lane, j1 = lane + 64;
                const float4 a0 = *(const float4*)(psum + 4 * j0), a1 = *(const float4*)(psum + 4 * j1);
                const float pm0 = j0 > 0 ? psum[4 * j0 - 1] : 0.f, pm1 = psum[4 * j1 - 1];
                const float imp0 = a0.x + a0.y + a0.z + 0.5f * a0.w + 0.5f * pm0, imp1 = a1.x + a1.y + a1.z + 0.5f * a1.w + 0.5f * pm1;
                const bool al0 = j0 <= cur, al1 = j1 <= cur;
                const bool f0 = (j0 == 0) || (j0 == cur) || (j0 == cur - 1), f1 = (j1 == cur) || (j1 == cur - 1);
                sc0 = (f0 && al0) ? 1e4f : (al0 ? imp0 : -1e30f); sc1 = (f1 && al1) ? 1e4f : (al1 ? imp1 : -1e30f);
            }
            int* sidx = (int*)(qs + 1008); unsigned svalid = 0;
#pragma unroll
            for (int it = 0; it < 16; ++it) {
                float bv = sc0; int bi = lane;
                if (sc1 > bv) { bv = sc1; bi = lane + 64; }
                wave_argmax(bv, bi);
                if (lane == 0) sidx[it] = bi; if (bv > -0.5e30f) svalid |= 1u << it;
                if (bi == lane) sc0 = -INFINITY; if (bi == lane + 64) sc1 = -INFINITY;
            }
            float os[4][1] = {{0.f}, {0.f}, {0.f}, {0.f}};
            {
                auto rowf = [&](int i, int key, bool& valid) -> long { const int pos = sidx[i] * 64 + key; valid = ((svalid >> i) & 1u) && pos <= t; return pos; };
                attend<64, 4, 16, false, bf16_t>(qs, pl, psum, KS + (size_t)b * 8192 * 128 + g * 64, VS + (size_t)b * 8192 * 128 + g * 64, 128, rowf, os, lane);
            }
            float ow[4][1] = {{0.f}, {0.f}, {0.f}, {0.f}};
            {
                auto rowf = [&](int i, int key, bool& valid) -> long { const int pos = t - 511 + i * 64 + key; valid = pos >= 0; return pos >= 0 ? pos : 0; };
                attend<64, 4, 8, false, bf16_t>(qs, pl, psum, KW + (size_t)b * 8192 * 128 + g * 64, VW + (size_t)b * 8192 * 128 + g * 64, 128, rowf, ow, lane);
            }
#pragma unroll
            for (int r = 0; r < 4; ++r) {
                const float* gp = GATES + (size_t)bt * 24 + (g * 4 + r) * 3;
                ONSA[(size_t)bt * 512 + g * 256 + r * 64 + lane] = f2bf(gp[0] * oc[r][0] + gp[1] * os[r][0] + gp[2] * ow[r][0]);
            }
        }
    }
    grid.sync();

    {
        bf16_t* As = (bf16_t*)smem; bf16_t* Bs = As + 128 * G_LD;
        const int wm = wave >> 2, wn = wave & 3;
        for (int tl = bid; tl < 128 * 8; tl += nb) {
            const int mt = tl >> 3, nt = tl & 7;
            f32x4 a1[4][2], a2[4][2];
#pragma unroll
            for (int i = 0; i < 4; ++i)
#pragma unroll
                for (int j = 0; j < 2; ++j) { a1[i][j] = (f32x4){0.f, 0.f, 0.f, 0.f}; a2[i][j] = (f32x4){0.f, 0.f, 0.f, 0.f}; }
            gemm_tile(a1, RowMajorA{ONSA, 512}, mt * 128, WNSA + (size_t)nt * 128 * 512, 512, 512, As, Bs);
            gemm_tile(a2, RowMajorA{OGM, 512}, mt * 128, WGM + (size_t)nt * 128 * 512, 512, 512, As, Bs);
#pragma unroll
            for (int i = 0; i < 4; ++i)
#pragma unroll
                for (int j = 0; j < 2; ++j) {
                    const int r = mt * 128 + wm * 64 + i * 16 + (lane & 15), c = nt * 128 + wn * 32 + j * 16 + (lane >> 4) * 4;
                    float m0[8], m1[8];
                    const uint2 w0 = *(const uint2*)(MG + (size_t)r * 2048 + c), w1 = *(const uint2*)(MG + (size_t)r * 2048 + 1024 + c);
                    m0[0] = __uint_as_float(w0.x << 16); m0[1] = __uint_as_float(w0.x & 0xffff0000u); m0[2] = __uint_as_float(w0.y << 16); m0[3] = __uint_as_float(w0.y & 0xffff0000u);
                    m1[0] = __uint_as_float(w1.x << 16); m1[1] = __uint_as_float(w1.x & 0xffff0000u); m1[2] = __uint_as_float(w1.y << 16); m1[3] = __uint_as_float(w1.y & 0xffff0000u);
                    store_bf16x4(Y + (size_t)r * 1024 + c, m0[0] * a1[i][j][0] + m1[0] * a2[i][j][0], m0[1] * a1[i][j][1] + m1[1] * a2[i][j][1],
                                 m0[2] * a1[i][j][2] + m1[2] * a2[i][j][2], m0[3] * a1[i][j][3] + m1[3] * a2[i][j][3]);
                }
        }
    }
    grid.sync();

    {
        auto epi = [&](int r, int c, const f32x4& v) { const float4 xv = *(const float4*)(p.x + (size_t)r * 1024 + c);
            *(float4*)(OUT + (size_t)r * 1024 + c) = make_float4(xv.x + v[0], xv.y + v[1], xv.z + v[2], xv.w + v[3]); };
        gemm_run(RowMajorA{Y, 1024}, WMIX, 1024, 128, 8, epi, smem, bid, nb);
    }
    grid.sync();

    for (int r = bid * 8 + wave; r < 16384; r += nb * 8) rmsnorm_row_bf16(OUT + (size_t)r * 1024, p.g_xattn, HN + (size_t)r * 1024, lane);
    grid.sync();

    {
        auto epi = [&](int r, int c, const f32x4& v) { store_bf16x4(QX + (size_t)r * 1024 + c, v[0] * 0.0625f, v[1] * 0.0625f, v[2] * 0.0625f, v[3] * 0.0625f); };
        gemm_run(RowMajorA{HN, 1024}, WXQ, 1024, 128, 8, epi, smem, bid, nb);
    }
    grid.sync();

    {
        float* qs = (float*)smem + wave * 1024; float* pl = qs + 256;
        for (int task = bid * 8 + wave; task < 65536; task += nb * 8) {
            const int h = task & 3, bt = task >> 2, b = bt >> 13;
#pragma unroll
            for (int j = 0; j < 4; ++j) qs[lane + 64 * j] = bf2f(QX[(size_t)bt * 1024 + h * 256 + lane + 64 * j]);
            lds_fence();
            float o[1][4] = {{0.f, 0.f, 0.f, 0.f}};
            auto rowf = [&](int i, int key, bool& valid) -> long { valid = true; return i * 64 + key; };
            attend<256, 1, 4, false, bf16_t>(qs, pl, pl, KVX + (size_t)b * 256 * 2048 + h * 256, KVX + (size_t)b * 256 * 2048 + 1024 + h * 256, 2048, rowf, o, lane);
#pragma unroll
            for (int j = 0; j < 4; ++j) OX[(size_t)bt * 1024 + h * 256 + lane + 64 * j] = f2bf(o[0][j]);
        }
    }
    grid.sync();

    {
        auto epi = [&](int r, int c, const f32x4& v) { float4* hp = (float4*)(OUT + (size_t)r * 1024 + c); const float4 hv = *hp;
            *hp = make_float4(hv.x + v[0], hv.y + v[1], hv.z + v[2], hv.w + v[3]); };
        gemm_run(RowMajorA{OX, 1024}, WXO, 1024, 128, 8, epi, smem, bid, nb);
    }
    grid.sync();

    for (int r = bid * 8 + wave; r < 16384; r += nb * 8) rmsnorm_row_bf16(OUT + (size_t)r * 1024, p.g_peer, HN + (size_t)r * 1024, lane);
    grid.sync();

    {
        auto epi = [&](int r, int c, const f32x4& v) { store_bf16x4(QP + (size_t)r * 2048 + c, v[0], v[1], v[2], v[3]); };
        gemm_run(RowMajorA{HN, 1024}, WPQ, 1024, 128, 16, epi, smem, bid, nb);
    }
    grid.sync();

    {
        float* kl = (float*)smem;
        float* ql = kl + 128 * 129 + wave * 128;
        for (int task = bid; task < 4096; task += nb) {
            const int hp = task & 15, tg = task >> 4;
            const float* src = p.sub_keys + (size_t)hp * 16384;
            for (int idx = tid; idx < 16384; idx += NTHREADS) kl[(idx >> 7) * 129 + (idx & 127)] = src[idx];
            __syncthreads();
            for (int tt = 0; tt < 8; ++tt) {
                const int tok = tg * 64 + wave * 8 + tt;
                ql[lane] = bf2f(QP[(size_t)tok * 2048 + hp * 128 + lane]); ql[lane + 64] = bf2f(QP[(size_t)tok * 2048 + hp * 128 + 64 + lane]);
                lds_fence();
                float s0 = 0.f, s1 = 0.f;
                for (int d = 0; d < 128; ++d) { const float q = ql[d]; s0 += q * kl[lane * 129 + d]; s1 += q * kl[(lane + 64) * 129 + d]; }
                float myv = 0.f; int myi = 0;
#pragma unroll
                for (int it = 0; it < 16; ++it) {
                    float bv = s0; int bi = lane;
                    if (s1 > bv) { bv = s1; bi = lane + 64; }
                    wave_argmax(bv, bi);
                    if (lane == it) { myv = bv; myi = bi; }
                    if (bi == lane) s0 = -INFINITY; if (bi == lane + 64) s1 = -INFINITY;
                }
                if (lane < 16) { HS[(size_t)tok * 256 + hp * 16 + lane] = myv; HI[(size_t)tok * 256 + hp * 16 + lane] = myi; }
                lds_fence();
            }
            __syncthreads();
        }
    }
    grid.sync();

    {
        int* exl = (int*)smem + wave * 256; float* gtl = (float*)(exl + 128);
        for (int tok = bid * 8 + wave; tok < 16384; tok += nb * 8) {
#pragma unroll 1
            for (int h = 0; h < 8; ++h) {
                const float* s0p = HS + (size_t)tok * 256 + (2 * h) * 16; const float* s1p = s0p + 16;
                const float a = s0p[lane >> 2];
                const float4 bq = *(const float4*)(s1p + (lane & 3) * 4);
                float c0 = a + bq.x, c1 = a + bq.y, c2 = a + bq.z, c3 = a + bq.w;
                float myv = 0.f; int myf = 0; float vmax = 0.f;
#pragma unroll
                for (int it = 0; it < 16; ++it) {
                    float bv = c0; int bi = lane * 4;
                    if (c1 > bv) { bv = c1; bi = lane * 4 + 1; }
                    if (c2 > bv) { bv = c2; bi = lane * 4 + 2; }
                    if (c3 > bv) { bv = c3; bi = lane * 4 + 3; }
                    wave_argmax(bv, bi);
                    if (it == 0) vmax = bv;
                    if (lane == it) { myv = bv; myf = bi; }
                    if (bi == lane * 4) c0 = -INFINITY; if (bi == lane * 4 + 1) c1 = -INFINITY; if (bi == lane * 4 + 2) c2 = -INFINITY; if (bi == lane * 4 + 3) c3 = -INFINITY;
                }
                const float e = lane < 16 ? expf(myv - vmax) : 0.f;
                const float se = wave_sum(e);
                if (lane < 16) {
                    const int* i0p = HI + (size_t)tok * 256 + (2 * h) * 16;
                    exl[h * 16 + lane] = i0p[myf >> 4] * 128 + i0p[16 + (myf & 15)];
                    gtl[h * 16 + lane] = e / se;
                }
            }
            lds_fence();
            float4 xv[4];
#pragma unroll
            for (int i = 0; i < 4; ++i) { const uint2 w = *(const uint2*)(HN + (size_t)tok * 1024 + i * 256 + lane * 4);
                xv[i] = make_float4(__uint_as_float(w.x << 16), __uint_as_float(w.x & 0xffff0000u), __uint_as_float(w.y << 16), __uint_as_float(w.y & 0xffff0000u)); }
            for (int e0 = 0; e0 < 128; e0 += 4) {
                float dsum[4];
#pragma unroll
                for (int q = 0; q < 4; ++q) {
                    const float* ur = p.peer_u + (size_t)exl[e0 + q] * 1024 + lane * 4;
                    float d = 0.f;
#pragma unroll
                    for (int i = 0; i < 4; ++i) { const float4 uv = *(const float4*)(ur + i * 256); d += uv.x * xv[i].x + uv.y * xv[i].y + uv.z * xv[i].z + uv.w * xv[i].w; }
                    dsum[q] = d;
                }
#pragma unroll
                for (int q = 0; q < 4; ++q) { const float d = wave_sum(dsum[q]); if (lane == 0) gtl[e0 + q] = gtl[e0 + q] * gelu_f(d); }
            }
            lds_fence();
            float4 acc[4];
#pragma unroll
            for (int i = 0; i < 4; ++i) acc[i] = make_float4(0.f, 0.f, 0.f, 0.f);
            for (int e0 = 0; e0 < 128; e0 += 4) {
#pragma unroll
                for (int q = 0; q < 4; ++q) {
                    const float* vr = p.peer_v + (size_t)exl[e0 + q] * 1024 + lane * 4; const float cf = gtl[e0 + q];
#pragma unroll
                    for (int i = 0; i < 4; ++i) { const float4 vv = *(const float4*)(vr + i * 256); acc[i].x += cf * vv.x; acc[i].y += cf * vv.y; acc[i].z += cf * vv.z; acc[i].w += cf * vv.w; }
                }
            }
            float ss = 0.f;
#pragma unroll
            for (int i = 0; i < 4; ++i) { const float4 hv = *(const float4*)(OUT + (size_t)tok * 1024 + i * 256 + lane * 4);
                acc[i].x += hv.x; acc[i].y += hv.y; acc[i].z += hv.z; acc[i].w += hv.w;
                ss += acc[i].x * acc[i].x + acc[i].y * acc[i].y + acc[i].z * acc[i].z + acc[i].w * acc[i].w; }
            ss = wave_sum(ss);
            const float rr = rsqrtf(ss * (1.0f / 1024.0f) + 1e-6f);
#pragma unroll
            for (int i = 0; i < 4; ++i) { const float4 gg = *(const float4*)(p.g_final + i * 256 + lane * 4);
                *(float4*)(OUT + (size_t)tok * 1024 + i * 256 + lane * 4) = make_float4(acc[i].x * rr * gg.x, acc[i].y * rr * gg.y, acc[i].z * rr * gg.z, acc[i].w * rr * gg.w); }
            lds_fence();
        }
    }
}

extern "C" void kernel_launch(void* const* d_in, const int* in_sizes, int n_in, void* d_out, int out_size, void* d_ws, size_t ws_size, hipStream_t stream) {
    static int grid_blocks = 0;
    if (grid_blocks == 0) {
        int dev = 0, cus = 0, per_cu = 0;
        hipGetDevice(&dev);
        hipDeviceGetAttribute(&cus, hipDeviceAttributeMultiprocessorCount, dev);
        if (hipFuncSetAttribute((const void*)fwd_mega, hipFuncAttributeMaxDynamicSharedMemorySize, LDS_BYTES) != hipSuccess) { fprintf(stderr, "hipFuncSetAttribute failed\n"); }
        if (hipOccupancyMaxActiveBlocksPerMultiprocessor(&per_cu, (const void*)fwd_mega, NTHREADS, LDS_BYTES) != hipSuccess || per_cu < 1) { fprintf(stderr, "occupancy query failed (%d)\n", per_cu); per_cu = 1; }
        (void)hipGetLastError();
        if (per_cu > 1) per_cu = 1;
        grid_blocks = cus * per_cu;
        if (ws_size < O_END) { fprintf(stderr, "workspace too small: %zu < %zu\n", ws_size, (size_t)O_END); grid_blocks = -1; }
    }
    if (grid_blocks < 0) return;
    Params p{};
    const float** pp = (const float**)&p;
    for (int i = 0; i < 30; ++i) pp[i] = (const float*)d_in[i];
    p.out = (float*)d_out; p.ws = (unsigned char*)d_ws;
    void* args[] = {&p};
    hipError_t e = hipLaunchCooperativeKernel((const void*)fwd_mega, dim3(grid_blocks), dim3(NTHREADS), args, LDS_BYTES, stream);
    if (e != hipSuccess) fprintf(stderr, "cooperative launch failed: %s (grid %d)\n", hipGetErrorString(e), grid_blocks);
}
```

```cpp
#include <hip/hip_runtime.h>
#include <hip/hip_cooperative_groups.h>
#include <cstdio>
#include <cstdint>
namespace cg = cooperative_groups;

typedef unsigned short bf16_t;
typedef short bf16x8 __attribute__((ext_vector_type(8)));
typedef float f32x4 __attribute__((ext_vector_type(4)));
#define DEVI __device__ __forceinline__

constexpr int NTHREADS = 512;
constexpr int LDS_BYTES = 140 * 1024;

constexpr size_t O_BAR  = 0;
constexpr size_t O_WIN  = 16384;
constexpr size_t O_W1K  = O_WIN  + 4480ull * 1024 * 2;
constexpr size_t O_W1V  = O_W1K  + 256ull * 2048 * 2;
constexpr size_t O_WNSA = O_W1V  + 256ull * 2048 * 2;
constexpr size_t O_WGM  = O_WNSA + 1024ull * 512 * 2;
constexpr size_t O_WMIX = O_WGM  + 1024ull * 512 * 2;
constexpr size_t O_WXQ  = O_WMIX + 1024ull * 1024 * 2;
constexpr size_t O_WXKV = O_WXQ  + 1024ull * 1024 * 2;
constexpr size_t O_WXO  = O_WXKV + 2048ull * 1024 * 2;
constexpr size_t O_WPQ  = O_WXO  + 1024ull * 1024 * 2;
constexpr size_t O_B1   = O_WPQ  + 2048ull * 1024 * 2;
constexpr size_t O_HN   = O_B1   + 2048;
constexpr size_t O_MN   = O_HN   + 16384ull * 1024 * 2;
constexpr size_t O_KVX  = O_MN   + 512ull * 1024 * 2;
constexpr size_t O_GATES= O_KVX  + 512ull * 2048 * 2;
constexpr size_t O_HID  = O_GATES+ 16384ull * 24 * 4;
constexpr size_t O_CMP  = O_HID  + 2ull * 2048 * 256 * 4;
constexpr size_t O_Q    = O_CMP  + 2ull * 4 * 512 * 64 * 4;
constexpr size_t O_KV6  = O_Q    + 16384ull * 512 * 2;
constexpr size_t O_U    = O_KV6  + 6ull * 16384 * 128 * 2;
constexpr size_t O_VG   = O_U    + 16384ull * 512 * 2;
constexpr size_t O_MG   = O_VG   + 16384ull * 512 * 2;
constexpr size_t O_ONSA = O_MG   + 16384ull * 2048 * 2;
constexpr size_t O_OGM  = O_ONSA + 16384ull * 512 * 2;
constexpr size_t O_END  = O_OGM  + 16384ull * 512 * 2;
constexpr size_t O_Y    = O_Q;
constexpr size_t O_QX   = O_U;
constexpr size_t O_OX   = O_ONSA;
constexpr size_t O_QP   = O_MG;
constexpr size_t O_HS   = O_Q;
constexpr size_t O_HI   = O_Q + 16384ull * 256 * 4;
constexpr size_t O_EX   = O_U;
static_assert(O_END <= 256ull * 1024 * 1024, "workspace too large");

struct Params {
    const float *x, *mem, *g_mix, *w_in, *pe_k, *w1_k, *b1_k, *w2_k, *pe_v, *w1_v, *b1_v, *w2_v, *ln_g, *ln_b, *gws, *gbs,
        *w_nsa_out, *w_gmlp_out, *w_mix_out, *g_xattn, *g_mem, *w_xq, *w_xkv, *w_xo, *g_peer, *w_peer_q, *sub_keys, *peer_u, *peer_v, *g_final;
    float* out;
    unsigned char* ws;
};

DEVI bf16_t f2bf(float f) { unsigned u = __float_as_uint(f); u += 0x7fffu + ((u >> 16) & 1u); return (bf16_t)(u >> 16); }
DEVI float bf2f(bf16_t h) { return __uint_as_float(((unsigned)h) << 16); }
DEVI float tof(float v) { return v; }
DEVI float tof(bf16_t v) { return bf2f(v); }
DEVI float wave_sum(float v) { for (int o = 32; o > 0; o >>= 1) v += __shfl_xor(v, o); return v; }
DEVI float wave_max(float v) { for (int o = 32; o > 0; o >>= 1) v = fmaxf(v, __shfl_xor(v, o)); return v; }
DEVI float gelu_f(float x) { return 0.5f * x * (1.0f + erff(x * 0.70710678118654752f)); }
DEVI float sigmoid_f(float x) { return 1.0f / (1.0f + expf(-x)); }
DEVI void wave_argmax(float& v, int& idx) {
    for (int o = 32; o > 0; o >>= 1) {
        const float ov = __shfl_xor(v, o); const int oi = __shfl_xor(idx, o);
        const bool take = (ov > v) || (ov == v && oi < idx);
        v = take ? ov : v; idx = take ? oi : idx;
    }
}
typedef unsigned u32x4 __attribute__((ext_vector_type(4)));
DEVI unsigned cvt_pk_bf16(float lo, float hi) { unsigned r; asm("v_cvt_pk_bf16_f32 %0, %1, %2" : "=v"(r) : "v"(lo), "v"(hi)); return r; }
DEVI bf16x8 pack8(const float (&p)[8]) { u32x4 u; u.x = cvt_pk_bf16(p[0], p[1]); u.y = cvt_pk_bf16(p[2], p[3]); u.z = cvt_pk_bf16(p[4], p[5]); u.w = cvt_pk_bf16(p[6], p[7]); return __builtin_bit_cast(bf16x8, u); }
DEVI void lds_fence() { asm volatile("s_waitcnt lgkmcnt(0)" ::: "memory"); }
DEVI void load8(const float* p, float (&f)[8]) { const float4 a = *(const float4*)p, b = *(const float4*)(p + 4); f[0]=a.x; f[1]=a.y; f[2]=a.z; f[3]=a.w; f[4]=b.x; f[5]=b.y; f[6]=b.z; f[7]=b.w; }
DEVI void load8(const bf16_t* p, float (&f)[8]) { const uint4 a = *(const uint4*)p;
    f[0] = __uint_as_float(a.x << 16); f[1] = __uint_as_float(a.x & 0xffff0000u); f[2] = __uint_as_float(a.y << 16); f[3] = __uint_as_float(a.y & 0xffff0000u);
    f[4] = __uint_as_float(a.z << 16); f[5] = __uint_as_float(a.z & 0xffff0000u); f[6] = __uint_as_float(a.w << 16); f[7] = __uint_as_float(a.w & 0xffff0000u); }

template <class CMap>
DEVI void transpose_tile(const float* src, int srcN, bf16_t* dst, int K, int tl, CMap cmap, float* tile) {
    const int nkt = K / 64, kt = tl % nkt, nt = tl / nkt, k0 = kt * 64, n0 = nt * 64;
    const int tx = threadIdx.x & 63, ty = threadIdx.x >> 6;
    const int sc = cmap(n0 + tx);
#pragma unroll
    for (int i = 0; i < 8; ++i) { const int k = k0 + ty + 8 * i; tile[(ty + 8 * i) * 65 + tx] = sc >= 0 ? src[(size_t)k * srcN + sc] : 0.f; }
    __syncthreads();
#pragma unroll
    for (int i = 0; i < 8; ++i) { const int n = n0 + ty + 8 * i; dst[(size_t)n * K + k0 + tx] = f2bf(tile[tx * 65 + ty + 8 * i]); }
    __syncthreads();
}
struct IdMap { DEVI int operator()(int n) const { return n; } };
struct WinMap { DEVI int operator()(int n) const { return n < 1280 ? n : (n < 4352 ? n + 24 : (n < 4376 ? n - 4352 + 1280 : -1)); } };

DEVI void rmsnorm_row_bf16(const float* xrow, const float* g, bf16_t* dst, int lane) {
    float4 v[4]; float ss = 0.f;
#pragma unroll
    for (int i = 0; i < 4; ++i) { v[i] = ((const float4*)xrow)[lane + 64 * i]; ss += v[i].x * v[i].x + v[i].y * v[i].y + v[i].z * v[i].z + v[i].w * v[i].w; }
    ss = wave_sum(ss);
    const float r = rsqrtf(ss * (1.0f / 1024.0f) + 1e-6f);
#pragma unroll
    for (int i = 0; i < 4; ++i) {
        const float4 gg = ((const float4*)g)[lane + 64 * i];
        uint2 w; w.x = (unsigned)f2bf(v[i].x * r * gg.x) | ((unsigned)f2bf(v[i].y * r * gg.y) << 16); w.y = (unsigned)f2bf(v[i].z * r * gg.z) | ((unsigned)f2bf(v[i].w * r * gg.w) << 16);
        ((uint2*)dst)[lane + 64 * i] = w;
    }
}

constexpr int G_LD = 72;
template <class AF>
DEVI void gemm_tile(f32x4 (&acc)[4][2], AF af, int m0, const bf16_t* Bt, int ldb, int K, bf16_t* As, bf16_t* Bs) {
    const int tid = threadIdx.x, lane = tid & 63, wave = tid >> 6, wm = wave >> 2, wn = wave & 3;
    const int r0 = tid >> 3, kc = (tid & 7) * 8;
    uint4 ra0, ra1, rb0, rb1;
    ra0 = *(const uint4*)af(m0 + r0, kc); ra1 = *(const uint4*)af(m0 + r0 + 64, kc);
    rb0 = *(const uint4*)(Bt + (size_t)r0 * ldb + kc); rb1 = *(const uint4*)(Bt + (size_t)(r0 + 64) * ldb + kc);
    for (int k0 = 0; k0 < K; k0 += 64) {
        __syncthreads();
        *(uint4*)(As + r0 * G_LD + kc) = ra0; *(uint4*)(As + (r0 + 64) * G_LD + kc) = ra1;
        *(uint4*)(Bs + r0 * G_LD + kc) = rb0; *(uint4*)(Bs + (r0 + 64) * G_LD + kc) = rb1;
        __syncthreads();
        if (k0 + 64 < K) {
            const int kn = k0 + 64 + kc;
            ra0 = *(const uint4*)af(m0 + r0, kn); ra1 = *(const uint4*)af(m0 + r0 + 64, kn);
            rb0 = *(const uint4*)(Bt + (size_t)r0 * ldb + kn); rb1 = *(const uint4*)(Bt + (size_t)(r0 + 64) * ldb + kn);
        }
#pragma unroll
        for (int ks = 0; ks < 2; ++ks) {
            bf16x8 af_[4], bf_[2];
#pragma unroll
            for (int i = 0; i < 4; ++i) af_[i] = *(const bf16x8*)(As + (wm * 64 + i * 16 + (lane & 15)) * G_LD + ks * 32 + (lane >> 4) * 8);
#pragma unroll
            for (int j = 0; j < 2; ++j) bf_[j] = *(const bf16x8*)(Bs + (wn * 32 + j * 16 + (lane & 15)) * G_LD + ks * 32 + (lane >> 4) * 8);
#pragma unroll
            for (int i = 0; i < 4; ++i)
#pragma unroll
                for (int j = 0; j < 2; ++j) acc[i][j] = __builtin_amdgcn_mfma_f32_16x16x32_bf16(bf_[j], af_[i], acc[i][j], 0, 0, 0);
        }
    }
}
struct RowMajorA { const bf16_t* A; int lda; DEVI const bf16_t* operator()(int row, int k) const { return A + (size_t)row * lda + k; } };
struct CmpA { const bf16_t* KC;
    DEVI const bf16_t* operator()(int row, int k) const { const int rr = row < 2044 ? row : 2043; const int b = rr / 1022, rem = rr - b * 1022, c = rem >> 1, g = rem & 1;
        return KC + ((size_t)(b * 8192 + 16 * c + (k >> 6)) * 128 + g * 64 + (k & 63)); } };

template <class AF, class Epi>
DEVI void gemm_run(AF af, const bf16_t* Bt, int K, int MT, int NT, Epi epi, unsigned char* smem, int bid, int nb) {
    bf16_t* As = (bf16_t*)smem; bf16_t* Bs = As + 128 * G_LD;
    const int lane = threadIdx.x & 63, wave = threadIdx.x >> 6, wm = wave >> 2, wn = wave & 3;
    for (int t = bid; t < MT * NT; t += nb) {
        const int mt = t / NT, nt = t % NT;
        f32x4 acc[4][2];
#pragma unroll
        for (int i = 0; i < 4; ++i)
#pragma unroll
            for (int j = 0; j < 2; ++j) acc[i][j] = (f32x4){0.f, 0.f, 0.f, 0.f};
        gemm_tile(acc, af, mt * 128, Bt + (size_t)nt * 128 * K, K, K, As, Bs);
#pragma unroll
        for (int i = 0; i < 4; ++i)
#pragma unroll
            for (int j = 0; j < 2; ++j) epi(mt * 128 + wm * 64 + i * 16 + (lane & 15), nt * 128 + wn * 32 + j * 16 + (lane >> 4) * 4, acc[i][j]);
    }
}
DEVI void store_bf16x4(bf16_t* p, float a, float b, float c, float d) { uint2 w; w.x = (unsigned)f2bf(a) | ((unsigned)f2bf(b) << 16); w.y = (unsigned)f2bf(c) | ((unsigned)f2bf(d) << 16); *(uint2*)p = w; }

template <int DH, int R, int NCH, bool PSUM, typename KT, class RowF>
DEVI void attend(const float* qs, float* pl, float* psum, const KT* Kb, const KT* Vb, size_t stride, RowF rowf, float (&o)[R][DH / 64], int lane) {
    float m[R], l[R];
#pragma unroll
    for (int r = 0; r < R; ++r) { m[r] = -1e30f; l[r] = 0.f; }
#pragma unroll 1
    for (int i = 0; i < NCH; ++i) {
        bool valid; const long row = rowf(i, lane, valid);
        if (__ballot(valid) == 0ull) continue;
        const KT* kp = Kb + (size_t)row * stride;
        float a[R];
#pragma unroll
        for (int r = 0; r < R; ++r) a[r] = 0.f;
#pragma unroll 2
        for (int d0 = 0; d0 < DH; d0 += 8) {
            float kf[8]; load8(kp + d0, kf);
#pragma unroll
            for (int r = 0; r < R; ++r) {
                const float4 q0 = *(const float4*)(qs + r * DH + d0), q1 = *(const float4*)(qs + r * DH + d0 + 4);
                a[r] += kf[0] * q0.x + kf[1] * q0.y + kf[2] * q0.z + kf[3] * q0.w + kf[4] * q1.x + kf[5] * q1.y + kf[6] * q1.z + kf[7] * q1.w;
            }
        }
#pragma unroll
        for (int r = 0; r < R; ++r) {
            const float sv = valid ? a[r] : -1e30f;
            const float mn = fmaxf(m[r], wave_max(sv));
            const float pe = valid ? expf(sv - mn) : 0.f;
            l[r] = l[r] * expf(m[r] - mn) + wave_sum(pe);
            m[r] = mn;
        }
    }
    float inv[R];
#pragma unroll
    for (int r = 0; r < R; ++r) inv[r] = 1.0f / fmaxf(l[r], 1e-30f);
#pragma unroll 1
    for (int i = 0; i < NCH; ++i) {
        bool valid; const long row = rowf(i, lane, valid);
        const bool any = __ballot(valid) != 0ull;
        float a[R];
#pragma unroll
        for (int r = 0; r < R; ++r) a[r] = 0.f;
        if (any) {
            const KT* kp = Kb + (size_t)row * stride;
#pragma unroll 2
            for (int d0 = 0; d0 < DH; d0 += 8) {
                float kf[8]; load8(kp + d0, kf);
#pragma unroll
                for (int r = 0; r < R; ++r) {
                    const float4 q0 = *(const float4*)(qs + r * DH + d0), q1 = *(const float4*)(qs + r * DH + d0 + 4);
                    a[r] += kf[0] * q0.x + kf[1] * q0.y + kf[2] * q0.z + kf[3] * q0.w + kf[4] * q1.x + kf[5] * q1.y + kf[6] * q1.z + kf[7] * q1.w;
                }
            }
        }
        float ps = 0.f;
#pragma unroll
        for (int r = 0; r < R; ++r) { const float pv = valid ? expf(a[r] - m[r]) * inv[r] : 0.f; pl[r * 64 + lane] = pv; ps += pv; }
        if (PSUM) psum[i * 64 + lane] = ps;
        lds_fence();
        if (any) {
#pragma unroll 2
            for (int key = 0; key < 64; ++key) {
                bool dummy; const long vrow = rowf(i, key, dummy);
                const KT* vp = Vb + (size_t)vrow * stride;
                float pr[R];
#pragma unroll
                for (int r = 0; r < R; ++r) pr[r] = pl[r * 64 + key];
#pragma unroll
                for (int j = 0; j < DH / 64; ++j) { const float v = tof(vp[lane + 64 * j]);
#pragma unroll
                    for (int r = 0; r < R; ++r) o[r][j] += pr[r] * v; }
            }
        }
        lds_fence();
    }
}


DEVI void nsa_load_k(bf16x8 (&ka)[4], const bf16_t* Kp, size_t stride, int kb, int rk, int dh) {
    const bf16_t* p0 = Kp + (size_t)(kb + rk) * stride + dh; const bf16_t* p1 = p0 + 4 * stride;
    ka[0] = *(const bf16x8*)p0; ka[1] = *(const bf16x8*)(p0 + 32); ka[2] = *(const bf16x8*)p1; ka[3] = *(const bf16x8*)(p1 + 32);
}
DEVI void nsa_load_v(bf16x8 (&va)[4], const bf16_t* Vp, size_t vstride, int kb8, int lr) {
#pragma unroll
    for (int dt = 0; dt < 4; ++dt) va[dt] = *(const bf16x8*)(Vp + (size_t)(dt * 16 + lr) * vstride + kb8);
}
DEVI void nsa_scores(const bf16x8 (&ka)[4], const bf16x8 (&qf)[2], float (&sv)[8]) {
    f32x4 s0 = {0.f, 0.f, 0.f, 0.f}, s1 = {0.f, 0.f, 0.f, 0.f};
    s0 = __builtin_amdgcn_mfma_f32_16x16x32_bf16(ka[0], qf[0], s0, 0, 0, 0); s1 = __builtin_amdgcn_mfma_f32_16x16x32_bf16(ka[2], qf[0], s1, 0, 0, 0);
    s0 = __builtin_amdgcn_mfma_f32_16x16x32_bf16(ka[1], qf[1], s0, 0, 0, 0); s1 = __builtin_amdgcn_mfma_f32_16x16x32_bf16(ka[3], qf[1], s1, 0, 0, 0);
    sv[0] = s0[0]; sv[1] = s0[1]; sv[2] = s0[2]; sv[3] = s0[3]; sv[4] = s1[0]; sv[5] = s1[1]; sv[6] = s1[2]; sv[7] = s1[3];
}
struct NsaSt { float m, l; f32x4 o[4]; };
DEVI void nsa_init(NsaSt& st) { st.m = -1e30f; st.l = 0.f;
#pragma unroll
    for (int dt = 0; dt < 4; ++dt) st.o[dt] = (f32x4){0.f, 0.f, 0.f, 0.f}; }
template <bool PV>
DEVI void nsa_chunk(NsaSt& st, float (&sv)[8], int pos0, int lo, int hi, const bf16x8 (&va)[4]) {
    float cm = -1e30f;
#pragma unroll
    for (int j = 0; j < 8; ++j) { const bool ok = (pos0 + j >= lo) && (pos0 + j <= hi); sv[j] = ok ? sv[j] : -1e30f; cm = fmaxf(cm, sv[j]); }
    cm = fmaxf(cm, __shfl_xor(cm, 16)); cm = fmaxf(cm, __shfl_xor(cm, 32));
    if (__any(cm > st.m)) {
        const float mn = fmaxf(st.m, cm), sc = __expf(st.m - mn);
        st.l *= sc;
        if (PV) {
#pragma unroll
            for (int dt = 0; dt < 4; ++dt) st.o[dt] *= sc;
        }
        st.m = mn;
    }
    float p[8]; float ps = 0.f;
#pragma unroll
    for (int j = 0; j < 8; ++j) { p[j] = sv[j] > -0.5e30f ? __expf(sv[j] - st.m) : 0.f; ps += p[j]; }
    st.l += ps;
    if (PV) {
        const bf16x8 pb = pack8(p);
#pragma unroll
        for (int dt = 0; dt < 4; ++dt) st.o[dt] = __builtin_amdgcn_mfma_f32_16x16x32_bf16(va[dt], pb, st.o[dt], 0, 0, 0);
    }
}
DEVI void nsa_fold(f32x4 (&comb)[4], NsaSt& st, float gate) {
    float l = st.l; l += __shfl_xor(l, 16); l += __shfl_xor(l, 32);
    const float w = gate / fmaxf(l, 1e-30f);
#pragma unroll
    for (int dt = 0; dt < 4; ++dt) comb[dt] += st.o[dt] * w;
}

__global__ void __launch_bounds__(NTHREADS) fwd_mega(Params p) {
    extern __shared__ __attribute__((aligned(16))) unsigned char smem[];
    cg::grid_group grid = cg::this_grid();
    const int bid = blockIdx.x, nb = gridDim.x, tid = threadIdx.x, lane = tid & 63, wave = tid >> 6;
    unsigned char* ws = p.ws;
    bf16_t* WIN = (bf16_t*)(ws + O_WIN); bf16_t* W1K = (bf16_t*)(ws + O_W1K); bf16_t* W1V = (bf16_t*)(ws + O_W1V);
    bf16_t* WNSA = (bf16_t*)(ws + O_WNSA); bf16_t* WGM = (bf16_t*)(ws + O_WGM); bf16_t* WMIX = (bf16_t*)(ws + O_WMIX);
    bf16_t* WXQ = (bf16_t*)(ws + O_WXQ); bf16_t* WXKV = (bf16_t*)(ws + O_WXKV); bf16_t* WXO = (bf16_t*)(ws + O_WXO); bf16_t* WPQ = (bf16_t*)(ws + O_WPQ);
    float* B1F = (float*)(ws + O_B1);
    bf16_t* HN = (bf16_t*)(ws + O_HN); bf16_t* MN = (bf16_t*)(ws + O_MN); bf16_t* KVX = (bf16_t*)(ws + O_KVX);
    float* GATES = (float*)(ws + O_GATES); float* HID = (float*)(ws + O_HID); float* CMP = (float*)(ws + O_CMP);
    bf16_t* Q = (bf16_t*)(ws + O_Q); bf16_t* KV6 = (bf16_t*)(ws + O_KV6); bf16_t* U = (bf16_t*)(ws + O_U); bf16_t* VG = (bf16_t*)(ws + O_VG);
    bf16_t* MG = (bf16_t*)(ws + O_MG); bf16_t* ONSA = (bf16_t*)(ws + O_ONSA); bf16_t* OGM = (bf16_t*)(ws + O_OGM);
    bf16_t* Y = (bf16_t*)(ws + O_Y); bf16_t* QX = (bf16_t*)(ws + O_QX); bf16_t* OX = (bf16_t*)(ws + O_OX); bf16_t* QP = (bf16_t*)(ws + O_QP);
    float* HS = (float*)(ws + O_HS); int* HI = (int*)(ws + O_HI);
    bf16_t* KCB = (bf16_t*)(ws + O_CMP); bf16_t* VCT = KCB + 4 * 512 * 64;
    bf16_t* PUB = (bf16_t*)(ws + O_U); bf16_t* PVB = (bf16_t*)(ws + O_ONSA);
    float* OUT = p.out;

    {
        float* tile = (float*)smem;
        for (int j = bid; j < 3424; j += nb) {
            int t = j;
            if (t < 1120) { transpose_tile(p.w_in, 4376, WIN, 1024, t, WinMap(), tile); continue; } t -= 1120;
            if (t < 128) { transpose_tile(p.w1_k, 256, W1K, 2048, t, IdMap(), tile); continue; } t -= 128;
            if (t < 128) { transpose_tile(p.w1_v, 256, W1V, 2048, t, IdMap(), tile); continue; } t -= 128;
            if (t < 128) { transpose_tile(p.w_nsa_out, 1024, WNSA, 512, t, IdMap(), tile); continue; } t -= 128;
            if (t < 128) { transpose_tile(p.w_gmlp_out, 1024, WGM, 512, t, IdMap(), tile); continue; } t -= 128;
            if (t < 256) { transpose_tile(p.w_mix_out, 1024, WMIX, 1024, t, IdMap(), tile); continue; } t -= 256;
            if (t < 256) { transpose_tile(p.w_xq, 1024, WXQ, 1024, t, IdMap(), tile); continue; } t -= 256;
            if (t < 512) { transpose_tile(p.w_xkv, 2048, WXKV, 1024, t, IdMap(), tile); continue; } t -= 512;
            if (t < 256) { transpose_tile(p.w_xo, 1024, WXO, 1024, t, IdMap(), tile); continue; } t -= 256;
            transpose_tile(p.w_peer_q, 2048, WPQ, 1024, t, IdMap(), tile);
        }
        for (int r = bid * 8 + wave; r < 16384 + 512; r += nb * 8) {
            if (r < 16384) rmsnorm_row_bf16(p.x + (size_t)r * 1024, p.g_mix, HN + (size_t)r * 1024, lane);
            else rmsnorm_row_bf16(p.mem + (size_t)(r - 16384) * 1024, p.g_mem, MN + (size_t)(r - 16384) * 1024, lane);
        }
        if (bid == nb - 1) {
            const int kv = tid >> 8, n = tid & 255;
            const float* pe = kv ? p.pe_v : p.pe_k; const float* w1 = kv ? p.w1_v : p.w1_k; const float* b1 = kv ? p.b1_v : p.b1_k;
            float a = b1[n];
            for (int k = 0; k < 2048; ++k) a += pe[k] * w1[(size_t)k * 256 + n];
            B1F[kv * 256 + n] = a;
        }
    }
    grid.sync();

    {
        auto epi = [&](int r, int c, const f32x4& v) {
            if (c < 512) store_bf16x4(Q + (size_t)r * 512 + c, v[0] * 0.125f, v[1] * 0.125f, v[2] * 0.125f, v[3] * 0.125f);
            else if (c < 1280) { const int w = (c - 512) >> 7, cc = (c - 512) & 127;
                if (w == 3 || w == 5) { const int b_ = r >> 13, t_ = r & 8191, g_ = cc >> 6, d_ = cc & 63;
                    bf16_t* vt = KV6 + (size_t)w * 16384 * 128 + ((size_t)(b_ * 2 + g_) * 64 + d_) * 8192 + t_;
                    vt[0] = f2bf(v[0]); vt[8192] = f2bf(v[1]); vt[2 * 8192] = f2bf(v[2]); vt[3 * 8192] = f2bf(v[3]); }
                else store_bf16x4(KV6 + ((size_t)w * 16384 + r) * 128 + cc, v[0], v[1], v[2], v[3]); }
            else if (c < 1792) store_bf16x4(U + (size_t)r * 512 + (c - 1280), gelu_f(v[0]), gelu_f(v[1]), gelu_f(v[2]), gelu_f(v[3]));
            else if (c < 2304) store_bf16x4(VG + (size_t)r * 512 + (c - 1792), gelu_f(v[0]), gelu_f(v[1]), gelu_f(v[2]), gelu_f(v[3]));
            else if (c < 4352) store_bf16x4(MG + (size_t)r * 2048 + (c - 2304), sigmoid_f(v[0]), sigmoid_f(v[1]), sigmoid_f(v[2]), sigmoid_f(v[3]));
            else if (c < 4376) { float* gp = GATES + (size_t)r * 24 + (c - 4352); gp[0] = sigmoid_f(v[0]); gp[1] = sigmoid_f(v[1]); gp[2] = sigmoid_f(v[2]); gp[3] = sigmoid_f(v[3]); }
        };
        gemm_run(RowMajorA{HN, 1024}, WIN, 1024, 128, 35, epi, smem, bid, nb);
        auto epi2 = [&](int r, int c, const f32x4& v) { store_bf16x4(KVX + (size_t)r * 2048 + c, v[0], v[1], v[2], v[3]); };
        gemm_run(RowMajorA{MN, 1024}, WXKV, 1024, 4, 16, epi2, smem, bid, nb);
    }
    grid.sync();

    {
        for (int task = bid; task < 192; task += nb) {
            if (task < 64) {
                const int kv = task >> 5, t = task & 31, mt = t >> 1, nt = t & 1;
                bf16_t* As = (bf16_t*)smem; bf16_t* Bs = As + 128 * G_LD;
                const int wm = wave >> 2, wn = wave & 3;
                f32x4 acc[4][2];
#pragma unroll
                for (int i = 0; i < 4; ++i)
#pragma unroll
                    for (int j = 0; j < 2; ++j) acc[i][j] = (f32x4){0.f, 0.f, 0.f, 0.f};
                gemm_tile(acc, CmpA{KV6 + (size_t)kv * 16384 * 128}, mt * 128, (kv ? W1V : W1K) + (size_t)nt * 128 * 2048, 2048, 2048, As, Bs);
#pragma unroll
                for (int i = 0; i < 4; ++i)
#pragma unroll
                    for (int j = 0; j < 2; ++j) {
                        const int r = mt * 128 + wm * 64 + i * 16 + (lane & 15), c = nt * 128 + wn * 32 + j * 16 + (lane >> 4) * 4;
                        if (r < 2044) { float* hp = HID + ((size_t)kv * 2048 + r) * 256 + c; const float* bb = B1F + kv * 256 + c;
                            hp[0] = gelu_f(acc[i][j][0] + bb[0]); hp[1] = gelu_f(acc[i][j][1] + bb[1]); hp[2] = gelu_f(acc[i][j][2] + bb[2]); hp[3] = gelu_f(acc[i][j][3] + bb[3]); }
                    }
                __syncthreads();
            } else {
                const int ch = task - 64;
                const size_t row0 = (size_t)ch * 128;
                float* vl = (float*)smem;
                float* wl = vl + 128 * 128;
                float* st = wl + 128 * 128;
                for (int r = wave; r < 128; r += 8) {
                    float f[8]; load8(VG + (row0 + r) * 512 + lane * 8, f);
                    float s1 = 0.f;
#pragma unroll
                    for (int e = 0; e < 8; ++e) s1 += f[e];
                    s1 = wave_sum(s1); const float mu = s1 * (1.0f / 512.0f);
                    float s2 = 0.f;
#pragma unroll
                    for (int e = 0; e < 8; ++e) s2 += (f[e] - mu) * (f[e] - mu);
                    s2 = wave_sum(s2);
                    if (lane == 0) { st[r * 2] = mu; st[r * 2 + 1] = rsqrtf(s2 * (1.0f / 512.0f) + 1e-6f); }
                }
                __syncthreads();
                for (int g = 0; g < 4; ++g) {
                    for (int idx = tid; idx < 128 * 128; idx += NTHREADS) {
                        const int s_ = idx >> 7, d = idx & 127, chn = g * 128 + d;
                        vl[idx] = (bf2f(VG[(row0 + s_) * 512 + chn]) - st[s_ * 2]) * st[s_ * 2 + 1] * p.ln_g[chn] + p.ln_b[chn];
                        wl[idx] = p.gws[(size_t)g * 16384 + idx];
                    }
                    __syncthreads();
                    const int d = tid & 127, tg = tid >> 7;
                    for (int i = 0; i < 32; ++i) {
                        const int t = tg + 4 * i;
                        float a = 0.f;
                        for (int s_ = 0; s_ <= t; ++s_) a += wl[t * 128 + s_] * vl[s_ * 128 + d];
                        a += p.gbs[g * 128 + t];
                        const size_t o = (row0 + t) * 512 + g * 128 + d;
                        OGM[o] = f2bf(bf2f(U[o]) * a);
                    }
                    __syncthreads();
                }
            }
        }
    }
    grid.sync();

    {
        for (int idx = bid * NTHREADS + tid; idx < 2 * 2044 * 64; idx += nb * NTHREADS) {
            const int kv = idx / (2044 * 64), rem = idx - kv * (2044 * 64), r = rem >> 6, n = rem & 63;
            const float* hp = HID + ((size_t)kv * 2048 + r) * 256; const float* w2 = kv ? p.w2_v : p.w2_k;
            float a = 0.f;
            for (int j = 0; j < 256; ++j) a += hp[j] * w2[j * 64 + n];
            const int b = r / 1022, rr = r - b * 1022, c = rr >> 1, g = rr & 1;
            if (kv == 0) KCB[((size_t)(b * 2 + g) * 512 + c) * 64 + n] = f2bf(a); else VCT[((size_t)(b * 2 + g) * 64 + n) * 512 + c] = f2bf(a);
        }
        if (bid == 0 && tid < 256) { const int bg = tid >> 6, n = tid & 63; KCB[((size_t)bg * 512 + 511) * 64 + n] = 0; VCT[((size_t)bg * 64 + n) * 512 + 511] = 0; }
    }
    grid.sync();

    {
        float* impL = (float*)smem + wave * 1024;
        int* sidxL = (int*)(impL + 512);
        const bf16_t* KS = KV6 + 2ull * 16384 * 128; const bf16_t* VST = KV6 + 3ull * 16384 * 128;
        const bf16_t* KW = KV6 + 4ull * 16384 * 128; const bf16_t* VWT = KV6 + 5ull * 16384 * 128;
        const int c = lane & 15, h = lane >> 4, tokc = c >> 2, headc = c & 3;
        const int rk = 8 * (c >> 2) + (c & 3), dh = 8 * h;
        for (int task = bid * 8 + wave; task < 8192; task += nb * 8) {
            const int bg = task >> 11, q4 = task & 2047, b = bg >> 1, g = bg & 1, t0 = q4 * 4;
            const int tcol = t0 + tokc; const size_t bt0 = (size_t)b * 8192 + t0;
            bf16x8 qf[2];
            { const bf16_t* qp = Q + (bt0 + tokc) * 512 + g * 256 + headc * 64 + dh; qf[0] = *(const bf16x8*)qp; qf[1] = *(const bf16x8*)(qp + 32); }
            const float* gp = GATES + (bt0 + tokc) * 24 + (g * 4 + headc) * 3;
            const float gate0 = gp[0], gate1 = gp[1], gate2 = gp[2];
            f32x4 comb[4];
#pragma unroll
            for (int dt = 0; dt < 4; ++dt) comb[dt] = (f32x4){0.f, 0.f, 0.f, 0.f};
            {
                const int ncvc = tcol >= 31 ? ((tcol - 31) >> 4) + 1 : 0;
                const int ncvmax = (t0 + 3) >= 31 ? ((t0 + 3 - 31) >> 4) + 1 : 0;
                const int nch = (ncvmax + 31) >> 5;
                const bf16_t* Kc = KCB + (size_t)bg * 512 * 64; const bf16_t* Vc = VCT + (size_t)bg * 64 * 512;
                NsaSt st; nsa_init(st);
                bf16x8 vdummy[4];
#pragma unroll 1
                for (int ch = 0; ch < nch; ++ch) {
                    bf16x8 ka[4]; nsa_load_k(ka, Kc, 64, ch * 32, rk, dh);
                    float sv[8]; nsa_scores(ka, qf, sv);
                    nsa_chunk<false>(st, sv, ch * 32 + dh, 0, ncvc - 1, vdummy);
                }
                float l = st.l; l += __shfl_xor(l, 16); l += __shfl_xor(l, 32);
                const float inv = 1.0f / fmaxf(l, 1e-30f), mfin = st.m;
                *(float4*)(impL + lane * 8) = make_float4(0.f, 0.f, 0.f, 0.f); *(float4*)(impL + lane * 8 + 4) = make_float4(0.f, 0.f, 0.f, 0.f);
                lds_fence();
                f32x4 oc[4];
#pragma unroll
                for (int dt = 0; dt < 4; ++dt) oc[dt] = (f32x4){0.f, 0.f, 0.f, 0.f};
                float carry = 0.f;
#pragma unroll 1
                for (int ch = 0; ch < nch; ++ch) {
                    bf16x8 ka[4], va[4]; nsa_load_k(ka, Kc, 64, ch * 32, rk, dh); nsa_load_v(va, Vc, 512, ch * 32 + dh, c);
                    float sv[8]; nsa_scores(ka, qf, sv);
                    float p[8];
#pragma unroll
                    for (int j = 0; j < 8; ++j) p[j] = (ch * 32 + dh + j < ncvc) ? __expf(sv[j] - mfin) * inv : 0.f;
                    const float up = __shfl(p[7], (lane + 48) & 63);
                    const float prev7 = (h >= 1) ? up : carry; carry = up;
                    float i0 = p[0] + p[1] + p[2] + 0.5f * p[3] + 0.5f * prev7, i1 = p[4] + p[5] + p[6] + 0.5f * p[7] + 0.5f * p[3];
                    i0 += __shfl_xor(i0, 1); i0 += __shfl_xor(i0, 2); i1 += __shfl_xor(i1, 1); i1 += __shfl_xor(i1, 2);
                    if (headc == 0) { impL[tokc * 128 + 8 * ch + 2 * h] = i0; impL[tokc * 128 + 8 * ch + 2 * h + 1] = i1; }
                    const bf16x8 pb = pack8(p);
#pragma unroll
                    for (int dt = 0; dt < 4; ++dt) oc[dt] = __builtin_amdgcn_mfma_f32_16x16x32_bf16(va[dt], pb, oc[dt], 0, 0, 0);
                }
#pragma unroll
                for (int dt = 0; dt < 4; ++dt) comb[dt] += oc[dt] * gate0;
            }
            lds_fence();
            {
                const int tok = lane >> 4, sub = lane & 15, cur = t0 >> 6;
                float sc[8];
#pragma unroll
                for (int e = 0; e < 8; ++e) { const int j = sub + 16 * e; const float imp = impL[tok * 128 + j];
                    const bool al = j <= cur, fo = (j == 0) || (j == cur) || (j == cur - 1);
                    sc[e] = (fo && al) ? 1e4f : (al ? imp : -1e30f); }
                float myv = -1e30f; int myi = 0;
#pragma unroll 1
                for (int it = 0; it < 16; ++it) {
                    float bv = sc[0]; int bi = sub;
#pragma unroll
                    for (int e = 1; e < 8; ++e) if (sc[e] > bv) { bv = sc[e]; bi = sub + 16 * e; }
#pragma unroll
                    for (int o = 1; o < 16; o <<= 1) { const float ov = __shfl_xor(bv, o); const int oi = __shfl_xor(bi, o);
                        const bool take = (ov > bv) || (ov == bv && oi < bi); bv = take ? ov : bv; bi = take ? oi : bi; }
                    if (sub == it) { myv = bv; myi = bi; }
#pragma unroll
                    for (int e = 0; e < 8; ++e) if (bi == sub + 16 * e) sc[e] = -INFINITY;
                }
                sidxL[lane] = myv > -0.5e30f ? myi : -1;
            }
            lds_fence();
            {
                NsaSt st; nsa_init(st);
                const bf16_t* Kp = KS + (size_t)b * 8192 * 128 + g * 64; const bf16_t* Vp = VST + (size_t)bg * 64 * 8192;
#pragma unroll 1
                for (int idx = 0; idx < 64; ++idx) {
                    const int blk = __builtin_amdgcn_readfirstlane(sidxL[idx]);
                    if (blk < 0) continue;
                    const int hi = (tokc == (idx >> 4)) ? tcol : -1;
                    bf16x8 ka0[4], ka1[4], va0[4], va1[4];
                    nsa_load_k(ka0, Kp, 128, blk * 64, rk, dh); nsa_load_k(ka1, Kp, 128, blk * 64 + 32, rk, dh);
                    nsa_load_v(va0, Vp, 8192, blk * 64 + dh, c); nsa_load_v(va1, Vp, 8192, blk * 64 + 32 + dh, c);
                    float sv[8];
                    nsa_scores(ka0, qf, sv); nsa_chunk<true>(st, sv, blk * 64 + dh, 0, hi, va0);
                    nsa_scores(ka1, qf, sv); nsa_chunk<true>(st, sv, blk * 64 + 32 + dh, 0, hi, va1);
                }
                nsa_fold(comb, st, gate1);
            }
            {
                NsaSt st; nsa_init(st);
                const bf16_t* Kp = KW + (size_t)b * 8192 * 128 + g * 64; const bf16_t* Vp = VWT + (size_t)bg * 64 * 8192;
                const int kbf = (t0 > 511 ? t0 - 511 : 0) & ~31, kbl = (t0 + 3) & ~31;
                const int lo = tcol > 511 ? tcol - 511 : 0;
#pragma unroll 1
                for (int kb = kbf; kb <= kbl; kb += 32) {
                    bf16x8 ka[4], va[4]; nsa_load_k(ka, Kp, 128, kb, rk, dh); nsa_load_v(va, Vp, 8192, kb + dh, c);
                    float sv[8]; nsa_scores(ka, qf, sv); nsa_chunk<true>(st, sv, kb + dh, lo, tcol, va);
                }
                nsa_fold(comb, st, gate2);
            }
            {
                bf16_t* op = ONSA + (bt0 + tokc) * 512 + g * 256 + headc * 64 + 4 * h;
#pragma unroll
                for (int dt = 0; dt < 4; ++dt) store_bf16x4(op + dt * 16, comb[dt][0], comb[dt][1], comb[dt][2], comb[dt][3]);
            }
            lds_fence();
        }
    }
    grid.sync();

    {
        bf16_t* As = (bf16_t*)smem; bf16_t* Bs = As + 128 * G_LD;
        const int wm = wave >> 2, wn = wave & 3;
        for (int tl = bid; tl < 128 * 8; tl += nb) {
            const int mt = tl >> 3, nt = tl & 7;
            f32x4 a1[4][2], a2[4][2];
#pragma unroll
            for (int i = 0; i < 4; ++i)
#pragma unroll
                for (int j = 0; j < 2; ++j) { a1[i][j] = (f32x4){0.f, 0.f, 0.f, 0.f}; a2[i][j] = (f32x4){0.f, 0.f, 0.f, 0.f}; }
            gemm_tile(a1, RowMajorA{ONSA, 512}, mt * 128, WNSA + (size_t)nt * 128 * 512, 512, 512, As, Bs);
            gemm_tile(a2, RowMajorA{OGM, 512}, mt * 128, WGM + (size_t)nt * 128 * 512, 512, 512, As, Bs);
#pragma unroll
            for (int i = 0; i < 4; ++i)
#pragma unroll
                for (int j = 0; j < 2; ++j) {
                    const int r = mt * 128 + wm * 64 + i * 16 + (lane & 15), c = nt * 128 + wn * 32 + j * 16 + (lane >> 4) * 4;
                    float m0[8], m1[8];
                    const uint2 w0 = *(const uint2*)(MG + (size_t)r * 2048 + c), w1 = *(const uint2*)(MG + (size_t)r * 2048 + 1024 + c);
                    m0[0] = __uint_as_float(w0.x << 16); m0[1] = __uint_as_float(w0.x & 0xffff0000u); m0[2] = __uint_as_float(w0.y << 16); m0[3] = __uint_as_float(w0.y & 0xffff0000u);
                    m1[0] = __uint_as_float(w1.x << 16); m1[1] = __uint_as_float(w1.x & 0xffff0000u); m1[2] = __uint_as_float(w1.y << 16); m1[3] = __uint_as_float(w1.y & 0xffff0000u);
                    store_bf16x4(Y + (size_t)r * 1024 + c, m0[0] * a1[i][j][0] + m1[0] * a2[i][j][0], m0[1] * a1[i][j][1] + m1[1] * a2[i][j][1],
                                 m0[2] * a1[i][j][2] + m1[2] * a2[i][j][2], m0[3] * a1[i][j][3] + m1[3] * a2[i][j][3]);
                }
        }
    }
    grid.sync();

    {
        auto epi = [&](int r, int c, const f32x4& v) { const float4 xv = *(const float4*)(p.x + (size_t)r * 1024 + c);
            *(float4*)(OUT + (size_t)r * 1024 + c) = make_float4(xv.x + v[0], xv.y + v[1], xv.z + v[2], xv.w + v[3]); };
        gemm_run(RowMajorA{Y, 1024}, WMIX, 1024, 128, 8, epi, smem, bid, nb);
    }
    grid.sync();

    for (int r = bid * 8 + wave; r < 16384; r += nb * 8) rmsnorm_row_bf16(OUT + (size_t)r * 1024, p.g_xattn, HN + (size_t)r * 1024, lane);
    grid.sync();

    {
        auto epi = [&](int r, int c, const f32x4& v) { store_bf16x4(QX + (size_t)r * 1024 + c, v[0] * 0.0625f, v[1] * 0.0625f, v[2] * 0.0625f, v[3] * 0.0625f); };
        gemm_run(RowMajorA{HN, 1024}, WXQ, 1024, 128, 8, epi, smem, bid, nb);
    }
    grid.sync();

    {
        float* qs = (float*)smem + wave * 1024; float* pl = qs + 256;
        for (int task = bid * 8 + wave; task < 65536; task += nb * 8) {
            const int h = task & 3, bt = task >> 2, b = bt >> 13;
#pragma unroll
            for (int j = 0; j < 4; ++j) qs[lane + 64 * j] = bf2f(QX[(size_t)bt * 1024 + h * 256 + lane + 64 * j]);
            lds_fence();
            float o[1][4] = {{0.f, 0.f, 0.f, 0.f}};
            auto rowf = [&](int i, int key, bool& valid) -> long { valid = true; return i * 64 + key; };
            attend<256, 1, 4, false, bf16_t>(qs, pl, pl, KVX + (size_t)b * 256 * 2048 + h * 256, KVX + (size_t)b * 256 * 2048 + 1024 + h * 256, 2048, rowf, o, lane);
#pragma unroll
            for (int j = 0; j < 4; ++j) OX[(size_t)bt * 1024 + h * 256 + lane + 64 * j] = f2bf(o[0][j]);
        }
    }
    grid.sync();

    {
        auto epi = [&](int r, int c, const f32x4& v) { float4* hp = (float4*)(OUT + (size_t)r * 1024 + c); const float4 hv = *hp;
            *hp = make_float4(hv.x + v[0], hv.y + v[1], hv.z + v[2], hv.w + v[3]); };
        gemm_run(RowMajorA{OX, 1024}, WXO, 1024, 128, 8, epi, smem, bid, nb);
    }
    grid.sync();

    for (int r = bid * 8 + wave; r < 16384; r += nb * 8) rmsnorm_row_bf16(OUT + (size_t)r * 1024, p.g_peer, HN + (size_t)r * 1024, lane);
    {
        for (size_t i = (size_t)bid * NTHREADS + tid; i < 2ull * 16384 * 1024 / 8; i += (size_t)nb * NTHREADS) {
            const bool isv = i >= 16384ull * 1024 / 8; const size_t j = isv ? i - 16384ull * 1024 / 8 : i;
            const float* src = (isv ? p.peer_v : p.peer_u) + j * 8;
            const float4 a = *(const float4*)src, b = *(const float4*)(src + 4);
            uint4 w; w.x = (unsigned)f2bf(a.x) | ((unsigned)f2bf(a.y) << 16); w.y = (unsigned)f2bf(a.z) | ((unsigned)f2bf(a.w) << 16);
            w.z = (unsigned)f2bf(b.x) | ((unsigned)f2bf(b.y) << 16); w.w = (unsigned)f2bf(b.z) | ((unsigned)f2bf(b.w) << 16);
            *(uint4*)((isv ? PVB : PUB) + j * 8) = w;
        }
    }
    grid.sync();

    {
        auto epi = [&](int r, int c, const f32x4& v) { store_bf16x4(QP + (size_t)r * 2048 + c, v[0], v[1], v[2], v[3]); };
        gemm_run(RowMajorA{HN, 1024}, WPQ, 1024, 128, 16, epi, smem, bid, nb);
    }
    grid.sync();

    {
        float* kl = (float*)smem;
        float* ql = kl + 128 * 129 + wave * 128;
        for (int task = bid; task < 4096; task += nb) {
            const int hp = task & 15, tg = task >> 4;
            const float* src = p.sub_keys + (size_t)hp * 16384;
            for (int idx = tid; idx < 16384; idx += NTHREADS) kl[(idx >> 7) * 129 + (idx & 127)] = src[idx];
            __syncthreads();
            for (int tt = 0; tt < 8; ++tt) {
                const int tok = tg * 64 + wave * 8 + tt;
                ql[lane] = bf2f(QP[(size_t)tok * 2048 + hp * 128 + lane]); ql[lane + 64] = bf2f(QP[(size_t)tok * 2048 + hp * 128 + 64 + lane]);
                lds_fence();
                float s0 = 0.f, s1 = 0.f;
                for (int d = 0; d < 128; ++d) { const float q = ql[d]; s0 += q * kl[lane * 129 + d]; s1 += q * kl[(lane + 64) * 129 + d]; }
                float myv = 0.f; int myi = 0;
#pragma unroll
                for (int it = 0; it < 16; ++it) {
                    float bv = s0; int bi = lane;
                    if (s1 > bv) { bv = s1; bi = lane + 64; }
                    wave_argmax(bv, bi);
                    if (lane == it) { myv = bv; myi = bi; }
                    if (bi == lane) s0 = -INFINITY; if (bi == lane + 64) s1 = -INFINITY;
                }
                if (lane < 16) { HS[(size_t)tok * 256 + hp * 16 + lane] = myv; HI[(size_t)tok * 256 + hp * 16 + lane] = myi; }
                lds_fence();
            }
            __syncthreads();
        }
    }
    grid.sync();

    {
        int* exl = (int*)smem + wave * 256; float* gtl = (float*)(exl + 128);
        for (int tok = bid * 8 + wave; tok < 16384; tok += nb * 8) {
#pragma unroll 1
            for (int h = 0; h < 8; ++h) {
                const float* s0p = HS + (size_t)tok * 256 + (2 * h) * 16; const float* s1p = s0p + 16;
                const float a = s0p[lane >> 2];
                const float4 bq = *(const float4*)(s1p + (lane & 3) * 4);
                float c0 = a + bq.x, c1 = a + bq.y, c2 = a + bq.z, c3 = a + bq.w;
                float myv = 0.f; int myf = 0; float vmax = 0.f;
#pragma unroll
                for (int it = 0; it < 16; ++it) {
                    float bv = c0; int bi = lane * 4;
                    if (c1 > bv) { bv = c1; bi = lane * 4 + 1; }
                    if (c2 > bv) { bv = c2; bi = lane * 4 + 2; }
                    if (c3 > bv) { bv = c3; bi = lane * 4 + 3; }
                    wave_argmax(bv, bi);
                    if (it == 0) vmax = bv;
                    if (lane == it) { myv = bv; myf = bi; }
                    if (bi == lane * 4) c0 = -INFINITY; if (bi == lane * 4 + 1) c1 = -INFINITY; if (bi == lane * 4 + 2) c2 = -INFINITY; if (bi == lane * 4 + 3) c3 = -INFINITY;
                }
                const float e = lane < 16 ? expf(myv - vmax) : 0.f;
                const float se = wave_sum(e);
                if (lane < 16) {
                    const int* i0p = HI + (size_t)tok * 256 + (2 * h) * 16;
                    exl[h * 16 + lane] = i0p[myf >> 4] * 128 + i0p[16 + (myf & 15)];
                    gtl[h * 16 + lane] = e / se;
                }
            }
            lds_fence();
            float xv[2][8];
#pragma unroll
            for (int i = 0; i < 2; ++i) load8(HN + (size_t)tok * 1024 + i * 512 + lane * 8, xv[i]);
#pragma unroll 1
            for (int e0 = 0; e0 < 128; e0 += 8) {
                uint4 ur[8][2];
#pragma unroll
                for (int q = 0; q < 8; ++q) { const bf16_t* up = PUB + (size_t)exl[e0 + q] * 1024 + lane * 8; ur[q][0] = *(const uint4*)up; ur[q][1] = *(const uint4*)(up + 512); }
                float dsum[8];
#pragma unroll
                for (int q = 0; q < 8; ++q) {
                    float d = 0.f;
#pragma unroll
                    for (int i = 0; i < 2; ++i) { const uint4 a = ur[q][i];
                        d += __uint_as_float(a.x << 16) * xv[i][0] + __uint_as_float(a.x & 0xffff0000u) * xv[i][1] + __uint_as_float(a.y << 16) * xv[i][2] + __uint_as_float(a.y & 0xffff0000u) * xv[i][3]
                           + __uint_as_float(a.z << 16) * xv[i][4] + __uint_as_float(a.z & 0xffff0000u) * xv[i][5] + __uint_as_float(a.w << 16) * xv[i][6] + __uint_as_float(a.w & 0xffff0000u) * xv[i][7]; }
                    dsum[q] = d;
                }
#pragma unroll
                for (int q = 0; q < 8; ++q) { const float d = wave_sum(dsum[q]); if (lane == 0) gtl[e0 + q] = gtl[e0 + q] * gelu_f(d); }
            }
            lds_fence();
            float ac[2][8];
#pragma unroll
            for (int i = 0; i < 2; ++i)
#pragma unroll
                for (int e = 0; e < 8; ++e) ac[i][e] = 0.f;
#pragma unroll 1
            for (int e0 = 0; e0 < 128; e0 += 8) {
                uint4 vr[8][2];
#pragma unroll
                for (int q = 0; q < 8; ++q) { const bf16_t* vp = PVB + (size_t)exl[e0 + q] * 1024 + lane * 8; vr[q][0] = *(const uint4*)vp; vr[q][1] = *(const uint4*)(vp + 512); }
#pragma unroll
                for (int q = 0; q < 8; ++q) { const float cf = gtl[e0 + q];
#pragma unroll
                    for (int i = 0; i < 2; ++i) { const uint4 a = vr[q][i];
                        ac[i][0] += cf * __uint_as_float(a.x << 16); ac[i][1] += cf * __uint_as_float(a.x & 0xffff0000u); ac[i][2] += cf * __uint_as_float(a.y << 16); ac[i][3] += cf * __uint_as_float(a.y & 0xffff0000u);
                        ac[i][4] += cf * __uint_as_float(a.z << 16); ac[i][5] += cf * __uint_as_float(a.z & 0xffff0000u); ac[i][6] += cf * __uint_as_float(a.w << 16); ac[i][7] += cf * __uint_as_float(a.w & 0xffff0000u); }
                }
            }
            float ss = 0.f;
#pragma unroll
            for (int i = 0; i < 2; ++i) { float hv[8]; load8(OUT + (size_t)tok * 1024 + i * 512 + lane * 8, hv);
#pragma unroll
                for (int e = 0; e < 8; ++e) { ac[i][e] += hv[e]; ss += ac[i][e] * ac[i][e]; } }
            ss = wave_sum(ss);
            const float rr = rsqrtf(ss * (1.0f / 1024.0f) + 1e-6f);
#pragma unroll
            for (int i = 0; i < 2; ++i) { float gg[8]; load8(p.g_final + i * 512 + lane * 8, gg);
                float* op = OUT + (size_t)tok * 1024 + i * 512 + lane * 8;
                *(float4*)op = make_float4(ac[i][0] * rr * gg[0], ac[i][1] * rr * gg[1], ac[i][2] * rr * gg[2], ac[i][3] * rr * gg[3]);
                *(float4*)(op + 4) = make_float4(ac[i][4] * rr * gg[4], ac[i][5] * rr * gg[5], ac[i][6] * rr * gg[6], ac[i][7] * rr * gg[7]); }
            lds_fence();
        }
    }
}

extern "C" void kernel_launch(void* const* d_in, const int* in_sizes, int n_in, void* d_out, int out_size, void* d_ws, size_t ws_size, hipStream_t stream) {
    static int grid_blocks = 0;
    if (grid_blocks == 0) {
        int dev = 0, cus = 0, per_cu = 0;
        hipGetDevice(&dev);
        hipDeviceGetAttribute(&cus, hipDeviceAttributeMultiprocessorCount, dev);
        if (hipFuncSetAttribute((const void*)fwd_mega, hipFuncAttributeMaxDynamicSharedMemorySize, LDS_BYTES) != hipSuccess) { fprintf(stderr, "hipFuncSetAttribute failed\n"); }
        if (hipOccupancyMaxActiveBlocksPerMultiprocessor(&per_cu, (const void*)fwd_mega, NTHREADS, LDS_BYTES) != hipSuccess || per_cu < 1) { fprintf(stderr, "occupancy query failed (%d)\n", per_cu); per_cu = 1; }
        (void)hipGetLastError();
        if (per_cu > 1) per_cu = 1;
        grid_blocks = cus * per_cu;
        if (ws_size < O_END) { fprintf(stderr, "workspace too small: %zu < %zu\n", ws_size, (size_t)O_END); grid_blocks = -1; }
    }
    if (grid_blocks < 0) return;
    Params p{};
    const float** pp = (const float**)&p;
    for (int i = 0; i < 30; ++i) pp[i] = (const float*)d_in[i];
    p.out = (float*)d_out; p.ws = (unsigned char*)d_ws;
    void* args[] = {&p};
    hipError_t e = hipLaunchCooperativeKernel((const void*)fwd_mega, dim3(grid_blocks), dim3(NTHREADS), args, LDS_BYTES, stream);
    if (e != hipSuccess) fprintf(stderr, "cooperative launch failed: %s (grid %d)\n", hipGetErrorString(e), grid_blocks);
}
```

```cpp
#include <hip/hip_runtime.h>
#include <hip/hip_cooperative_groups.h>
#include <cstdio>
#include <cstdint>
namespace cg = cooperative_groups;

typedef unsigned short bf16_t;
typedef short bf16x8 __attribute__((ext_vector_type(8)));
typedef float f32x4 __attribute__((ext_vector_type(4)));
#define DEVI __device__ __forceinline__

constexpr int NTHREADS = 512;
constexpr int LDS_BYTES = 140 * 1024;

constexpr size_t O_BAR  = 0;
constexpr size_t O_WIN  = 16384;
constexpr size_t O_W1K  = O_WIN  + 4480ull * 1024 * 2;
constexpr size_t O_W1V  = O_W1K  + 256ull * 2048 * 2;
constexpr size_t O_WNSA = O_W1V  + 256ull * 2048 * 2;
constexpr size_t O_WGM  = O_WNSA + 1024ull * 512 * 2;
constexpr size_t O_WMIX = O_WGM  + 1024ull * 512 * 2;
constexpr size_t O_WXQ  = O_WMIX + 1024ull * 1024 * 2;
constexpr size_t O_WXKV = O_WXQ  + 1024ull * 1024 * 2;
constexpr size_t O_WXO  = O_WXKV + 2048ull * 1024 * 2;
constexpr size_t O_WPQ  = O_WXO  + 1024ull * 1024 * 2;
constexpr size_t O_B1   = O_WPQ  + 2048ull * 1024 * 2;
constexpr size_t O_VXT  = O_B1   + 2048;
constexpr size_t O_SUBK = O_VXT  + 8ull * 256 * 256 * 2;
constexpr size_t O_HN   = O_SUBK + 16ull * 128 * 128 * 2;
constexpr size_t O_MN   = O_HN   + 16384ull * 1024 * 2;
constexpr size_t O_KVX  = O_MN   + 512ull * 1024 * 2;
constexpr size_t O_GATES= O_KVX  + 512ull * 2048 * 2;
constexpr size_t O_HID  = O_GATES+ 16384ull * 24 * 4;
constexpr size_t O_CMP  = O_HID  + 2ull * 2048 * 256 * 4;
constexpr size_t O_Q    = O_CMP  + 2ull * 4 * 512 * 64 * 4;
constexpr size_t O_KV6  = O_Q    + 16384ull * 512 * 2;
constexpr size_t O_U    = O_KV6  + 6ull * 16384 * 128 * 2;
constexpr size_t O_VG   = O_U    + 16384ull * 512 * 2;
constexpr size_t O_MG   = O_VG   + 16384ull * 512 * 2;
constexpr size_t O_ONSA = O_MG   + 16384ull * 2048 * 2;
constexpr size_t O_OGM  = O_ONSA + 16384ull * 512 * 2;
constexpr size_t O_END  = O_OGM  + 16384ull * 512 * 2;
constexpr size_t O_Y    = O_Q;
constexpr size_t O_QX   = O_U;
constexpr size_t O_OX   = O_ONSA;
constexpr size_t O_QP   = O_MG;
constexpr size_t O_HS   = O_Q;
constexpr size_t O_HI   = O_Q + 16384ull * 256 * 4;
constexpr size_t O_EX   = O_U;
static_assert(O_END <= 256ull * 1024 * 1024, "workspace too large");

struct Params {
    const float *x, *mem, *g_mix, *w_in, *pe_k, *w1_k, *b1_k, *w2_k, *pe_v, *w1_v, *b1_v, *w2_v, *ln_g, *ln_b, *gws, *gbs,
        *w_nsa_out, *w_gmlp_out, *w_mix_out, *g_xattn, *g_mem, *w_xq, *w_xkv, *w_xo, *g_peer, *w_peer_q, *sub_keys, *peer_u, *peer_v, *g_final;
    float* out;
    unsigned char* ws;
};

DEVI bf16_t f2bf(float f) { unsigned u = __float_as_uint(f); u += 0x7fffu + ((u >> 16) & 1u); return (bf16_t)(u >> 16); }
DEVI float bf2f(bf16_t h) { return __uint_as_float(((unsigned)h) << 16); }
DEVI float tof(float v) { return v; }
DEVI float tof(bf16_t v) { return bf2f(v); }
DEVI float wave_sum(float v) { for (int o = 32; o > 0; o >>= 1) v += __shfl_xor(v, o); return v; }
DEVI float wave_max(float v) { for (int o = 32; o > 0; o >>= 1) v = fmaxf(v, __shfl_xor(v, o)); return v; }
DEVI float gelu_f(float x) { return 0.5f * x * (1.0f + erff(x * 0.70710678118654752f)); }
DEVI float sigmoid_f(float x) { return 1.0f / (1.0f + expf(-x)); }
DEVI void wave_argmax(float& v, int& idx) {
    for (int o = 32; o > 0; o >>= 1) {
        const float ov = __shfl_xor(v, o); const int oi = __shfl_xor(idx, o);
        const bool take = (ov > v) || (ov == v && oi < idx);
        v = take ? ov : v; idx = take ? oi : idx;
    }
}
typedef unsigned u32x4 __attribute__((ext_vector_type(4)));
DEVI unsigned cvt_pk_bf16(float lo, float hi) { unsigned r; asm("v_cvt_pk_bf16_f32 %0, %1, %2" : "=v"(r) : "v"(lo), "v"(hi)); return r; }
DEVI bf16x8 pack8(const float (&p)[8]) { u32x4 u; u.x = cvt_pk_bf16(p[0], p[1]); u.y = cvt_pk_bf16(p[2], p[3]); u.z = cvt_pk_bf16(p[4], p[5]); u.w = cvt_pk_bf16(p[6], p[7]); return __builtin_bit_cast(bf16x8, u); }
DEVI void lds_fence() { asm volatile("s_waitcnt lgkmcnt(0)" ::: "memory"); }
DEVI void load8(const float* p, float (&f)[8]) { const float4 a = *(const float4*)p, b = *(const float4*)(p + 4); f[0]=a.x; f[1]=a.y; f[2]=a.z; f[3]=a.w; f[4]=b.x; f[5]=b.y; f[6]=b.z; f[7]=b.w; }
DEVI void load8(const bf16_t* p, float (&f)[8]) { const uint4 a = *(const uint4*)p;
    f[0] = __uint_as_float(a.x << 16); f[1] = __uint_as_float(a.x & 0xffff0000u); f[2] = __uint_as_float(a.y << 16); f[3] = __uint_as_float(a.y & 0xffff0000u);
    f[4] = __uint_as_float(a.z << 16); f[5] = __uint_as_float(a.z & 0xffff0000u); f[6] = __uint_as_float(a.w << 16); f[7] = __uint_as_float(a.w & 0xffff0000u); }

template <class CMap>
DEVI void transpose_tile(const float* src, int srcN, bf16_t* dst, int K, int tl, CMap cmap, float* tile) {
    const int nkt = K / 64, kt = tl % nkt, nt = tl / nkt, k0 = kt * 64, n0 = nt * 64;
    const int tx = threadIdx.x & 63, ty = threadIdx.x >> 6;
    const int sc = cmap(n0 + tx);
#pragma unroll
    for (int i = 0; i < 8; ++i) { const int k = k0 + ty + 8 * i; tile[(ty + 8 * i) * 65 + tx] = sc >= 0 ? src[(size_t)k * srcN + sc] : 0.f; }
    __syncthreads();
#pragma unroll
    for (int i = 0; i < 8; ++i) { const int n = n0 + ty + 8 * i; dst[(size_t)n * K + k0 + tx] = f2bf(tile[tx * 65 + ty + 8 * i]); }
    __syncthreads();
}
struct IdMap { DEVI int operator()(int n) const { return n; } };
struct WinMap { DEVI int operator()(int n) const { return n < 1280 ? n : (n < 4352 ? n + 24 : (n < 4376 ? n - 4352 + 1280 : -1)); } };

DEVI void rmsnorm_row_bf16(const float* xrow, const float* g, bf16_t* dst, int lane) {
    float4 v[4]; float ss = 0.f;
#pragma unroll
    for (int i = 0; i < 4; ++i) { v[i] = ((const float4*)xrow)[lane + 64 * i]; ss += v[i].x * v[i].x + v[i].y * v[i].y + v[i].z * v[i].z + v[i].w * v[i].w; }
    ss = wave_sum(ss);
    const float r = rsqrtf(ss * (1.0f / 1024.0f) + 1e-6f);
#pragma unroll
    for (int i = 0; i < 4; ++i) {
        const float4 gg = ((const float4*)g)[lane + 64 * i];
        uint2 w; w.x = (unsigned)f2bf(v[i].x * r * gg.x) | ((unsigned)f2bf(v[i].y * r * gg.y) << 16); w.y = (unsigned)f2bf(v[i].z * r * gg.z) | ((unsigned)f2bf(v[i].w * r * gg.w) << 16);
        ((uint2*)dst)[lane + 64 * i] = w;
    }
}

constexpr int G_LD = 72;
template <class AF>
DEVI void gemm_tile(f32x4 (&acc)[4][2], AF af, int m0, const bf16_t* Bt, int ldb, int K, bf16_t* As, bf16_t* Bs) {
    const int tid = threadIdx.x, lane = tid & 63, wave = tid >> 6, wm = wave >> 2, wn = wave & 3;
    const int r0 = tid >> 3, kc = (tid & 7) * 8;
    uint4 ra0, ra1, rb0, rb1;
    ra0 = *(const uint4*)af(m0 + r0, kc); ra1 = *(const uint4*)af(m0 + r0 + 64, kc);
    rb0 = *(const uint4*)(Bt + (size_t)r0 * ldb + kc); rb1 = *(const uint4*)(Bt + (size_t)(r0 + 64) * ldb + kc);
    for (int k0 = 0; k0 < K; k0 += 64) {
        __syncthreads();
        *(uint4*)(As + r0 * G_LD + kc) = ra0; *(uint4*)(As + (r0 + 64) * G_LD + kc) = ra1;
        *(uint4*)(Bs + r0 * G_LD + kc) = rb0; *(uint4*)(Bs + (r0 + 64) * G_LD + kc) = rb1;
        __syncthreads();
        if (k0 + 64 < K) {
            const int kn = k0 + 64 + kc;
            ra0 = *(const uint4*)af(m0 + r0, kn); ra1 = *(const uint4*)af(m0 + r0 + 64, kn);
            rb0 = *(const uint4*)(Bt + (size_t)r0 * ldb + kn); rb1 = *(const uint4*)(Bt + (size_t)(r0 + 64) * ldb + kn);
        }
#pragma unroll
        for (int ks = 0; ks < 2; ++ks) {
            bf16x8 af_[4], bf_[2];
#pragma unroll
            for (int i = 0; i < 4; ++i) af_[i] = *(const bf16x8*)(As + (wm * 64 + i * 16 + (lane & 15)) * G_LD + ks * 32 + (lane >> 4) * 8);
#pragma unroll
            for (int j = 0; j < 2; ++j) bf_[j] = *(const bf16x8*)(Bs + (wn * 32 + j * 16 + (lane & 15)) * G_LD + ks * 32 + (lane >> 4) * 8);
#pragma unroll
            for (int i = 0; i < 4; ++i)
#pragma unroll
                for (int j = 0; j < 2; ++j) acc[i][j] = __builtin_amdgcn_mfma_f32_16x16x32_bf16(bf_[j], af_[i], acc[i][j], 0, 0, 0);
        }
    }
}
struct RowMajorA { const bf16_t* A; int lda; DEVI const bf16_t* operator()(int row, int k) const { return A + (size_t)row * lda + k; } };
struct CmpA { const bf16_t* KC;
    DEVI const bf16_t* operator()(int row, int k) const { const int rr = row < 2044 ? row : 2043; const int b = rr / 1022, rem = rr - b * 1022, c = rem >> 1, g = rem & 1;
        return KC + ((size_t)(b * 8192 + 16 * c + (k >> 6)) * 128 + g * 64 + (k & 63)); } };

template <class AF, class Epi>
DEVI void gemm_run(AF af, const bf16_t* Bt, int K, int MT, int NT, Epi epi, unsigned char* smem, int bid, int nb) {
    bf16_t* As = (bf16_t*)smem; bf16_t* Bs = As + 128 * G_LD;
    const int lane = threadIdx.x & 63, wave = threadIdx.x >> 6, wm = wave >> 2, wn = wave & 3;
    for (int t = bid; t < MT * NT; t += nb) {
        const int mt = t / NT, nt = t % NT;
        f32x4 acc[4][2];
#pragma unroll
        for (int i = 0; i < 4; ++i)
#pragma unroll
            for (int j = 0; j < 2; ++j) acc[i][j] = (f32x4){0.f, 0.f, 0.f, 0.f};
        gemm_tile(acc, af, mt * 128, Bt + (size_t)nt * 128 * K, K, K, As, Bs);
#pragma unroll
        for (int i = 0; i < 4; ++i)
#pragma unroll
            for (int j = 0; j < 2; ++j) epi(mt * 128 + wm * 64 + i * 16 + (lane & 15), nt * 128 + wn * 32 + j * 16 + (lane >> 4) * 4, acc[i][j]);
    }
}
DEVI void store_bf16x4(bf16_t* p, float a, float b, float c, float d) { uint2 w; w.x = (unsigned)f2bf(a) | ((unsigned)f2bf(b) << 16); w.y = (unsigned)f2bf(c) | ((unsigned)f2bf(d) << 16); *(uint2*)p = w; }

template <int DH, int R, int NCH, bool PSUM, typename KT, class RowF>
DEVI void attend(const float* qs, float* pl, float* psum, const KT* Kb, const KT* Vb, size_t stride, RowF rowf, float (&o)[R][DH / 64], int lane) {
    float m[R], l[R];
#pragma unroll
    for (int r = 0; r < R; ++r) { m[r] = -1e30f; l[r] = 0.f; }
#pragma unroll 1
    for (int i = 0; i < NCH; ++i) {
        bool valid; const long row = rowf(i, lane, valid);
        if (__ballot(valid) == 0ull) continue;
        const KT* kp = Kb + (size_t)row * stride;
        float a[R];
#pragma unroll
        for (int r = 0; r < R; ++r) a[r] = 0.f;
#pragma unroll 2
        for (int d0 = 0; d0 < DH; d0 += 8) {
            float kf[8]; load8(kp + d0, kf);
#pragma unroll
            for (int r = 0; r < R; ++r) {
                const float4 q0 = *(const float4*)(qs + r * DH + d0), q1 = *(const float4*)(qs + r * DH + d0 + 4);
                a[r] += kf[0] * q0.x + kf[1] * q0.y + kf[2] * q0.z + kf[3] * q0.w + kf[4] * q1.x + kf[5] * q1.y + kf[6] * q1.z + kf[7] * q1.w;
            }
        }
#pragma unroll
        for (int r = 0; r < R; ++r) {
            const float sv = valid ? a[r] : -1e30f;
            const float mn = fmaxf(m[r], wave_max(sv));
            const float pe = valid ? expf(sv - mn) : 0.f;
            l[r] = l[r] * expf(m[r] - mn) + wave_sum(pe);
            m[r] = mn;
        }
    }
    float inv[R];
#pragma unroll
    for (int r = 0; r < R; ++r) inv[r] = 1.0f / fmaxf(l[r], 1e-30f);
#pragma unroll 1
    for (int i = 0; i < NCH; ++i) {
        bool valid; const long row = rowf(i, lane, valid);
        const bool any = __ballot(valid) != 0ull;
        float a[R];
#pragma unroll
        for (int r = 0; r < R; ++r) a[r] = 0.f;
        if (any) {
            const KT* kp = Kb + (size_t)row * stride;
#pragma unroll 2
            for (int d0 = 0; d0 < DH; d0 += 8) {
                float kf[8]; load8(kp + d0, kf);
#pragma unroll
                for (int r = 0; r < R; ++r) {
                    const float4 q0 = *(const float4*)(qs + r * DH + d0), q1 = *(const float4*)(qs + r * DH + d0 + 4);
                    a[r] += kf[0] * q0.x + kf[1] * q0.y + kf[2] * q0.z + kf[3] * q0.w + kf[4] * q1.x + kf[5] * q1.y + kf[6] * q1.z + kf[7] * q1.w;
                }
            }
        }
        float ps = 0.f;
#pragma unroll
        for (int r = 0; r < R; ++r) { const float pv = valid ? expf(a[r] - m[r]) * inv[r] : 0.f; pl[r * 64 + lane] = pv; ps += pv; }
        if (PSUM) psum[i * 64 + lane] = ps;
        lds_fence();
        if (any) {
#pragma unroll 2
            for (int key = 0; key < 64; ++key) {
                bool dummy; const long vrow = rowf(i, key, dummy);
                const KT* vp = Vb + (size_t)vrow * stride;
                float pr[R];
#pragma unroll
                for (int r = 0; r < R; ++r) pr[r] = pl[r * 64 + key];
#pragma unroll
                for (int j = 0; j < DH / 64; ++j) { const float v = tof(vp[lane + 64 * j]);
#pragma unroll
                    for (int r = 0; r < R; ++r) o[r][j] += pr[r] * v; }
            }
        }
        lds_fence();
    }
}


DEVI void nsa_load_k(bf16x8 (&ka)[4], const bf16_t* Kp, size_t stride, int kb, int rk, int dh) {
    const bf16_t* p0 = Kp + (size_t)(kb + rk) * stride + dh; const bf16_t* p1 = p0 + 4 * stride;
    ka[0] = *(const bf16x8*)p0; ka[1] = *(const bf16x8*)(p0 + 32); ka[2] = *(const bf16x8*)p1; ka[3] = *(const bf16x8*)(p1 + 32);
}
DEVI void nsa_load_v(bf16x8 (&va)[4], const bf16_t* Vp, size_t vstride, int kb8, int lr) {
#pragma unroll
    for (int dt = 0; dt < 4; ++dt) va[dt] = *(const bf16x8*)(Vp + (size_t)(dt * 16 + lr) * vstride + kb8);
}
DEVI void nsa_scores(const bf16x8 (&ka)[4], const bf16x8 (&qf)[2], float (&sv)[8]) {
    f32x4 s0 = {0.f, 0.f, 0.f, 0.f}, s1 = {0.f, 0.f, 0.f, 0.f};
    s0 = __builtin_amdgcn_mfma_f32_16x16x32_bf16(ka[0], qf[0], s0, 0, 0, 0); s1 = __builtin_amdgcn_mfma_f32_16x16x32_bf16(ka[2], qf[0], s1, 0, 0, 0);
    s0 = __builtin_amdgcn_mfma_f32_16x16x32_bf16(ka[1], qf[1], s0, 0, 0, 0); s1 = __builtin_amdgcn_mfma_f32_16x16x32_bf16(ka[3], qf[1], s1, 0, 0, 0);
    sv[0] = s0[0]; sv[1] = s0[1]; sv[2] = s0[2]; sv[3] = s0[3]; sv[4] = s1[0]; sv[5] = s1[1]; sv[6] = s1[2]; sv[7] = s1[3];
}
struct NsaSt { float m, l; f32x4 o[4]; };
DEVI void nsa_init(NsaSt& st) { st.m = -1e30f; st.l = 0.f;
#pragma unroll
    for (int dt = 0; dt < 4; ++dt) st.o[dt] = (f32x4){0.f, 0.f, 0.f, 0.f}; }
template <bool PV>
DEVI void nsa_chunk(NsaSt& st, float (&sv)[8], int pos0, int lo, int hi, const bf16x8 (&va)[4]) {
    float cm = -1e30f;
#pragma unroll
    for (int j = 0; j < 8; ++j) { const bool ok = (pos0 + j >= lo) && (pos0 + j <= hi); sv[j] = ok ? sv[j] : -1e30f; cm = fmaxf(cm, sv[j]); }
    cm = fmaxf(cm, __shfl_xor(cm, 16)); cm = fmaxf(cm, __shfl_xor(cm, 32));
    if (__any(cm > st.m)) {
        const float mn = fmaxf(st.m, cm), sc = __expf(st.m - mn);
        st.l *= sc;
        if (PV) {
#pragma unroll
            for (int dt = 0; dt < 4; ++dt) st.o[dt] *= sc;
        }
        st.m = mn;
    }
    float p[8]; float ps = 0.f;
#pragma unroll
    for (int j = 0; j < 8; ++j) { p[j] = sv[j] > -0.5e30f ? __expf(sv[j] - st.m) : 0.f; ps += p[j]; }
    st.l += ps;
    if (PV) {
        const bf16x8 pb = pack8(p);
#pragma unroll
        for (int dt = 0; dt < 4; ++dt) st.o[dt] = __builtin_amdgcn_mfma_f32_16x16x32_bf16(va[dt], pb, st.o[dt], 0, 0, 0);
    }
}
DEVI void nsa_fold(f32x4 (&comb)[4], NsaSt& st, float gate) {
    float l = st.l; l += __shfl_xor(l, 16); l += __shfl_xor(l, 32);
    const float w = gate / fmaxf(l, 1e-30f);
#pragma unroll
    for (int dt = 0; dt < 4; ++dt) comb[dt] += st.o[dt] * w;
}

__global__ void __launch_bounds__(NTHREADS) fwd_mega(Params p) {
    extern __shared__ __attribute__((aligned(16))) unsigned char smem[];
    cg::grid_group grid = cg::this_grid();
    const int bid = blockIdx.x, nb = gridDim.x, tid = threadIdx.x, lane = tid & 63, wave = tid >> 6;
    unsigned char* ws = p.ws;
    bf16_t* WIN = (bf16_t*)(ws + O_WIN); bf16_t* W1K = (bf16_t*)(ws + O_W1K); bf16_t* W1V = (bf16_t*)(ws + O_W1V);
    bf16_t* WNSA = (bf16_t*)(ws + O_WNSA); bf16_t* WGM = (bf16_t*)(ws + O_WGM); bf16_t* WMIX = (bf16_t*)(ws + O_WMIX);
    bf16_t* WXQ = (bf16_t*)(ws + O_WXQ); bf16_t* WXKV = (bf16_t*)(ws + O_WXKV); bf16_t* WXO = (bf16_t*)(ws + O_WXO); bf16_t* WPQ = (bf16_t*)(ws + O_WPQ);
    float* B1F = (float*)(ws + O_B1);
    bf16_t* HN = (bf16_t*)(ws + O_HN); bf16_t* MN = (bf16_t*)(ws + O_MN); bf16_t* KVX = (bf16_t*)(ws + O_KVX);
    float* GATES = (float*)(ws + O_GATES); float* HID = (float*)(ws + O_HID); float* CMP = (float*)(ws + O_CMP);
    bf16_t* Q = (bf16_t*)(ws + O_Q); bf16_t* KV6 = (bf16_t*)(ws + O_KV6); bf16_t* U = (bf16_t*)(ws + O_U); bf16_t* VG = (bf16_t*)(ws + O_VG);
    bf16_t* MG = (bf16_t*)(ws + O_MG); bf16_t* ONSA = (bf16_t*)(ws + O_ONSA); bf16_t* OGM = (bf16_t*)(ws + O_OGM);
    bf16_t* Y = (bf16_t*)(ws + O_Y); bf16_t* QX = (bf16_t*)(ws + O_QX); bf16_t* OX = (bf16_t*)(ws + O_OX); bf16_t* QP = (bf16_t*)(ws + O_QP);
    float* HS = (float*)(ws + O_HS); int* HI = (int*)(ws + O_HI);
    bf16_t* VXT = (bf16_t*)(ws + O_VXT); bf16_t* SUBK = (bf16_t*)(ws + O_SUBK);
    bf16_t* KCB = (bf16_t*)(ws + O_CMP); bf16_t* VCT = KCB + 4 * 512 * 64;
    bf16_t* PUB = (bf16_t*)(ws + O_U); bf16_t* PVB = (bf16_t*)(ws + O_ONSA);
    float* OUT = p.out;

    {
        float* tile = (float*)smem;
        for (int j = bid; j < 3424; j += nb) {
            int t = j;
            if (t < 1120) { transpose_tile(p.w_in, 4376, WIN, 1024, t, WinMap(), tile); continue; } t -= 1120;
            if (t < 128) { transpose_tile(p.w1_k, 256, W1K, 2048, t, IdMap(), tile); continue; } t -= 128;
            if (t < 128) { transpose_tile(p.w1_v, 256, W1V, 2048, t, IdMap(), tile); continue; } t -= 128;
            if (t < 128) { transpose_tile(p.w_nsa_out, 1024, WNSA, 512, t, IdMap(), tile); continue; } t -= 128;
            if (t < 128) { transpose_tile(p.w_gmlp_out, 1024, WGM, 512, t, IdMap(), tile); continue; } t -= 128;
            if (t < 256) { transpose_tile(p.w_mix_out, 1024, WMIX, 1024, t, IdMap(), tile); continue; } t -= 256;
            if (t < 256) { transpose_tile(p.w_xq, 1024, WXQ, 1024, t, IdMap(), tile); continue; } t -= 256;
            if (t < 512) { transpose_tile(p.w_xkv, 2048, WXKV, 1024, t, IdMap(), tile); continue; } t -= 512;
            if (t < 256) { transpose_tile(p.w_xo, 1024, WXO, 1024, t, IdMap(), tile); continue; } t -= 256;
            transpose_tile(p.w_peer_q, 2048, WPQ, 1024, t, IdMap(), tile);
        }
        for (int r = bid * 8 + wave; r < 16384 + 512; r += nb * 8) {
            if (r < 16384) rmsnorm_row_bf16(p.x + (size_t)r * 1024, p.g_mix, HN + (size_t)r * 1024, lane);
            else rmsnorm_row_bf16(p.mem + (size_t)(r - 16384) * 1024, p.g_mem, MN + (size_t)(r - 16384) * 1024, lane);
        }
        for (int i = bid * NTHREADS + tid; i < 16 * 128 * 128; i += nb * NTHREADS) SUBK[i] = f2bf(p.sub_keys[i]);
        if (bid == nb - 1) {
            const int kv = tid >> 8, n = tid & 255;
            const float* pe = kv ? p.pe_v : p.pe_k; const float* w1 = kv ? p.w1_v : p.w1_k; const float* b1 = kv ? p.b1_v : p.b1_k;
            float a = b1[n];
            for (int k = 0; k < 2048; ++k) a += pe[k] * w1[(size_t)k * 256 + n];
            B1F[kv * 256 + n] = a;
        }
    }
    grid.sync();

    {
        auto epi = [&](int r, int c, const f32x4& v) {
            if (c < 512) store_bf16x4(Q + (size_t)r * 512 + c, v[0] * 0.125f, v[1] * 0.125f, v[2] * 0.125f, v[3] * 0.125f);
            else if (c < 1280) { const int w = (c - 512) >> 7, cc = (c - 512) & 127;
                if (w == 3 || w == 5) { const int b_ = r >> 13, t_ = r & 8191, g_ = cc >> 6, d_ = cc & 63;
                    bf16_t* vt = KV6 + (size_t)w * 16384 * 128 + ((size_t)(b_ * 2 + g_) * 64 + d_) * 8192 + t_;
                    vt[0] = f2bf(v[0]); vt[8192] = f2bf(v[1]); vt[2 * 8192] = f2bf(v[2]); vt[3 * 8192] = f2bf(v[3]); }
                else store_bf16x4(KV6 + ((size_t)w * 16384 + r) * 128 + cc, v[0], v[1], v[2], v[3]); }
            else if (c < 1792) store_bf16x4(U + (size_t)r * 512 + (c - 1280), gelu_f(v[0]), gelu_f(v[1]), gelu_f(v[2]), gelu_f(v[3]));
            else if (c < 2304) store_bf16x4(VG + (size_t)r * 512 + (c - 1792), gelu_f(v[0]), gelu_f(v[1]), gelu_f(v[2]), gelu_f(v[3]));
            else if (c < 4352) store_bf16x4(MG + (size_t)r * 2048 + (c - 2304), sigmoid_f(v[0]), sigmoid_f(v[1]), sigmoid_f(v[2]), sigmoid_f(v[3]));
            else if (c < 4376) { float* gp = GATES + (size_t)r * 24 + (c - 4352); gp[0] = sigmoid_f(v[0]); gp[1] = sigmoid_f(v[1]); gp[2] = sigmoid_f(v[2]); gp[3] = sigmoid_f(v[3]); }
        };
        gemm_run(RowMajorA{HN, 1024}, WIN, 1024, 128, 35, epi, smem, bid, nb);
        auto epi2 = [&](int r, int c, const f32x4& v) {
            if (c < 1024) store_bf16x4(KVX + (size_t)r * 2048 + c, v[0], v[1], v[2], v[3]);
            else { const int hd = c - 1024, h_ = hd >> 8, d_ = hd & 255, b_ = r >> 8, m_ = r & 255;
                bf16_t* vt = VXT + ((size_t)(b_ * 4 + h_) * 256 + d_) * 256 + m_;
                vt[0] = f2bf(v[0]); vt[256] = f2bf(v[1]); vt[512] = f2bf(v[2]); vt[768] = f2bf(v[3]); } };
        gemm_run(RowMajorA{MN, 1024}, WXKV, 1024, 4, 16, epi2, smem, bid, nb);
    }
    grid.sync();

    {
        for (int task = bid; task < 192; task += nb) {
            if (task < 64) {
                const int kv = task >> 5, t = task & 31, mt = t >> 1, nt = t & 1;
                bf16_t* As = (bf16_t*)smem; bf16_t* Bs = As + 128 * G_LD;
                const int wm = wave >> 2, wn = wave & 3;
                f32x4 acc[4][2];
#pragma unroll
                for (int i = 0; i < 4; ++i)
#pragma unroll
                    for (int j = 0; j < 2; ++j) acc[i][j] = (f32x4){0.f, 0.f, 0.f, 0.f};
                gemm_tile(acc, CmpA{KV6 + (size_t)kv * 16384 * 128}, mt * 128, (kv ? W1V : W1K) + (size_t)nt * 128 * 2048, 2048, 2048, As, Bs);
#pragma unroll
                for (int i = 0; i < 4; ++i)
#pragma unroll
                    for (int j = 0; j < 2; ++j) {
                        const int r = mt * 128 + wm * 64 + i * 16 + (lane & 15), c = nt * 128 + wn * 32 + j * 16 + (lane >> 4) * 4;
                        if (r < 2044) { float* hp = HID + ((size_t)kv * 2048 + r) * 256 + c; const float* bb = B1F + kv * 256 + c;
                            hp[0] = gelu_f(acc[i][j][0] + bb[0]); hp[1] = gelu_f(acc[i][j][1] + bb[1]); hp[2] = gelu_f(acc[i][j][2] + bb[2]); hp[3] = gelu_f(acc[i][j][3] + bb[3]); }
                    }
                __syncthreads();
            } else {
                const int ch = task - 64;
                const size_t row0 = (size_t)ch * 128;
                float* vl = (float*)smem;
                float* wl = vl + 128 * 128;
                float* st = wl + 128 * 128;
                for (int r = wave; r < 128; r += 8) {
                    float f[8]; load8(VG + (row0 + r) * 512 + lane * 8, f);
                    float s1 = 0.f;
#pragma unroll
                    for (int e = 0; e < 8; ++e) s1 += f[e];
                    s1 = wave_sum(s1); const float mu = s1 * (1.0f / 512.0f);
                    float s2 = 0.f;
#pragma unroll
                    for (int e = 0; e < 8; ++e) s2 += (f[e] - mu) * (f[e] - mu);
                    s2 = wave_sum(s2);
                    if (lane == 0) { st[r * 2] = mu; st[r * 2 + 1] = rsqrtf(s2 * (1.0f / 512.0f) + 1e-6f); }
                }
                __syncthreads();
                for (int g = 0; g < 4; ++g) {
                    for (int idx = tid; idx < 128 * 128; idx += NTHREADS) {
                        const int s_ = idx >> 7, d = idx & 127, chn = g * 128 + d;
                        vl[idx] = (bf2f(VG[(row0 + s_) * 512 + chn]) - st[s_ * 2]) * st[s_ * 2 + 1] * p.ln_g[chn] + p.ln_b[chn];
                        wl[idx] = p.gws[(size_t)g * 16384 + idx];
                    }
                    __syncthreads();
                    const int d = tid & 127, tg = tid >> 7;
                    for (int i = 0; i < 32; ++i) {
                        const int t = tg + 4 * i;
                        float a = 0.f;
                        for (int s_ = 0; s_ <= t; ++s_) a += wl[t * 128 + s_] * vl[s_ * 128 + d];
                        a += p.gbs[g * 128 + t];
                        const size_t o = (row0 + t) * 512 + g * 128 + d;
                        OGM[o] = f2bf(bf2f(U[o]) * a);
                    }
                    __syncthreads();
                }
            }
        }
    }
    grid.sync();

    {
        for (int idx = bid * NTHREADS + tid; idx < 2 * 2044 * 64; idx += nb * NTHREADS) {
            const int kv = idx / (2044 * 64), rem = idx - kv * (2044 * 64), r = rem >> 6, n = rem & 63;
            const float* hp = HID + ((size_t)kv * 2048 + r) * 256; const float* w2 = kv ? p.w2_v : p.w2_k;
            float a = 0.f;
            for (int j = 0; j < 256; ++j) a += hp[j] * w2[j * 64 + n];
            const int b = r / 1022, rr = r - b * 1022, c = rr >> 1, g = rr & 1;
            if (kv == 0) KCB[((size_t)(b * 2 + g) * 512 + c) * 64 + n] = f2bf(a); else VCT[((size_t)(b * 2 + g) * 64 + n) * 512 + c] = f2bf(a);
        }
        if (bid == 0 && tid < 256) { const int bg = tid >> 6, n = tid & 63; KCB[((size_t)bg * 512 + 511) * 64 + n] = 0; VCT[((size_t)bg * 64 + n) * 512 + 511] = 0; }
    }
    grid.sync();

    {
        float* impL = (float*)smem + wave * 1024;
        int* sidxL = (int*)(impL + 512);
        const bf16_t* KS = KV6 + 2ull * 16384 * 128; const bf16_t* VST = KV6 + 3ull * 16384 * 128;
        const bf16_t* KW = KV6 + 4ull * 16384 * 128; const bf16_t* VWT = KV6 + 5ull * 16384 * 128;
        const int c = lane & 15, h = lane >> 4, tokc = c >> 2, headc = c & 3;
        const int rk = 8 * (c >> 2) + (c & 3), dh = 8 * h;
        for (int task = bid * 8 + wave; task < 8192; task += nb * 8) {
            const int bg = task >> 11, q4 = task & 2047, b = bg >> 1, g = bg & 1, t0 = q4 * 4;
            const int tcol = t0 + tokc; const size_t bt0 = (size_t)b * 8192 + t0;
            bf16x8 qf[2];
            { const bf16_t* qp = Q + (bt0 + tokc) * 512 + g * 256 + headc * 64 + dh; qf[0] = *(const bf16x8*)qp; qf[1] = *(const bf16x8*)(qp + 32); }
            const float* gp = GATES + (bt0 + tokc) * 24 + (g * 4 + headc) * 3;
            const float gate0 = gp[0], gate1 = gp[1], gate2 = gp[2];
            f32x4 comb[4];
#pragma unroll
            for (int dt = 0; dt < 4; ++dt) comb[dt] = (f32x4){0.f, 0.f, 0.f, 0.f};
            {
                const int ncvc = tcol >= 31 ? ((tcol - 31) >> 4) + 1 : 0;
                const int ncvmax = (t0 + 3) >= 31 ? ((t0 + 3 - 31) >> 4) + 1 : 0;
                const int nch = (ncvmax + 31) >> 5;
                const bf16_t* Kc = KCB + (size_t)bg * 512 * 64; const bf16_t* Vc = VCT + (size_t)bg * 64 * 512;
                NsaSt st; nsa_init(st);
                bf16x8 vdummy[4];
#pragma unroll 1
                for (int ch = 0; ch < nch; ++ch) {
                    bf16x8 ka[4]; nsa_load_k(ka, Kc, 64, ch * 32, rk, dh);
                    float sv[8]; nsa_scores(ka, qf, sv);
                    nsa_chunk<false>(st, sv, ch * 32 + dh, 0, ncvc - 1, vdummy);
                }
                float l = st.l; l += __shfl_xor(l, 16); l += __shfl_xor(l, 32);
                const float inv = 1.0f / fmaxf(l, 1e-30f), mfin = st.m;
                *(float4*)(impL + lane * 8) = make_float4(0.f, 0.f, 0.f, 0.f); *(float4*)(impL + lane * 8 + 4) = make_float4(0.f, 0.f, 0.f, 0.f);
                lds_fence();
                f32x4 oc[4];
#pragma unroll
                for (int dt = 0; dt < 4; ++dt) oc[dt] = (f32x4){0.f, 0.f, 0.f, 0.f};
                float carry = 0.f;
#pragma unroll 1
                for (int ch = 0; ch < nch; ++ch) {
                    bf16x8 ka[4], va[4]; nsa_load_k(ka, Kc, 64, ch * 32, rk, dh); nsa_load_v(va, Vc, 512, ch * 32 + dh, c);
                    float sv[8]; nsa_scores(ka, qf, sv);
                    float p[8];
#pragma unroll
                    for (int j = 0; j < 8; ++j) p[j] = (ch * 32 + dh + j < ncvc) ? __expf(sv[j] - mfin) * inv : 0.f;
                    const float up = __shfl(p[7], (lane + 48) & 63);
                    const float prev7 = (h >= 1) ? up : carry; carry = up;
                    float i0 = p[0] + p[1] + p[2] + 0.5f * p[3] + 0.5f * prev7, i1 = p[4] + p[5] + p[6] + 0.5f * p[7] + 0.5f * p[3];
                    i0 += __shfl_xor(i0, 1); i0 += __shfl_xor(i0, 2); i1 += __shfl_xor(i1, 1); i1 += __shfl_xor(i1, 2);
                    if (headc == 0) { impL[tokc * 128 + 8 * ch + 2 * h] = i0; impL[tokc * 128 + 8 * ch + 2 * h + 1] = i1; }
                    const bf16x8 pb = pack8(p);
#pragma unroll
                    for (int dt = 0; dt < 4; ++dt) oc[dt] = __builtin_amdgcn_mfma_f32_16x16x32_bf16(va[dt], pb, oc[dt], 0, 0, 0);
                }
#pragma unroll
                for (int dt = 0; dt < 4; ++dt) comb[dt] += oc[dt] * gate0;
            }
            lds_fence();
            {
                const int tok = lane >> 4, sub = lane & 15, cur = t0 >> 6;
                float sc[8];
#pragma unroll
                for (int e = 0; e < 8; ++e) { const int j = sub + 16 * e; const float imp = impL[tok * 128 + j];
                    const bool al = j <= cur, fo = (j == 0) || (j == cur) || (j == cur - 1);
                    sc[e] = (fo && al) ? 1e4f : (al ? imp : -1e30f); }
                float myv = -1e30f; int myi = 0;
#pragma unroll 1
                for (int it = 0; it < 16; ++it) {
                    float bv = sc[0]; int bi = sub;
#pragma unroll
                    for (int e = 1; e < 8; ++e) if (sc[e] > bv) { bv = sc[e]; bi = sub + 16 * e; }
#pragma unroll
                    for (int o = 1; o < 16; o <<= 1) { const float ov = __shfl_xor(bv, o); const int oi = __shfl_xor(bi, o);
                        const bool take = (ov > bv) || (ov == bv && oi < bi); bv = take ? ov : bv; bi = take ? oi : bi; }
                    if (sub == it) { myv = bv; myi = bi; }
#pragma unroll
                    for (int e = 0; e < 8; ++e) if (bi == sub + 16 * e) sc[e] = -INFINITY;
                }
                sidxL[lane] = myv > -0.5e30f ? myi : -1;
            }
            lds_fence();
            {
                NsaSt st; nsa_init(st);
                const bf16_t* Kp = KS + (size_t)b * 8192 * 128 + g * 64; const bf16_t* Vp = VST + (size_t)bg * 64 * 8192;
#pragma unroll 1
                for (int idx = 0; idx < 64; ++idx) {
                    const int blk = __builtin_amdgcn_readfirstlane(sidxL[idx]);
                    if (blk < 0) continue;
                    const int hi = (tokc == (idx >> 4)) ? tcol : -1;
                    bf16x8 ka0[4], ka1[4], va0[4], va1[4];
                    nsa_load_k(ka0, Kp, 128, blk * 64, rk, dh); nsa_load_k(ka1, Kp, 128, blk * 64 + 32, rk, dh);
                    nsa_load_v(va0, Vp, 8192, blk * 64 + dh, c); nsa_load_v(va1, Vp, 8192, blk * 64 + 32 + dh, c);
                    float sv[8];
                    nsa_scores(ka0, qf, sv); nsa_chunk<true>(st, sv, blk * 64 + dh, 0, hi, va0);
                    nsa_scores(ka1, qf, sv); nsa_chunk<true>(st, sv, blk * 64 + 32 + dh, 0, hi, va1);
                }
                nsa_fold(comb, st, gate1);
            }
            {
                NsaSt st; nsa_init(st);
                const bf16_t* Kp = KW + (size_t)b * 8192 * 128 + g * 64; const bf16_t* Vp = VWT + (size_t)bg * 64 * 8192;
                const int kbf = (t0 > 511 ? t0 - 511 : 0) & ~31, kbl = (t0 + 3) & ~31;
                const int lo = tcol > 511 ? tcol - 511 : 0;
#pragma unroll 1
                for (int kb = kbf; kb <= kbl; kb += 32) {
                    bf16x8 ka[4], va[4]; nsa_load_k(ka, Kp, 128, kb, rk, dh); nsa_load_v(va, Vp, 8192, kb + dh, c);
                    float sv[8]; nsa_scores(ka, qf, sv); nsa_chunk<true>(st, sv, kb + dh, lo, tcol, va);
                }
                nsa_fold(comb, st, gate2);
            }
            {
                bf16_t* op = ONSA + (bt0 + tokc) * 512 + g * 256 + headc * 64 + 4 * h;
#pragma unroll
                for (int dt = 0; dt < 4; ++dt) store_bf16x4(op + dt * 16, comb[dt][0], comb[dt][1], comb[dt][2], comb[dt][3]);
            }
            lds_fence();
        }
    }
    grid.sync();

    {
        bf16_t* As = (bf16_t*)smem; bf16_t* Bs = As + 128 * G_LD;
        const int wm = wave >> 2, wn = wave & 3;
        for (int tl = bid; tl < 128 * 8; tl += nb) {
            const int mt = tl >> 3, nt = tl & 7;
            f32x4 a1[4][2], a2[4][2];
#pragma unroll
            for (int i = 0; i < 4; ++i)
#pragma unroll
                for (int j = 0; j < 2; ++j) { a1[i][j] = (f32x4){0.f, 0.f, 0.f, 0.f}; a2[i][j] = (f32x4){0.f, 0.f, 0.f, 0.f}; }
            gemm_tile(a1, RowMajorA{ONSA, 512}, mt * 128, WNSA + (size_t)nt * 128 * 512, 512, 512, As, Bs);
            gemm_tile(a2, RowMajorA{OGM, 512}, mt * 128, WGM + (size_t)nt * 128 * 512, 512, 512, As, Bs);
#pragma unroll
            for (int i = 0; i < 4; ++i)
#pragma unroll
                for (int j = 0; j < 2; ++j) {
                    const int r = mt * 128 + wm * 64 + i * 16 + (lane & 15), c = nt * 128 + wn * 32 + j * 16 + (lane >> 4) * 4;
                    float m0[8], m1[8];
                    const uint2 w0 = *(const uint2*)(MG + (size_t)r * 2048 + c), w1 = *(const uint2*)(MG + (size_t)r * 2048 + 1024 + c);
                    m0[0] = __uint_as_float(w0.x << 16); m0[1] = __uint_as_float(w0.x & 0xffff0000u); m0[2] = __uint_as_float(w0.y << 16); m0[3] = __uint_as_float(w0.y & 0xffff0000u);
                    m1[0] = __uint_as_float(w1.x << 16); m1[1] = __uint_as_float(w1.x & 0xffff0000u); m1[2] = __uint_as_float(w1.y << 16); m1[3] = __uint_as_float(w1.y & 0xffff0000u);
                    store_bf16x4(Y + (size_t)r * 1024 + c, m0[0] * a1[i][j][0] + m1[0] * a2[i][j][0], m0[1] * a1[i][j][1] + m1[1] * a2[i][j][1],
                                 m0[2] * a1[i][j][2] + m1[2] * a2[i][j][2], m0[3] * a1[i][j][3] + m1[3] * a2[i][j][3]);
                }
        }
    }
    grid.sync();

    {
        auto epi = [&](int r, int c, const f32x4& v) { const float4 xv = *(const float4*)(p.x + (size_t)r * 1024 + c);
            *(float4*)(OUT + (size_t)r * 1024 + c) = make_float4(xv.x + v[0], xv.y + v[1], xv.z + v[2], xv.w + v[3]); };
        gemm_run(RowMajorA{Y, 1024}, WMIX, 1024, 128, 8, epi, smem, bid, nb);
    }
    grid.sync();

    for (int r = bid * 8 + wave; r < 16384; r += nb * 8) rmsnorm_row_bf16(OUT + (size_t)r * 1024, p.g_xattn, HN + (size_t)r * 1024, lane);
    grid.sync();

    {
        auto epi = [&](int r, int c, const f32x4& v) { store_bf16x4(QX + (size_t)r * 1024 + c, v[0] * 0.0625f, v[1] * 0.0625f, v[2] * 0.0625f, v[3] * 0.0625f); };
        gemm_run(RowMajorA{HN, 1024}, WXQ, 1024, 128, 8, epi, smem, bid, nb);
    }
    grid.sync();

    {
        const int c = lane & 15, hg = lane >> 4, rk = 8 * (c >> 2) + (c & 3);
        for (int task = bid * 8 + wave; task < 4096; task += nb * 8) {
            const int h = task & 3, tgrp = task >> 2, b = tgrp >> 9; const size_t bt0 = (size_t)tgrp * 16;
            bf16x8 qf[8];
#pragma unroll
            for (int ks = 0; ks < 8; ++ks) qf[ks] = *(const bf16x8*)(QX + (bt0 + c) * 1024 + h * 256 + ks * 32 + 8 * hg);
            const bf16_t* Kp = KVX + (size_t)b * 256 * 2048 + h * 256; const bf16_t* Vp = VXT + (size_t)(b * 4 + h) * 256 * 256;
            float m = -1e30f, l = 0.f; f32x4 o[16];
#pragma unroll
            for (int dt = 0; dt < 16; ++dt) o[dt] = (f32x4){0.f, 0.f, 0.f, 0.f};
#pragma unroll 1
            for (int ch = 0; ch < 8; ++ch) {
                const int kb = ch * 32;
                const bf16_t* k0 = Kp + (size_t)(kb + rk) * 2048 + 8 * hg; const bf16_t* k1 = k0 + 4 * 2048;
                f32x4 s0 = {0.f, 0.f, 0.f, 0.f}, s1 = {0.f, 0.f, 0.f, 0.f};
#pragma unroll
                for (int ks = 0; ks < 8; ++ks) {
                    const bf16x8 a0 = *(const bf16x8*)(k0 + ks * 32), a1 = *(const bf16x8*)(k1 + ks * 32);
                    s0 = __builtin_amdgcn_mfma_f32_16x16x32_bf16(a0, qf[ks], s0, 0, 0, 0); s1 = __builtin_amdgcn_mfma_f32_16x16x32_bf16(a1, qf[ks], s1, 0, 0, 0);
                }
                float sv[8] = {s0[0], s0[1], s0[2], s0[3], s1[0], s1[1], s1[2], s1[3]};
                float cm = sv[0];
#pragma unroll
                for (int j = 1; j < 8; ++j) cm = fmaxf(cm, sv[j]);
                cm = fmaxf(cm, __shfl_xor(cm, 16)); cm = fmaxf(cm, __shfl_xor(cm, 32));
                if (__any(cm > m)) { const float mn = fmaxf(m, cm), sc = __expf(m - mn); l *= sc;
#pragma unroll
                    for (int dt = 0; dt < 16; ++dt) o[dt] *= sc;
                    m = mn; }
                float p[8]; float ps = 0.f;
#pragma unroll
                for (int j = 0; j < 8; ++j) { p[j] = __expf(sv[j] - m); ps += p[j]; }
                l += ps;
                const bf16x8 pb = pack8(p);
#pragma unroll
                for (int dt = 0; dt < 16; ++dt) { const bf16x8 va = *(const bf16x8*)(Vp + (size_t)(dt * 16 + c) * 256 + kb + 8 * hg);
                    o[dt] = __builtin_amdgcn_mfma_f32_16x16x32_bf16(va, pb, o[dt], 0, 0, 0); }
            }
            l += __shfl_xor(l, 16); l += __shfl_xor(l, 32);
            const float inv = 1.0f / l;
            bf16_t* op = OX + (bt0 + c) * 1024 + h * 256 + 4 * hg;
#pragma unroll
            for (int dt = 0; dt < 16; ++dt) store_bf16x4(op + dt * 16, o[dt][0] * inv, o[dt][1] * inv, o[dt][2] * inv, o[dt][3] * inv);
        }
    }
    grid.sync();

    {
        auto epi = [&](int r, int c, const f32x4& v) { float4* hp = (float4*)(OUT + (size_t)r * 1024 + c); const float4 hv = *hp;
            *hp = make_float4(hv.x + v[0], hv.y + v[1], hv.z + v[2], hv.w + v[3]); };
        gemm_run(RowMajorA{OX, 1024}, WXO, 1024, 128, 8, epi, smem, bid, nb);
    }
    grid.sync();

    for (int r = bid * 8 + wave; r < 16384; r += nb * 8) rmsnorm_row_bf16(OUT + (size_t)r * 1024, p.g_peer, HN + (size_t)r * 1024, lane);
    {
        for (size_t i = (size_t)bid * NTHREADS + tid; i < 2ull * 16384 * 1024 / 8; i += (size_t)nb * NTHREADS) {
            const bool isv = i >= 16384ull * 1024 / 8; const size_t j = isv ? i - 16384ull * 1024 / 8 : i;
            const float* src = (isv ? p.peer_v : p.peer_u) + j * 8;
            const float4 a = *(const float4*)src, b = *(const float4*)(src + 4);
            uint4 w; w.x = (unsigned)f2bf(a.x) | ((unsigned)f2bf(a.y) << 16); w.y = (unsigned)f2bf(a.z) | ((unsigned)f2bf(a.w) << 16);
            w.z = (unsigned)f2bf(b.x) | ((unsigned)f2bf(b.y) << 16); w.w = (unsigned)f2bf(b.z) | ((unsigned)f2bf(b.w) << 16);
            *(uint4*)((isv ? PVB : PUB) + j * 8) = w;
        }
    }
    grid.sync();

    {
        auto epi = [&](int r, int c, const f32x4& v) { store_bf16x4(QP + (size_t)r * 2048 + c, v[0], v[1], v[2], v[3]); };
        gemm_run(RowMajorA{HN, 1024}, WPQ, 1024, 128, 16, epi, smem, bid, nb);
    }
    grid.sync();

    {
        const int c = lane & 15, hg = lane >> 4;
        for (int task = bid * 8 + wave; task < 16384; task += nb * 8) {
            const int hp = task & 15, tgrp = task >> 4; const size_t bt0 = (size_t)tgrp * 16;
            bf16x8 qf[4];
#pragma unroll
            for (int ks = 0; ks < 4; ++ks) qf[ks] = *(const bf16x8*)(QP + (bt0 + c) * 2048 + hp * 128 + ks * 32 + 8 * hg);
            const bf16_t* Kp = SUBK + (size_t)hp * 16384 + c * 128 + 8 * hg;
            float sc[32];
#pragma unroll
            for (int kt = 0; kt < 8; ++kt) {
                f32x4 a = {0.f, 0.f, 0.f, 0.f};
#pragma unroll
                for (int ks = 0; ks < 4; ++ks) a = __builtin_amdgcn_mfma_f32_16x16x32_bf16(*(const bf16x8*)(Kp + kt * 16 * 128 + ks * 32), qf[ks], a, 0, 0, 0);
                sc[kt * 4 + 0] = a[0]; sc[kt * 4 + 1] = a[1]; sc[kt * 4 + 2] = a[2]; sc[kt * 4 + 3] = a[3];
            }
            float* hsp = HS + (bt0 + c) * 256 + hp * 16; int* hip_ = HI + (bt0 + c) * 256 + hp * 16;
#pragma unroll 1
            for (int it = 0; it < 16; ++it) {
                float bv = sc[0]; int be = 0;
#pragma unroll
                for (int e = 1; e < 32; ++e) if (sc[e] > bv) { bv = sc[e]; be = e; }
                int key = (be >> 2) * 16 + 4 * hg + (be & 3);
#pragma unroll
                for (int o = 16; o < 64; o <<= 1) { const float ov = __shfl_xor(bv, o); const int ok = __shfl_xor(key, o);
                    const bool take = (ov > bv) || (ov == bv && ok < key); bv = take ? ov : bv; key = take ? ok : key; }
                if (hg == 0) { hsp[it] = bv; hip_[it] = key; }
                const int ew = (((key >> 2) & 3) == hg) ? ((key >> 4) * 4 + (key & 3)) : -1;
#pragma unroll
                for (int e = 0; e < 32; ++e) if (e == ew) sc[e] = -INFINITY;
            }
        }
    }
    grid.sync();

    {
        int* exl = (int*)smem + wave * 256; float* gtl = (float*)(exl + 128);
        for (int tok = bid * 8 + wave; tok < 16384; tok += nb * 8) {
#pragma unroll 1
            for (int hh = 0; hh < 2; ++hh) {
                const int head = hh * 4 + (lane >> 4), i = lane & 15, gb = lane & 48;
                const float* s0p = HS + (size_t)tok * 256 + (2 * head) * 16;
                const float s0i = s0p[i], s1m = s0p[16 + i];
                int pj = 0; float myv = 0.f; int myf = 0;
#pragma unroll 1
                for (int it = 0; it < 16; ++it) {
                    const float s1v = __shfl(s1m, gb + (pj & 15));
                    float bv = pj < 16 ? s0i + s1v : -INFINITY; int bf = i * 16 + pj;
#pragma unroll
                    for (int o = 1; o < 16; o <<= 1) { const float ov = __shfl_xor(bv, o); const int of = __shfl_xor(bf, o);
                        const bool take = (ov > bv) || (ov == bv && of < bf); bv = take ? ov : bv; bf = take ? of : bf; }
                    if (i == it) { myv = bv; myf = bf; }
                    if ((bf >> 4) == i) ++pj;
                }
                const float vmax = __shfl(myv, gb);
                const float e = expf(myv - vmax);
                float se = e;
#pragma unroll
                for (int o = 1; o < 16; o <<= 1) se += __shfl_xor(se, o);
                const int* i0p = HI + (size_t)tok * 256 + (2 * head) * 16;
                exl[head * 16 + i] = i0p[myf >> 4] * 128 + i0p[16 + (myf & 15)];
                gtl[head * 16 + i] = e / se;
            }
            lds_fence();
            float xv[2][8];
#pragma unroll
            for (int i = 0; i < 2; ++i) load8(HN + (size_t)tok * 1024 + i * 512 + lane * 8, xv[i]);
#pragma unroll 1
            for (int e0 = 0; e0 < 128; e0 += 8) {
                uint4 ur[8][2];
#pragma unroll
                for (int q = 0; q < 8; ++q) { const bf16_t* up = PUB + (size_t)exl[e0 + q] * 1024 + lane * 8; ur[q][0] = *(const uint4*)up; ur[q][1] = *(const uint4*)(up + 512); }
                float dsum[8];
#pragma unroll
                for (int q = 0; q < 8; ++q) {
                    float d = 0.f;
#pragma unroll
                    for (int i = 0; i < 2; ++i) { const uint4 a = ur[q][i];
                        d += __uint_as_float(a.x << 16) * xv[i][0] + __uint_as_float(a.x & 0xffff0000u) * xv[i][1] + __uint_as_float(a.y << 16) * xv[i][2] + __uint_as_float(a.y & 0xffff0000u) * xv[i][3]
                           + __uint_as_float(a.z << 16) * xv[i][4] + __uint_as_float(a.z & 0xffff0000u) * xv[i][5] + __uint_as_float(a.w << 16) * xv[i][6] + __uint_as_float(a.w & 0xffff0000u) * xv[i][7]; }
                    dsum[q] = d;
                }
#pragma unroll
                for (int q = 0; q < 8; ++q) { const float d = wave_sum(dsum[q]); if (lane == 0) gtl[e0 + q] = gtl[e0 + q] * gelu_f(d); }
            }
            lds_fence();
            float ac[2][8];
#pragma unroll
            for (int i = 0; i < 2; ++i)
#pragma unroll
                for (int e = 0; e < 8; ++e) ac[i][e] = 0.f;
#pragma unroll 1
            for (int e0 = 0; e0 < 128; e0 += 8) {
                uint4 vr[8][2];
#pragma unroll
                for (int q = 0; q < 8; ++q) { const bf16_t* vp = PVB + (size_t)exl[e0 + q] * 1024 + lane * 8; vr[q][0] = *(const uint4*)vp; vr[q][1] = *(const uint4*)(vp + 512); }
#pragma unroll
                for (int q = 0; q < 8; ++q) { const float cf = gtl[e0 + q];
#pragma unroll
                    for (int i = 0; i < 2; ++i) { const uint4 a = vr[q][i];
                        ac[i][0] += cf * __uint_as_float(a.x << 16); ac[i][1] += cf * __uint_as_float(a.x & 0xffff0000u); ac[i][2] += cf * __uint_as_float(a.y << 16); ac[i][3] += cf * __uint_as_float(a.y & 0xffff0000u);
                        ac[i][4] += cf * __uint_as_float(a.z << 16); ac[i][5] += cf * __uint_as_float(a.z & 0xffff0000u); ac[i][6] += cf * __uint_as_float(a.w << 16); ac[i][7] += cf * __uint_as_float(a.w & 0xffff0000u); }
                }
            }
            float ss = 0.f;
#pragma unroll
            for (int i = 0; i < 2; ++i) { float hv[8]; load8(OUT + (size_t)tok * 1024 + i * 512 + lane * 8, hv);
#pragma unroll
                for (int e = 0; e < 8; ++e) { ac[i][e] += hv[e]; ss += ac[i][e] * ac[i][e]; } }
            ss = wave_sum(ss);
            const float rr = rsqrtf(ss * (1.0f / 1024.0f) + 1e-6f);
#pragma unroll
            for (int i = 0; i < 2; ++i) { float gg[8]; load8(p.g_final + i * 512 + lane * 8, gg);
                float* op = OUT + (size_t)tok * 1024 + i * 512 + lane * 8;
                *(float4*)op = make_float4(ac[i][0] * rr * gg[0], ac[i][1] * rr * gg[1], ac[i][2] * rr * gg[2], ac[i][3] * rr * gg[3]);
                *(float4*)(op + 4) = make_float4(ac[i][4] * rr * gg[4], ac[i][5] * rr * gg[5], ac[i][6] * rr * gg[6], ac[i][7] * rr * gg[7]); }
            lds_fence();
        }
    }
}

extern "C" void kernel_launch(void* const* d_in, const int* in_sizes, int n_in, void* d_out, int out_size, void* d_ws, size_t ws_size, hipStream_t stream) {
    static int grid_blocks = 0;
    if (grid_blocks == 0) {
        int dev = 0, cus = 0, per_cu = 0;
        hipGetDevice(&dev);
        hipDeviceGetAttribute(&cus, hipDeviceAttributeMultiprocessorCount, dev);
        if (hipFuncSetAttribute((const void*)fwd_mega, hipFuncAttributeMaxDynamicSharedMemorySize, LDS_BYTES) != hipSuccess) { fprintf(stderr, "hipFuncSetAttribute failed\n"); }
        if (hipOccupancyMaxActiveBlocksPerMultiprocessor(&per_cu, (const void*)fwd_mega, NTHREADS, LDS_BYTES) != hipSuccess || per_cu < 1) { fprintf(stderr, "occupancy query failed (%d)\n", per_cu); per_cu = 1; }
        (void)hipGetLastError();
        if (per_cu > 1) per_cu = 1;
        grid_blocks = cus * per_cu;
        if (ws_size < O_END) { fprintf(stderr, "workspace too small: %zu < %zu\n", ws_size, (size_t)O_END); grid_blocks = -1; }
    }
    if (grid_blocks < 0) return;
    Params p{};
    const float** pp = (const float**)&p;
    for (int i = 0; i < 30; ++i) pp[i] = (const float*)d_in[i];
    p.out = (float*)d_out; p.ws = (unsigned char*)d_ws;
    void* args[] = {&p};
    hipError_t e = hipLaunchCooperativeKernel((const void*)fwd_mega, dim3(grid_blocks), dim3(NTHREADS), args, LDS_BYTES, stream);
    if (e != hipSuccess) fprintf(stderr, "cooperative launch failed: %s (grid %d)\n", hipGetErrorString(e), grid_blocks);
}
```

```cpp
#include <hip/hip_runtime.h>
#include <cstdio>
#include <cstdint>

typedef unsigned short bf16_t;
typedef short bf16x8 __attribute__((ext_vector_type(8)));
typedef float f32x4 __attribute__((ext_vector_type(4)));
#define DEVI __device__ __forceinline__

constexpr int NTHREADS = 512;
constexpr int LDS_BYTES = 140 * 1024;

constexpr size_t O_BAR  = 0;
constexpr size_t O_WIN  = 16384;
constexpr size_t O_W1K  = O_WIN  + 4480ull * 1024 * 2;
constexpr size_t O_W1V  = O_W1K  + 256ull * 2048 * 2;
constexpr size_t O_WNSA = O_W1V  + 256ull * 2048 * 2;
constexpr size_t O_WGM  = O_WNSA + 1024ull * 512 * 2;
constexpr size_t O_WMIX = O_WGM  + 1024ull * 512 * 2;
constexpr size_t O_WXQ  = O_WMIX + 1024ull * 1024 * 2;
constexpr size_t O_WXKV = O_WXQ  + 1024ull * 1024 * 2;
constexpr size_t O_WXO  = O_WXKV + 2048ull * 1024 * 2;
constexpr size_t O_WPQ  = O_WXO  + 1024ull * 1024 * 2;
constexpr size_t O_B1   = O_WPQ  + 2048ull * 1024 * 2;
constexpr size_t O_VXT  = O_B1   + 2048;
constexpr size_t O_SUBK = O_VXT  + 8ull * 256 * 256 * 2;
constexpr size_t O_HN   = O_SUBK + 16ull * 128 * 128 * 2;
constexpr size_t O_MN   = O_HN   + 16384ull * 1024 * 2;
constexpr size_t O_KVX  = O_MN   + 512ull * 1024 * 2;
constexpr size_t O_GATES= O_KVX  + 512ull * 2048 * 2;
constexpr size_t O_HID  = O_GATES+ 16384ull * 24 * 4;
constexpr size_t O_CMP  = O_HID  + 2ull * 2048 * 256 * 4;
constexpr size_t O_Q    = O_CMP  + 2ull * 4 * 512 * 64 * 4;
constexpr size_t O_KV6  = O_Q    + 16384ull * 512 * 2;
constexpr size_t O_U    = O_KV6  + 6ull * 16384 * 128 * 2;
constexpr size_t O_VG   = O_U    + 16384ull * 512 * 2;
constexpr size_t O_MG   = O_VG   + 16384ull * 512 * 2;
constexpr size_t O_ONSA = O_MG   + 16384ull * 2048 * 2;
constexpr size_t O_OGM  = O_ONSA + 16384ull * 512 * 2;
constexpr size_t O_END  = O_OGM  + 16384ull * 512 * 2;
constexpr size_t O_Y    = O_Q;
constexpr size_t O_QX   = O_U;
constexpr size_t O_OX   = O_ONSA;
constexpr size_t O_QP   = O_MG;
constexpr size_t O_HS   = O_Q;
constexpr size_t O_HI   = O_Q + 16384ull * 256 * 4;
constexpr size_t O_EX   = O_U;
static_assert(O_END <= 256ull * 1024 * 1024, "workspace too large");

struct Params {
    const float *x, *mem, *g_mix, *w_in, *pe_k, *w1_k, *b1_k, *w2_k, *pe_v, *w1_v, *b1_v, *w2_v, *ln_g, *ln_b, *gws, *gbs,
        *w_nsa_out, *w_gmlp_out, *w_mix_out, *g_xattn, *g_mem, *w_xq, *w_xkv, *w_xo, *g_peer, *w_peer_q, *sub_keys, *peer_u, *peer_v, *g_final;
    float* out;
    unsigned char* ws;
};

DEVI bf16_t f2bf(float f) { unsigned u = __float_as_uint(f); u += 0x7fffu + ((u >> 16) & 1u); return (bf16_t)(u >> 16); }
DEVI float bf2f(bf16_t h) { return __uint_as_float(((unsigned)h) << 16); }
DEVI float tof(float v) { return v; }
DEVI float tof(bf16_t v) { return bf2f(v); }
DEVI float wave_sum(float v) { for (int o = 32; o > 0; o >>= 1) v += __shfl_xor(v, o); return v; }
DEVI float wave_max(float v) { for (int o = 32; o > 0; o >>= 1) v = fmaxf(v, __shfl_xor(v, o)); return v; }
DEVI float gelu_f(float x) { return 0.5f * x * (1.0f + erff(x * 0.70710678118654752f)); }
DEVI float sigmoid_f(float x) { return 1.0f / (1.0f + expf(-x)); }
DEVI void wave_argmax(float& v, int& idx) {
    for (int o = 32; o > 0; o >>= 1) {
        const float ov = __shfl_xor(v, o); const int oi = __shfl_xor(idx, o);
        const bool take = (ov > v) || (ov == v && oi < idx);
        v = take ? ov : v; idx = take ? oi : idx;
    }
}
typedef unsigned u32x4 __attribute__((ext_vector_type(4)));
DEVI unsigned cvt_pk_bf16(float lo, float hi) { unsigned r; asm("v_cvt_pk_bf16_f32 %0, %1, %2" : "=v"(r) : "v"(lo), "v"(hi)); return r; }
DEVI bf16x8 pack8(const float (&p)[8]) { u32x4 u; u.x = cvt_pk_bf16(p[0], p[1]); u.y = cvt_pk_bf16(p[2], p[3]); u.z = cvt_pk_bf16(p[4], p[5]); u.w = cvt_pk_bf16(p[6], p[7]); return __builtin_bit_cast(bf16x8, u); }
DEVI void lds_fence() { asm volatile("s_waitcnt lgkmcnt(0)" ::: "memory"); }
DEVI void load8(const float* p, float (&f)[8]) { const float4 a = *(const float4*)p, b = *(const float4*)(p + 4); f[0]=a.x; f[1]=a.y; f[2]=a.z; f[3]=a.w; f[4]=b.x; f[5]=b.y; f[6]=b.z; f[7]=b.w; }
DEVI void load8(const bf16_t* p, float (&f)[8]) { const uint4 a = *(const uint4*)p;
    f[0] = __uint_as_float(a.x << 16); f[1] = __uint_as_float(a.x & 0xffff0000u); f[2] = __uint_as_float(a.y << 16); f[3] = __uint_as_float(a.y & 0xffff0000u);
    f[4] = __uint_as_float(a.z << 16); f[5] = __uint_as_float(a.z & 0xffff0000u); f[6] = __uint_as_float(a.w << 16); f[7] = __uint_as_float(a.w & 0xffff0000u); }

template <class CMap>
DEVI void transpose_tile(const float* src, int srcN, bf16_t* dst, int K, int tl, CMap cmap, float* tile) {
    const int nkt = K / 64, kt = tl % nkt, nt = tl / nkt, k0 = kt * 64, n0 = nt * 64;
    const int tx = threadIdx.x & 63, ty = threadIdx.x >> 6;
    const int sc = cmap(n0 + tx);
#pragma unroll
    for (int i = 0; i < 8; ++i) { const int k = k0 + ty + 8 * i; tile[(ty + 8 * i) * 65 + tx] = sc >= 0 ? src[(size_t)k * srcN + sc] : 0.f; }
    __syncthreads();
#pragma unroll
    for (int i = 0; i < 8; ++i) { const int n = n0 + ty + 8 * i; dst[(size_t)n * K + k0 + tx] = f2bf(tile[tx * 65 + ty + 8 * i]); }
    __syncthreads();
}
struct IdMap { DEVI int operator()(int n) const { return n; } };
struct WinMap { DEVI int operator()(int n) const { return n < 1280 ? n : (n < 4352 ? n + 24 : (n < 4376 ? n - 4352 + 1280 : -1)); } };

DEVI void rmsnorm_row_bf16(const float* xrow, const float* g, bf16_t* dst, int lane) {
    float4 v[4]; float ss = 0.f;
#pragma unroll
    for (int i = 0; i < 4; ++i) { v[i] = ((const float4*)xrow)[lane + 64 * i]; ss += v[i].x * v[i].x + v[i].y * v[i].y + v[i].z * v[i].z + v[i].w * v[i].w; }
    ss = wave_sum(ss);
    const float r = rsqrtf(ss * (1.0f / 1024.0f) + 1e-6f);
#pragma unroll
    for (int i = 0; i < 4; ++i) {
        const float4 gg = ((const float4*)g)[lane + 64 * i];
        uint2 w; w.x = (unsigned)f2bf(v[i].x * r * gg.x) | ((unsigned)f2bf(v[i].y * r * gg.y) << 16); w.y = (unsigned)f2bf(v[i].z * r * gg.z) | ((unsigned)f2bf(v[i].w * r * gg.w) << 16);
        ((uint2*)dst)[lane + 64 * i] = w;
    }
}

constexpr int G_LD = 72;
template <class AF>
DEVI void gemm_tile(f32x4 (&acc)[4][2], AF af, int m0, const bf16_t* Bt, int ldb, int K, bf16_t* As, bf16_t* Bs) {
    const int tid = threadIdx.x, lane = tid & 63, wave = tid >> 6, wm = wave >> 2, wn = wave & 3;
    const int r0 = tid >> 3, kc = (tid & 7) * 8;
    uint4 ra0, ra1, rb0, rb1;
    ra0 = *(const uint4*)af(m0 + r0, kc); ra1 = *(const uint4*)af(m0 + r0 + 64, kc);
    rb0 = *(const uint4*)(Bt + (size_t)r0 * ldb + kc); rb1 = *(const uint4*)(Bt + (size_t)(r0 + 64) * ldb + kc);
    for (int k0 = 0; k0 < K; k0 += 64) {
        __syncthreads();
        *(uint4*)(As + r0 * G_LD + kc) = ra0; *(uint4*)(As + (r0 + 64) * G_LD + kc) = ra1;
        *(uint4*)(Bs + r0 * G_LD + kc) = rb0; *(uint4*)(Bs + (r0 + 64) * G_LD + kc) = rb1;
        __syncthreads();
        if (k0 + 64 < K) {
            const int kn = k0 + 64 + kc;
            ra0 = *(const uint4*)af(m0 + r0, kn); ra1 = *(const uint4*)af(m0 + r0 + 64, kn);
            rb0 = *(const uint4*)(Bt + (size_t)r0 * ldb + kn); rb1 = *(const uint4*)(Bt + (size_t)(r0 + 64) * ldb + kn);
        }
#pragma unroll
        for (int ks = 0; ks < 2; ++ks) {
            bf16x8 af_[4], bf_[2];
#pragma unroll
            for (int i = 0; i < 4; ++i) af_[i] = *(const bf16x8*)(As + (wm * 64 + i * 16 + (lane & 15)) * G_LD + ks * 32 + (lane >> 4) * 8);
#pragma unroll
            for (int j = 0; j < 2; ++j) bf_[j] = *(const bf16x8*)(Bs + (wn * 32 + j * 16 + (lane & 15)) * G_LD + ks * 32 + (lane >> 4) * 8);
#pragma unroll
            for (int i = 0; i < 4; ++i)
#pragma unroll
                for (int j = 0; j < 2; ++j) acc[i][j] = __builtin_amdgcn_mfma_f32_16x16x32_bf16(bf_[j], af_[i], acc[i][j], 0, 0, 0);
        }
    }
}
struct RowMajorA { const bf16_t* A; int lda; DEVI const bf16_t* operator()(int row, int k) const { return A + (size_t)row * lda + k; } };
struct CmpA { const bf16_t* KC;
    DEVI const bf16_t* operator()(int row, int k) const { const int rr = row < 2044 ? row : 2043; const int b = rr / 1022, rem = rr - b * 1022, c = rem >> 1, g = rem & 1;
        return KC + ((size_t)(b * 8192 + 16 * c + (k >> 6)) * 128 + g * 64 + (k & 63)); } };

template <class AF, class Epi>
DEVI void gemm_run(AF af, const bf16_t* Bt, int K, int MT, int NT, Epi epi, unsigned char* smem, int bid, int nb) {
    bf16_t* As = (bf16_t*)smem; bf16_t* Bs = As + 128 * G_LD;
    const int lane = threadIdx.x & 63, wave = threadIdx.x >> 6, wm = wave >> 2, wn = wave & 3;
    for (int t = bid; t < MT * NT; t += nb) {
        const int mt = t / NT, nt = t % NT;
        f32x4 acc[4][2];
#pragma unroll
        for (int i = 0; i < 4; ++i)
#pragma unroll
            for (int j = 0; j < 2; ++j) acc[i][j] = (f32x4){0.f, 0.f, 0.f, 0.f};
        gemm_tile(acc, af, mt * 128, Bt + (size_t)nt * 128 * K, K, K, As, Bs);
#pragma unroll
        for (int i = 0; i < 4; ++i)
#pragma unroll
            for (int j = 0; j < 2; ++j) epi(mt * 128 + wm * 64 + i * 16 + (lane & 15), nt * 128 + wn * 32 + j * 16 + (lane >> 4) * 4, acc[i][j]);
    }
}
DEVI void store_bf16x4(bf16_t* p, float a, float b, float c, float d) { uint2 w; w.x = (unsigned)f2bf(a) | ((unsigned)f2bf(b) << 16); w.y = (unsigned)f2bf(c) | ((unsigned)f2bf(d) << 16); *(uint2*)p = w; }

template <int DH, int R, int NCH, bool PSUM, typename KT, class RowF>
DEVI void attend(const float* qs, float* pl, float* psum, const KT* Kb, const KT* Vb, size_t stride, RowF rowf, float (&o)[R][DH / 64], int lane) {
    float m[R], l[R];
#pragma unroll
    for (int r = 0; r < R; ++r) { m[r] = -1e30f; l[r] = 0.f; }
#pragma unroll 1
    for (int i = 0; i < NCH; ++i) {
        bool valid; const long row = rowf(i, lane, valid);
        if (__ballot(valid) == 0ull) continue;
        const KT* kp = Kb + (size_t)row * stride;
        float a[R];
#pragma unroll
        for (int r = 0; r < R; ++r) a[r] = 0.f;
#pragma unroll 2
        for (int d0 = 0; d0 < DH; d0 += 8) {
            float kf[8]; load8(kp + d0, kf);
#pragma unroll
            for (int r = 0; r < R; ++r) {
                const float4 q0 = *(const float4*)(qs + r * DH + d0), q1 = *(const float4*)(qs + r * DH + d0 + 4);
                a[r] += kf[0] * q0.x + kf[1] * q0.y + kf[2] * q0.z + kf[3] * q0.w + kf[4] * q1.x + kf[5] * q1.y + kf[6] * q1.z + kf[7] * q1.w;
            }
        }
#pragma unroll
        for (int r = 0; r < R; ++r) {
            const float sv = valid ? a[r] : -1e30f;
            const float mn = fmaxf(m[r], wave_max(sv));
            const float pe = valid ? expf(sv - mn) : 0.f;
            l[r] = l[r] * expf(m[r] - mn) + wave_sum(pe);
            m[r] = mn;
        }
    }
    float inv[R];
#pragma unroll
    for (int r = 0; r < R; ++r) inv[r] = 1.0f / fmaxf(l[r], 1e-30f);
#pragma unroll 1
    for (int i = 0; i < NCH; ++i) {
        bool valid; const long row = rowf(i, lane, valid);
        const bool any = __ballot(valid) != 0ull;
        float a[R];
#pragma unroll
        for (int r = 0; r < R; ++r) a[r] = 0.f;
        if (any) {
            const KT* kp = Kb + (size_t)row * stride;
#pragma unroll 2
            for (int d0 = 0; d0 < DH; d0 += 8) {
                float kf[8]; load8(kp + d0, kf);
#pragma unroll
                for (int r = 0; r < R; ++r) {
                    const float4 q0 = *(const float4*)(qs + r * DH + d0), q1 = *(const float4*)(qs + r * DH + d0 + 4);
                    a[r] += kf[0] * q0.x + kf[1] * q0.y + kf[2] * q0.z + kf[3] * q0.w + kf[4] * q1.x + kf[5] * q1.y + kf[6] * q1.z + kf[7] * q1.w;
                }
            }
        }
        float ps = 0.f;
#pragma unroll
        for (int r = 0; r < R; ++r) { const float pv = valid ? expf(a[r] - m[r]) * inv[r] : 0.f; pl[r * 64 + lane] = pv; ps += pv; }
        if (PSUM) psum[i * 64 + lane] = ps;
        lds_fence();
        if (any) {
#pragma unroll 2
            for (int key = 0; key < 64; ++key) {
                bool dummy; const long vrow = rowf(i, key, dummy);
                const KT* vp = Vb + (size_t)vrow * stride;
                float pr[R];
#pragma unroll
                for (int r = 0; r < R; ++r) pr[r] = pl[r * 64 + key];
#pragma unroll
                for (int j = 0; j < DH / 64; ++j) { const float v = tof(vp[lane + 64 * j]);
#pragma unroll
                    for (int r = 0; r < R; ++r) o[r][j] += pr[r] * v; }
            }
        }
        lds_fence();
    }
}


DEVI int nsa_koff(int t, int d) { return ((((t >> 5) * 4 + (((t >> 2) & 1) * 2 + (d >> 5))) * 64) + ((((t & 31) >> 3) << 2) | (t & 3)) + 16 * ((d >> 3) & 3)) * 8 + (d & 7); }
DEVI int nsa_voff(int t, int d) { return ((((t >> 5) * 4 + (d >> 4)) * 64) + (d & 15) + 16 * ((t & 31) >> 3)) * 8 + (t & 7); }
DEVI int xat_koff(int m, int d) { return ((((m >> 5) * 16 + ((m >> 2) & 1) * 8 + (d >> 5)) * 64) + ((((m & 31) >> 3) << 2) | (m & 3)) + 16 * ((d >> 3) & 3)) * 8 + (d & 7); }
DEVI int xat_voff(int m, int d) { return ((((m >> 5) * 16 + (d >> 4)) * 64) + (d & 15) + 16 * ((m & 31) >> 3)) * 8 + (m & 7); }
DEVI int pk_koff(int k, int d) { return ((((k >> 4) * 4 + (d >> 5)) * 64) + (k & 15) + 16 * ((d >> 3) & 3)) * 8 + (d & 7); }
DEVI void nsa_load_kf(bf16x8 (&ka)[4], const bf16_t* Kp, int ch, int lane) {
#pragma unroll
    for (int f = 0; f < 4; ++f) ka[f] = *(const bf16x8*)(Kp + ((ch * 4 + f) * 64 + lane) * 8);
}
DEVI void nsa_load_k(bf16x8 (&ka)[4], const bf16_t* Kp, int stride, int kb, int rk, int dh) {
    const int o0 = (kb + rk) * stride + dh, o1 = o0 + 4 * stride;
    ka[0] = *(const bf16x8*)(Kp + o0); ka[1] = *(const bf16x8*)(Kp + o0 + 32); ka[2] = *(const bf16x8*)(Kp + o1); ka[3] = *(const bf16x8*)(Kp + o1 + 32);
}
DEVI void nsa_load_v(bf16x8 (&va)[4], const bf16_t* Vp, int vstride, int kb8, int lr) {
    const int o = lr * vstride + kb8;
#pragma unroll
    for (int dt = 0; dt < 4; ++dt) va[dt] = *(const bf16x8*)(Vp + o + dt * 16 * vstride);
}
DEVI void nsa_load_vb(bf16x8 (&va)[4], const bf16_t* Vp, int kb8, int lr) {
    const int o = ((kb8 >> 6) * 64 + lr) * 64 + (kb8 & 63);
#pragma unroll
    for (int dt = 0; dt < 4; ++dt) va[dt] = *(const bf16x8*)(Vp + o + dt * 16 * 64);
}
DEVI void nsa_scores(const bf16x8 (&ka)[4], const bf16x8 (&qf)[2], float (&sv)[8]) {
    f32x4 s0 = {0.f, 0.f, 0.f, 0.f}, s1 = {0.f, 0.f, 0.f, 0.f};
    s0 = __builtin_amdgcn_mfma_f32_16x16x32_bf16(ka[0], qf[0], s0, 0, 0, 0); s1 = __builtin_amdgcn_mfma_f32_16x16x32_bf16(ka[2], qf[0], s1, 0, 0, 0);
    s0 = __builtin_amdgcn_mfma_f32_16x16x32_bf16(ka[1], qf[1], s0, 0, 0, 0); s1 = __builtin_amdgcn_mfma_f32_16x16x32_bf16(ka[3], qf[1], s1, 0, 0, 0);
    sv[0] = s0[0]; sv[1] = s0[1]; sv[2] = s0[2]; sv[3] = s0[3]; sv[4] = s1[0]; sv[5] = s1[1]; sv[6] = s1[2]; sv[7] = s1[3];
}
struct NsaSt { float m, l; f32x4 o[4]; };
struct NsaBuf { bf16x8 ka[4]; bf16x8 va[4]; };
DEVI void nsa_init(NsaSt& st) { st.m = -1e20f; st.l = 0.f;
#pragma unroll
    for (int dt = 0; dt < 4; ++dt) st.o[dt] = (f32x4){0.f, 0.f, 0.f, 0.f}; }
template <bool PV>
DEVI void nsa_chunk(NsaSt& st, float (&sv)[8], int pos0, int lo, int hi, const bf16x8 (&va)[4]) {
    float cm = -1e30f;
#pragma unroll
    for (int j = 0; j < 8; ++j) { const bool ok = (pos0 + j >= lo) && (pos0 + j <= hi); sv[j] = ok ? sv[j] : -1e30f; cm = fmaxf(cm, sv[j]); }
    cm = fmaxf(cm, __shfl_xor(cm, 16)); cm = fmaxf(cm, __shfl_xor(cm, 32));
    if (__any(cm > st.m)) {
        const float mn = fmaxf(st.m, cm), sc = __builtin_amdgcn_exp2f(st.m - mn);
        st.l *= sc;
        if (PV) {
#pragma unroll
            for (int dt = 0; dt < 4; ++dt) st.o[dt] *= sc;
        }
        st.m = mn;
    }
    float p[8]; float ps = 0.f;
#pragma unroll
    for (int j = 0; j < 8; ++j) { p[j] = __builtin_amdgcn_exp2f(sv[j] - st.m); ps += p[j]; }
    st.l += ps;
    if (PV) {
        const bf16x8 pb = pack8(p);
#pragma unroll
        for (int dt = 0; dt < 4; ++dt) st.o[dt] = __builtin_amdgcn_mfma_f32_16x16x32_bf16(va[dt], pb, st.o[dt], 0, 0, 0);
    }
}
DEVI void nsa_fold(f32x4 (&comb)[4], NsaSt& st, float gate) {
    float l = st.l; l += __shfl_xor(l, 16); l += __shfl_xor(l, 32);
    const float w = gate / fmaxf(l, 1e-30f);
#pragma unroll
    for (int dt = 0; dt < 4; ++dt) comb[dt] += st.o[dt] * w;
}
template <class LD, class CP>
DEVI void nsa_stream(int n, LD ld, CP cp) {
    NsaBuf A, B, C;
    if (n > 0) ld(A, 0);
    if (n > 1) ld(B, 1);
#pragma unroll 1
    for (int i = 0; i < n; i += 3) {
        if (i + 2 < n) ld(C, i + 2);
        cp(A, i);
        if (i + 1 < n) { if (i + 3 < n) ld(A, i + 3); cp(B, i + 1); }
        if (i + 2 < n) { if (i + 4 < n) ld(B, i + 4); cp(C, i + 2); }
    }
}
template <class LD, class CP>
DEVI void nsa_stream2(int n, LD ld, CP cp) {
    NsaBuf A, B;
    if (n > 0) ld(A, 0);
#pragma unroll 1
    for (int i = 0; i < n; i += 2) {
        if (i + 1 < n) ld(B, i + 1);
        cp(A, i);
        if (i + 1 < n) { if (i + 2 < n) ld(A, i + 2); cp(B, i + 1); }
    }
}

#define XB_TMO      128
#define XB_XCNT(j)  (256  + 64 * (j))
#define XB_XSUB(j)  (1280 + 64 * (j))
#define XB_XGEN(j)  (2304 + 64 * (j))
#define XB_TOP      3328
#define XB_TOPGEN   3392
#define XCD_BAR_WORDS 3456
#define XB_SPIN_CAP (1u << 22)
#define LAS __attribute__((address_space(3)))
DEVI unsigned xb_ld(unsigned* p)              { return __hip_atomic_load(p, __ATOMIC_RELAXED, __HIP_MEMORY_SCOPE_AGENT); }
DEVI unsigned xb_add(unsigned* p, unsigned v) { return __hip_atomic_fetch_add(p, v, __ATOMIC_RELAXED, __HIP_MEMORY_SCOPE_AGENT); }
DEVI unsigned xb_xcc_id() { return (unsigned)__builtin_amdgcn_s_getreg((3 << 11) | 20) & 0xFu; }
#define XB_SPIN(cond, bar) do { unsigned _sp = 0; while (cond) { __builtin_amdgcn_s_sleep(1); \
    if ((++_sp & 255u) == 0u) { if (xb_ld(&(bar)[XB_TMO])) break; if (_sp > XB_SPIN_CAP) { atomicAdd(&(bar)[XB_TMO], 1u); break; } } } } while (0)
struct XcdBarrier { unsigned* bar; unsigned x; volatile LAS unsigned* st; };
DEVI XcdBarrier xcd_barrier_post(unsigned* bar, volatile LAS unsigned* st) {
    XcdBarrier b; b.bar = bar; b.x = xb_xcc_id(); b.st = st;
    if (threadIdx.x == 0) (void)xb_add(&bar[XB_XCNT(b.x)], 1u);
    return b;
}
DEVI void xcd_barrier_complete(unsigned* bar, unsigned x, unsigned& nloc, unsigned& nx) {
    const unsigned G = gridDim.x * gridDim.y * gridDim.z;
    unsigned sum, cnt, mine, sp = 0u;
    for (;;) {
        sum = 0u; cnt = 0u; mine = 0u;
#pragma unroll
        for (unsigned j = 0; j < 16; ++j) { const unsigned c = xb_ld(&bar[XB_XCNT(j)]); sum += c; cnt += (c > 0u) ? 1u : 0u; mine = (j == x) ? c : mine; }
        if (sum == G) break;
        __builtin_amdgcn_s_sleep(1);
        if ((++sp & 255u) == 0u) { if (xb_ld(&bar[XB_TMO])) break; if (sp > XB_SPIN_CAP) { atomicAdd(&bar[XB_TMO], 1u); break; } }
    }
    nloc = mine > 0u ? mine : 1u; nx = cnt > 0u ? cnt : 1u;
}
DEVI void xcd_barrier(const XcdBarrier& b) {
    asm volatile("s_waitcnt vmcnt(0)" ::: "memory");
    __syncthreads();
    if (threadIdx.x == 0) {
        unsigned* bar = b.bar;
        __builtin_amdgcn_s_waitcnt(0);
        unsigned nloc = b.st[0], nx = b.st[1];
        if (nloc == 0u) { xcd_barrier_complete(bar, b.x, nloc, nx); b.st[0] = nloc; b.st[1] = nx; }
        const unsigned old = xb_add(&bar[XB_XSUB(b.x)], 1u);
        const unsigned gen = old / nloc;
        if (old + 1u == (gen + 1u) * nloc) {
            __builtin_amdgcn_fence(__ATOMIC_RELEASE, "agent");
            asm volatile("s_waitcnt vmcnt(0)" ::: "memory");
            const unsigned og = xb_add(&bar[XB_TOP], 1u);
            const unsigned tg = og / nx;
            if (og + 1u == (tg + 1u) * nx) xb_add(&bar[XB_TOPGEN], 1u);
            else XB_SPIN(xb_ld(&bar[XB_TOPGEN]) == tg, bar);
            __builtin_amdgcn_fence(__ATOMIC_ACQUIRE, "agent");
            xb_add(&bar[XB_XGEN(b.x)], 1u);
            asm volatile("s_waitcnt vmcnt(0)" ::: "memory");
        } else {
            XB_SPIN(xb_ld(&bar[XB_XGEN(b.x)]) == gen, bar);
            __builtin_amdgcn_fence(__ATOMIC_ACQUIRE, "agent");
            asm volatile("s_waitcnt vmcnt(0)" ::: "memory");
        }
    }
    __syncthreads();
}

__global__ void __launch_bounds__(NTHREADS) fwd_mega(Params p) {
    extern __shared__ __attribute__((aligned(16))) unsigned char smem[];
    {
        volatile LAS unsigned* st0 = (volatile LAS unsigned*)(smem + LDS_BYTES - 16);
        if (threadIdx.x < 4) st0[threadIdx.x] = 0u;
        __syncthreads();
    }
    const XcdBarrier xb = xcd_barrier_post((unsigned*)(p.ws + O_BAR), (volatile LAS unsigned*)(smem + LDS_BYTES - 16));
    const int bid = blockIdx.x, nb = gridDim.x, tid = threadIdx.x, lane = tid & 63, wave = tid >> 6;
    unsigned char* ws = p.ws;
    bf16_t* WIN = (bf16_t*)(ws + O_WIN); bf16_t* W1K = (bf16_t*)(ws + O_W1K); bf16_t* W1V = (bf16_t*)(ws + O_W1V);
    bf16_t* WNSA = (bf16_t*)(ws + O_WNSA); bf16_t* WGM = (bf16_t*)(ws + O_WGM); bf16_t* WMIX = (bf16_t*)(ws + O_WMIX);
    bf16_t* WXQ = (bf16_t*)(ws + O_WXQ); bf16_t* WXKV = (bf16_t*)(ws + O_WXKV); bf16_t* WXO = (bf16_t*)(ws + O_WXO); bf16_t* WPQ = (bf16_t*)(ws + O_WPQ);
    float* B1F = (float*)(ws + O_B1);
    bf16_t* HN = (bf16_t*)(ws + O_HN); bf16_t* MN = (bf16_t*)(ws + O_MN); bf16_t* KVX = (bf16_t*)(ws + O_KVX);
    float* GATES = (float*)(ws + O_GATES); float* HID = (float*)(ws + O_HID); float* CMP = (float*)(ws + O_CMP);
    bf16_t* Q = (bf16_t*)(ws + O_Q); bf16_t* KV6 = (bf16_t*)(ws + O_KV6); bf16_t* U = (bf16_t*)(ws + O_U); bf16_t* VG = (bf16_t*)(ws + O_VG);
    bf16_t* MG = (bf16_t*)(ws + O_MG); bf16_t* ONSA = (bf16_t*)(ws + O_ONSA); bf16_t* OGM = (bf16_t*)(ws + O_OGM);
    bf16_t* Y = (bf16_t*)(ws + O_Y); bf16_t* QX = (bf16_t*)(ws + O_QX); bf16_t* OX = (bf16_t*)(ws + O_OX); bf16_t* QP = (bf16_t*)(ws + O_QP);
    float* HS = (float*)(ws + O_HS); int* HI = (int*)(ws + O_HI);
    bf16_t* VXT = (bf16_t*)(ws + O_VXT); bf16_t* SUBK = (bf16_t*)(ws + O_SUBK);
    bf16_t* KCB = (bf16_t*)(ws + O_CMP); bf16_t* VCT = KCB + 4 * 512 * 64;
    bf16_t* PUB = (bf16_t*)(ws + O_U); bf16_t* PVB = (bf16_t*)(ws + O_ONSA);
    float* OUT = p.out;

    {
        float* tile = (float*)smem;
        for (int j = bid; j < 3424; j += nb) {
            int t = j;
            if (t < 1120) { transpose_tile(p.w_in, 4376, WIN, 1024, t, WinMap(), tile); continue; } t -= 1120;
            if (t < 128) { transpose_tile(p.w1_k, 256, W1K, 2048, t, IdMap(), tile); continue; } t -= 128;
            if (t < 128) { transpose_tile(p.w1_v, 256, W1V, 2048, t, IdMap(), tile); continue; } t -= 128;
            if (t < 128) { transpose_tile(p.w_nsa_out, 1024, WNSA, 512, t, IdMap(), tile); continue; } t -= 128;
            if (t < 128) { transpose_tile(p.w_gmlp_out, 1024, WGM, 512, t, IdMap(), tile); continue; } t -= 128;
            if (t < 256) { transpose_tile(p.w_mix_out, 1024, WMIX, 1024, t, IdMap(), tile); continue; } t -= 256;
            if (t < 256) { transpose_tile(p.w_xq, 1024, WXQ, 1024, t, IdMap(), tile); continue; } t -= 256;
            if (t < 512) { transpose_tile(p.w_xkv, 2048, WXKV, 1024, t, IdMap(), tile); continue; } t -= 512;
            if (t < 256) { transpose_tile(p.w_xo, 1024, WXO, 1024, t, IdMap(), tile); continue; } t -= 256;
            transpose_tile(p.w_peer_q, 2048, WPQ, 1024, t, IdMap(), tile);
        }
        for (int r = bid * 8 + wave; r < 16384 + 512; r += nb * 8) {
            if (r < 16384) rmsnorm_row_bf16(p.x + (size_t)r * 1024, p.g_mix, HN + (size_t)r * 1024, lane);
            else rmsnorm_row_bf16(p.mem + (size_t)(r - 16384) * 1024, p.g_mem, MN + (size_t)(r - 16384) * 1024, lane);
        }
        for (int i = bid * NTHREADS + tid; i < 16 * 128 * 128; i += nb * NTHREADS) SUBK[(i & ~16383) + pk_koff((i >> 7) & 127, i & 127)] = f2bf(p.sub_keys[i]);
        if (bid == nb - 1) {
            const int kv = tid >> 8, n = tid & 255;
            const float* pe = kv ? p.pe_v : p.pe_k; const float* w1 = kv ? p.w1_v : p.w1_k; const float* b1 = kv ? p.b1_v : p.b1_k;
            float a = b1[n];
            for (int k = 0; k < 2048; ++k) a += pe[k] * w1[(size_t)k * 256 + n];
            B1F[kv * 256 + n] = a;
        }
    }
    xcd_barrier(xb);

    {
        auto epi = [&](int r, int c, const f32x4& v) {
            if (c < 512) { const float qs_ = 0.125f * 1.4426950408889634f; store_bf16x4(Q + (size_t)r * 512 + c, v[0] * qs_, v[1] * qs_, v[2] * qs_, v[3] * qs_); }
            else if (c < 1280) { const int w = (c - 512) >> 7, cc = (c - 512) & 127;
                if (w == 3 || w == 5) { const int b_ = r >> 13, t_ = r & 8191, g_ = cc >> 6, d_ = cc & 63;
                    bf16_t* vt = KV6 + (size_t)w * 16384 * 128 + (size_t)(b_ * 2 + g_) * 8192 * 64 + nsa_voff(t_, d_);
                    vt[0] = f2bf(v[0]); vt[8] = f2bf(v[1]); vt[16] = f2bf(v[2]); vt[24] = f2bf(v[3]); }
                else if (w == 2 || w == 4) { const int b_ = r >> 13, t_ = r & 8191, g_ = cc >> 6, d_ = cc & 63;
                    store_bf16x4(KV6 + (size_t)w * 16384 * 128 + (size_t)(b_ * 2 + g_) * 8192 * 64 + nsa_koff(t_, d_), v[0], v[1], v[2], v[3]); }
                else store_bf16x4(KV6 + ((size_t)w * 16384 + r) * 128 + cc, v[0], v[1], v[2], v[3]); }
            else if (c < 1792) store_bf16x4(U + (size_t)r * 512 + (c - 1280), gelu_f(v[0]), gelu_f(v[1]), gelu_f(v[2]), gelu_f(v[3]));
            else if (c < 2304) store_bf16x4(VG + (size_t)r * 512 + (c - 1792), gelu_f(v[0]), gelu_f(v[1]), gelu_f(v[2]), gelu_f(v[3]));
            else if (c < 4352) store_bf16x4(MG + (size_t)r * 2048 + (c - 2304), sigmoid_f(v[0]), sigmoid_f(v[1]), sigmoid_f(v[2]), sigmoid_f(v[3]));
            else if (c < 4376) { float* gp = GATES + (size_t)r * 24 + (c - 4352); gp[0] = sigmoid_f(v[0]); gp[1] = sigmoid_f(v[1]); gp[2] = sigmoid_f(v[2]); gp[3] = sigmoid_f(v[3]); }
        };
        gemm_run(RowMajorA{HN, 1024}, WIN, 1024, 128, 35, epi, smem, bid, nb);
        auto epi2 = [&](int r, int c, const f32x4& v) {
            const int b_ = r >> 8, m_ = r & 255;
            if (c < 1024) { const int h_ = c >> 8, d_ = c & 255; store_bf16x4(KVX + (size_t)(b_ * 4 + h_) * 65536 + xat_koff(m_, d_), v[0], v[1], v[2], v[3]); }
            else { const int hd = c - 1024, h_ = hd >> 8, d_ = hd & 255;
                bf16_t* vt = VXT + (size_t)(b_ * 4 + h_) * 65536 + xat_voff(m_, d_);
                vt[0] = f2bf(v[0]); vt[8] = f2bf(v[1]); vt[16] = f2bf(v[2]); vt[24] = f2bf(v[3]); } };
        gemm_run(RowMajorA{MN, 1024}, WXKV, 1024, 4, 16, epi2, smem, bid, nb);
    }
    xcd_barrier(xb);

    {
        for (int task = bid; task < 192; task += nb) {
            if (task < 64) {
                const int kv = task >> 5, t = task & 31, mt = t >> 1, nt = t & 1;
                bf16_t* As = (bf16_t*)smem; bf16_t* Bs = As + 128 * G_LD;
                const int wm = wave >> 2, wn = wave & 3;
                f32x4 acc[4][2];
#pragma unroll
                for (int i = 0; i < 4; ++i)
#pragma unroll
                    for (int j = 0; j < 2; ++j) acc[i][j] = (f32x4){0.f, 0.f, 0.f, 0.f};
                gemm_tile(acc, CmpA{KV6 + (size_t)kv * 16384 * 128}, mt * 128, (kv ? W1V : W1K) + (size_t)nt * 128 * 2048, 2048, 2048, As, Bs);
#pragma unroll
                for (int i = 0; i < 4; ++i)
#pragma unroll
                    for (int j = 0; j < 2; ++j) {
                        const int r = mt * 128 + wm * 64 + i * 16 + (lane & 15), c = nt * 128 + wn * 32 + j * 16 + (lane >> 4) * 4;
                        if (r < 2044) { float* hp = HID + ((size_t)kv * 2048 + r) * 256 + c; const float* bb = B1F + kv * 256 + c;
                            hp[0] = gelu_f(acc[i][j][0] + bb[0]); hp[1] = gelu_f(acc[i][j][1] + bb[1]); hp[2] = gelu_f(acc[i][j][2] + bb[2]); hp[3] = gelu_f(acc[i][j][3] + bb[3]); }
                    }
                __syncthreads();
            } else {
                const int ch = task - 64;
                const size_t row0 = (size_t)ch * 128;
                float* vl = (float*)smem;
                float* wl = vl + 128 * 128;
                float* st = wl + 128 * 128;
                for (int r = wave; r < 128; r += 8) {
                    float f[8]; load8(VG + (row0 + r) * 512 + lane * 8, f);
                    float s1 = 0.f;
#pragma unroll
                    for (int e = 0; e < 8; ++e) s1 += f[e];
                    s1 = wave_sum(s1); const float mu = s1 * (1.0f / 512.0f);
                    float s2 = 0.f;
#pragma unroll
                    for (int e = 0; e < 8; ++e) s2 += (f[e] - mu) * (f[e] - mu);
                    s2 = wave_sum(s2);
                    if (lane == 0) { st[r * 2] = mu; st[r * 2 + 1] = rsqrtf(s2 * (1.0f / 512.0f) + 1e-6f); }
                }
                __syncthreads();
                for (int g = 0; g < 4; ++g) {
                    for (int idx = tid; idx < 128 * 128; idx += NTHREADS) {
                        const int s_ = idx >> 7, d = idx & 127, chn = g * 128 + d;
                        vl[idx] = (bf2f(VG[(row0 + s_) * 512 + chn]) - st[s_ * 2]) * st[s_ * 2 + 1] * p.ln_g[chn] + p.ln_b[chn];
                        wl[idx] = p.gws[(size_t)g * 16384 + idx];
                    }
                    __syncthreads();
                    const int d = tid & 127, tg = tid >> 7;
                    for (int i = 0; i < 32; ++i) {
                        const int t = tg + 4 * i;
                        float a = 0.f;
                        for (int s_ = 0; s_ <= t; ++s_) a += wl[t * 128 + s_] * vl[s_ * 128 + d];
                        a += p.gbs[g * 128 + t];
                        const size_t o = (row0 + t) * 512 + g * 128 + d;
                        OGM[o] = f2bf(bf2f(U[o]) * a);
                    }
                    __syncthreads();
                }
            }
        }
    }
    xcd_barrier(xb);

    {
        for (int idx = bid * NTHREADS + tid; idx < 2 * 2044 * 64; idx += nb * NTHREADS) {
            const int kv = idx / (2044 * 64), rem = idx - kv * (2044 * 64), r = rem >> 6, n = rem & 63;
            const float* hp = HID + ((size_t)kv * 2048 + r) * 256; const float* w2 = kv ? p.w2_v : p.w2_k;
            float a = 0.f;
            for (int j = 0; j < 256; ++j) a += hp[j] * w2[j * 64 + n];
            const int b = r / 1022, rr = r - b * 1022, c = rr >> 1, g = rr & 1;
            if (kv == 0) KCB[(size_t)(b * 2 + g) * 512 * 64 + nsa_koff(c, n)] = f2bf(a); else VCT[(size_t)(b * 2 + g) * 512 * 64 + nsa_voff(c, n)] = f2bf(a);
        }
        if (bid == 0 && tid < 256) { const int bg = tid >> 6, n = tid & 63; KCB[(size_t)bg * 512 * 64 + nsa_koff(511, n)] = 0; VCT[(size_t)bg * 512 * 64 + nsa_voff(511, n)] = 0; }
    }
    xcd_barrier(xb);

    {
        float* impL = (float*)smem + wave * 1024;
        int* sidxL = (int*)(impL + 512);
        const bf16_t* KS = KV6 + 2ull * 16384 * 128; const bf16_t* VST = KV6 + 3ull * 16384 * 128;
        const bf16_t* KW = KV6 + 4ull * 16384 * 128; const bf16_t* VWT = KV6 + 5ull * 16384 * 128;
        const int c = lane & 15, h = lane >> 4, tokc = c >> 2, headc = c & 3;
        const int rk = 8 * (c >> 2) + (c & 3), dh = 8 * h;
      for (int pass = 0; pass < 2; ++pass) {
        for (int task = bid * 8 + wave; task < 8192; task += nb * 8) {
            const int bg = task >> 11, q4 = task & 2047, b = bg >> 1, g = bg & 1, t0 = q4 * 4;
            const int tcol = t0 + tokc; const size_t bt0 = (size_t)b * 8192 + t0;
            bf16x8 qf[2];
            { const bf16_t* qp = Q + (bt0 + tokc) * 512 + g * 256 + headc * 64 + dh; qf[0] = *(const bf16x8*)qp; qf[1] = *(const bf16x8*)(qp + 32); }
            const float* gp = GATES + (bt0 + tokc) * 24 + (g * 4 + headc) * 3;
            const float gate0 = gp[0], gate1 = gp[1], gate2 = gp[2];
            f32x4 comb[4];
#pragma unroll
            for (int dt = 0; dt < 4; ++dt) comb[dt] = (f32x4){0.f, 0.f, 0.f, 0.f};
            if (pass == 1) {
            {
                const int ncvc = tcol >= 31 ? ((tcol - 31) >> 4) + 1 : 0;
                const int ncvmax = (t0 + 3) >= 31 ? ((t0 + 3 - 31) >> 4) + 1 : 0;
                const int nch = (ncvmax + 31) >> 5;
                const bf16_t* Kc = KCB + (size_t)bg * 512 * 64; const bf16_t* Vc = VCT + (size_t)bg * 64 * 512;
                NsaSt st; nsa_init(st);
                {
                    auto ld = [&](NsaBuf& bf, int i) { nsa_load_kf(bf.ka, Kc, i, lane); };
                    auto cp = [&](NsaBuf& bf, int i) { float sv[8]; nsa_scores(bf.ka, qf, sv); nsa_chunk<false>(st, sv, i * 32 + dh, 0, ncvc - 1, bf.va); };
                    nsa_stream2(nch, ld, cp);
                }
                float l = st.l; l += __shfl_xor(l, 16); l += __shfl_xor(l, 32);
                const float inv = 1.0f / fmaxf(l, 1e-30f), mfin = st.m;
                *(float4*)(impL + lane * 8) = make_float4(0.f, 0.f, 0.f, 0.f); *(float4*)(impL + lane * 8 + 4) = make_float4(0.f, 0.f, 0.f, 0.f);
                lds_fence();
                f32x4 oc[4];
#pragma unroll
                for (int dt = 0; dt < 4; ++dt) oc[dt] = (f32x4){0.f, 0.f, 0.f, 0.f};
                float carry = 0.f;
                {
                    auto ld = [&](NsaBuf& bf, int i) { nsa_load_kf(bf.ka, Kc, i, lane); nsa_load_kf(bf.va, Vc, i, lane); };
                    auto cp = [&](NsaBuf& bf, int ch) {
                        float sv[8]; nsa_scores(bf.ka, qf, sv);
                        float p[8];
#pragma unroll
                        for (int j = 0; j < 8; ++j) p[j] = (ch * 32 + dh + j < ncvc) ? __builtin_amdgcn_exp2f(sv[j] - mfin) * inv : 0.f;
                        const float up = __shfl(p[7], (lane + 48) & 63);
                        const float prev7 = (h >= 1) ? up : carry; carry = up;
                        float i0 = p[0] + p[1] + p[2] + 0.5f * p[3] + 0.5f * prev7, i1 = p[4] + p[5] + p[6] + 0.5f * p[7] + 0.5f * p[3];
                        i0 += __shfl_xor(i0, 1); i0 += __shfl_xor(i0, 2); i1 += __shfl_xor(i1, 1); i1 += __shfl_xor(i1, 2);
                        if (headc == 0) { impL[tokc * 128 + 8 * ch + 2 * h] = i0; impL[tokc * 128 + 8 * ch + 2 * h + 1] = i1; }
                        const bf16x8 pb = pack8(p);
#pragma unroll
                        for (int dt = 0; dt < 4; ++dt) oc[dt] = __builtin_amdgcn_mfma_f32_16x16x32_bf16(bf.va[dt], pb, oc[dt], 0, 0, 0);
                    };
                    nsa_stream2(nch, ld, cp);
                }
#pragma unroll
                for (int dt = 0; dt < 4; ++dt) comb[dt] += oc[dt] * gate0;
            }
            lds_fence();
            int nblk;
            {
                const int tok = lane >> 4, sub = lane & 15, cur = t0 >> 6;
                float sc[8];
#pragma unroll
                for (int e = 0; e < 8; ++e) { const int j = sub + 16 * e; const float imp = impL[tok * 128 + j];
                    const bool al = j <= cur, fo = (j == 0) || (j == cur) || (j == cur - 1);
                    sc[e] = (fo && al) ? 1e4f : (al ? imp : -1e30f); }
                float myv = -1e30f; int myi = 0;
#pragma unroll 1
                for (int it = 0; it < 16; ++it) {
                    float bv = sc[0]; int bi = sub;
#pragma unroll
                    for (int e = 1; e < 8; ++e) if (sc[e] > bv) { bv = sc[e]; bi = sub + 16 * e; }
#pragma unroll
                    for (int o = 1; o < 16; o <<= 1) { const float ov = __shfl_xor(bv, o); const int oi = __shfl_xor(bi, o);
                        const bool take = (ov > bv) || (ov == bv && oi < bi); bv = take ? ov : bv; bi = take ? oi : bi; }
                    if (sub == it) { myv = bv; myi = bi; }
#pragma unroll
                    for (int e = 0; e < 8; ++e) if (bi == sub + 16 * e) sc[e] = -INFINITY;
                }
                const bool forced = myv > 5e3f;
                const bool keep = (myv > -0.5e30f) && !(forced && tok > 0);
                const unsigned long long bal = __ballot(keep);
                const int pos = __popcll(bal & ((1ull << lane) - 1ull));
                lds_fence();
                if (keep) sidxL[pos] = ((forced ? 7 : tok) << 16) | myi;
                nblk = __popcll(bal);
            }
            lds_fence();
            {
                NsaSt st; nsa_init(st);
                const bf16_t* Kp = KS + (size_t)bg * 8192 * 64; const bf16_t* Vp = VST + (size_t)bg * 8192 * 64;
                auto ld = [&](NsaBuf& bf, int i) { const int e = __builtin_amdgcn_readfirstlane(sidxL[i >> 1]); const int kb = (e & 0xffff) * 64 + (i & 1) * 32;
                    nsa_load_kf(bf.ka, Kp, kb >> 5, lane); nsa_load_kf(bf.va, Vp, kb >> 5, lane); };
                auto cp = [&](NsaBuf& bf, int i) { const int e = __builtin_amdgcn_readfirstlane(sidxL[i >> 1]); const int kb = (e & 0xffff) * 64 + (i & 1) * 32, ow = e >> 16;
                    const int hi = (ow == 7 || ow == tokc) ? tcol : -1;
                    float sv[8]; nsa_scores(bf.ka, qf, sv); nsa_chunk<true>(st, sv, kb + dh, 0, hi, bf.va); };
                nsa_stream(2 * nblk, ld, cp);
                nsa_fold(comb, st, gate1);
            }
            {
                const bf16_t* op = ONSA + (bt0 + tokc) * 512 + g * 256 + headc * 64 + 4 * h;
#pragma unroll
                for (int dt = 0; dt < 4; ++dt) { const uint2 w = *(const uint2*)(op + dt * 16);
                    comb[dt][0] += __uint_as_float(w.x << 16); comb[dt][1] += __uint_as_float(w.x & 0xffff0000u); comb[dt][2] += __uint_as_float(w.y << 16); comb[dt][3] += __uint_as_float(w.y & 0xffff0000u); }
            }
            } else {
            {
                NsaSt st; nsa_init(st);
                const bf16_t* Kp = KW + (size_t)bg * 8192 * 64; const bf16_t* Vp = VWT + (size_t)bg * 8192 * 64;
                const int kbf = (t0 > 511 ? t0 - 511 : 0) & ~31, kbl = (t0 + 3) & ~31;
                const int lo = tcol > 511 ? tcol - 511 : 0;
                auto ld = [&](NsaBuf& bf, int i) { const int kb = kbf + i * 32; nsa_load_kf(bf.ka, Kp, kb >> 5, lane); nsa_load_kf(bf.va, Vp, kb >> 5, lane); };
                auto cp = [&](NsaBuf& bf, int i) { const int kb = kbf + i * 32; float sv[8]; nsa_scores(bf.ka, qf, sv); nsa_chunk<true>(st, sv, kb + dh, lo, tcol, bf.va); };
                nsa_stream2(((kbl - kbf) >> 5) + 1, ld, cp);
                nsa_fold(comb, st, gate2);
            }
            }
            {
                bf16_t* op = ONSA + (bt0 + tokc) * 512 + g * 256 + headc * 64 + 4 * h;
#pragma unroll
                for (int dt = 0; dt < 4; ++dt) store_bf16x4(op + dt * 16, comb[dt][0], comb[dt][1], comb[dt][2], comb[dt][3]);
            }
            lds_fence();
        }
        if (pass == 0) xcd_barrier(xb);
      }
    }
    xcd_barrier(xb);

    {
        bf16_t* As = (bf16_t*)smem; bf16_t* Bs = As + 128 * G_LD;
        const int wm = wave >> 2, wn = wave & 3;
        for (int tl = bid; tl < 128 * 8; tl += nb) {
            const int mt = tl >> 3, nt = tl & 7;
            f32x4 a1[4][2], a2[4][2];
#pragma unroll
            for (int i = 0; i < 4; ++i)
#pragma unroll
                for (int j = 0; j < 2; ++j) { a1[i][j] = (f32x4){0.f, 0.f, 0.f, 0.f}; a2[i][j] = (f32x4){0.f, 0.f, 0.f, 0.f}; }
            gemm_tile(a1, RowMajorA{ONSA, 512}, mt * 128, WNSA + (size_t)nt * 128 * 512, 512, 512, As, Bs);
            gemm_tile(a2, RowMajorA{OGM, 512}, mt * 128, WGM + (size_t)nt * 128 * 512, 512, 512, As, Bs);
#pragma unroll
            for (int i = 0; i < 4; ++i)
#pragma unroll
                for (int j = 0; j < 2; ++j) {
                    const int r = mt * 128 + wm * 64 + i * 16 + (lane & 15), c = nt * 128 + wn * 32 + j * 16 + (lane >> 4) * 4;
                    float m0[8], m1[8];
                    const uint2 w0 = *(const uint2*)(MG + (size_t)r * 2048 + c), w1 = *(const uint2*)(MG + (size_t)r * 2048 + 1024 + c);
                    m0[0] = __uint_as_float(w0.x << 16); m0[1] = __uint_as_float(w0.x & 0xffff0000u); m0[2] = __uint_as_float(w0.y << 16); m0[3] = __uint_as_float(w0.y & 0xffff0000u);
                    m1[0] = __uint_as_float(w1.x << 16); m1[1] = __uint_as_float(w1.x & 0xffff0000u); m1[2] = __uint_as_float(w1.y << 16); m1[3] = __uint_as_float(w1.y & 0xffff0000u);
                    store_bf16x4(Y + (size_t)r * 1024 + c, m0[0] * a1[i][j][0] + m1[0] * a2[i][j][0], m0[1] * a1[i][j][1] + m1[1] * a2[i][j][1],
                                 m0[2] * a1[i][j][2] + m1[2] * a2[i][j][2], m0[3] * a1[i][j][3] + m1[3] * a2[i][j][3]);
                }
        }
    }
    xcd_barrier(xb);

    {
        auto epi = [&](int r, int c, const f32x4& v) { const float4 xv = *(const float4*)(p.x + (size_t)r * 1024 + c);
            *(float4*)(OUT + (size_t)r * 1024 + c) = make_float4(xv.x + v[0], xv.y + v[1], xv.z + v[2], xv.w + v[3]); };
        gemm_run(RowMajorA{Y, 1024}, WMIX, 1024, 128, 8, epi, smem, bid, nb);
    }
    xcd_barrier(xb);

    for (int r = bid * 8 + wave; r < 16384; r += nb * 8) rmsnorm_row_bf16(OUT + (size_t)r * 1024, p.g_xattn, HN + (size_t)r * 1024, lane);
    xcd_barrier(xb);

    {
        auto epi = [&](int r, int c, const f32x4& v) { store_bf16x4(QX + (size_t)r * 1024 + c, v[0] * 0.0625f, v[1] * 0.0625f, v[2] * 0.0625f, v[3] * 0.0625f); };
        gemm_run(RowMajorA{HN, 1024}, WXQ, 1024, 128, 8, epi, smem, bid, nb);
    }
    xcd_barrier(xb);

    {
        const int c = lane & 15, hg = lane >> 4, rk = 8 * (c >> 2) + (c & 3);
        for (int task = bid * 8 + wave; task < 4096; task += nb * 8) {
            const int h = task & 3, tgrp = task >> 2, b = tgrp >> 9; const size_t bt0 = (size_t)tgrp * 16;
            bf16x8 qf[8];
#pragma unroll
            for (int ks = 0; ks < 8; ++ks) qf[ks] = *(const bf16x8*)(QX + (bt0 + c) * 1024 + h * 256 + ks * 32 + 8 * hg);
            const bf16_t* Kp = KVX + (size_t)(b * 4 + h) * 65536; const bf16_t* Vp = VXT + (size_t)(b * 4 + h) * 65536;
            float m = -1e30f, l = 0.f; f32x4 o[16];
#pragma unroll
            for (int dt = 0; dt < 16; ++dt) o[dt] = (f32x4){0.f, 0.f, 0.f, 0.f};
#pragma unroll 1
            for (int ch = 0; ch < 8; ++ch) {
                const int kb = ch * 32;
                const bf16_t* k0 = Kp + ((ch * 16) * 64 + lane) * 8; const bf16_t* k1 = k0 + 8 * 64 * 8;
                f32x4 s0 = {0.f, 0.f, 0.f, 0.f}, s1 = {0.f, 0.f, 0.f, 0.f};
#pragma unroll
                for (int ks = 0; ks < 8; ++ks) {
                    const bf16x8 a0 = *(const bf16x8*)(k0 + ks * 512), a1 = *(const bf16x8*)(k1 + ks * 512);
                    s0 = __builtin_amdgcn_mfma_f32_16x16x32_bf16(a0, qf[ks], s0, 0, 0, 0); s1 = __builtin_amdgcn_mfma_f32_16x16x32_bf16(a1, qf[ks], s1, 0, 0, 0);
                }
                float sv[8] = {s0[0], s0[1], s0[2], s0[3], s1[0], s1[1], s1[2], s1[3]};
                float cm = sv[0];
#pragma unroll
                for (int j = 1; j < 8; ++j) cm = fmaxf(cm, sv[j]);
                cm = fmaxf(cm, __shfl_xor(cm, 16)); cm = fmaxf(cm, __shfl_xor(cm, 32));
                if (__any(cm > m)) { const float mn = fmaxf(m, cm), sc = __expf(m - mn); l *= sc;
#pragma unroll
                    for (int dt = 0; dt < 16; ++dt) o[dt] *= sc;
                    m = mn; }
                float p[8]; float ps = 0.f;
#pragma unroll
                for (int j = 0; j < 8; ++j) { p[j] = __expf(sv[j] - m); ps += p[j]; }
                l += ps;
                const bf16x8 pb = pack8(p);
#pragma unroll
                for (int dt = 0; dt < 16; ++dt) { const bf16x8 va = *(const bf16x8*)(Vp + ((ch * 16 + dt) * 64 + lane) * 8);
                    o[dt] = __builtin_amdgcn_mfma_f32_16x16x32_bf16(va, pb, o[dt], 0, 0, 0); }
            }
            l += __shfl_xor(l, 16); l += __shfl_xor(l, 32);
            const float inv = 1.0f / l;
            bf16_t* op = OX + (bt0 + c) * 1024 + h * 256 + 4 * hg;
#pragma unroll
            for (int dt = 0; dt < 16; ++dt) store_bf16x4(op + dt * 16, o[dt][0] * inv, o[dt][1] * inv, o[dt][2] * inv, o[dt][3] * inv);
        }
    }
    xcd_barrier(xb);

    {
        auto epi = [&](int r, int c, const f32x4& v) { float4* hp = (float4*)(OUT + (size_t)r * 1024 + c); const float4 hv = *hp;
            *hp = make_float4(hv.x + v[0], hv.y + v[1], hv.z + v[2], hv.w + v[3]); };
        gemm_run(RowMajorA{OX, 1024}, WXO, 1024, 128, 8, epi, smem, bid, nb);
    }
    xcd_barrier(xb);

    for (int r = bid * 8 + wave; r < 16384; r += nb * 8) rmsnorm_row_bf16(OUT + (size_t)r * 1024, p.g_peer, HN + (size_t)r * 1024, lane);
    {
        for (size_t i = (size_t)bid * NTHREADS + tid; i < 2ull * 16384 * 1024 / 8; i += (size_t)nb * NTHREADS) {
            const bool isv = i >= 16384ull * 1024 / 8; const size_t j = isv ? i - 16384ull * 1024 / 8 : i;
            const float* src = (isv ? p.peer_v : p.peer_u) + j * 8;
            const float4 a = *(const float4*)src, b = *(const float4*)(src + 4);
            uint4 w; w.x = (unsigned)f2bf(a.x) | ((unsigned)f2bf(a.y) << 16); w.y = (unsigned)f2bf(a.z) | ((unsigned)f2bf(a.w) << 16);
            w.z = (unsigned)f2bf(b.x) | ((unsigned)f2bf(b.y) << 16); w.w = (unsigned)f2bf(b.z) | ((unsigned)f2bf(b.w) << 16);
            *(uint4*)((isv ? PVB : PUB) + j * 8) = w;
        }
    }
    xcd_barrier(xb);

    {
        auto epi = [&](int r, int c, const f32x4& v) { store_bf16x4(QP + (size_t)r * 2048 + c, v[0], v[1], v[2], v[3]); };
        gemm_run(RowMajorA{HN, 1024}, WPQ, 1024, 128, 16, epi, smem, bid, nb);
    }
    xcd_barrier(xb);

    {
        const int c = lane & 15, hg = lane >> 4;
        for (int task = bid * 8 + wave; task < 16384; task += nb * 8) {
            const int hp = task & 15, tgrp = task >> 4; const size_t bt0 = (size_t)tgrp * 16;
            bf16x8 qf[4];
#pragma unroll
            for (int ks = 0; ks < 4; ++ks) qf[ks] = *(const bf16x8*)(QP + (bt0 + c) * 2048 + hp * 128 + ks * 32 + 8 * hg);
            const bf16_t* Kp = SUBK + (size_t)hp * 16384 + lane * 8;
            float sc[32];
#pragma unroll
            for (int kt = 0; kt < 8; ++kt) {
                f32x4 a = {0.f, 0.f, 0.f, 0.f};
#pragma unroll
                for (int ks = 0; ks < 4; ++ks) a = __builtin_amdgcn_mfma_f32_16x16x32_bf16(*(const bf16x8*)(Kp + (kt * 4 + ks) * 512), qf[ks], a, 0, 0, 0);
                sc[kt * 4 + 0] = a[0]; sc[kt * 4 + 1] = a[1]; sc[kt * 4 + 2] = a[2]; sc[kt * 4 + 3] = a[3];
            }
            float* hsp = HS + (bt0 + c) * 256 + hp * 16; int* hip_ = HI + (bt0 + c) * 256 + hp * 16;
#pragma unroll 1
            for (int it = 0; it < 16; ++it) {
                float bv = sc[0]; int be = 0;
#pragma unroll
                for (int e = 1; e < 32; ++e) if (sc[e] > bv) { bv = sc[e]; be = e; }
                int key = (be >> 2) * 16 + 4 * hg + (be & 3);
#pragma unroll
                for (int o = 16; o < 64; o <<= 1) { const float ov = __shfl_xor(bv, o); const int ok = __shfl_xor(key, o);
                    const bool take = (ov > bv) || (ov == bv && ok < key); bv = take ? ov : bv; key = take ? ok : key; }
                if (hg == 0) { hsp[it] = bv; hip_[it] = key; }
                const int ew = (((key >> 2) & 3) == hg) ? ((key >> 4) * 4 + (key & 3)) : -1;
#pragma unroll
                for (int e = 0; e < 32; ++e) if (e == ew) sc[e] = -INFINITY;
            }
        }
    }
    xcd_barrier(xb);

    {
        int* exl = (int*)smem + wave * 256; float* gtl = (float*)(exl + 128);
        for (int tok = bid * 8 + wave; tok < 16384; tok += nb * 8) {
#pragma unroll 1
            for (int hh = 0; hh < 2; ++hh) {
                const int head = hh * 4 + (lane >> 4), i = lane & 15, gb = lane & 48;
                const float* s0p = HS + (size_t)tok * 256 + (2 * head) * 16;
                const float s0i = s0p[i], s1m = s0p[16 + i];
                int pj = 0; float myv = 0.f; int myf = 0;
#pragma unroll 1
                for (int it = 0; it < 16; ++it) {
                    const float s1v = __shfl(s1m, gb + (pj & 15));
                    float bv = pj < 16 ? s0i + s1v : -INFINITY; int bf = i * 16 + pj;
#pragma unroll
                    for (int o = 1; o < 16; o <<= 1) { const float ov = __shfl_xor(bv, o); const int of = __shfl_xor(bf, o);
                        const bool take = (ov > bv) || (ov == bv && of < bf); bv = take ? ov : bv; bf = take ? of : bf; }
                    if (i == it) { myv = bv; myf = bf; }
                    if ((bf >> 4) == i) ++pj;
                }
                const float vmax = __shfl(myv, gb);
                const float e = expf(myv - vmax);
                float se = e;
#pragma unroll
                for (int o = 1; o < 16; o <<= 1) se += __shfl_xor(se, o);
                const int* i0p = HI + (size_t)tok * 256 + (2 * head) * 16;
                exl[head * 16 + i] = i0p[myf >> 4] * 128 + i0p[16 + (myf & 15)];
                gtl[head * 16 + i] = e / se;
            }
            lds_fence();
            float xv[2][8];
#pragma unroll
            for (int i = 0; i < 2; ++i) load8(HN + (size_t)tok * 1024 + i * 512 + lane * 8, xv[i]);
#pragma unroll 1
            for (int e0 = 0; e0 < 128; e0 += 8) {
                uint4 ur[8][2];
#pragma unroll
                for (int q = 0; q < 8; ++q) { const bf16_t* up = PUB + (size_t)exl[e0 + q] * 1024 + lane * 8; ur[q][0] = *(const uint4*)up; ur[q][1] = *(const uint4*)(up + 512); }
                float dsum[8];
#pragma unroll
                for (int q = 0; q < 8; ++q) {
                    float d = 0.f;
#pragma unroll
                    for (int i = 0; i < 2; ++i) { const uint4 a = ur[q][i];
                        d += __uint_as_float(a.x << 16) * xv[i][0] + __uint_as_float(a.x & 0xffff0000u) * xv[i][1] + __uint_as_float(a.y << 16) * xv[i][2] + __uint_as_float(a.y & 0xffff0000u) * xv[i][3]
                           + __uint_as_float(a.z << 16) * xv[i][4] + __uint_as_float(a.z & 0xffff0000u) * xv[i][5] + __uint_as_float(a.w << 16) * xv[i][6] + __uint_as_float(a.w & 0xffff0000u) * xv[i][7]; }
                    dsum[q] = d;
                }
#pragma unroll
                for (int q = 0; q < 8; ++q) { const float d = wave_sum(dsum[q]); if (lane == 0) gtl[e0 + q] = gtl[e0 + q] * gelu_f(d); }
            }
            lds_fence();
            float ac[2][8];
#pragma unroll
            for (int i = 0; i < 2; ++i)
#pragma unroll
                for (int e = 0; e < 8; ++e) ac[i][e] = 0.f;
#pragma unroll 1
            for (int e0 = 0; e0 < 128; e0 += 8) {
                uint4 vr[8][2];
#pragma unroll
                for (int q = 0; q < 8; ++q) { const bf16_t* vp = PVB + (size_t)exl[e0 + q] * 1024 + lane * 8; vr[q][0] = *(const uint4*)vp; vr[q][1] = *(const uint4*)(vp + 512); }
#pragma unroll
                for (int q = 0; q < 8; ++q) { const float cf = gtl[e0 + q];
#pragma unroll
                    for (int i = 0; i < 2; ++i) { const uint4 a = vr[q][i];
                        ac[i][0] += cf * __uint_as_float(a.x << 16); ac[i][1] += cf * __uint_as_float(a.x & 0xffff0000u); ac[i][2] += cf * __uint_as_float(a.y << 16); ac[i][3] += cf * __uint_as_float(a.y & 0xffff0000u);
                        ac[i][4] += cf * __uint_as_float(a.z << 16); ac[i][5] += cf * __uint_as_float(a.z & 0xffff0000u); ac[i][6] += cf * __uint_as_float(a.w << 16); ac[i][7] += cf * __uint_as_float(a.w & 0xffff0000u); }
                }
            }
            float ss = 0.f;
#pragma unroll
            for (int i = 0; i < 2; ++i) { float hv[8]; load8(OUT + (size_t)tok * 1024 + i * 512 + lane * 8, hv);
#pragma unroll
                for (int e = 0; e < 8; ++e) { ac[i][e] += hv[e]; ss += ac[i][e] * ac[i][e]; } }
            ss = wave_sum(ss);
            const float rr = rsqrtf(ss * (1.0f / 1024.0f) + 1e-6f);
#pragma unroll
            for (int i = 0; i < 2; ++i) { float gg[8]; load8(p.g_final + i * 512 + lane * 8, gg);
                float* op = OUT + (size_t)tok * 1024 + i * 512 + lane * 8;
                *(float4*)op = make_float4(ac[i][0] * rr * gg[0], ac[i][1] * rr * gg[1], ac[i][2] * rr * gg[2], ac[i][3] * rr * gg[3]);
                *(float4*)(op + 4) = make_float4(ac[i][4] * rr * gg[4], ac[i][5] * rr * gg[5], ac[i][6] * rr * gg[6], ac[i][7] * rr * gg[7]); }
            lds_fence();
        }
    }
}

extern "C" void kernel_launch(void* const* d_in, const int* in_sizes, int n_in, void* d_out, int out_size, void* d_ws, size_t ws_size, hipStream_t stream) {
    static int grid_blocks = 0;
    if (grid_blocks == 0) {
        int dev = 0, cus = 0, per_cu = 0;
        hipGetDevice(&dev);
        hipDeviceGetAttribute(&cus, hipDeviceAttributeMultiprocessorCount, dev);
        if (hipFuncSetAttribute((const void*)fwd_mega, hipFuncAttributeMaxDynamicSharedMemorySize, LDS_BYTES) != hipSuccess) { fprintf(stderr, "hipFuncSetAttribute failed\n"); }
        if (hipOccupancyMaxActiveBlocksPerMultiprocessor(&per_cu, (const void*)fwd_mega, NTHREADS, LDS_BYTES) != hipSuccess || per_cu < 1) { fprintf(stderr, "occupancy query failed (%d)\n", per_cu); per_cu = 1; }
        (void)hipGetLastError();
        if (per_cu > 1) per_cu = 1;
        grid_blocks = cus * per_cu;
        if (ws_size < O_END) { fprintf(stderr, "workspace too small: %zu < %zu\n", ws_size, (size_t)O_END); grid_blocks = -1; }
    }
    if (grid_blocks < 0) return;
    Params p{};
    const float** pp = (const float**)&p;
    for (int i = 0; i < 30; ++i) pp[i] = (const float*)d_in[i];
    p.out = (float*)d_out; p.ws = (unsigned char*)d_ws;
    if (hipMemsetAsync((char*)d_ws + O_BAR, 0, 16384, stream) != hipSuccess) { fprintf(stderr, "memset of barrier words failed\n"); return; }
    void* args[] = {&p};
    hipError_t e = hipLaunchCooperativeKernel((const void*)fwd_mega, dim3(grid_blocks), dim3(NTHREADS), args, LDS_BYTES, stream);
    if (e != hipSuccess) fprintf(stderr, "cooperative launch failed: %s (grid %d)\n", hipGetErrorString(e), grid_blocks);
}
```

```cpp
#include <hip/hip_runtime.h>
#include <cstdio>
#include <cstdint>

typedef unsigned short bf16_t;
typedef short bf16x8 __attribute__((ext_vector_type(8)));
typedef float f32x4 __attribute__((ext_vector_type(4)));
#define DEVI __device__ __forceinline__

constexpr int NTHREADS = 512;
constexpr int LDS_BYTES = 140 * 1024;

constexpr size_t O_BAR  = 0;
constexpr size_t O_WIN  = 16384;
constexpr size_t O_W1K  = O_WIN  + 4480ull * 1024 * 2;
constexpr size_t O_W1V  = O_W1K  + 256ull * 2048 * 2;
constexpr size_t O_WNSA = O_W1V  + 256ull * 2048 * 2;
constexpr size_t O_WGM  = O_WNSA + 1024ull * 512 * 2;
constexpr size_t O_WMIX = O_WGM  + 1024ull * 512 * 2;
constexpr size_t O_WXQ  = O_WMIX + 1024ull * 1024 * 2;
constexpr size_t O_WXKV = O_WXQ  + 1024ull * 1024 * 2;
constexpr size_t O_WXO  = O_WXKV + 2048ull * 1024 * 2;
constexpr size_t O_WPQ  = O_WXO  + 1024ull * 1024 * 2;
constexpr size_t O_B1   = O_WPQ  + 2048ull * 1024 * 2;
constexpr size_t O_VXT  = O_B1   + 2048;
constexpr size_t O_SUBK = O_VXT  + 8ull * 256 * 256 * 2;
constexpr size_t O_PSC  = O_SUBK + 16ull * 128 * 128 * 2;
constexpr size_t O_HN   = O_PSC  + 2ull * 16384 * 4;
constexpr size_t O_MN   = O_HN   + 16384ull * 1024 * 2;
constexpr size_t O_KVX  = O_MN   + 512ull * 1024 * 2;
constexpr size_t O_GATES= O_KVX  + 512ull * 2048 * 2;
constexpr size_t O_HID  = O_GATES+ 16384ull * 24 * 4;
constexpr size_t O_CMP  = O_HID  + 2ull * 2048 * 256 * 4;
constexpr size_t O_Q    = O_CMP  + 2ull * 4 * 512 * 64 * 4;
constexpr size_t O_KV6  = O_Q    + 16384ull * 512 * 2;
constexpr size_t O_U    = O_KV6  + 6ull * 16384 * 128 * 2;
constexpr size_t O_VG   = O_U    + 16384ull * 512 * 2;
constexpr size_t O_MG   = O_VG   + 16384ull * 512 * 2;
constexpr size_t O_ONSA = O_MG   + 16384ull * 2048 * 2;
constexpr size_t O_OGM  = O_ONSA + 16384ull * 512 * 2;
constexpr size_t O_END  = O_OGM  + 16384ull * 512 * 2;
constexpr size_t O_Y    = O_Q;
constexpr size_t O_QX   = O_U;
constexpr size_t O_OX   = O_ONSA;
constexpr size_t O_QP   = O_MG;
constexpr size_t O_HS   = O_Q;
constexpr size_t O_HI   = O_Q + 16384ull * 256 * 4;
constexpr size_t O_EX   = O_U;
static_assert(O_END <= 256ull * 1024 * 1024, "workspace too large");

struct Params {
    const float *x, *mem, *g_mix, *w_in, *pe_k, *w1_k, *b1_k, *w2_k, *pe_v, *w1_v, *b1_v, *w2_v, *ln_g, *ln_b, *gws, *gbs,
        *w_nsa_out, *w_gmlp_out, *w_mix_out, *g_xattn, *g_mem, *w_xq, *w_xkv, *w_xo, *g_peer, *w_peer_q, *sub_keys, *peer_u, *peer_v, *g_final;
    float* out;
    unsigned char* ws;
};

DEVI bf16_t f2bf(float f) { unsigned u = __float_as_uint(f); u += 0x7fffu + ((u >> 16) & 1u); return (bf16_t)(u >> 16); }
DEVI float bf2f(bf16_t h) { return __uint_as_float(((unsigned)h) << 16); }
DEVI float tof(float v) { return v; }
DEVI float tof(bf16_t v) { return bf2f(v); }
DEVI float wave_sum(float v) { for (int o = 32; o > 0; o >>= 1) v += __shfl_xor(v, o); return v; }
DEVI float wave_max(float v) { for (int o = 32; o > 0; o >>= 1) v = fmaxf(v, __shfl_xor(v, o)); return v; }
DEVI float gelu_f(float x) { return 0.5f * x * (1.0f + erff(x * 0.70710678118654752f)); }
DEVI float sigmoid_f(float x) { return 1.0f / (1.0f + expf(-x)); }
DEVI void wave_argmax(float& v, int& idx) {
    for (int o = 32; o > 0; o >>= 1) {
        const float ov = __shfl_xor(v, o); const int oi = __shfl_xor(idx, o);
        const bool take = (ov > v) || (ov == v && oi < idx);
        v = take ? ov : v; idx = take ? oi : idx;
    }
}
typedef unsigned u32x4 __attribute__((ext_vector_type(4)));
DEVI unsigned cvt_pk_bf16(float lo, float hi) { unsigned r; asm("v_cvt_pk_bf16_f32 %0, %1, %2" : "=v"(r) : "v"(lo), "v"(hi)); return r; }
DEVI bf16x8 pack8(const float (&p)[8]) { u32x4 u; u.x = cvt_pk_bf16(p[0], p[1]); u.y = cvt_pk_bf16(p[2], p[3]); u.z = cvt_pk_bf16(p[4], p[5]); u.w = cvt_pk_bf16(p[6], p[7]); return __builtin_bit_cast(bf16x8, u); }
DEVI void lds_fence() { asm volatile("s_waitcnt lgkmcnt(0)" ::: "memory"); }
DEVI void load8(const float* p, float (&f)[8]) { const float4 a = *(const float4*)p, b = *(const float4*)(p + 4); f[0]=a.x; f[1]=a.y; f[2]=a.z; f[3]=a.w; f[4]=b.x; f[5]=b.y; f[6]=b.z; f[7]=b.w; }
DEVI void load8(const bf16_t* p, float (&f)[8]) { const uint4 a = *(const uint4*)p;
    f[0] = __uint_as_float(a.x << 16); f[1] = __uint_as_float(a.x & 0xffff0000u); f[2] = __uint_as_float(a.y << 16); f[3] = __uint_as_float(a.y & 0xffff0000u);
    f[4] = __uint_as_float(a.z << 16); f[5] = __uint_as_float(a.z & 0xffff0000u); f[6] = __uint_as_float(a.w << 16); f[7] = __uint_as_float(a.w & 0xffff0000u); }

template <class CMap>
DEVI void transpose_tile(const float* src, int srcN, bf16_t* dst, int K, int tl, CMap cmap, float* tile) {
    const int nkt = K / 64, kt = tl % nkt, nt = tl / nkt, k0 = kt * 64, n0 = nt * 64;
    const int tx = threadIdx.x & 63, ty = threadIdx.x >> 6;
    const int sc = cmap(n0 + tx);
#pragma unroll
    for (int i = 0; i < 8; ++i) { const int k = k0 + ty + 8 * i; tile[(ty + 8 * i) * 65 + tx] = sc >= 0 ? src[(size_t)k * srcN + sc] : 0.f; }
    __syncthreads();
#pragma unroll
    for (int i = 0; i < 8; ++i) { const int n = n0 + ty + 8 * i; dst[(size_t)n * K + k0 + tx] = f2bf(tile[tx * 65 + ty + 8 * i]); }
    __syncthreads();
}
struct IdMap { DEVI int operator()(int n) const { return n; } };
struct WinMap { DEVI int operator()(int n) const { return n < 1280 ? n : (n < 4352 ? n + 24 : (n < 4376 ? n - 4352 + 1280 : -1)); } };

DEVI void rmsnorm_row_bf16(const float* xrow, const float* g, bf16_t* dst, int lane) {
    float4 v[4]; float ss = 0.f;
#pragma unroll
    for (int i = 0; i < 4; ++i) { v[i] = ((const float4*)xrow)[lane + 64 * i]; ss += v[i].x * v[i].x + v[i].y * v[i].y + v[i].z * v[i].z + v[i].w * v[i].w; }
    ss = wave_sum(ss);
    const float r = rsqrtf(ss * (1.0f / 1024.0f) + 1e-6f);
#pragma unroll
    for (int i = 0; i < 4; ++i) {
        const float4 gg = ((const float4*)g)[lane + 64 * i];
        uint2 w; w.x = (unsigned)f2bf(v[i].x * r * gg.x) | ((unsigned)f2bf(v[i].y * r * gg.y) << 16); w.y = (unsigned)f2bf(v[i].z * r * gg.z) | ((unsigned)f2bf(v[i].w * r * gg.w) << 16);
        ((uint2*)dst)[lane + 64 * i] = w;
    }
}

constexpr int G_LD = 72;
template <class AF>
DEVI void gemm_tile(f32x4 (&acc)[4][2], AF af, int m0, const bf16_t* Bt, int ldb, int K, bf16_t* As, bf16_t* Bs) {
    const int tid = threadIdx.x, lane = tid & 63, wave = tid >> 6, wm = wave >> 2, wn = wave & 3;
    const int r0 = tid >> 3, kc = (tid & 7) * 8;
    uint4 ra0, ra1, rb0, rb1;
    ra0 = *(const uint4*)af(m0 + r0, kc); ra1 = *(const uint4*)af(m0 + r0 + 64, kc);
    rb0 = *(const uint4*)(Bt + (size_t)r0 * ldb + kc); rb1 = *(const uint4*)(Bt + (size_t)(r0 + 64) * ldb + kc);
    for (int k0 = 0; k0 < K; k0 += 64) {
        __syncthreads();
        *(uint4*)(As + r0 * G_LD + kc) = ra0; *(uint4*)(As + (r0 + 64) * G_LD + kc) = ra1;
        *(uint4*)(Bs + r0 * G_LD + kc) = rb0; *(uint4*)(Bs + (r0 + 64) * G_LD + kc) = rb1;
        __syncthreads();
        if (k0 + 64 < K) {
            const int kn = k0 + 64 + kc;
            ra0 = *(const uint4*)af(m0 + r0, kn); ra1 = *(const uint4*)af(m0 + r0 + 64, kn);
            rb0 = *(const uint4*)(Bt + (size_t)r0 * ldb + kn); rb1 = *(const uint4*)(Bt + (size_t)(r0 + 64) * ldb + kn);
        }
#pragma unroll
        for (int ks = 0; ks < 2; ++ks) {
            bf16x8 af_[4], bf_[2];
#pragma unroll
            for (int i = 0; i < 4; ++i) af_[i] = *(const bf16x8*)(As + (wm * 64 + i * 16 + (lane & 15)) * G_LD + ks * 32 + (lane >> 4) * 8);
#pragma unroll
            for (int j = 0; j < 2; ++j) bf_[j] = *(const bf16x8*)(Bs + (wn * 32 + j * 16 + (lane & 15)) * G_LD + ks * 32 + (lane >> 4) * 8);
#pragma unroll
            for (int i = 0; i < 4; ++i)
#pragma unroll
                for (int j = 0; j < 2; ++j) acc[i][j] = __builtin_amdgcn_mfma_f32_16x16x32_bf16(bf_[j], af_[i], acc[i][j], 0, 0, 0);
        }
    }
}
struct RowMajorA { const bf16_t* A; int lda; DEVI const bf16_t* operator()(int row, int k) const { return A + (size_t)row * lda + k; } };
struct CmpA { const bf16_t* KC; int koff;
    DEVI const bf16_t* operator()(int row, int k_) const { const int k = k_ + koff; const int rr = row < 2044 ? row : 2043; const int b = rr / 1022, rem = rr - b * 1022, c = rem >> 1, g = rem & 1;
        return KC + ((size_t)(b * 8192 + 16 * c + (k >> 6)) * 128 + g * 64 + (k & 63)); } };

template <class AF, class Epi>
DEVI void gemm_run(AF af, const bf16_t* Bt, int K, int MT, int NT, Epi epi, unsigned char* smem, int bid, int nb) {
    bf16_t* As = (bf16_t*)smem; bf16_t* Bs = As + 128 * G_LD;
    const int lane = threadIdx.x & 63, wave = threadIdx.x >> 6, wm = wave >> 2, wn = wave & 3;
    for (int t = bid; t < MT * NT; t += nb) {
        const int mt = t / NT, nt = t % NT;
        f32x4 acc[4][2];
#pragma unroll
        for (int i = 0; i < 4; ++i)
#pragma unroll
            for (int j = 0; j < 2; ++j) acc[i][j] = (f32x4){0.f, 0.f, 0.f, 0.f};
        gemm_tile(acc, af, mt * 128, Bt + (size_t)nt * 128 * K, K, K, As, Bs);
#pragma unroll
        for (int i = 0; i < 4; ++i)
#pragma unroll
            for (int j = 0; j < 2; ++j) epi(mt * 128 + wm * 64 + i * 16 + (lane & 15), nt * 128 + wn * 32 + j * 16 + (lane >> 4) * 4, acc[i][j]);
    }
}
DEVI void store_bf16x4(bf16_t* p, float a, float b, float c, float d) { uint2 w; w.x = (unsigned)f2bf(a) | ((unsigned)f2bf(b) << 16); w.y = (unsigned)f2bf(c) | ((unsigned)f2bf(d) << 16); *(uint2*)p = w; }

template <int DH, int R, int NCH, bool PSUM, typename KT, class RowF>
DEVI void attend(const float* qs, float* pl, float* psum, const KT* Kb, const KT* Vb, size_t stride, RowF rowf, float (&o)[R][DH / 64], int lane) {
    float m[R], l[R];
#pragma unroll
    for (int r = 0; r < R; ++r) { m[r] = -1e30f; l[r] = 0.f; }
#pragma unroll 1
    for (int i = 0; i < NCH; ++i) {
        bool valid; const long row = rowf(i, lane, valid);
        if (__ballot(valid) == 0ull) continue;
        const KT* kp = Kb + (size_t)row * stride;
        float a[R];
#pragma unroll
        for (int r = 0; r < R; ++r) a[r] = 0.f;
#pragma unroll 2
        for (int d0 = 0; d0 < DH; d0 += 8) {
            float kf[8]; load8(kp + d0, kf);
#pragma unroll
            for (int r = 0; r < R; ++r) {
                const float4 q0 = *(const float4*)(qs + r * DH + d0), q1 = *(const float4*)(qs + r * DH + d0 + 4);
                a[r] += kf[0] * q0.x + kf[1] * q0.y + kf[2] * q0.z + kf[3] * q0.w + kf[4] * q1.x + kf[5] * q1.y + kf[6] * q1.z + kf[7] * q1.w;
            }
        }
#pragma unroll
        for (int r = 0; r < R; ++r) {
            const float sv = valid ? a[r] : -1e30f;
            const float mn = fmaxf(m[r], wave_max(sv));
            const float pe = valid ? expf(sv - mn) : 0.f;
            l[r] = l[r] * expf(m[r] - mn) + wave_sum(pe);
            m[r] = mn;
        }
    }
    float inv[R];
#pragma unroll
    for (int r = 0; r < R; ++r) inv[r] = 1.0f / fmaxf(l[r], 1e-30f);
#pragma unroll 1
    for (int i = 0; i < NCH; ++i) {
        bool valid; const long row = rowf(i, lane, valid);
        const bool any = __ballot(valid) != 0ull;
        float a[R];
#pragma unroll
        for (int r = 0; r < R; ++r) a[r] = 0.f;
        if (any) {
            const KT* kp = Kb + (size_t)row * stride;
#pragma unroll 2
            for (int d0 = 0; d0 < DH; d0 += 8) {
                float kf[8]; load8(kp + d0, kf);
#pragma unroll
                for (int r = 0; r < R; ++r) {
                    const float4 q0 = *(const float4*)(qs + r * DH + d0), q1 = *(const float4*)(qs + r * DH + d0 + 4);
                    a[r] += kf[0] * q0.x + kf[1] * q0.y + kf[2] * q0.z + kf[3] * q0.w + kf[4] * q1.x + kf[5] * q1.y + kf[6] * q1.z + kf[7] * q1.w;
                }
            }
        }
        float ps = 0.f;
#pragma unroll
        for (int r = 0; r < R; ++r) { const float pv = valid ? expf(a[r] - m[r]) * inv[r] : 0.f; pl[r * 64 + lane] = pv; ps += pv; }
        if (PSUM) psum[i * 64 + lane] = ps;
        lds_fence();
        if (any) {
#pragma unroll 2
            for (int key = 0; key < 64; ++key) {
                bool dummy; const long vrow = rowf(i, key, dummy);
                const KT* vp = Vb + (size_t)vrow * stride;
                float pr[R];
#pragma unroll
                for (int r = 0; r < R; ++r) pr[r] = pl[r * 64 + key];
#pragma unroll
                for (int j = 0; j < DH / 64; ++j) { const float v = tof(vp[lane + 64 * j]);
#pragma unroll
                    for (int r = 0; r < R; ++r) o[r][j] += pr[r] * v; }
            }
        }
        lds_fence();
    }
}


DEVI int nsa_koff(int t, int d) { return ((((t >> 5) * 4 + (((t >> 2) & 1) * 2 + (d >> 5))) * 64) + ((((t & 31) >> 3) << 2) | (t & 3)) + 16 * ((d >> 3) & 3)) * 8 + (d & 7); }
DEVI int nsa_voff(int t, int d) { return ((((t >> 5) * 4 + (d >> 4)) * 64) + (d & 15) + 16 * ((t & 31) >> 3)) * 8 + (t & 7); }
DEVI int xat_koff(int m, int d) { return ((((m >> 5) * 16 + ((m >> 2) & 1) * 8 + (d >> 5)) * 64) + ((((m & 31) >> 3) << 2) | (m & 3)) + 16 * ((d >> 3) & 3)) * 8 + (d & 7); }
DEVI int xat_voff(int m, int d) { return ((((m >> 5) * 16 + (d >> 4)) * 64) + (d & 15) + 16 * ((m & 31) >> 3)) * 8 + (m & 7); }
DEVI int pk_koff(int k, int d) { return ((((k >> 4) * 4 + (d >> 5)) * 64) + (k & 15) + 16 * ((d >> 3) & 3)) * 8 + (d & 7); }
DEVI void nsa_load_kf(bf16x8 (&ka)[4], const bf16_t* Kp, int ch, int lane) {
#pragma unroll
    for (int f = 0; f < 4; ++f) ka[f] = *(const bf16x8*)(Kp + ((ch * 4 + f) * 64 + lane) * 8);
}
DEVI void nsa_load_k(bf16x8 (&ka)[4], const bf16_t* Kp, int stride, int kb, int rk, int dh) {
    const int o0 = (kb + rk) * stride + dh, o1 = o0 + 4 * stride;
    ka[0] = *(const bf16x8*)(Kp + o0); ka[1] = *(const bf16x8*)(Kp + o0 + 32); ka[2] = *(const bf16x8*)(Kp + o1); ka[3] = *(const bf16x8*)(Kp + o1 + 32);
}
DEVI void nsa_load_v(bf16x8 (&va)[4], const bf16_t* Vp, int vstride, int kb8, int lr) {
    const int o = lr * vstride + kb8;
#pragma unroll
    for (int dt = 0; dt < 4; ++dt) va[dt] = *(const bf16x8*)(Vp + o + dt * 16 * vstride);
}
DEVI void nsa_load_vb(bf16x8 (&va)[4], const bf16_t* Vp, int kb8, int lr) {
    const int o = ((kb8 >> 6) * 64 + lr) * 64 + (kb8 & 63);
#pragma unroll
    for (int dt = 0; dt < 4; ++dt) va[dt] = *(const bf16x8*)(Vp + o + dt * 16 * 64);
}
DEVI void nsa_scores(const bf16x8 (&ka)[4], const bf16x8 (&qf)[2], float (&sv)[8]) {
    f32x4 s0 = {0.f, 0.f, 0.f, 0.f}, s1 = {0.f, 0.f, 0.f, 0.f};
    s0 = __builtin_amdgcn_mfma_f32_16x16x32_bf16(ka[0], qf[0], s0, 0, 0, 0); s1 = __builtin_amdgcn_mfma_f32_16x16x32_bf16(ka[2], qf[0], s1, 0, 0, 0);
    s0 = __builtin_amdgcn_mfma_f32_16x16x32_bf16(ka[1], qf[1], s0, 0, 0, 0); s1 = __builtin_amdgcn_mfma_f32_16x16x32_bf16(ka[3], qf[1], s1, 0, 0, 0);
    sv[0] = s0[0]; sv[1] = s0[1]; sv[2] = s0[2]; sv[3] = s0[3]; sv[4] = s1[0]; sv[5] = s1[1]; sv[6] = s1[2]; sv[7] = s1[3];
}
struct NsaSt { float m, l; f32x4 o[4]; };
struct NsaBuf { bf16x8 ka[4]; bf16x8 va[4]; };
DEVI void nsa_init(NsaSt& st) { st.m = -1e20f; st.l = 0.f;
#pragma unroll
    for (int dt = 0; dt < 4; ++dt) st.o[dt] = (f32x4){0.f, 0.f, 0.f, 0.f}; }
template <bool PV>
DEVI void nsa_chunk(NsaSt& st, float (&sv)[8], int pos0, int lo, int hi, const bf16x8 (&va)[4]) {
    float cm = -1e30f;
#pragma unroll
    for (int j = 0; j < 8; ++j) { const bool ok = (pos0 + j >= lo) && (pos0 + j <= hi); sv[j] = ok ? sv[j] : -1e30f; cm = fmaxf(cm, sv[j]); }
    cm = fmaxf(cm, __shfl_xor(cm, 16)); cm = fmaxf(cm, __shfl_xor(cm, 32));
    if (__any(cm > st.m)) {
        const float mn = fmaxf(st.m, cm), sc = __builtin_amdgcn_exp2f(st.m - mn);
        st.l *= sc;
        if (PV) {
#pragma unroll
            for (int dt = 0; dt < 4; ++dt) st.o[dt] *= sc;
        }
        st.m = mn;
    }
    float p[8]; float ps = 0.f;
#pragma unroll
    for (int j = 0; j < 8; ++j) { p[j] = __builtin_amdgcn_exp2f(sv[j] - st.m); ps += p[j]; }
    st.l += ps;
    if (PV) {
        const bf16x8 pb = pack8(p);
#pragma unroll
        for (int dt = 0; dt < 4; ++dt) st.o[dt] = __builtin_amdgcn_mfma_f32_16x16x32_bf16(va[dt], pb, st.o[dt], 0, 0, 0);
    }
}
DEVI void nsa_fold(f32x4 (&comb)[4], NsaSt& st, float gate) {
    float l = st.l; l += __shfl_xor(l, 16); l += __shfl_xor(l, 32);
    const float w = gate / fmaxf(l, 1e-30f);
#pragma unroll
    for (int dt = 0; dt < 4; ++dt) comb[dt] += st.o[dt] * w;
}
template <class LD, class CP>
DEVI void nsa_stream(int n, LD ld, CP cp) {
    NsaBuf A, B, C;
    if (n > 0) ld(A, 0);
    if (n > 1) ld(B, 1);
#pragma unroll 1
    for (int i = 0; i < n; i += 3) {
        if (i + 2 < n) ld(C, i + 2);
        cp(A, i);
        if (i + 1 < n) { if (i + 3 < n) ld(A, i + 3); cp(B, i + 1); }
        if (i + 2 < n) { if (i + 4 < n) ld(B, i + 4); cp(C, i + 2); }
    }
}
template <class LD, class CP>
DEVI void nsa_stream2(int n, LD ld, CP cp) {
    NsaBuf A, B;
    if (n > 0) ld(A, 0);
#pragma unroll 1
    for (int i = 0; i < n; i += 2) {
        if (i + 1 < n) ld(B, i + 1);
        cp(A, i);
        if (i + 1 < n) { if (i + 2 < n) ld(A, i + 2); cp(B, i + 1); }
    }
}

#define XB_TMO      128
#define XB_XCNT(j)  (256  + 64 * (j))
#define XB_XSUB(j)  (1280 + 64 * (j))
#define XB_XGEN(j)  (2304 + 64 * (j))
#define XB_TOP      3328
#define XB_TOPGEN   3392
#define XCD_BAR_WORDS 3456
#define XB_SPIN_CAP (1u << 22)
#define LAS __attribute__((address_space(3)))
DEVI unsigned xb_ld(unsigned* p)              { return __hip_atomic_load(p, __ATOMIC_RELAXED, __HIP_MEMORY_SCOPE_AGENT); }
DEVI unsigned xb_add(unsigned* p, unsigned v) { return __hip_atomic_fetch_add(p, v, __ATOMIC_RELAXED, __HIP_MEMORY_SCOPE_AGENT); }
DEVI unsigned xb_xcc_id() { return (unsigned)__builtin_amdgcn_s_getreg((3 << 11) | 20) & 0xFu; }
#define XB_SPIN(cond, bar) do { unsigned _sp = 0; while (cond) { __builtin_amdgcn_s_sleep(1); \
    if ((++_sp & 255u) == 0u) { if (xb_ld(&(bar)[XB_TMO])) break; if (_sp > XB_SPIN_CAP) { atomicAdd(&(bar)[XB_TMO], 1u); break; } } } } while (0)
struct XcdBarrier { unsigned* bar; unsigned x; volatile LAS unsigned* st; };
DEVI XcdBarrier xcd_barrier_post(unsigned* bar, volatile LAS unsigned* st) {
    XcdBarrier b; b.bar = bar; b.x = xb_xcc_id(); b.st = st;
    if (threadIdx.x == 0) (void)xb_add(&bar[XB_XCNT(b.x)], 1u);
    return b;
}
DEVI void xcd_barrier_complete(unsigned* bar, unsigned x, unsigned& nloc, unsigned& nx) {
    const unsigned G = gridDim.x * gridDim.y * gridDim.z;
    unsigned sum, cnt, mine, sp = 0u;
    for (;;) {
        sum = 0u; cnt = 0u; mine = 0u;
#pragma unroll
        for (unsigned j = 0; j < 16; ++j) { const unsigned c = xb_ld(&bar[XB_XCNT(j)]); sum += c; cnt += (c > 0u) ? 1u : 0u; mine = (j == x) ? c : mine; }
        if (sum == G) break;
        __builtin_amdgcn_s_sleep(1);
        if ((++sp & 255u) == 0u) { if (xb_ld(&bar[XB_TMO])) break; if (sp > XB_SPIN_CAP) { atomicAdd(&bar[XB_TMO], 1u); break; } }
    }
    nloc = mine > 0u ? mine : 1u; nx = cnt > 0u ? cnt : 1u;
}
DEVI void xcd_barrier(const XcdBarrier& b) {
    asm volatile("s_waitcnt vmcnt(0)" ::: "memory");
    __syncthreads();
    if (threadIdx.x == 0) {
        unsigned* bar = b.bar;
        __builtin_amdgcn_s_waitcnt(0);
        unsigned nloc = b.st[0], nx = b.st[1];
        if (nloc == 0u) { xcd_barrier_complete(bar, b.x, nloc, nx); b.st[0] = nloc; b.st[1] = nx; }
        const unsigned old = xb_add(&bar[XB_XSUB(b.x)], 1u);
        const unsigned gen = old / nloc;
        if (old + 1u == (gen + 1u) * nloc) {
            __builtin_amdgcn_fence(__ATOMIC_RELEASE, "agent");
            asm volatile("s_waitcnt vmcnt(0)" ::: "memory");
            const unsigned og = xb_add(&bar[XB_TOP], 1u);
            const unsigned tg = og / nx;
            if (og + 1u == (tg + 1u) * nx) xb_add(&bar[XB_TOPGEN], 1u);
            else XB_SPIN(xb_ld(&bar[XB_TOPGEN]) == tg, bar);
            __builtin_amdgcn_fence(__ATOMIC_ACQUIRE, "agent");
            xb_add(&bar[XB_XGEN(b.x)], 1u);
            asm volatile("s_waitcnt vmcnt(0)" ::: "memory");
        } else {
            XB_SPIN(xb_ld(&bar[XB_XGEN(b.x)]) == gen, bar);
            __builtin_amdgcn_fence(__ATOMIC_ACQUIRE, "agent");
            asm volatile("s_waitcnt vmcnt(0)" ::: "memory");
        }
    }
    __syncthreads();
}

__global__ void __launch_bounds__(NTHREADS) fwd_mega(Params p) {
    extern __shared__ __attribute__((aligned(16))) unsigned char smem[];
    {
        volatile LAS unsigned* st0 = (volatile LAS unsigned*)(smem + LDS_BYTES - 16);
        if (threadIdx.x < 4) st0[threadIdx.x] = 0u;
        __syncthreads();
    }
    const XcdBarrier xb = xcd_barrier_post((unsigned*)(p.ws + O_BAR), (volatile LAS unsigned*)(smem + LDS_BYTES - 16));
    const int bid = blockIdx.x, nb = gridDim.x, tid = threadIdx.x, lane = tid & 63, wave = tid >> 6;
    unsigned char* ws = p.ws;
    bf16_t* WIN = (bf16_t*)(ws + O_WIN); bf16_t* W1K = (bf16_t*)(ws + O_W1K); bf16_t* W1V = (bf16_t*)(ws + O_W1V);
    bf16_t* WNSA = (bf16_t*)(ws + O_WNSA); bf16_t* WGM = (bf16_t*)(ws + O_WGM); bf16_t* WMIX = (bf16_t*)(ws + O_WMIX);
    bf16_t* WXQ = (bf16_t*)(ws + O_WXQ); bf16_t* WXKV = (bf16_t*)(ws + O_WXKV); bf16_t* WXO = (bf16_t*)(ws + O_WXO); bf16_t* WPQ = (bf16_t*)(ws + O_WPQ);
    float* B1F = (float*)(ws + O_B1);
    bf16_t* HN = (bf16_t*)(ws + O_HN); bf16_t* MN = (bf16_t*)(ws + O_MN); bf16_t* KVX = (bf16_t*)(ws + O_KVX);
    float* GATES = (float*)(ws + O_GATES); float* HID = (float*)(ws + O_HID); float* CMP = (float*)(ws + O_CMP);
    bf16_t* Q = (bf16_t*)(ws + O_Q); bf16_t* KV6 = (bf16_t*)(ws + O_KV6); bf16_t* U = (bf16_t*)(ws + O_U); bf16_t* VG = (bf16_t*)(ws + O_VG);
    bf16_t* MG = (bf16_t*)(ws + O_MG); bf16_t* ONSA = (bf16_t*)(ws + O_ONSA); bf16_t* OGM = (bf16_t*)(ws + O_OGM);
    bf16_t* Y = (bf16_t*)(ws + O_Y); bf16_t* QX = (bf16_t*)(ws + O_QX); bf16_t* OX = (bf16_t*)(ws + O_OX); bf16_t* QP = (bf16_t*)(ws + O_QP);
    float* HS = (float*)(ws + O_HS); int* HI = (int*)(ws + O_HI);
    bf16_t* VXT = (bf16_t*)(ws + O_VXT); bf16_t* SUBK = (bf16_t*)(ws + O_SUBK);
    bf16_t* KCB = (bf16_t*)(ws + O_CMP); bf16_t* VCT = KCB + 4 * 512 * 64;
    unsigned char* PU8 = ws + O_U; unsigned char* PV8 = ws + O_U + 16384ull * 1024;
    float* PSC = (float*)(ws + O_PSC);
    float* OUT = p.out;

    {
        float* tile = (float*)smem;
        for (int j = bid; j < 3424; j += nb) {
            int t = j;
            if (t < 1120) { transpose_tile(p.w_in, 4376, WIN, 1024, t, WinMap(), tile); continue; } t -= 1120;
            if (t < 128) { transpose_tile(p.w1_k, 256, W1K, 2048, t, IdMap(), tile); continue; } t -= 128;
            if (t < 128) { transpose_tile(p.w1_v, 256, W1V, 2048, t, IdMap(), tile); continue; } t -= 128;
            if (t < 128) { transpose_tile(p.w_nsa_out, 1024, WNSA, 512, t, IdMap(), tile); continue; } t -= 128;
            if (t < 128) { transpose_tile(p.w_gmlp_out, 1024, WGM, 512, t, IdMap(), tile); continue; } t -= 128;
            if (t < 256) { transpose_tile(p.w_mix_out, 1024, WMIX, 1024, t, IdMap(), tile); continue; } t -= 256;
            if (t < 256) { transpose_tile(p.w_xq, 1024, WXQ, 1024, t, IdMap(), tile); continue; } t -= 256;
            if (t < 512) { transpose_tile(p.w_xkv, 2048, WXKV, 1024, t, IdMap(), tile); continue; } t -= 512;
            if (t < 256) { transpose_tile(p.w_xo, 1024, WXO, 1024, t, IdMap(), tile); continue; } t -= 256;
            transpose_tile(p.w_peer_q, 2048, WPQ, 1024, t, IdMap(), tile);
        }
        for (int r = bid * 8 + wave; r < 16384 + 512; r += nb * 8) {
            if (r < 16384) rmsnorm_row_bf16(p.x + (size_t)r * 1024, p.g_mix, HN + (size_t)r * 1024, lane);
            else rmsnorm_row_bf16(p.mem + (size_t)(r - 16384) * 1024, p.g_mem, MN + (size_t)(r - 16384) * 1024, lane);
        }
        for (int i = bid * NTHREADS + tid; i < 16 * 128 * 128; i += nb * NTHREADS) SUBK[(i & ~16383) + pk_koff((i >> 7) & 127, i & 127)] = f2bf(p.sub_keys[i]);
        if (bid == nb - 1) {
            const int kv = tid >> 8, n = tid & 255;
            const float* pe = kv ? p.pe_v : p.pe_k; const float* w1 = kv ? p.w1_v : p.w1_k; const float* b1 = kv ? p.b1_v : p.b1_k;
            float a = b1[n];
            for (int k = 0; k < 2048; ++k) a += pe[k] * w1[(size_t)k * 256 + n];
            B1F[kv * 256 + n] = a;
        }
    }
    xcd_barrier(xb);

    {
        auto epi = [&](int r, int c, const f32x4& v) {
            if (c < 512) { const float qs_ = 0.125f * 1.4426950408889634f; store_bf16x4(Q + (size_t)r * 512 + c, v[0] * qs_, v[1] * qs_, v[2] * qs_, v[3] * qs_); }
            else if (c < 1280) { const int w = (c - 512) >> 7, cc = (c - 512) & 127;
                if (w == 3 || w == 5) { const int b_ = r >> 13, t_ = r & 8191, g_ = cc >> 6, d_ = cc & 63;
                    bf16_t* vt = KV6 + (size_t)w * 16384 * 128 + (size_t)(b_ * 2 + g_) * 8192 * 64 + nsa_voff(t_, d_);
                    vt[0] = f2bf(v[0]); vt[8] = f2bf(v[1]); vt[16] = f2bf(v[2]); vt[24] = f2bf(v[3]); }
                else if (w == 2 || w == 4) { const int b_ = r >> 13, t_ = r & 8191, g_ = cc >> 6, d_ = cc & 63;
                    store_bf16x4(KV6 + (size_t)w * 16384 * 128 + (size_t)(b_ * 2 + g_) * 8192 * 64 + nsa_koff(t_, d_), v[0], v[1], v[2], v[3]); }
                else store_bf16x4(KV6 + ((size_t)w * 16384 + r) * 128 + cc, v[0], v[1], v[2], v[3]); }
            else if (c < 1792) store_bf16x4(U + (size_t)r * 512 + (c - 1280), gelu_f(v[0]), gelu_f(v[1]), gelu_f(v[2]), gelu_f(v[3]));
            else if (c < 2304) store_bf16x4(VG + (size_t)r * 512 + (c - 1792), gelu_f(v[0]), gelu_f(v[1]), gelu_f(v[2]), gelu_f(v[3]));
            else if (c < 4352) store_bf16x4(MG + (size_t)r * 2048 + (c - 2304), sigmoid_f(v[0]), sigmoid_f(v[1]), sigmoid_f(v[2]), sigmoid_f(v[3]));
            else if (c < 4376) { float* gp = GATES + (size_t)r * 24 + (c - 4352); gp[0] = sigmoid_f(v[0]); gp[1] = sigmoid_f(v[1]); gp[2] = sigmoid_f(v[2]); gp[3] = sigmoid_f(v[3]); }
        };
        gemm_run(RowMajorA{HN, 1024}, WIN, 1024, 128, 35, epi, smem, bid, nb);
        auto epi2 = [&](int r, int c, const f32x4& v) {
            const int b_ = r >> 8, m_ = r & 255;
            if (c < 1024) { const int h_ = c >> 8, d_ = c & 255; store_bf16x4(KVX + (size_t)(b_ * 4 + h_) * 65536 + xat_koff(m_, d_), v[0], v[1], v[2], v[3]); }
            else { const int hd = c - 1024, h_ = hd >> 8, d_ = hd & 255;
                bf16_t* vt = VXT + (size_t)(b_ * 4 + h_) * 65536 + xat_voff(m_, d_);
                vt[0] = f2bf(v[0]); vt[8] = f2bf(v[1]); vt[16] = f2bf(v[2]); vt[24] = f2bf(v[3]); } };
        gemm_run(RowMajorA{MN, 1024}, WXKV, 1024, 4, 16, epi2, smem, bid, nb);
        for (int i = bid * NTHREADS + tid; i < 2 * 2048 * 256 / 4; i += nb * NTHREADS) ((float4*)HID)[i] = make_float4(0.f, 0.f, 0.f, 0.f);
    }
    xcd_barrier(xb);

    {
        for (int task = bid; task < 256; task += nb) {
            if (task < 128) {
                const int kv = task >> 6, t = task & 63, mt = t >> 2, nt = (t >> 1) & 1, kh = t & 1;
                bf16_t* As = (bf16_t*)smem; bf16_t* Bs = As + 128 * G_LD;
                const int wm = wave >> 2, wn = wave & 3;
                f32x4 acc[4][2];
#pragma unroll
                for (int i = 0; i < 4; ++i)
#pragma unroll
                    for (int j = 0; j < 2; ++j) acc[i][j] = (f32x4){0.f, 0.f, 0.f, 0.f};
                gemm_tile(acc, CmpA{KV6 + (size_t)kv * 16384 * 128, kh * 1024}, mt * 128, (kv ? W1V : W1K) + (size_t)nt * 128 * 2048 + kh * 1024, 2048, 1024, As, Bs);
#pragma unroll
                for (int i = 0; i < 4; ++i)
#pragma unroll
                    for (int j = 0; j < 2; ++j) {
                        const int r = mt * 128 + wm * 64 + i * 16 + (lane & 15), c = nt * 128 + wn * 32 + j * 16 + (lane >> 4) * 4;
                        if (r < 2044) { float* hp = HID + ((size_t)kv * 2048 + r) * 256 + c;
                            unsafeAtomicAdd(hp, acc[i][j][0]); unsafeAtomicAdd(hp + 1, acc[i][j][1]); unsafeAtomicAdd(hp + 2, acc[i][j][2]); unsafeAtomicAdd(hp + 3, acc[i][j][3]); }
                    }
                __syncthreads();
            } else {
                const int ch = task - 128;
                const size_t row0 = (size_t)ch * 128;
                constexpr int VLD = 136;
                bf16_t* VT = (bf16_t*)smem;
                float* st = (float*)(smem + 512 * VLD * 2);
                for (int r = wave * 16; r < wave * 16 + 16; ++r) {
                    float f[8]; load8(VG + (row0 + r) * 512 + lane * 8, f);
                    float s1 = 0.f;
#pragma unroll
                    for (int e = 0; e < 8; ++e) s1 += f[e];
                    s1 = wave_sum(s1); const float mu = s1 * (1.0f / 512.0f);
                    float s2 = 0.f;
#pragma unroll
                    for (int e = 0; e < 8; ++e) s2 += (f[e] - mu) * (f[e] - mu);
                    s2 = wave_sum(s2);
                    if (lane == 0) { st[r * 2] = mu; st[r * 2 + 1] = rsqrtf(s2 * (1.0f / 512.0f) + 1e-6f); }
                }
                __syncthreads();
                {
                    const int s_ = tid & 127; const float mu = st[s_ * 2], rs = st[s_ * 2 + 1];
#pragma unroll 1
                    for (int i = 0; i < 16; ++i) {
                        const int d0 = ((tid >> 7) + 4 * i) * 8;
                        float f[8]; load8(VG + (row0 + s_) * 512 + d0, f);
#pragma unroll
                        for (int e = 0; e < 8; ++e) VT[(d0 + e) * VLD + s_] = f2bf((f[e] - mu) * rs * p.ln_g[d0 + e] + p.ln_b[d0 + e]);
                    }
                }
                __syncthreads();
                {
                    const int tl = wave * 16 + (lane & 15), hq = lane >> 4, kmax = (wave * 16 + 15) >> 5;
                    for (int g = 0; g < 4; ++g) {
                        bf16x8 wf[4];
#pragma unroll
                        for (int ks = 0; ks < 4; ++ks) {
                            if (ks <= kmax) {
                                const float* wp = p.gws + (size_t)g * 16384 + tl * 128 + ks * 32 + 8 * hq;
                                float f[8]; load8(wp, f);
#pragma unroll
                                for (int e = 0; e < 8; ++e) f[e] = (ks * 32 + 8 * hq + e <= tl) ? f[e] : 0.f;
                                wf[ks] = pack8(f);
                            }
                        }
                        const float bsv = p.gbs[g * 128 + tl];
#pragma unroll 2
                        for (int dt = 0; dt < 8; ++dt) {
                            f32x4 a = {0.f, 0.f, 0.f, 0.f};
                            const bf16_t* vp = VT + (g * 128 + dt * 16 + (lane & 15)) * VLD + 8 * hq;
#pragma unroll
                            for (int ks = 0; ks < 4; ++ks) if (ks <= kmax) a = __builtin_amdgcn_mfma_f32_16x16x32_bf16(*(const bf16x8*)(vp + ks * 32), wf[ks], a, 0, 0, 0);
                            const size_t o = (row0 + tl) * 512 + g * 128 + dt * 16 + 4 * hq;
                            const uint2 uw = *(const uint2*)(U + o);
                            store_bf16x4(OGM + o, __uint_as_float(uw.x << 16) * (a[0] + bsv), __uint_as_float(uw.x & 0xffff0000u) * (a[1] + bsv),
                                         __uint_as_float(uw.y << 16) * (a[2] + bsv), __uint_as_float(uw.y & 0xffff0000u) * (a[3] + bsv));
                        }
                    }
                }
                __syncthreads();
            }
        }
    }
    xcd_barrier(xb);

    {
        float* gl = (float*)smem + wave * 256;
        for (int task = bid * 8 + wave; task < 2 * 2044; task += nb * 8) {
            const int kv = task >= 2044 ? 1 : 0, r = task - kv * 2044;
            const float* hp = HID + ((size_t)kv * 2048 + r) * 256; const float* bb = B1F + kv * 256;
#pragma unroll
            for (int i = 0; i < 4; ++i) gl[lane + 64 * i] = gelu_f(hp[lane + 64 * i] + bb[lane + 64 * i]);
            lds_fence();
            const float* w2 = kv ? p.w2_v : p.w2_k;
            float a = 0.f;
#pragma unroll 8
            for (int j = 0; j < 256; ++j) a += gl[j] * w2[j * 64 + lane];
            const int b = r / 1022, rr = r - b * 1022, c = rr >> 1, g = rr & 1, n = lane;
            if (kv == 0) KCB[(size_t)(b * 2 + g) * 512 * 64 + nsa_koff(c, n)] = f2bf(a); else VCT[(size_t)(b * 2 + g) * 512 * 64 + nsa_voff(c, n)] = f2bf(a);
            lds_fence();
        }
        if (bid == 0 && tid < 256) { const int bg = tid >> 6, n = tid & 63; KCB[(size_t)bg * 512 * 64 + nsa_koff(511, n)] = 0; VCT[(size_t)bg * 512 * 64 + nsa_voff(511, n)] = 0; }
    }
    xcd_barrier(xb);

    {
        float* impL = (float*)smem + wave * 1024;
        int* sidxL = (int*)(impL + 512);
        const bf16_t* KS = KV6 + 2ull * 16384 * 128; const bf16_t* VST = KV6 + 3ull * 16384 * 128;
        const bf16_t* KW = KV6 + 4ull * 16384 * 128; const bf16_t* VWT = KV6 + 5ull * 16384 * 128;
        const int c = lane & 15, h = lane >> 4, tokc = c >> 2, headc = c & 3;
        const int rk = 8 * (c >> 2) + (c & 3), dh = 8 * h;
      for (int pass = 0; pass < 2; ++pass) {
        for (int task = bid * 8 + wave; task < 8192; task += nb * 8) {
            const int bg = task >> 11, q4 = task & 2047, b = bg >> 1, g = bg & 1, t0 = q4 * 4;
            const int tcol = t0 + tokc; const size_t bt0 = (size_t)b * 8192 + t0;
            bf16x8 qf[2];
            { const bf16_t* qp = Q + (bt0 + tokc) * 512 + g * 256 + headc * 64 + dh; qf[0] = *(const bf16x8*)qp; qf[1] = *(const bf16x8*)(qp + 32); }
            const float* gp = GATES + (bt0 + tokc) * 24 + (g * 4 + headc) * 3;
            const float gate0 = gp[0], gate1 = gp[1], gate2 = gp[2];
            f32x4 comb[4];
#pragma unroll
            for (int dt = 0; dt < 4; ++dt) comb[dt] = (f32x4){0.f, 0.f, 0.f, 0.f};
            if (pass == 1) {
            {
                const int ncvc = tcol >= 31 ? ((tcol - 31) >> 4) + 1 : 0;
                const int ncvmax = (t0 + 3) >= 31 ? ((t0 + 3 - 31) >> 4) + 1 : 0;
                const int nch = (ncvmax + 31) >> 5;
                const bf16_t* Kc = KCB + (size_t)bg * 512 * 64; const bf16_t* Vc = VCT + (size_t)bg * 64 * 512;
                NsaSt st; nsa_init(st);
                {
                    auto ld = [&](NsaBuf& bf, int i) { nsa_load_kf(bf.ka, Kc, i, lane); };
                    auto cp = [&](NsaBuf& bf, int i) { float sv[8]; nsa_scores(bf.ka, qf, sv); nsa_chunk<false>(st, sv, i * 32 + dh, 0, ncvc - 1, bf.va); };
                    nsa_stream2(nch, ld, cp);
                }
                float l = st.l; l += __shfl_xor(l, 16); l += __shfl_xor(l, 32);
                const float inv = 1.0f / fmaxf(l, 1e-30f), mfin = st.m;
                *(float4*)(impL + lane * 8) = make_float4(0.f, 0.f, 0.f, 0.f); *(float4*)(impL + lane * 8 + 4) = make_float4(0.f, 0.f, 0.f, 0.f);
                lds_fence();
                f32x4 oc[4];
#pragma unroll
                for (int dt = 0; dt < 4; ++dt) oc[dt] = (f32x4){0.f, 0.f, 0.f, 0.f};
                float carry = 0.f;
                {
                    auto ld = [&](NsaBuf& bf, int i) { nsa_load_kf(bf.ka, Kc, i, lane); nsa_load_kf(bf.va, Vc, i, lane); };
                    auto cp = [&](NsaBuf& bf, int ch) {
                        float sv[8]; nsa_scores(bf.ka, qf, sv);
                        float p[8];
#pragma unroll
                        for (int j = 0; j < 8; ++j) p[j] = (ch * 32 + dh + j < ncvc) ? __builtin_amdgcn_exp2f(sv[j] - mfin) * inv : 0.f;
                        const float up = __shfl(p[7], (lane + 48) & 63);
                        const float prev7 = (h >= 1) ? up : carry; carry = up;
                        float i0 = p[0] + p[1] + p[2] + 0.5f * p[3] + 0.5f * prev7, i1 = p[4] + p[5] + p[6] + 0.5f * p[7] + 0.5f * p[3];
                        i0 += __shfl_xor(i0, 1); i0 += __shfl_xor(i0, 2); i1 += __shfl_xor(i1, 1); i1 += __shfl_xor(i1, 2);
                        if (headc == 0) { impL[tokc * 128 + 8 * ch + 2 * h] = i0; impL[tokc * 128 + 8 * ch + 2 * h + 1] = i1; }
                        const bf16x8 pb = pack8(p);
#pragma unroll
                        for (int dt = 0; dt < 4; ++dt) oc[dt] = __builtin_amdgcn_mfma_f32_16x16x32_bf16(bf.va[dt], pb, oc[dt], 0, 0, 0);
                    };
                    nsa_stream2(nch, ld, cp);
                }
#pragma unroll
                for (int dt = 0; dt < 4; ++dt) comb[dt] += oc[dt] * gate0;
            }
            lds_fence();
            int nblk;
            {
                const int tok = lane >> 4, sub = lane & 15, cur = t0 >> 6;
                float sc[8];
#pragma unroll
                for (int e = 0; e < 8; ++e) { const int j = sub + 16 * e; const float imp = impL[tok * 128 + j];
                    const bool al = j <= cur, fo = (j == 0) || (j == cur) || (j == cur - 1);
                    sc[e] = (fo && al) ? 1e4f : (al ? imp : -1e30f); }
                float myv = -1e30f; int myi = 0;
#pragma unroll 1
                for (int it = 0; it < 16; ++it) {
                    float bv = sc[0]; int bi = sub;
#pragma unroll
                    for (int e = 1; e < 8; ++e) if (sc[e] > bv) { bv = sc[e]; bi = sub + 16 * e; }
#pragma unroll
                    for (int o = 1; o < 16; o <<= 1) { const float ov = __shfl_xor(bv, o); const int oi = __shfl_xor(bi, o);
                        const bool take = (ov > bv) || (ov == bv && oi < bi); bv = take ? ov : bv; bi = take ? oi : bi; }
                    if (sub == it) { myv = bv; myi = bi; }
#pragma unroll
                    for (int e = 0; e < 8; ++e) if (bi == sub + 16 * e) sc[e] = -INFINITY;
                }
                const bool forced = myv > 5e3f;
                const bool keep = (myv > -0.5e30f) && !(forced && tok > 0);
                const unsigned long long bal = __ballot(keep);
                const int pos = __popcll(bal & ((1ull << lane) - 1ull));
                lds_fence();
                if (keep) sidxL[pos] = ((forced ? 7 : tok) << 16) | myi;
                nblk = __popcll(bal);
            }
            lds_fence();
            {
                NsaSt st; nsa_init(st);
                const bf16_t* Kp = KS + (size_t)bg * 8192 * 64; const bf16_t* Vp = VST + (size_t)bg * 8192 * 64;
                auto ld = [&](NsaBuf& bf, int i) { const int e = __builtin_amdgcn_readfirstlane(sidxL[i >> 1]); const int kb = (e & 0xffff) * 64 + (i & 1) * 32;
                    nsa_load_kf(bf.ka, Kp, kb >> 5, lane); nsa_load_kf(bf.va, Vp, kb >> 5, lane); };
                auto cp = [&](NsaBuf& bf, int i) { const int e = __builtin_amdgcn_readfirstlane(sidxL[i >> 1]); const int kb = (e & 0xffff) * 64 + (i & 1) * 32, ow = e >> 16;
                    const int hi = (ow == 7 || ow == tokc) ? tcol : -1;
                    float sv[8]; nsa_scores(bf.ka, qf, sv); nsa_chunk<true>(st, sv, kb + dh, 0, hi, bf.va); };
                nsa_stream(2 * nblk, ld, cp);
                nsa_fold(comb, st, gate1);
            }
            {
                const bf16_t* op = ONSA + (bt0 + tokc) * 512 + g * 256 + headc * 64 + 4 * h;
#pragma unroll
                for (int dt = 0; dt < 4; ++dt) { const uint2 w = *(const uint2*)(op + dt * 16);
                    comb[dt][0] += __uint_as_float(w.x << 16); comb[dt][1] += __uint_as_float(w.x & 0xffff0000u); comb[dt][2] += __uint_as_float(w.y << 16); comb[dt][3] += __uint_as_float(w.y & 0xffff0000u); }
            }
            } else {
            {
                NsaSt st; nsa_init(st);
                const bf16_t* Kp = KW + (size_t)bg * 8192 * 64; const bf16_t* Vp = VWT + (size_t)bg * 8192 * 64;
                const int kbf = (t0 > 511 ? t0 - 511 : 0) & ~31, kbl = (t0 + 3) & ~31;
                const int lo = tcol > 511 ? tcol - 511 : 0;
                auto ld = [&](NsaBuf& bf, int i) { const int kb = kbf + i * 32; nsa_load_kf(bf.ka, Kp, kb >> 5, lane); nsa_load_kf(bf.va, Vp, kb >> 5, lane); };
                auto cp = [&](NsaBuf& bf, int i) { const int kb = kbf + i * 32; float sv[8]; nsa_scores(bf.ka, qf, sv); nsa_chunk<true>(st, sv, kb + dh, lo, tcol, bf.va); };
                nsa_stream2(((kbl - kbf) >> 5) + 1, ld, cp);
                nsa_fold(comb, st, gate2);
            }
            }
            {
                bf16_t* op = ONSA + (bt0 + tokc) * 512 + g * 256 + headc * 64 + 4 * h;
#pragma unroll
                for (int dt = 0; dt < 4; ++dt) store_bf16x4(op + dt * 16, comb[dt][0], comb[dt][1], comb[dt][2], comb[dt][3]);
            }
            lds_fence();
        }
        if (pass == 0) xcd_barrier(xb);
      }
    }
    xcd_barrier(xb);

    {
        bf16_t* As = (bf16_t*)smem; bf16_t* Bs = As + 128 * G_LD;
        const int wm = wave >> 2, wn = wave & 3;
        for (int tl = bid; tl < 128 * 8; tl += nb) {
            const int mt = tl >> 3, nt = tl & 7;
            f32x4 a1[4][2], a2[4][2];
#pragma unroll
            for (int i = 0; i < 4; ++i)
#pragma unroll
                for (int j = 0; j < 2; ++j) { a1[i][j] = (f32x4){0.f, 0.f, 0.f, 0.f}; a2[i][j] = (f32x4){0.f, 0.f, 0.f, 0.f}; }
            gemm_tile(a1, RowMajorA{ONSA, 512}, mt * 128, WNSA + (size_t)nt * 128 * 512, 512, 512, As, Bs);
            gemm_tile(a2, RowMajorA{OGM, 512}, mt * 128, WGM + (size_t)nt * 128 * 512, 512, 512, As, Bs);
#pragma unroll
            for (int i = 0; i < 4; ++i)
#pragma unroll
                for (int j = 0; j < 2; ++j) {
                    const int r = mt * 128 + wm * 64 + i * 16 + (lane & 15), c = nt * 128 + wn * 32 + j * 16 + (lane >> 4) * 4;
                    float m0[8], m1[8];
                    const uint2 w0 = *(const uint2*)(MG + (size_t)r * 2048 + c), w1 = *(const uint2*)(MG + (size_t)r * 2048 + 1024 + c);
                    m0[0] = __uint_as_float(w0.x << 16); m0[1] = __uint_as_float(w0.x & 0xffff0000u); m0[2] = __uint_as_float(w0.y << 16); m0[3] = __uint_as_float(w0.y & 0xffff0000u);
                    m1[0] = __uint_as_float(w1.x << 16); m1[1] = __uint_as_float(w1.x & 0xffff0000u); m1[2] = __uint_as_float(w1.y << 16); m1[3] = __uint_as_float(w1.y & 0xffff0000u);
                    store_bf16x4(Y + (size_t)r * 1024 + c, m0[0] * a1[i][j][0] + m1[0] * a2[i][j][0], m0[1] * a1[i][j][1] + m1[1] * a2[i][j][1],
                                 m0[2] * a1[i][j][2] + m1[2] * a2[i][j][2], m0[3] * a1[i][j][3] + m1[3] * a2[i][j][3]);
                }
        }
    }
    xcd_barrier(xb);

    {
        auto epi = [&](int r, int c, const f32x4& v) { const float4 xv = *(const float4*)(p.x + (size_t)r * 1024 + c);
            *(float4*)(OUT + (size_t)r * 1024 + c) = make_float4(xv.x + v[0], xv.y + v[1], xv.z + v[2], xv.w + v[3]); };
        gemm_run(RowMajorA{Y, 1024}, WMIX, 1024, 128, 8, epi, smem, bid, nb);
    }
    xcd_barrier(xb);

    for (int r = bid * 8 + wave; r < 16384; r += nb * 8) rmsnorm_row_bf16(OUT + (size_t)r * 1024, p.g_xattn, HN + (size_t)r * 1024, lane);
    xcd_barrier(xb);

    {
        auto epi = [&](int r, int c, const f32x4& v) { store_bf16x4(QX + (size_t)r * 1024 + c, v[0] * 0.0625f, v[1] * 0.0625f, v[2] * 0.0625f, v[3] * 0.0625f); };
        gemm_run(RowMajorA{HN, 1024}, WXQ, 1024, 128, 8, epi, smem, bid, nb);
    }
    xcd_barrier(xb);

    {
        const int c = lane & 15, hg = lane >> 4, rk = 8 * (c >> 2) + (c & 3);
        for (int task = bid * 8 + wave; task < 4096; task += nb * 8) {
            const int h = task & 3, tgrp = task >> 2, b = tgrp >> 9; const size_t bt0 = (size_t)tgrp * 16;
            bf16x8 qf[8];
#pragma unroll
            for (int ks = 0; ks < 8; ++ks) qf[ks] = *(const bf16x8*)(QX + (bt0 + c) * 1024 + h * 256 + ks * 32 + 8 * hg);
            const bf16_t* Kp = KVX + (size_t)(b * 4 + h) * 65536; const bf16_t* Vp = VXT + (size_t)(b * 4 + h) * 65536;
            float m = -1e30f, l = 0.f; f32x4 o[16];
#pragma unroll
            for (int dt = 0; dt < 16; ++dt) o[dt] = (f32x4){0.f, 0.f, 0.f, 0.f};
#pragma unroll 1
            for (int ch = 0; ch < 8; ++ch) {
                const int kb = ch * 32;
                const bf16_t* k0 = Kp + ((ch * 16) * 64 + lane) * 8; const bf16_t* k1 = k0 + 8 * 64 * 8;
                f32x4 s0 = {0.f, 0.f, 0.f, 0.f}, s1 = {0.f, 0.f, 0.f, 0.f};
#pragma unroll
                for (int ks = 0; ks < 8; ++ks) {
                    const bf16x8 a0 = *(const bf16x8*)(k0 + ks * 512), a1 = *(const bf16x8*)(k1 + ks * 512);
                    s0 = __builtin_amdgcn_mfma_f32_16x16x32_bf16(a0, qf[ks], s0, 0, 0, 0); s1 = __builtin_amdgcn_mfma_f32_16x16x32_bf16(a1, qf[ks], s1, 0, 0, 0);
                }
                float sv[8] = {s0[0], s0[1], s0[2], s0[3], s1[0], s1[1], s1[2], s1[3]};
                float cm = sv[0];
#pragma unroll
                for (int j = 1; j < 8; ++j) cm = fmaxf(cm, sv[j]);
                cm = fmaxf(cm, __shfl_xor(cm, 16)); cm = fmaxf(cm, __shfl_xor(cm, 32));
                if (__any(cm > m)) { const float mn = fmaxf(m, cm), sc = __expf(m - mn); l *= sc;
#pragma unroll
                    for (int dt = 0; dt < 16; ++dt) o[dt] *= sc;
                    m = mn; }
                float p[8]; float ps = 0.f;
#pragma unroll
                for (int j = 0; j < 8; ++j) { p[j] = __expf(sv[j] - m); ps += p[j]; }
                l += ps;
                const bf16x8 pb = pack8(p);
#pragma unroll
                for (int dt = 0; dt < 16; ++dt) { const bf16x8 va = *(const bf16x8*)(Vp + ((ch * 16 + dt) * 64 + lane) * 8);
                    o[dt] = __builtin_amdgcn_mfma_f32_16x16x32_bf16(va, pb, o[dt], 0, 0, 0); }
            }
            l += __shfl_xor(l, 16); l += __shfl_xor(l, 32);
            const float inv = 1.0f / l;
            bf16_t* op = OX + (bt0 + c) * 1024 + h * 256 + 4 * hg;
#pragma unroll
            for (int dt = 0; dt < 16; ++dt) store_bf16x4(op + dt * 16, o[dt][0] * inv, o[dt][1] * inv, o[dt][2] * inv, o[dt][3] * inv);
        }
    }
    xcd_barrier(xb);

    {
        auto epi = [&](int r, int c, const f32x4& v) { float4* hp = (float4*)(OUT + (size_t)r * 1024 + c); const float4 hv = *hp;
            *hp = make_float4(hv.x + v[0], hv.y + v[1], hv.z + v[2], hv.w + v[3]); };
        gemm_run(RowMajorA{OX, 1024}, WXO, 1024, 128, 8, epi, smem, bid, nb);
    }
    xcd_barrier(xb);

    for (int r = bid * 8 + wave; r < 16384; r += nb * 8) rmsnorm_row_bf16(OUT + (size_t)r * 1024, p.g_peer, HN + (size_t)r * 1024, lane);
    {
        for (int row = bid * 8 + wave; row < 32768; row += nb * 8) {
            const bool isv = row >= 16384; const int rr = isv ? row - 16384 : row;
            const float* src = (isv ? p.peer_v : p.peer_u) + (size_t)rr * 1024 + lane * 16;
            float f[16];
#pragma unroll
            for (int i = 0; i < 4; ++i) { const float4 a = *(const float4*)(src + 4 * i); f[4 * i] = a.x; f[4 * i + 1] = a.y; f[4 * i + 2] = a.z; f[4 * i + 3] = a.w; }
            float am = 0.f;
#pragma unroll
            for (int i = 0; i < 16; ++i) am = fmaxf(am, fabsf(f[i]));
            am = wave_max(am);
            int ex = 0; (void)frexpf(am, &ex);
            if (am == 0.f) ex = 8;
            const float sc = ldexpf(1.0f, 8 - ex);
            uint4 w; unsigned* wp = (unsigned*)&w;
#pragma unroll
            for (int i = 0; i < 4; ++i) { int t = 0; t = __builtin_amdgcn_cvt_pk_fp8_f32(f[4 * i] * sc, f[4 * i + 1] * sc, t, false); t = __builtin_amdgcn_cvt_pk_fp8_f32(f[4 * i + 2] * sc, f[4 * i + 3] * sc, t, true); wp[i] = (unsigned)t; }
            *(uint4*)((isv ? PV8 : PU8) + (size_t)rr * 1024 + lane * 16) = w;
            if (lane == 0) PSC[row] = ldexpf(1.0f, ex - 8);
        }
    }
    xcd_barrier(xb);

    {
        auto epi = [&](int r, int c, const f32x4& v) { store_bf16x4(QP + (size_t)r * 2048 + c, v[0], v[1], v[2], v[3]); };
        gemm_run(RowMajorA{HN, 1024}, WPQ, 1024, 128, 16, epi, smem, bid, nb);
    }
    xcd_barrier(xb);

    {
        const int c = lane & 15, hg = lane >> 4;
        for (int task = bid * 8 + wave; task < 16384; task += nb * 8) {
            const int hp = task & 15, tgrp = task >> 4; const size_t bt0 = (size_t)tgrp * 16;
            bf16x8 qf[4];
#pragma unroll
            for (int ks = 0; ks < 4; ++ks) qf[ks] = *(const bf16x8*)(QP + (bt0 + c) * 2048 + hp * 128 + ks * 32 + 8 * hg);
            const bf16_t* Kp = SUBK + (size_t)hp * 16384 + lane * 8;
            float sc[32];
#pragma unroll
            for (int kt = 0; kt < 8; ++kt) {
                f32x4 a = {0.f, 0.f, 0.f, 0.f};
#pragma unroll
                for (int ks = 0; ks < 4; ++ks) a = __builtin_amdgcn_mfma_f32_16x16x32_bf16(*(const bf16x8*)(Kp + (kt * 4 + ks) * 512), qf[ks], a, 0, 0, 0);
                sc[kt * 4 + 0] = a[0]; sc[kt * 4 + 1] = a[1]; sc[kt * 4 + 2] = a[2]; sc[kt * 4 + 3] = a[3];
            }
            float* hsp = HS + (bt0 + c) * 256 + hp * 16; int* hip_ = HI + (bt0 + c) * 256 + hp * 16;
#pragma unroll 1
            for (int it = 0; it < 16; ++it) {
                float bv = sc[0]; int be = 0;
#pragma unroll
                for (int e = 1; e < 32; ++e) if (sc[e] > bv) { bv = sc[e]; be = e; }
                int key = (be >> 2) * 16 + 4 * hg + (be & 3);
#pragma unroll
                for (int o = 16; o < 64; o <<= 1) { const float ov = __shfl_xor(bv, o); const int ok = __shfl_xor(key, o);
                    const bool take = (ov > bv) || (ov == bv && ok < key); bv = take ? ov : bv; key = take ? ok : key; }
                if (hg == 0) { hsp[it] = bv; hip_[it] = key; }
                const int ew = (((key >> 2) & 3) == hg) ? ((key >> 4) * 4 + (key & 3)) : -1;
#pragma unroll
                for (int e = 0; e < 32; ++e) if (e == ew) sc[e] = -INFINITY;
            }
        }
    }
    xcd_barrier(xb);

    {
        int* exl = (int*)smem + wave * 256; float* gtl = (float*)(exl + 128);
        for (int tok = bid * 8 + wave; tok < 16384; tok += nb * 8) {
#pragma unroll 1
            for (int hh = 0; hh < 2; ++hh) {
                const int head = hh * 4 + (lane >> 4), i = lane & 15, gb = lane & 48;
                const float* s0p = HS + (size_t)tok * 256 + (2 * head) * 16;
                const float s0i = s0p[i], s1m = s0p[16 + i];
                int pj = 0; float myv = 0.f; int myf = 0;
#pragma unroll 1
                for (int it = 0; it < 16; ++it) {
                    const float s1v = __shfl(s1m, gb + (pj & 15));
                    float bv = pj < 16 ? s0i + s1v : -INFINITY; int bf = i * 16 + pj;
#pragma unroll
                    for (int o = 1; o < 16; o <<= 1) { const float ov = __shfl_xor(bv, o); const int of = __shfl_xor(bf, o);
                        const bool take = (ov > bv) || (ov == bv && of < bf); bv = take ? ov : bv; bf = take ? of : bf; }
                    if (i == it) { myv = bv; myf = bf; }
                    if ((bf >> 4) == i) ++pj;
                }
                const float vmax = __shfl(myv, gb);
                const float e = expf(myv - vmax);
                float se = e;
#pragma unroll
                for (int o = 1; o < 16; o <<= 1) se += __shfl_xor(se, o);
                const int* i0p = HI + (size_t)tok * 256 + (2 * head) * 16;
                exl[head * 16 + i] = i0p[myf >> 4] * 128 + i0p[16 + (myf & 15)];
                gtl[head * 16 + i] = e / se;
            }
            lds_fence();
            float xv[16];
            { float t0_[8], t1_[8]; load8(HN + (size_t)tok * 1024 + lane * 16, t0_); load8(HN + (size_t)tok * 1024 + lane * 16 + 8, t1_);
#pragma unroll
              for (int i = 0; i < 8; ++i) { xv[i] = t0_[i]; xv[8 + i] = t1_[i]; } }
#pragma unroll 1
            for (int e0 = 0; e0 < 128; e0 += 16) {
                uint4 ur[16];
#pragma unroll
                for (int q = 0; q < 16; ++q) ur[q] = *(const uint4*)(PU8 + (size_t)exl[e0 + q] * 1024 + lane * 16);
                float d[16];
#pragma unroll
                for (int q = 0; q < 16; ++q) {
                    const unsigned* wp = (const unsigned*)&ur[q]; float a = 0.f;
#pragma unroll
                    for (int i = 0; i < 4; ++i) { const auto lo = __builtin_amdgcn_cvt_pk_f32_fp8((int)wp[i], false); const auto hi = __builtin_amdgcn_cvt_pk_f32_fp8((int)wp[i], true);
                        a += lo[0] * xv[4 * i] + lo[1] * xv[4 * i + 1] + hi[0] * xv[4 * i + 2] + hi[1] * xv[4 * i + 3]; }
                    d[q] = a;
                }
                {
                    const bool u5 = lane & 32, u4 = lane & 16, u3 = lane & 8, u2 = lane & 4;
                    float e8[8], e4[4], e2[2], e1;
#pragma unroll
                    for (int q = 0; q < 8; ++q) { const float keep = u5 ? d[q + 8] : d[q], send = u5 ? d[q] : d[q + 8]; e8[q] = keep + __shfl_xor(send, 32); }
#pragma unroll
                    for (int q = 0; q < 4; ++q) { const float keep = u4 ? e8[q + 4] : e8[q], send = u4 ? e8[q] : e8[q + 4]; e4[q] = keep + __shfl_xor(send, 16); }
#pragma unroll
                    for (int q = 0; q < 2; ++q) { const float keep = u3 ? e4[q + 2] : e4[q], send = u3 ? e4[q] : e4[q + 2]; e2[q] = keep + __shfl_xor(send, 8); }
                    { const float keep = u2 ? e2[1] : e2[0], send = u2 ? e2[0] : e2[1]; e1 = keep + __shfl_xor(send, 4); }
                    e1 += __shfl_xor(e1, 2); e1 += __shfl_xor(e1, 1);
                    if ((lane & 3) == 0) { const int q = ((lane >> 5) & 1) * 8 + ((lane >> 4) & 1) * 4 + ((lane >> 3) & 1) * 2 + ((lane >> 2) & 1);
                        const int ex_ = exl[e0 + q];
                        gtl[e0 + q] = gtl[e0 + q] * gelu_f(e1 * PSC[ex_]) * PSC[16384 + ex_]; }
                }
            }
            lds_fence();
            float ac[16];
#pragma unroll
            for (int i = 0; i < 16; ++i) ac[i] = 0.f;
#pragma unroll 1
            for (int e0 = 0; e0 < 128; e0 += 16) {
                uint4 vr[16];
#pragma unroll
                for (int q = 0; q < 16; ++q) vr[q] = *(const uint4*)(PV8 + (size_t)exl[e0 + q] * 1024 + lane * 16);
#pragma unroll
                for (int q = 0; q < 16; ++q) { const float cf = gtl[e0 + q]; const unsigned* wp = (const unsigned*)&vr[q];
#pragma unroll
                    for (int i = 0; i < 4; ++i) { const auto lo = __builtin_amdgcn_cvt_pk_f32_fp8((int)wp[i], false); const auto hi = __builtin_amdgcn_cvt_pk_f32_fp8((int)wp[i], true);
                        ac[4 * i] += cf * lo[0]; ac[4 * i + 1] += cf * lo[1]; ac[4 * i + 2] += cf * hi[0]; ac[4 * i + 3] += cf * hi[1]; }
                }
            }
            float ss = 0.f;
            {
                float* hp = OUT + (size_t)tok * 1024 + lane * 16;
#pragma unroll
                for (int i = 0; i < 4; ++i) { const float4 hv = *(const float4*)(hp + 4 * i);
                    ac[4 * i] += hv.x; ac[4 * i + 1] += hv.y; ac[4 * i + 2] += hv.z; ac[4 * i + 3] += hv.w; }
#pragma unroll
                for (int i = 0; i < 16; ++i) ss += ac[i] * ac[i];
                ss = wave_sum(ss);
                const float rr = rsqrtf(ss * (1.0f / 1024.0f) + 1e-6f);
#pragma unroll
                for (int i = 0; i < 4; ++i) { const float4 gg = *(const float4*)(p.g_final + lane * 16 + 4 * i);
                    *(float4*)(hp + 4 * i) = make_float4(ac[4 * i] * rr * gg.x, ac[4 * i + 1] * rr * gg.y, ac[4 * i + 2] * rr * gg.z, ac[4 * i + 3] * rr * gg.w); }
            }
            lds_fence();
        }
    }
}

extern "C" void kernel_launch(void* const* d_in, const int* in_sizes, int n_in, void* d_out, int out_size, void* d_ws, size_t ws_size, hipStream_t stream) {
    static int grid_blocks = 0;
    if (grid_blocks == 0) {
        int dev = 0, cus = 0, per_cu = 0;
        hipGetDevice(&dev);
        hipDeviceGetAttribute(&cus, hipDeviceAttributeMultiprocessorCount, dev);
        if (hipFuncSetAttribute((const void*)fwd_mega, hipFuncAttributeMaxDynamicSharedMemorySize, LDS_BYTES) != hipSuccess) { fprintf(stderr, "hipFuncSetAttribute failed\n"); }
        if (hipOccupancyMaxActiveBlocksPerMultiprocessor(&per_cu, (const void*)fwd_mega, NTHREADS, LDS_BYTES) != hipSuccess || per_cu < 1) { fprintf(stderr, "occupancy query failed (%d)\n", per_cu); per_cu = 1; }
        (void)hipGetLastError();
        if (per_cu > 1) per_cu = 1;
        grid_blocks = cus * per_cu;
        if (ws_size < O_END) { fprintf(stderr, "workspace too small: %zu < %zu\n", ws_size, (size_t)O_END); grid_blocks = -1; }
    }
    if (grid_blocks < 0) return;
    Params p{};
    const float** pp = (const float**)&p;
    for (int i = 0; i < 30; ++i) pp[i] = (const float*)d_in[i];
    p.out = (float*)d_out; p.ws = (unsigned char*)d_ws;
    if (hipMemsetAsync((char*)d_ws + O_BAR, 0, 16384, stream) != hipSuccess) { fprintf(stderr, "memset of barrier words failed\n"); return; }
    void* args[] = {&p};
    hipError_t e = hipLaunchCooperativeKernel((const void*)fwd_mega, dim3(grid_blocks), dim3(NTHREADS), args, LDS_BYTES, stream);
    if (e != hipSuccess) fprintf(stderr, "cooperative launch failed: %s (grid %d)\n", hipGetErrorString(e), grid_blocks);
}
```

```cpp
#include <hip/hip_runtime.h>
#include <cstdio>
#include <cstdint>

typedef unsigned short bf16_t;
typedef short bf16x8 __attribute__((ext_vector_type(8)));
typedef float f32x4 __attribute__((ext_vector_type(4)));
#define DEVI __device__ __forceinline__

constexpr int NTHREADS = 512;
constexpr int LDS_BYTES = 140 * 1024;

constexpr size_t O_BAR  = 0;
constexpr size_t O_WIN  = 16384;
constexpr size_t O_W1K  = O_WIN  + 4480ull * 1024 * 2;
constexpr size_t O_W1V  = O_W1K  + 256ull * 2048 * 2;
constexpr size_t O_WNSA = O_W1V  + 256ull * 2048 * 2;
constexpr size_t O_WGM  = O_WNSA + 1024ull * 512 * 2;
constexpr size_t O_WMIX = O_WGM  + 1024ull * 512 * 2;
constexpr size_t O_WXQ  = O_WMIX + 1024ull * 1024 * 2;
constexpr size_t O_WXKV = O_WXQ  + 1024ull * 1024 * 2;
constexpr size_t O_WXO  = O_WXKV + 2048ull * 1024 * 2;
constexpr size_t O_WPQ  = O_WXO  + 1024ull * 1024 * 2;
constexpr size_t O_B1   = O_WPQ  + 2048ull * 1024 * 2;
constexpr size_t O_VXT  = O_B1   + 2048;
constexpr size_t O_SUBK = O_VXT  + 8ull * 256 * 256 * 2;
constexpr size_t O_PSC  = O_SUBK + 16ull * 128 * 128 * 2;
constexpr size_t O_HN   = O_PSC  + 2ull * 16384 * 4;
constexpr size_t O_MN   = O_HN   + 16384ull * 1024 * 2;
constexpr size_t O_KVX  = O_MN   + 512ull * 1024 * 2;
constexpr size_t O_GATES= O_KVX  + 512ull * 2048 * 2;
constexpr size_t O_HID  = O_GATES+ 16384ull * 24 * 4;
constexpr size_t O_CMP  = O_HID  + 2ull * 2048 * 256 * 4;
constexpr size_t O_Q    = O_CMP  + 2ull * 4 * 512 * 64 * 4;
constexpr size_t O_KV6  = O_Q    + 16384ull * 512 * 2;
constexpr size_t O_U    = O_KV6  + 6ull * 16384 * 128 * 2;
constexpr size_t O_VG   = O_U    + 16384ull * 512 * 2;
constexpr size_t O_MG   = O_VG   + 16384ull * 512 * 2;
constexpr size_t O_ONSA = O_MG   + 16384ull * 2048 * 2;
constexpr size_t O_OGM  = O_ONSA + 16384ull * 512 * 2;
constexpr size_t O_END  = O_OGM  + 16384ull * 512 * 2;
constexpr size_t O_Y    = O_Q;
constexpr size_t O_QX   = O_U;
constexpr size_t O_OX   = O_ONSA;
constexpr size_t O_QP   = O_MG;
constexpr size_t O_HS   = O_Q;
constexpr size_t O_HI   = O_Q + 16384ull * 256 * 4;
constexpr size_t O_EX   = O_U;
static_assert(O_END <= 256ull * 1024 * 1024, "workspace too large");

struct Params {
    const float *x, *mem, *g_mix, *w_in, *pe_k, *w1_k, *b1_k, *w2_k, *pe_v, *w1_v, *b1_v, *w2_v, *ln_g, *ln_b, *gws, *gbs,
        *w_nsa_out, *w_gmlp_out, *w_mix_out, *g_xattn, *g_mem, *w_xq, *w_xkv, *w_xo, *g_peer, *w_peer_q, *sub_keys, *peer_u, *peer_v, *g_final;
    float* out;
    unsigned char* ws;
};

DEVI bf16_t f2bf(float f) { unsigned u = __float_as_uint(f); u += 0x7fffu + ((u >> 16) & 1u); return (bf16_t)(u >> 16); }
DEVI float bf2f(bf16_t h) { return __uint_as_float(((unsigned)h) << 16); }
DEVI float tof(float v) { return v; }
DEVI float tof(bf16_t v) { return bf2f(v); }
DEVI float wave_sum(float v) { for (int o = 32; o > 0; o >>= 1) v += __shfl_xor(v, o); return v; }
DEVI float wave_max(float v) { for (int o = 32; o > 0; o >>= 1) v = fmaxf(v, __shfl_xor(v, o)); return v; }
DEVI float gelu_f(float x) { return 0.5f * x * (1.0f + erff(x * 0.70710678118654752f)); }
DEVI float sigmoid_f(float x) { return 1.0f / (1.0f + expf(-x)); }
DEVI void wave_argmax(float& v, int& idx) {
    for (int o = 32; o > 0; o >>= 1) {
        const float ov = __shfl_xor(v, o); const int oi = __shfl_xor(idx, o);
        const bool take = (ov > v) || (ov == v && oi < idx);
        v = take ? ov : v; idx = take ? oi : idx;
    }
}
typedef unsigned u32x4 __attribute__((ext_vector_type(4)));
DEVI unsigned cvt_pk_bf16(float lo, float hi) { unsigned r; asm("v_cvt_pk_bf16_f32 %0, %1, %2" : "=v"(r) : "v"(lo), "v"(hi)); return r; }
DEVI bf16x8 pack8(const float (&p)[8]) { u32x4 u; u.x = cvt_pk_bf16(p[0], p[1]); u.y = cvt_pk_bf16(p[2], p[3]); u.z = cvt_pk_bf16(p[4], p[5]); u.w = cvt_pk_bf16(p[6], p[7]); return __builtin_bit_cast(bf16x8, u); }
DEVI void lds_fence() { asm volatile("s_waitcnt lgkmcnt(0)" ::: "memory"); }
DEVI void load8(const float* p, float (&f)[8]) { const float4 a = *(const float4*)p, b = *(const float4*)(p + 4); f[0]=a.x; f[1]=a.y; f[2]=a.z; f[3]=a.w; f[4]=b.x; f[5]=b.y; f[6]=b.z; f[7]=b.w; }
DEVI void load8(const bf16_t* p, float (&f)[8]) { const uint4 a = *(const uint4*)p;
    f[0] = __uint_as_float(a.x << 16); f[1] = __uint_as_float(a.x & 0xffff0000u); f[2] = __uint_as_float(a.y << 16); f[3] = __uint_as_float(a.y & 0xffff0000u);
    f[4] = __uint_as_float(a.z << 16); f[5] = __uint_as_float(a.z & 0xffff0000u); f[6] = __uint_as_float(a.w << 16); f[7] = __uint_as_float(a.w & 0xffff0000u); }

template <class CMap>
DEVI void transpose_tile(const float* src, int srcN, bf16_t* dst, int K, int tl, CMap cmap, float* tile) {
    const int nkt = K / 64, kt = tl % nkt, nt = tl / nkt, k0 = kt * 64, n0 = nt * 64;
    const int tx = threadIdx.x & 63, ty = threadIdx.x >> 6;
    const int sc = cmap(n0 + tx);
#pragma unroll
    for (int i = 0; i < 8; ++i) { const int k = k0 + ty + 8 * i; tile[(ty + 8 * i) * 65 + tx] = sc >= 0 ? src[(size_t)k * srcN + sc] : 0.f; }
    __syncthreads();
#pragma unroll
    for (int i = 0; i < 8; ++i) { const int n = n0 + ty + 8 * i; dst[(size_t)n * K + k0 + tx] = f2bf(tile[tx * 65 + ty + 8 * i]); }
    __syncthreads();
}
struct IdMap { DEVI int operator()(int n) const { return n; } };
struct WinMap { DEVI int operator()(int n) const { return n < 1280 ? n : (n < 4352 ? n + 24 : (n < 4376 ? n - 4352 + 1280 : -1)); } };

DEVI void rmsnorm_row_bf16(const float* xrow, const float* g, bf16_t* dst, int lane) {
    float4 v[4]; float ss = 0.f;
#pragma unroll
    for (int i = 0; i < 4; ++i) { v[i] = ((const float4*)xrow)[lane + 64 * i]; ss += v[i].x * v[i].x + v[i].y * v[i].y + v[i].z * v[i].z + v[i].w * v[i].w; }
    ss = wave_sum(ss);
    const float r = rsqrtf(ss * (1.0f / 1024.0f) + 1e-6f);
#pragma unroll
    for (int i = 0; i < 4; ++i) {
        const float4 gg = ((const float4*)g)[lane + 64 * i];
        uint2 w; w.x = (unsigned)f2bf(v[i].x * r * gg.x) | ((unsigned)f2bf(v[i].y * r * gg.y) << 16); w.y = (unsigned)f2bf(v[i].z * r * gg.z) | ((unsigned)f2bf(v[i].w * r * gg.w) << 16);
        ((uint2*)dst)[lane + 64 * i] = w;
    }
}

constexpr int G_LD = 72;
template <class AF>
DEVI void gemm_tile(f32x4 (&acc)[4][2], AF af, int m0, const bf16_t* Bt, int ldb, int K, bf16_t* As, bf16_t* Bs) {
    const int tid = threadIdx.x, lane = tid & 63, wave = tid >> 6, wm = wave >> 2, wn = wave & 3;
    const int r0 = tid >> 3, kc = (tid & 7) * 8;
    uint4 ra0, ra1, rb0, rb1;
    ra0 = *(const uint4*)af(m0 + r0, kc); ra1 = *(const uint4*)af(m0 + r0 + 64, kc);
    rb0 = *(const uint4*)(Bt + (size_t)r0 * ldb + kc); rb1 = *(const uint4*)(Bt + (size_t)(r0 + 64) * ldb + kc);
    for (int k0 = 0; k0 < K; k0 += 64) {
        __syncthreads();
        *(uint4*)(As + r0 * G_LD + kc) = ra0; *(uint4*)(As + (r0 + 64) * G_LD + kc) = ra1;
        *(uint4*)(Bs + r0 * G_LD + kc) = rb0; *(uint4*)(Bs + (r0 + 64) * G_LD + kc) = rb1;
        __syncthreads();
        if (k0 + 64 < K) {
            const int kn = k0 + 64 + kc;
            ra0 = *(const uint4*)af(m0 + r0, kn); ra1 = *(const uint4*)af(m0 + r0 + 64, kn);
            rb0 = *(const uint4*)(Bt + (size_t)r0 * ldb + kn); rb1 = *(const uint4*)(Bt + (size_t)(r0 + 64) * ldb + kn);
        }
#pragma unroll
        for (int ks = 0; ks < 2; ++ks) {
            bf16x8 af_[4], bf_[2];
#pragma unroll
            for (int i = 0; i < 4; ++i) af_[i] = *(const bf16x8*)(As + (wm * 64 + i * 16 + (lane & 15)) * G_LD + ks * 32 + (lane >> 4) * 8);
#pragma unroll
            for (int j = 0; j < 2; ++j) bf_[j] = *(const bf16x8*)(Bs + (wn * 32 + j * 16 + (lane & 15)) * G_LD + ks * 32 + (lane >> 4) * 8);
#pragma unroll
            for (int i = 0; i < 4; ++i)
#pragma unroll
                for (int j = 0; j < 2; ++j) acc[i][j] = __builtin_amdgcn_mfma_f32_16x16x32_bf16(bf_[j], af_[i], acc[i][j], 0, 0, 0);
        }
    }
}
struct RowMajorA { const bf16_t* A; int lda; DEVI const bf16_t* operator()(int row, int k) const { return A + (size_t)row * lda + k; } };
struct CmpA { const bf16_t* KC; int koff;
    DEVI const bf16_t* operator()(int row, int k_) const { const int k = k_ + koff; const int rr = row < 2044 ? row : 2043; const int b = rr / 1022, rem = rr - b * 1022, c = rem >> 1, g = rem & 1;
        return KC + ((size_t)(b * 8192 + 16 * c + (k >> 6)) * 128 + g * 64 + (k & 63)); } };

template <class AF, class Epi>
DEVI void gemm_run(AF af, const bf16_t* Bt, int K, int MT, int NT, Epi epi, unsigned char* smem, int bid, int nb) {
    bf16_t* As = (bf16_t*)smem; bf16_t* Bs = As + 128 * G_LD;
    const int lane = threadIdx.x & 63, wave = threadIdx.x >> 6, wm = wave >> 2, wn = wave & 3;
    for (int t = bid; t < MT * NT; t += nb) {
        const int mt = t / NT, nt = t % NT;
        f32x4 acc[4][2];
#pragma unroll
        for (int i = 0; i < 4; ++i)
#pragma unroll
            for (int j = 0; j < 2; ++j) acc[i][j] = (f32x4){0.f, 0.f, 0.f, 0.f};
        gemm_tile(acc, af, mt * 128, Bt + (size_t)nt * 128 * K, K, K, As, Bs);
#pragma unroll
        for (int i = 0; i < 4; ++i)
#pragma unroll
            for (int j = 0; j < 2; ++j) epi(mt * 128 + wm * 64 + i * 16 + (lane & 15), nt * 128 + wn * 32 + j * 16 + (lane >> 4) * 4, acc[i][j]);
    }
}
DEVI void store_bf16x4(bf16_t* p, float a, float b, float c, float d) { uint2 w; w.x = (unsigned)f2bf(a) | ((unsigned)f2bf(b) << 16); w.y = (unsigned)f2bf(c) | ((unsigned)f2bf(d) << 16); *(uint2*)p = w; }

namespace pg8 {
#define PG8_LAS __attribute__((address_space(3)))
typedef unsigned short bf16_t;
typedef short bf16x8 __attribute__((ext_vector_type(8)));
typedef float f32x4 __attribute__((ext_vector_type(4)));
typedef unsigned u32x4 __attribute__((ext_vector_type(4)));
constexpr int BM = 256, BK = 64, HALF = 128, HTB = HALF * BK * 2  , STAGE_BYTES = 8 * HTB, NXCD = 8, WGM = 8;

__host__ __device__ __forceinline__ int lds_byte(int r, int c) { const int st = (r >> 4) * 2 + (c >> 5), rr = r & 15, cc = c & 31, ob = rr * 64 + cc * 2; return st * 1024 + (ob ^ (((ob >> 9) & 1) << 5)); }
__host__ __device__ __forceinline__ void stage_rc(int b, int& R, int& C) { const int st = b / 1024, sb = b % 1024, swz = sb ^ (((sb >> 9) & 1) << 5); R = (st >> 1) * 16 + swz / 64; C = (st & 1) * 32 + (swz % 64) / 2; }
__host__ __device__ __forceinline__ int perm32(int rho) { const int n = rho >> 4, i = rho & 15; return 8 * (i >> 2) + 4 * n + (i & 3); }

struct Unit { int pm, pn; };
struct Gemm { const bf16_t* A; const bf16_t* Bt; int M, N, K; };

struct StaticOrder {
    int nM, nN, nwg, G, c;
    __host__ __device__ void init(int M, int N, int G_, int c_) { nM = M / BM; nN = N / BM; nwg = nM * nN; G = G_; c = c_; }
    __host__ __device__ bool next(int i, Unit& u) const {
        const long L = (long)i * G + c; if (L >= nwg) return false;
        int wgid = (int)L; { const int q = nwg / NXCD, r = nwg % NXCD, xcd = wgid % NXCD, off = wgid / NXCD; wgid = (xcd < r ? xcd * (q + 1) : r * (q + 1) + (xcd - r) * q) + off; }
        const int nig = WGM * nN, gid = wgid / nig, fm = gid * WGM, gsz = (nM - fm) < WGM ? (nM - fm) : WGM;
        u.pm = fm + ((wgid % nig) % gsz); u.pn = (wgid % nig) / gsz; return true;
    }
    __device__ __forceinline__ void a_ready(const Unit&) const {}
    __device__ __forceinline__ void done(const Unit&) const {}
};

template <class Epi, class Sched, bool ALIGN_EPI = false, bool SP2 = false>
__device__ __forceinline__ void gemm_phase(PG8_LAS unsigned char* lds, const Gemm g, const Sched& S, const Epi& E) {
    const int tid = threadIdx.x, wid = __builtin_amdgcn_readfirstlane(tid >> 6), lane = tid & 63, wr = wid >> 2, wc = wid & 3, fr = lane & 15, fq = lane >> 4;
    const int K = g.K, nt = K / BK;
    unsigned voffA[2], voffB[2];
#pragma unroll
    for (int i = 0; i < 2; ++i) { int R, C; stage_rc(tid * 16 + i * 8192, R, C); const int Rb = Epi::PERM ? ((R & ~31) + perm32(R & 31)) : R;
        voffA[i] = (unsigned)(R * K + C) * 2u; voffB[i] = (unsigned)(Rb * K + C) * 2u; }
    const size_t kstep = (size_t)(BK * 2);
    const size_t hstep = (size_t)HALF * K * 2;
    const size_t tstep = 2 * hstep;
    const unsigned ldsw = (unsigned)wid * 1024u;
    const int aoff = lds_byte(wr * 64 + fr, fq * 8), boff = lds_byte(wc * 32 + fr, fq * 8);
#define PG8_SA(b, h) (((b) * 2 + (h)) * HTB)
#define PG8_SB(b, h) ((4 + (b) * 2 + (h)) * HTB)
#define PG8_STAGE(bufoff, gbase, voff) do { _Pragma("unroll") for (int _i = 0; _i < 2; ++_i) \
        __builtin_amdgcn_global_load_lds((const unsigned*)((const char*)(gbase) + (voff)[_i]), (PG8_LAS unsigned*)(lds + (bufoff) + ldsw + _i * 8192), 16, 0, 0); } while (0)
#define PG8_LDA(dst, b, h) do { _Pragma("unroll") for (int m = 0; m < 4; ++m) _Pragma("unroll") for (int k = 0; k < 2; ++k) dst[m][k] = *(const PG8_LAS bf16x8*)(lds + PG8_SA(b, h) + aoff + m * 2048 + k * 1024); } while (0)
#define PG8_LDB(dst, b, h) do { _Pragma("unroll") for (int n = 0; n < 2; ++n) _Pragma("unroll") for (int k = 0; k < 2; ++k) dst[n][k] = *(const PG8_LAS bf16x8*)(lds + PG8_SB(b, h) + boff + n * 2048 + k * 1024); } while (0)
#define PG8_MMA(ai, bj, At, Bt) do { __builtin_amdgcn_s_setprio(1); _Pragma("unroll") for (int m = 0; m < 4; ++m) _Pragma("unroll") for (int n = 0; n < 2; ++n) _Pragma("unroll") for (int k = 0; k < 2; ++k) \
        acc[ai][bj][m][n] = __builtin_amdgcn_mfma_f32_16x16x32_bf16(Bt[n][k], At[m][k], acc[ai][bj][m][n], 0, 0, 0); __builtin_amdgcn_s_setprio(0); } while (0)
#define PG8_WAIT_V(n) asm volatile("s_waitcnt vmcnt(" #n ")" ::: "memory")
#define PG8_WAIT_L(n) asm volatile("s_waitcnt lgkmcnt(" #n ")" ::: "memory")
#define PG8_BAR __builtin_amdgcn_s_barrier()
#define PG8_SCHED __builtin_amdgcn_sched_barrier(0)
    Unit cur, nxt; int ui = 0;
    if (!S.next(0, cur)) return;
    f32x4 acc[2][2][4][2];
#pragma unroll
    for (int a = 0; a < 2; ++a)
#pragma unroll
        for (int b = 0; b < 2; ++b)
#pragma unroll
            for (int m = 0; m < 4; ++m)
#pragma unroll
                for (int n = 0; n < 2; ++n) acc[a][b][m][n] = (f32x4){0.f, 0.f, 0.f, 0.f};
    bf16x8 At[4][2], B0[2][2], B1[2][2];
    const char* cA = (const char*)g.A + (size_t)cur.pm * tstep; const char* cB = (const char*)g.Bt + (size_t)cur.pn * tstep;
    S.a_ready(cur);
    if constexpr (SP2) {
        PG8_STAGE(PG8_SB(0, 0), cB, voffB); PG8_STAGE(PG8_SB(0, 1), cB + hstep, voffB); PG8_STAGE(PG8_SA(0, 0), cA, voffA); PG8_STAGE(PG8_SA(0, 1), cA + hstep, voffA);
        if (wr == 1) PG8_BAR;
        PG8_WAIT_V(2); PG8_BAR;
        PG8_STAGE(PG8_SB(1, 0), cB + kstep, voffB); PG8_STAGE(PG8_SA(1, 0), cA + kstep, voffA); PG8_STAGE(PG8_SB(1, 1), cB + hstep + kstep, voffB);
        PG8_WAIT_V(6); PG8_BAR;
    } else {
        PG8_STAGE(PG8_SB(0, 0), cB, voffB); PG8_STAGE(PG8_SA(0, 0), cA, voffA); PG8_STAGE(PG8_SB(0, 1), cB + hstep, voffB); PG8_STAGE(PG8_SA(0, 1), cA + hstep, voffA);
        if (wr == 1) PG8_BAR;
        PG8_WAIT_V(4); PG8_BAR;
        PG8_STAGE(PG8_SB(1, 0), cB + kstep, voffB); PG8_STAGE(PG8_SA(1, 0), cA + kstep, voffA); PG8_STAGE(PG8_SB(1, 1), cB + hstep + kstep, voffB);
        PG8_WAIT_V(6); PG8_BAR;
    }
    for (;;) {
        const bool has_next = S.next(ui + 1, nxt);
        const char* nA = has_next ? (const char*)g.A + (size_t)nxt.pm * tstep : cA; const char* nB = has_next ? (const char*)g.Bt + (size_t)nxt.pn * tstep : cB;
        for (int t = 0; t < nt; t += 2) {
            const bool last = (t == nt - 2);
            const char* a1 = cA + (size_t)(t + 1) * kstep;
            const char* a2 = last ? nA : cA + (size_t)(t + 2) * kstep; const char* b2 = last ? nB : cB + (size_t)(t + 2) * kstep;
            const char* a3 = a2 + kstep; const char* b3 = b2 + kstep;
            if (last && has_next) S.a_ready(nxt);
            if constexpr (SP2) {
            PG8_LDB(B0, 0, 0); PG8_LDB(B1, 0, 1); PG8_SCHED; PG8_LDA(At, 0, 0); PG8_STAGE(PG8_SA(1, 1), a1 + hstep, voffA);
            PG8_WAIT_V(8); PG8_WAIT_L(0); PG8_BAR; PG8_MMA(0, 0, At, B0); PG8_MMA(0, 1, At, B1); PG8_BAR; PG8_SCHED;
            PG8_LDA(At, 0, 1); PG8_STAGE(PG8_SB(0, 0), b2, voffB); PG8_STAGE(PG8_SB(0, 1), b2 + hstep, voffB); PG8_STAGE(PG8_SA(0, 0), a2, voffA);
            PG8_WAIT_V(8); PG8_WAIT_L(0); PG8_BAR; PG8_MMA(1, 0, At, B0); PG8_MMA(1, 1, At, B1); PG8_BAR; PG8_SCHED;
            PG8_LDB(B0, 1, 0); PG8_LDB(B1, 1, 1); PG8_SCHED; PG8_LDA(At, 1, 0); PG8_STAGE(PG8_SA(0, 1), a2 + hstep, voffA);
            PG8_WAIT_V(8); PG8_WAIT_L(0); PG8_BAR; PG8_MMA(0, 0, At, B0); PG8_MMA(0, 1, At, B1); PG8_BAR; PG8_SCHED;
            PG8_LDA(At, 1, 1); PG8_STAGE(PG8_SB(1, 0), b3, voffB); PG8_STAGE(PG8_SB(1, 1), b3 + hstep, voffB); PG8_STAGE(PG8_SA(1, 0), a3, voffA);
            PG8_WAIT_V(8); PG8_WAIT_L(0); PG8_BAR; PG8_MMA(1, 0, At, B0); PG8_MMA(1, 1, At, B1); PG8_BAR; PG8_SCHED;
            } else {
            PG8_LDB(B0, 0, 0); PG8_SCHED; PG8_LDA(At, 0, 0); PG8_STAGE(PG8_SA(1, 1), a1 + hstep, voffA);
            PG8_WAIT_L(8); PG8_BAR; PG8_WAIT_L(0); PG8_MMA(0, 0, At, B0); PG8_BAR; PG8_SCHED;
            PG8_LDB(B1, 0, 1); PG8_STAGE(PG8_SB(0, 0), b2, voffB);
            PG8_BAR; PG8_WAIT_L(0); PG8_MMA(0, 1, At, B1); PG8_BAR;
            PG8_LDA(At, 0, 1); PG8_STAGE(PG8_SA(0, 0), a2, voffA);
            PG8_BAR; PG8_WAIT_L(0); PG8_MMA(1, 0, At, B0); PG8_BAR; PG8_SCHED;
            PG8_STAGE(PG8_SB(0, 1), b2 + hstep, voffB);
            PG8_WAIT_V(6); PG8_BAR; PG8_MMA(1, 1, At, B1); PG8_BAR;
            PG8_LDB(B0, 1, 0); PG8_SCHED; PG8_LDA(At, 1, 0); PG8_STAGE(PG8_SA(0, 1), a2 + hstep, voffA);
            PG8_WAIT_L(8); PG8_BAR; PG8_WAIT_L(0); PG8_MMA(0, 0, At, B0); PG8_BAR; PG8_SCHED;
            PG8_LDB(B1, 1, 1); PG8_STAGE(PG8_SB(1, 0), b3, voffB);
            PG8_BAR; PG8_WAIT_L(0); PG8_MMA(0, 1, At, B1); PG8_BAR;
            PG8_LDA(At, 1, 1); PG8_STAGE(PG8_SA(1, 0), a3, voffA);
            PG8_BAR; PG8_WAIT_L(0); PG8_MMA(1, 0, At, B0); PG8_BAR; PG8_SCHED;
            PG8_STAGE(PG8_SB(1, 1), b3 + hstep, voffB);
            PG8_WAIT_V(6); PG8_BAR; PG8_MMA(1, 1, At, B1); PG8_BAR;
            }
        }
        if constexpr (ALIGN_EPI) { if (wr == 0) PG8_BAR; }
        if constexpr (!Epi::AFTER_DRAIN) { E(acc, cur, wr, wc, fr, fq); S.done(cur); }
        if (!has_next) break;
#pragma unroll
        for (int a = 0; a < 2; ++a)
#pragma unroll
            for (int b = 0; b < 2; ++b)
#pragma unroll
                for (int m = 0; m < 4; ++m)
#pragma unroll
                    for (int n = 0; n < 2; ++n) acc[a][b][m][n] = (f32x4){0.f, 0.f, 0.f, 0.f};
        cur = nxt; cA = nA; cB = nB; ++ui;
        if constexpr (ALIGN_EPI) { if (wr == 1) PG8_BAR; }
    }
    PG8_WAIT_V(0);
    if constexpr (!ALIGN_EPI) { if (wr == 0) PG8_BAR; }
    PG8_BAR;
    if constexpr (Epi::AFTER_DRAIN) { E.fused(acc, cur, wr, wc, fr, fq, lds, wid, lane); S.done(cur); }
#undef PG8_SA
#undef PG8_SB
#undef PG8_STAGE
#undef PG8_LDA
#undef PG8_LDB
#undef PG8_MMA
#undef PG8_WAIT_V
#undef PG8_WAIT_L
#undef PG8_BAR
#undef PG8_SCHED
}
}

template <class F> struct EpiFn {
    static constexpr bool PERM = true, AFTER_DRAIN = false;
    F f;
    DEVI void operator()(const f32x4 (&acc)[2][2][4][2], const pg8::Unit& u, int wr, int wc, int fr, int fq) const {
#pragma unroll
        for (int ai = 0; ai < 2; ++ai)
#pragma unroll
            for (int m = 0; m < 4; ++m) {
                const int row = u.pm * 256 + ai * 128 + wr * 64 + m * 16 + fr;
#pragma unroll
                for (int bj = 0; bj < 2; ++bj) f(row, u.pn * 256 + bj * 128 + wc * 32 + 8 * fq, acc[ai][bj][m][0], acc[ai][bj][m][1]);
            }
    }
};
template <class F> DEVI EpiFn<F> make_epi(F f) { return EpiFn<F>{f}; }
template <class F>
DEVI void big_gemm(unsigned char* smem, const bf16_t* A, const bf16_t* Bt, int M, int N, int K, F f) {
    pg8::StaticOrder S; S.init(M, N, (int)gridDim.x, (int)blockIdx.x);
    const pg8::Gemm g{A, Bt, M, N, K};
    const auto E = make_epi(f);
    pg8::gemm_phase<EpiFn<F>, pg8::StaticOrder, true, true>((PG8_LAS unsigned char*)smem, g, S, E);
}
DEVI void store_bf16x8(bf16_t* p, const f32x4& a, const f32x4& b) { u32x4 w; w.x = cvt_pk_bf16(a[0], a[1]); w.y = cvt_pk_bf16(a[2], a[3]); w.z = cvt_pk_bf16(b[0], b[1]); w.w = cvt_pk_bf16(b[2], b[3]); *(u32x4*)p = w; }

template <int DH, int R, int NCH, bool PSUM, typename KT, class RowF>
DEVI void attend(const float* qs, float* pl, float* psum, const KT* Kb, const KT* Vb, size_t stride, RowF rowf, float (&o)[R][DH / 64], int lane) {
    float m[R], l[R];
#pragma unroll
    for (int r = 0; r < R; ++r) { m[r] = -1e30f; l[r] = 0.f; }
#pragma unroll 1
    for (int i = 0; i < NCH; ++i) {
        bool valid; const long row = rowf(i, lane, valid);
        if (__ballot(valid) == 0ull) continue;
        const KT* kp = Kb + (size_t)row * stride;
        float a[R];
#pragma unroll
        for (int r = 0; r < R; ++r) a[r] = 0.f;
#pragma unroll 2
        for (int d0 = 0; d0 < DH; d0 += 8) {
            float kf[8]; load8(kp + d0, kf);
#pragma unroll
            for (int r = 0; r < R; ++r) {
                const float4 q0 = *(const float4*)(qs + r * DH + d0), q1 = *(const float4*)(qs + r * DH + d0 + 4);
                a[r] += kf[0] * q0.x + kf[1] * q0.y + kf[2] * q0.z + kf[3] * q0.w + kf[4] * q1.x + kf[5] * q1.y + kf[6] * q1.z + kf[7] * q1.w;
            }
        }
#pragma unroll
        for (int r = 0; r < R; ++r) {
            const float sv = valid ? a[r] : -1e30f;
            const float mn = fmaxf(m[r], wave_max(sv));
            const float pe = valid ? expf(sv - mn) : 0.f;
            l[r] = l[r] * expf(m[r] - mn) + wave_sum(pe);
            m[r] = mn;
        }
    }
    float inv[R];
#pragma unroll
    for (int r = 0; r < R; ++r) inv[r] = 1.0f / fmaxf(l[r], 1e-30f);
#pragma unroll 1
    for (int i = 0; i < NCH; ++i) {
        bool valid; const long row = rowf(i, lane, valid);
        const bool any = __ballot(valid) != 0ull;
        float a[R];
#pragma unroll
        for (int r = 0; r < R; ++r) a[r] = 0.f;
        if (any) {
            const KT* kp = Kb + (size_t)row * stride;
#pragma unroll 2
            for (int d0 = 0; d0 < DH; d0 += 8) {
                float kf[8]; load8(kp + d0, kf);
#pragma unroll
                for (int r = 0; r < R; ++r) {
                    const float4 q0 = *(const float4*)(qs + r * DH + d0), q1 = *(const float4*)(qs + r * DH + d0 + 4);
                    a[r] += kf[0] * q0.x + kf[1] * q0.y + kf[2] * q0.z + kf[3] * q0.w + kf[4] * q1.x + kf[5] * q1.y + kf[6] * q1.z + kf[7] * q1.w;
                }
            }
        }
        float ps = 0.f;
#pragma unroll
        for (int r = 0; r < R; ++r) { const float pv = valid ? expf(a[r] - m[r]) * inv[r] : 0.f; pl[r * 64 + lane] = pv; ps += pv; }
        if (PSUM) psum[i * 64 + lane] = ps;
        lds_fence();
        if (any) {
#pragma unroll 2
            for (int key = 0; key < 64; ++key) {
                bool dummy; const long vrow = rowf(i, key, dummy);
                const KT* vp = Vb + (size_t)vrow * stride;
                float pr[R];
#pragma unroll
                for (int r = 0; r < R; ++r) pr[r] = pl[r * 64 + key];
#pragma unroll
                for (int j = 0; j < DH / 64; ++j) { const float v = tof(vp[lane + 64 * j]);
#pragma unroll
                    for (int r = 0; r < R; ++r) o[r][j] += pr[r] * v; }
            }
        }
        lds_fence();
    }
}


DEVI int nsa_koff(int t, int d) { return ((((t >> 5) * 4 + (((t >> 2) & 1) * 2 + (d >> 5))) * 64) + ((((t & 31) >> 3) << 2) | (t & 3)) + 16 * ((d >> 3) & 3)) * 8 + (d & 7); }
DEVI int nsa_voff(int t, int d) { return ((((t >> 5) * 4 + (d >> 4)) * 64) + (d & 15) + 16 * ((t & 31) >> 3)) * 8 + (t & 7); }
DEVI int xat_koff(int m, int d) { return ((((m >> 5) * 16 + ((m >> 2) & 1) * 8 + (d >> 5)) * 64) + ((((m & 31) >> 3) << 2) | (m & 3)) + 16 * ((d >> 3) & 3)) * 8 + (d & 7); }
DEVI int xat_voff(int m, int d) { return ((((m >> 5) * 16 + (d >> 4)) * 64) + (d & 15) + 16 * ((m & 31) >> 3)) * 8 + (m & 7); }
DEVI int pk_koff(int k, int d) { return ((((k >> 4) * 4 + (d >> 5)) * 64) + (k & 15) + 16 * ((d >> 3) & 3)) * 8 + (d & 7); }
DEVI void nsa_load_kf(bf16x8 (&ka)[4], const bf16_t* Kp, int ch, int lane) {
#pragma unroll
    for (int f = 0; f < 4; ++f) ka[f] = *(const bf16x8*)(Kp + ((ch * 4 + f) * 64 + lane) * 8);
}
DEVI void nsa_load_k(bf16x8 (&ka)[4], const bf16_t* Kp, int stride, int kb, int rk, int dh) {
    const int o0 = (kb + rk) * stride + dh, o1 = o0 + 4 * stride;
    ka[0] = *(const bf16x8*)(Kp + o0); ka[1] = *(const bf16x8*)(Kp + o0 + 32); ka[2] = *(const bf16x8*)(Kp + o1); ka[3] = *(const bf16x8*)(Kp + o1 + 32);
}
DEVI void nsa_load_v(bf16x8 (&va)[4], const bf16_t* Vp, int vstride, int kb8, int lr) {
    const int o = lr * vstride + kb8;
#pragma unroll
    for (int dt = 0; dt < 4; ++dt) va[dt] = *(const bf16x8*)(Vp + o + dt * 16 * vstride);
}
DEVI void nsa_load_vb(bf16x8 (&va)[4], const bf16_t* Vp, int kb8, int lr) {
    const int o = ((kb8 >> 6) * 64 + lr) * 64 + (kb8 & 63);
#pragma unroll
    for (int dt = 0; dt < 4; ++dt) va[dt] = *(const bf16x8*)(Vp + o + dt * 16 * 64);
}
DEVI void nsa_scores(const bf16x8 (&ka)[4], const bf16x8 (&qf)[2], float (&sv)[8]) {
    f32x4 s0 = {0.f, 0.f, 0.f, 0.f}, s1 = {0.f, 0.f, 0.f, 0.f};
    s0 = __builtin_amdgcn_mfma_f32_16x16x32_bf16(ka[0], qf[0], s0, 0, 0, 0); s1 = __builtin_amdgcn_mfma_f32_16x16x32_bf16(ka[2], qf[0], s1, 0, 0, 0);
    s0 = __builtin_amdgcn_mfma_f32_16x16x32_bf16(ka[1], qf[1], s0, 0, 0, 0); s1 = __builtin_amdgcn_mfma_f32_16x16x32_bf16(ka[3], qf[1], s1, 0, 0, 0);
    sv[0] = s0[0]; sv[1] = s0[1]; sv[2] = s0[2]; sv[3] = s0[3]; sv[4] = s1[0]; sv[5] = s1[1]; sv[6] = s1[2]; sv[7] = s1[3];
}
struct NsaSt { float m, l; f32x4 o[4]; };
struct NsaBuf { bf16x8 ka[4]; bf16x8 va[4]; };
DEVI void nsa_init(NsaSt& st) { st.m = -1e20f; st.l = 0.f;
#pragma unroll
    for (int dt = 0; dt < 4; ++dt) st.o[dt] = (f32x4){0.f, 0.f, 0.f, 0.f}; }
template <bool PV>
DEVI void nsa_chunk(NsaSt& st, float (&sv)[8], int pos0, int lo, int hi, const bf16x8 (&va)[4]) {
    float cm = -1e30f;
#pragma unroll
    for (int j = 0; j < 8; ++j) { const bool ok = (pos0 + j >= lo) && (pos0 + j <= hi); sv[j] = ok ? sv[j] : -1e30f; cm = fmaxf(cm, sv[j]); }
    cm = fmaxf(cm, __shfl_xor(cm, 16)); cm = fmaxf(cm, __shfl_xor(cm, 32));
    if (__any(cm > st.m)) {
        const float mn = fmaxf(st.m, cm), sc = __builtin_amdgcn_exp2f(st.m - mn);
        st.l *= sc;
        if (PV) {
#pragma unroll
            for (int dt = 0; dt < 4; ++dt) st.o[dt] *= sc;
        }
        st.m = mn;
    }
    float p[8]; float ps = 0.f;
#pragma unroll
    for (int j = 0; j < 8; ++j) { p[j] = __builtin_amdgcn_exp2f(sv[j] - st.m); ps += p[j]; }
    st.l += ps;
    if (PV) {
        const bf16x8 pb = pack8(p);
#pragma unroll
        for (int dt = 0; dt < 4; ++dt) st.o[dt] = __builtin_amdgcn_mfma_f32_16x16x32_bf16(va[dt], pb, st.o[dt], 0, 0, 0);
    }
}
DEVI void nsa_fold(f32x4 (&comb)[4], NsaSt& st, float gate) {
    float l = st.l; l += __shfl_xor(l, 16); l += __shfl_xor(l, 32);
    const float w = gate / fmaxf(l, 1e-30f);
#pragma unroll
    for (int dt = 0; dt < 4; ++dt) comb[dt] += st.o[dt] * w;
}
template <class LD, class CP>
DEVI void nsa_stream(int n, LD ld, CP cp) {
    NsaBuf A, B, C;
    if (n > 0) ld(A, 0);
    if (n > 1) ld(B, 1);
#pragma unroll 1
    for (int i = 0; i < n; i += 3) {
        if (i + 2 < n) ld(C, i + 2);
        cp(A, i);
        if (i + 1 < n) { if (i + 3 < n) ld(A, i + 3); cp(B, i + 1); }
        if (i + 2 < n) { if (i + 4 < n) ld(B, i + 4); cp(C, i + 2); }
    }
}
template <class LD, class CP>
DEVI void nsa_stream2(int n, LD ld, CP cp) {
    NsaBuf A, B;
    if (n > 0) ld(A, 0);
#pragma unroll 1
    for (int i = 0; i < n; i += 2) {
        if (i + 1 < n) ld(B, i + 1);
        cp(A, i);
        if (i + 1 < n) { if (i + 2 < n) ld(A, i + 2); cp(B, i + 1); }
    }
}

#define XB_TMO      128
#define XB_XCNT(j)  (256  + 64 * (j))
#define XB_XSUB(j)  (1280 + 64 * (j))
#define XB_XGEN(j)  (2304 + 64 * (j))
#define XB_TOP      3328
#define XB_TOPGEN   3392
#define XCD_BAR_WORDS 3456
#define XB_SPIN_CAP (1u << 22)
#define LAS __attribute__((address_space(3)))
DEVI unsigned xb_ld(unsigned* p)              { return __hip_atomic_load(p, __ATOMIC_RELAXED, __HIP_MEMORY_SCOPE_AGENT); }
DEVI unsigned xb_add(unsigned* p, unsigned v) { return __hip_atomic_fetch_add(p, v, __ATOMIC_RELAXED, __HIP_MEMORY_SCOPE_AGENT); }
DEVI unsigned xb_xcc_id() { return (unsigned)__builtin_amdgcn_s_getreg((3 << 11) | 20) & 0xFu; }
#define XB_SPIN(cond, bar) do { unsigned _sp = 0; while (cond) { __builtin_amdgcn_s_sleep(1); \
    if ((++_sp & 255u) == 0u) { if (xb_ld(&(bar)[XB_TMO])) break; if (_sp > XB_SPIN_CAP) { atomicAdd(&(bar)[XB_TMO], 1u); break; } } } } while (0)
struct XcdBarrier { unsigned* bar; unsigned x; volatile LAS unsigned* st; };
DEVI XcdBarrier xcd_barrier_post(unsigned* bar, volatile LAS unsigned* st) {
    XcdBarrier b; b.bar = bar; b.x = xb_xcc_id(); b.st = st;
    if (threadIdx.x == 0) (void)xb_add(&bar[XB_XCNT(b.x)], 1u);
    return b;
}
DEVI void xcd_barrier_complete(unsigned* bar, unsigned x, unsigned& nloc, unsigned& nx) {
    const unsigned G = gridDim.x * gridDim.y * gridDim.z;
    unsigned sum, cnt, mine, sp = 0u;
    for (;;) {
        sum = 0u; cnt = 0u; mine = 0u;
#pragma unroll
        for (unsigned j = 0; j < 16; ++j) { const unsigned c = xb_ld(&bar[XB_XCNT(j)]); sum += c; cnt += (c > 0u) ? 1u : 0u; mine = (j == x) ? c : mine; }
        if (sum == G) break;
        __builtin_amdgcn_s_sleep(1);
        if ((++sp & 255u) == 0u) { if (xb_ld(&bar[XB_TMO])) break; if (sp > XB_SPIN_CAP) { atomicAdd(&bar[XB_TMO], 1u); break; } }
    }
    nloc = mine > 0u ? mine : 1u; nx = cnt > 0u ? cnt : 1u;
}
DEVI void xcd_barrier(const XcdBarrier& b) {
    asm volatile("s_waitcnt vmcnt(0)" ::: "memory");
    __syncthreads();
    if (threadIdx.x == 0) {
        unsigned* bar = b.bar;
        __builtin_amdgcn_s_waitcnt(0);
        unsigned nloc = b.st[0], nx = b.st[1];
        if (nloc == 0u) { xcd_barrier_complete(bar, b.x, nloc, nx); b.st[0] = nloc; b.st[1] = nx; }
        const unsigned old = xb_add(&bar[XB_XSUB(b.x)], 1u);
        const unsigned gen = old / nloc;
        if (old + 1u == (gen + 1u) * nloc) {
            __builtin_amdgcn_fence(__ATOMIC_RELEASE, "agent");
            asm volatile("s_waitcnt vmcnt(0)" ::: "memory");
            const unsigned og = xb_add(&bar[XB_TOP], 1u);
            const unsigned tg = og / nx;
            if (og + 1u == (tg + 1u) * nx) xb_add(&bar[XB_TOPGEN], 1u);
            else XB_SPIN(xb_ld(&bar[XB_TOPGEN]) == tg, bar);
            __builtin_amdgcn_fence(__ATOMIC_ACQUIRE, "agent");
            xb_add(&bar[XB_XGEN(b.x)], 1u);
            asm volatile("s_waitcnt vmcnt(0)" ::: "memory");
        } else {
            XB_SPIN(xb_ld(&bar[XB_XGEN(b.x)]) == gen, bar);
            __builtin_amdgcn_fence(__ATOMIC_ACQUIRE, "agent");
            asm volatile("s_waitcnt vmcnt(0)" ::: "memory");
        }
    }
    __syncthreads();
}

DEVI void* ldptr(volatile LAS unsigned long long* tab, int i) { const unsigned long long v = tab[i];
    const unsigned lo = __builtin_amdgcn_readfirstlane((unsigned)v), hi = __builtin_amdgcn_readfirstlane((unsigned)(v >> 32)); return (void*)(((unsigned long long)hi << 32) | lo); }

__global__ void __launch_bounds__(NTHREADS) fwd_mega(Params pa) {
    extern __shared__ __attribute__((aligned(16))) unsigned char smem[];
    const int bid = blockIdx.x, nb = gridDim.x, tid = threadIdx.x, lane = tid & 63, wave = tid >> 6;
    volatile LAS unsigned long long* ptab = (volatile LAS unsigned long long*)(smem + LDS_BYTES - 16 - 32 * 8);
    {
        volatile LAS unsigned* st0 = (volatile LAS unsigned*)(smem + LDS_BYTES - 16);
        if (tid < 4) st0[tid] = 0u;
        if (tid == 0) {
            ptab[0] = (unsigned long long)pa.x; ptab[1] = (unsigned long long)pa.mem; ptab[2] = (unsigned long long)pa.g_mix; ptab[3] = (unsigned long long)pa.w_in;
            ptab[4] = (unsigned long long)pa.pe_k; ptab[5] = (unsigned long long)pa.w1_k; ptab[6] = (unsigned long long)pa.b1_k; ptab[7] = (unsigned long long)pa.w2_k;
            ptab[8] = (unsigned long long)pa.pe_v; ptab[9] = (unsigned long long)pa.w1_v; ptab[10] = (unsigned long long)pa.b1_v; ptab[11] = (unsigned long long)pa.w2_v;
            ptab[12] = (unsigned long long)pa.ln_g; ptab[13] = (unsigned long long)pa.ln_b; ptab[14] = (unsigned long long)pa.gws; ptab[15] = (unsigned long long)pa.gbs;
            ptab[16] = (unsigned long long)pa.w_nsa_out; ptab[17] = (unsigned long long)pa.w_gmlp_out; ptab[18] = (unsigned long long)pa.w_mix_out; ptab[19] = (unsigned long long)pa.g_xattn;
            ptab[20] = (unsigned long long)pa.g_mem; ptab[21] = (unsigned long long)pa.w_xq; ptab[22] = (unsigned long long)pa.w_xkv; ptab[23] = (unsigned long long)pa.w_xo;
            ptab[24] = (unsigned long long)pa.g_peer; ptab[25] = (unsigned long long)pa.w_peer_q; ptab[26] = (unsigned long long)pa.sub_keys; ptab[27] = (unsigned long long)pa.peer_u;
            ptab[28] = (unsigned long long)pa.peer_v; ptab[29] = (unsigned long long)pa.g_final; ptab[30] = (unsigned long long)pa.out; ptab[31] = (unsigned long long)pa.ws;
        }
        __syncthreads();
    }
    const XcdBarrier xb = xcd_barrier_post((unsigned*)pa.ws, (volatile LAS unsigned*)(smem + LDS_BYTES - 16));
#define LDP(i) ((const float*)ldptr(ptab, i))
#define PHASE_BEGIN \
    int tid_ = threadIdx.x; asm volatile("" : "+v"(tid_)); const int tid = tid_, lane = tid & 63, wave = tid >> 6; (void)lane; (void)wave; \
    Params p; p.x = LDP(0); p.mem = LDP(1); p.g_mix = LDP(2); p.w_in = LDP(3); p.pe_k = LDP(4); p.w1_k = LDP(5); p.b1_k = LDP(6); p.w2_k = LDP(7); p.pe_v = LDP(8); p.w1_v = LDP(9); p.b1_v = LDP(10); p.w2_v = LDP(11); \
    p.ln_g = LDP(12); p.ln_b = LDP(13); p.gws = LDP(14); p.gbs = LDP(15); p.w_nsa_out = LDP(16); p.w_gmlp_out = LDP(17); p.w_mix_out = LDP(18); p.g_xattn = LDP(19); p.g_mem = LDP(20); p.w_xq = LDP(21); p.w_xkv = LDP(22); p.w_xo = LDP(23); \
    p.g_peer = LDP(24); p.w_peer_q = LDP(25); p.sub_keys = LDP(26); p.peer_u = LDP(27); p.peer_v = LDP(28); p.g_final = LDP(29); p.out = (float*)ldptr(ptab, 30); p.ws = (unsigned char*)ldptr(ptab, 31); \
    unsigned char* const ws = p.ws; \
    bf16_t* WIN = (bf16_t*)(ws + O_WIN); bf16_t* W1K = (bf16_t*)(ws + O_W1K); bf16_t* W1V = (bf16_t*)(ws + O_W1V); \
    bf16_t* WNSA = (bf16_t*)(ws + O_WNSA); bf16_t* WGM = (bf16_t*)(ws + O_WGM); bf16_t* WMIX = (bf16_t*)(ws + O_WMIX); \
    bf16_t* WXQ = (bf16_t*)(ws + O_WXQ); bf16_t* WXKV = (bf16_t*)(ws + O_WXKV); bf16_t* WXO = (bf16_t*)(ws + O_WXO); bf16_t* WPQ = (bf16_t*)(ws + O_WPQ); \
    float* B1F = (float*)(ws + O_B1); \
    bf16_t* HN = (bf16_t*)(ws + O_HN); bf16_t* MN = (bf16_t*)(ws + O_MN); bf16_t* KVX = (bf16_t*)(ws + O_KVX); \
    float* GATES = (float*)(ws + O_GATES); float* HID = (float*)(ws + O_HID); \
    bf16_t* Q = (bf16_t*)(ws + O_Q); bf16_t* KV6 = (bf16_t*)(ws + O_KV6); bf16_t* U = (bf16_t*)(ws + O_U); bf16_t* VG = (bf16_t*)(ws + O_VG); \
    bf16_t* MG = (bf16_t*)(ws + O_MG); bf16_t* ONSA = (bf16_t*)(ws + O_ONSA); bf16_t* OGM = (bf16_t*)(ws + O_OGM); \
    bf16_t* Y = (bf16_t*)(ws + O_Y); bf16_t* QX = (bf16_t*)(ws + O_QX); bf16_t* OX = (bf16_t*)(ws + O_OX); bf16_t* QP = (bf16_t*)(ws + O_QP); \
    float* HS = (float*)(ws + O_HS); int* HI = (int*)(ws + O_HI); \
    bf16_t* VXT = (bf16_t*)(ws + O_VXT); bf16_t* SUBK = (bf16_t*)(ws + O_SUBK); \
    bf16_t* KCB = (bf16_t*)(ws + O_CMP); bf16_t* VCT = KCB + 4 * 512 * 64; \
    unsigned char* PU8 = ws + O_U; unsigned char* PV8 = ws + O_U + 16384ull * 1024; \
    float* PSC = (float*)(ws + O_PSC); \
    float* OUT = p.out; \
    (void)WIN; (void)W1K; (void)W1V; (void)WNSA; (void)WGM; (void)WMIX; (void)WXQ; (void)WXKV; (void)WXO; (void)WPQ; (void)B1F; (void)HN; (void)MN; (void)KVX; (void)GATES; (void)HID; (void)Q; (void)KV6; (void)U; (void)VG; \
    (void)MG; (void)ONSA; (void)OGM; (void)Y; (void)QX; (void)OX; (void)QP; (void)HS; (void)HI; (void)VXT; (void)SUBK; (void)KCB; (void)VCT; (void)PU8; (void)PV8; (void)PSC; (void)OUT;

    { PHASE_BEGIN
    {
        float* tile = (float*)smem;
        for (int j = bid; j < 3424; j += nb) {
            int t = j;
            if (t < 1120) { transpose_tile(p.w_in, 4376, WIN, 1024, t, WinMap(), tile); continue; } t -= 1120;
            if (t < 128) { transpose_tile(p.w1_k, 256, W1K, 2048, t, IdMap(), tile); continue; } t -= 128;
            if (t < 128) { transpose_tile(p.w1_v, 256, W1V, 2048, t, IdMap(), tile); continue; } t -= 128;
            if (t < 128) { transpose_tile(p.w_nsa_out, 1024, WNSA, 512, t, IdMap(), tile); continue; } t -= 128;
            if (t < 128) { transpose_tile(p.w_gmlp_out, 1024, WGM, 512, t, IdMap(), tile); continue; } t -= 128;
            if (t < 256) { transpose_tile(p.w_mix_out, 1024, WMIX, 1024, t, IdMap(), tile); continue; } t -= 256;
            if (t < 256) { transpose_tile(p.w_xq, 1024, WXQ, 1024, t, IdMap(), tile); continue; } t -= 256;
            if (t < 512) { transpose_tile(p.w_xkv, 2048, WXKV, 1024, t, IdMap(), tile); continue; } t -= 512;
            if (t < 256) { transpose_tile(p.w_xo, 1024, WXO, 1024, t, IdMap(), tile); continue; } t -= 256;
            transpose_tile(p.w_peer_q, 2048, WPQ, 1024, t, IdMap(), tile);
        }
        for (int r = bid * 8 + wave; r < 16384 + 512; r += nb * 8) {
            if (r < 16384) rmsnorm_row_bf16(p.x + (size_t)r * 1024, p.g_mix, HN + (size_t)r * 1024, lane);
            else rmsnorm_row_bf16(p.mem + (size_t)(r - 16384) * 1024, p.g_mem, MN + (size_t)(r - 16384) * 1024, lane);
        }
        for (int i = bid * NTHREADS + tid; i < 16 * 128 * 128; i += nb * NTHREADS) SUBK[(i & ~16383) + pk_koff((i >> 7) & 127, i & 127)] = f2bf(p.sub_keys[i]);
        for (int i = bid * NTHREADS + tid; i < 2 * 2048 * 256 / 4; i += nb * NTHREADS) ((float4*)HID)[i] = make_float4(0.f, 0.f, 0.f, 0.f);
        if (bid == nb - 1) {
            const int kv = tid >> 8, n = tid & 255;
            const float* pe = kv ? p.pe_v : p.pe_k; const float* w1 = kv ? p.w1_v : p.w1_k; const float* b1 = kv ? p.b1_v : p.b1_k;
            float a = b1[n];
            for (int k = 0; k < 2048; ++k) a += pe[k] * w1[(size_t)k * 256 + n];
            B1F[kv * 256 + n] = a;
        }
    }
    }
    xcd_barrier(xb);

    { PHASE_BEGIN
    {
        auto epi = [&](int r, int c, const f32x4& v0, const f32x4& v1) {
            if (c < 512) { const float qs_ = 0.125f * 1.4426950408889634f; store_bf16x8(Q + (size_t)r * 512 + c, v0 * qs_, v1 * qs_); }
            else if (c < 1280) { const int w = (c - 512) >> 7, cc = (c - 512) & 127;
                const int b_ = r >> 13, t_ = r & 8191, g_ = cc >> 6, d_ = cc & 63;
                if (w == 3 || w == 5) {
                    bf16_t* vt = KV6 + (size_t)w * 16384 * 128 + (size_t)(b_ * 2 + g_) * 8192 * 64 + nsa_voff(t_, d_);
                    vt[0] = f2bf(v0[0]); vt[8] = f2bf(v0[1]); vt[16] = f2bf(v0[2]); vt[24] = f2bf(v0[3]); vt[32] = f2bf(v1[0]); vt[40] = f2bf(v1[1]); vt[48] = f2bf(v1[2]); vt[56] = f2bf(v1[3]); }
                else if (w == 2 || w == 4) store_bf16x8(KV6 + (size_t)w * 16384 * 128 + (size_t)(b_ * 2 + g_) * 8192 * 64 + nsa_koff(t_, d_), v0, v1);
                else store_bf16x8(KV6 + ((size_t)w * 16384 + r) * 128 + cc, v0, v1); }
            else if (c < 2304) { bf16_t* dst = c < 1792 ? U + (size_t)r * 512 + (c - 1280) : VG + (size_t)r * 512 + (c - 1792);
                f32x4 a, b;
#pragma unroll
                for (int e = 0; e < 4; ++e) { a[e] = gelu_f(v0[e]); b[e] = gelu_f(v1[e]); }
                store_bf16x8(dst, a, b); }
            else { f32x4 a, b;
#pragma unroll
                for (int e = 0; e < 4; ++e) { a[e] = sigmoid_f(v0[e]); b[e] = sigmoid_f(v1[e]); }
                store_bf16x8(MG + (size_t)r * 2048 + (c - 2304), a, b); }
        };
        big_gemm(smem, HN, WIN, 16384, 4352, 1024, epi);
    }
    }
    xcd_barrier(xb);

    { PHASE_BEGIN
    {
        for (int task = bid; task < 256; task += nb) {
            if (task < 128) {
                const int kv = task >> 6, t = task & 63, mt = t >> 2, nt = (t >> 1) & 1, kh = t & 1;
                bf16_t* As = (bf16_t*)smem; bf16_t* Bs = As + 128 * G_LD;
                const int wm = wave >> 2, wn = wave & 3;
                f32x4 acc[4][2];
#pragma unroll
                for (int i = 0; i < 4; ++i)
#pragma unroll
                    for (int j = 0; j < 2; ++j) acc[i][j] = (f32x4){0.f, 0.f, 0.f, 0.f};
                gemm_tile(acc, CmpA{KV6 + (size_t)kv * 16384 * 128, kh * 1024}, mt * 128, (kv ? W1V : W1K) + (size_t)nt * 128 * 2048 + kh * 1024, 2048, 1024, As, Bs);
#pragma unroll
                for (int i = 0; i < 4; ++i)
#pragma unroll
                    for (int j = 0; j < 2; ++j) {
                        const int r = mt * 128 + wm * 64 + i * 16 + (lane & 15), c = nt * 128 + wn * 32 + j * 16 + (lane >> 4) * 4;
                        if (r < 2044) { float* hp = HID + ((size_t)kv * 2048 + r) * 256 + c;
                            unsafeAtomicAdd(hp, acc[i][j][0]); unsafeAtomicAdd(hp + 1, acc[i][j][1]); unsafeAtomicAdd(hp + 2, acc[i][j][2]); unsafeAtomicAdd(hp + 3, acc[i][j][3]); }
                    }
                __syncthreads();
            } else {
                const int ch = task - 128;
                const size_t row0 = (size_t)ch * 128;
                constexpr int VLD = 136;
                bf16_t* VT = (bf16_t*)smem;
                float* st = (float*)(smem + 512 * VLD * 2);
                for (int r = wave * 16; r < wave * 16 + 16; ++r) {
                    float f[8]; load8(VG + (row0 + r) * 512 + lane * 8, f);
                    float s1 = 0.f;
#pragma unroll
                    for (int e = 0; e < 8; ++e) s1 += f[e];
                    s1 = wave_sum(s1); const float mu = s1 * (1.0f / 512.0f);
                    float s2 = 0.f;
#pragma unroll
                    for (int e = 0; e < 8; ++e) s2 += (f[e] - mu) * (f[e] - mu);
                    s2 = wave_sum(s2);
                    if (lane == 0) { st[r * 2] = mu; st[r * 2 + 1] = rsqrtf(s2 * (1.0f / 512.0f) + 1e-6f); }
                }
                __syncthreads();
                {
                    const int s_ = tid & 127; const float mu = st[s_ * 2], rs = st[s_ * 2 + 1];
#pragma unroll 1
                    for (int i = 0; i < 16; ++i) {
                        const int d0 = ((tid >> 7) + 4 * i) * 8;
                        float f[8]; load8(VG + (row0 + s_) * 512 + d0, f);
#pragma unroll
                        for (int e = 0; e < 8; ++e) VT[(d0 + e) * VLD + s_] = f2bf((f[e] - mu) * rs * p.ln_g[d0 + e] + p.ln_b[d0 + e]);
                    }
                }
                __syncthreads();
                {
                    const int tl = wave * 16 + (lane & 15), hq = lane >> 4, kmax = (wave * 16 + 15) >> 5;
                    for (int g = 0; g < 4; ++g) {
                        bf16x8 wf[4];
#pragma unroll
                        for (int ks = 0; ks < 4; ++ks) {
                            if (ks <= kmax) {
                                const float* wp = p.gws + (size_t)g * 16384 + tl * 128 + ks * 32 + 8 * hq;
                                float f[8]; load8(wp, f);
#pragma unroll
                                for (int e = 0; e < 8; ++e) f[e] = (ks * 32 + 8 * hq + e <= tl) ? f[e] : 0.f;
                                wf[ks] = pack8(f);
                            }
                        }
                        const float bsv = p.gbs[g * 128 + tl];
#pragma unroll 2
                        for (int dt = 0; dt < 8; ++dt) {
                            f32x4 a = {0.f, 0.f, 0.f, 0.f};
                            const bf16_t* vp = VT + (g * 128 + dt * 16 + (lane & 15)) * VLD + 8 * hq;
#pragma unroll
                            for (int ks = 0; ks < 4; ++ks) if (ks <= kmax) a = __builtin_amdgcn_mfma_f32_16x16x32_bf16(*(const bf16x8*)(vp + ks * 32), wf[ks], a, 0, 0, 0);
                            const size_t o = (row0 + tl) * 512 + g * 128 + dt * 16 + 4 * hq;
                            const uint2 uw = *(const uint2*)(U + o);
                            store_bf16x4(OGM + o, __uint_as_float(uw.x << 16) * (a[0] + bsv), __uint_as_float(uw.x & 0xffff0000u) * (a[1] + bsv),
                                         __uint_as_float(uw.y << 16) * (a[2] + bsv), __uint_as_float(uw.y & 0xffff0000u) * (a[3] + bsv));
                        }
                    }
                }
                __syncthreads();
            }
        }
    }
    }
    xcd_barrier(xb);

    { PHASE_BEGIN
    {
        auto epig = [&](int r, int c, const f32x4& v) { if (c < 24) { float* gp = GATES + (size_t)r * 24 + c; gp[0] = sigmoid_f(v[0]); gp[1] = sigmoid_f(v[1]); gp[2] = sigmoid_f(v[2]); gp[3] = sigmoid_f(v[3]); } };
        gemm_run(RowMajorA{HN, 1024}, WIN + (size_t)4352 * 1024, 1024, 128, 1, epig, smem, bid, nb);
        auto epi2 = [&](int r, int c, const f32x4& v) {
            const int b_ = r >> 8, m_ = r & 255;
            if (c < 1024) { const int h_ = c >> 8, d_ = c & 255; store_bf16x4(KVX + (size_t)(b_ * 4 + h_) * 65536 + xat_koff(m_, d_), v[0], v[1], v[2], v[3]); }
            else { const int hd = c - 1024, h_ = hd >> 8, d_ = hd & 255;
                bf16_t* vt = VXT + (size_t)(b_ * 4 + h_) * 65536 + xat_voff(m_, d_);
                vt[0] = f2bf(v[0]); vt[8] = f2bf(v[1]); vt[16] = f2bf(v[2]); vt[24] = f2bf(v[3]); } };
        gemm_run(RowMajorA{MN, 1024}, WXKV, 1024, 4, 16, epi2, smem, bid, nb);
        __syncthreads();
        float* gl = (float*)smem + wave * 256;
        for (int task = bid * 8 + wave; task < 2 * 2044; task += nb * 8) {
            const int kv = task >= 2044 ? 1 : 0, r = task - kv * 2044;
            const float* hp = HID + ((size_t)kv * 2048 + r) * 256; const float* bb = B1F + kv * 256;
#pragma unroll
            for (int i = 0; i < 4; ++i) gl[lane + 64 * i] = gelu_f(hp[lane + 64 * i] + bb[lane + 64 * i]);
            lds_fence();
            const float* w2 = kv ? p.w2_v : p.w2_k;
            float a = 0.f;
#pragma unroll 8
            for (int j = 0; j < 256; ++j) a += gl[j] * w2[j * 64 + lane];
            const int b = r / 1022, rr = r - b * 1022, c = rr >> 1, g = rr & 1, n = lane;
            if (kv == 0) KCB[(size_t)(b * 2 + g) * 512 * 64 + nsa_koff(c, n)] = f2bf(a); else VCT[(size_t)(b * 2 + g) * 512 * 64 + nsa_voff(c, n)] = f2bf(a);
            lds_fence();
        }
        if (bid == 0 && tid < 256) { const int bg = tid >> 6, n = tid & 63; KCB[(size_t)bg * 512 * 64 + nsa_koff(511, n)] = 0; VCT[(size_t)bg * 512 * 64 + nsa_voff(511, n)] = 0; }
    }
    }
    xcd_barrier(xb);

    { PHASE_BEGIN
    {
        float* impL = (float*)smem + wave * 1024;
        int* sidxL = (int*)(impL + 512);
        const bf16_t* KS = KV6 + 2ull * 16384 * 128; const bf16_t* VST = KV6 + 3ull * 16384 * 128;
        const bf16_t* KW = KV6 + 4ull * 16384 * 128; const bf16_t* VWT = KV6 + 5ull * 16384 * 128;
        const int c = lane & 15, h = lane >> 4, tokc = c >> 2, headc = c & 3;
        const int rk = 8 * (c >> 2) + (c & 3), dh = 8 * h;
      for (int pass = 0; pass < 2; ++pass) {
        for (int task = bid * 8 + wave; task < 8192; task += nb * 8) {
            const int bg = task >> 11, q4 = task & 2047, b = bg >> 1, g = bg & 1, t0 = q4 * 4;
            const int tcol = t0 + tokc; const size_t bt0 = (size_t)b * 8192 + t0;
            bf16x8 qf[2];
            { const bf16_t* qp = Q + (bt0 + tokc) * 512 + g * 256 + headc * 64 + dh; qf[0] = *(const bf16x8*)qp; qf[1] = *(const bf16x8*)(qp + 32); }
            const float* gp = GATES + (bt0 + tokc) * 24 + (g * 4 + headc) * 3;
            const float gate0 = gp[0], gate1 = gp[1], gate2 = gp[2];
            f32x4 comb[4];
#pragma unroll
            for (int dt = 0; dt < 4; ++dt) comb[dt] = (f32x4){0.f, 0.f, 0.f, 0.f};
            if (pass == 1) {
            {
                const int ncvc = tcol >= 31 ? ((tcol - 31) >> 4) + 1 : 0;
                const int ncvmax = (t0 + 3) >= 31 ? ((t0 + 3 - 31) >> 4) + 1 : 0;
                const int nch = (ncvmax + 31) >> 5;
                const bf16_t* Kc = KCB + (size_t)bg * 512 * 64; const bf16_t* Vc = VCT + (size_t)bg * 64 * 512;
                NsaSt st; nsa_init(st);
                {
                    auto ld = [&](NsaBuf& bf, int i) { nsa_load_kf(bf.ka, Kc, i, lane); };
                    auto cp = [&](NsaBuf& bf, int i) { float sv[8]; nsa_scores(bf.ka, qf, sv); nsa_chunk<false>(st, sv, i * 32 + dh, 0, ncvc - 1, bf.va); };
                    nsa_stream2(nch, ld, cp);
                }
                float l = st.l; l += __shfl_xor(l, 16); l += __shfl_xor(l, 32);
                const float inv = 1.0f / fmaxf(l, 1e-30f), mfin = st.m;
                *(float4*)(impL + lane * 8) = make_float4(0.f, 0.f, 0.f, 0.f); *(float4*)(impL + lane * 8 + 4) = make_float4(0.f, 0.f, 0.f, 0.f);
                lds_fence();
                f32x4 oc[4];
#pragma unroll
                for (int dt = 0; dt < 4; ++dt) oc[dt] = (f32x4){0.f, 0.f, 0.f, 0.f};
                float carry = 0.f;
                {
                    auto ld = [&](NsaBuf& bf, int i) { nsa_load_kf(bf.ka, Kc, i, lane); nsa_load_kf(bf.va, Vc, i, lane); };
                    auto cp = [&](NsaBuf& bf, int ch) {
                        float sv[8]; nsa_scores(bf.ka, qf, sv);
                        float p[8];
#pragma unroll
                        for (int j = 0; j < 8; ++j) p[j] = (ch * 32 + dh + j < ncvc) ? __builtin_amdgcn_exp2f(sv[j] - mfin) * inv : 0.f;
                        const float up = __shfl(p[7], (lane + 48) & 63);
                        const float prev7 = (h >= 1) ? up : carry; carry = up;
                        float i0 = p[0] + p[1] + p[2] + 0.5f * p[3] + 0.5f * prev7, i1 = p[4] + p[5] + p[6] + 0.5f * p[7] + 0.5f * p[3];
                        i0 += __shfl_xor(i0, 1); i0 += __shfl_xor(i0, 2); i1 += __shfl_xor(i1, 1); i1 += __shfl_xor(i1, 2);
                        if (headc == 0) { impL[tokc * 128 + 8 * ch + 2 * h] = i0; impL[tokc * 128 + 8 * ch + 2 * h + 1] = i1; }
                        const bf16x8 pb = pack8(p);
#pragma unroll
                        for (int dt = 0; dt < 4; ++dt) oc[dt] = __builtin_amdgcn_mfma_f32_16x16x32_bf16(bf.va[dt], pb, oc[dt], 0, 0, 0);
                    };
                    nsa_stream2(nch, ld, cp);
                }
#pragma unroll
                for (int dt = 0; dt < 4; ++dt) comb[dt] += oc[dt] * gate0;
            }
            lds_fence();
            int nblk;
            {
                const int tok = lane >> 4, sub = lane & 15, cur = t0 >> 6;
                float sc[8];
#pragma unroll
                for (int e = 0; e < 8; ++e) { const int j = sub + 16 * e; const float imp = impL[tok * 128 + j];
                    const bool al = j <= cur, fo = (j == 0) || (j == cur) || (j == cur - 1);
                    sc[e] = (fo && al) ? 1e4f : (al ? imp : -1e30f); }
                float myv = -1e30f; int myi = 0;
#pragma unroll 1
                for (int it = 0; it < 16; ++it) {
                    float bv = sc[0]; int bi = sub;
#pragma unroll
                    for (int e = 1; e < 8; ++e) if (sc[e] > bv) { bv = sc[e]; bi = sub + 16 * e; }
#pragma unroll
                    for (int o = 1; o < 16; o <<= 1) { const float ov = __shfl_xor(bv, o); const int oi = __shfl_xor(bi, o);
                        const bool take = (ov > bv) || (ov == bv && oi < bi); bv = take ? ov : bv; bi = take ? oi : bi; }
                    if (sub == it) { myv = bv; myi = bi; }
#pragma unroll
                    for (int e = 0; e < 8; ++e) if (bi == sub + 16 * e) sc[e] = -INFINITY;
                }
                const bool forced = myv > 5e3f;
                const bool keep = (myv > -0.5e30f) && !(forced && tok > 0);
                const unsigned long long bal = __ballot(keep);
                const int pos = __popcll(bal & ((1ull << lane) - 1ull));
                lds_fence();
                if (keep) sidxL[pos] = ((forced ? 7 : tok) << 16) | myi;
                nblk = __popcll(bal);
            }
            lds_fence();
            {
                NsaSt st; nsa_init(st);
                const bf16_t* Kp = KS + (size_t)bg * 8192 * 64; const bf16_t* Vp = VST + (size_t)bg * 8192 * 64;
                auto ld = [&](NsaBuf& bf, int i) { const int e = __builtin_amdgcn_readfirstlane(sidxL[i >> 1]); const int kb = (e & 0xffff) * 64 + (i & 1) * 32;
                    nsa_load_kf(bf.ka, Kp, kb >> 5, lane); nsa_load_kf(bf.va, Vp, kb >> 5, lane); };
                auto cp = [&](NsaBuf& bf, int i) { const int e = __builtin_amdgcn_readfirstlane(sidxL[i >> 1]); const int kb = (e & 0xffff) * 64 + (i & 1) * 32, ow = e >> 16;
                    const int hi = (ow == 7 || ow == tokc) ? tcol : -1;
                    float sv[8]; nsa_scores(bf.ka, qf, sv); nsa_chunk<true>(st, sv, kb + dh, 0, hi, bf.va); };
                nsa_stream(2 * nblk, ld, cp);
                nsa_fold(comb, st, gate1);
            }
            {
                const bf16_t* op = ONSA + (bt0 + tokc) * 512 + g * 256 + headc * 64 + 4 * h;
#pragma unroll
                for (int dt = 0; dt < 4; ++dt) { const uint2 w = *(const uint2*)(op + dt * 16);
                    comb[dt][0] += __uint_as_float(w.x << 16); comb[dt][1] += __uint_as_float(w.x & 0xffff0000u); comb[dt][2] += __uint_as_float(w.y << 16); comb[dt][3] += __uint_as_float(w.y & 0xffff0000u); }
            }
            } else {
            {
                NsaSt st; nsa_init(st);
                const bf16_t* Kp = KW + (size_t)bg * 8192 * 64; const bf16_t* Vp = VWT + (size_t)bg * 8192 * 64;
                const int kbf = (t0 > 511 ? t0 - 511 : 0) & ~31, kbl = (t0 + 3) & ~31;
                const int lo = tcol > 511 ? tcol - 511 : 0;
                auto ld = [&](NsaBuf& bf, int i) { const int kb = kbf + i * 32; nsa_load_kf(bf.ka, Kp, kb >> 5, lane); nsa_load_kf(bf.va, Vp, kb >> 5, lane); };
                auto cp = [&](NsaBuf& bf, int i) { const int kb = kbf + i * 32; float sv[8]; nsa_scores(bf.ka, qf, sv); nsa_chunk<true>(st, sv, kb + dh, lo, tcol, bf.va); };
                nsa_stream2(((kbl - kbf) >> 5) + 1, ld, cp);
                nsa_fold(comb, st, gate2);
            }
            }
            {
                bf16_t* op = ONSA + (bt0 + tokc) * 512 + g * 256 + headc * 64 + 4 * h;
#pragma unroll
                for (int dt = 0; dt < 4; ++dt) store_bf16x4(op + dt * 16, comb[dt][0], comb[dt][1], comb[dt][2], comb[dt][3]);
            }
            lds_fence();
        }
        if (pass == 0) xcd_barrier(xb);
      }
    }
    }
    xcd_barrier(xb);

    { PHASE_BEGIN
    {
        auto unpack8 = [](const u32x4& w, f32x4& a, f32x4& b) { a[0] = __uint_as_float(w.x << 16); a[1] = __uint_as_float(w.x & 0xffff0000u); a[2] = __uint_as_float(w.y << 16); a[3] = __uint_as_float(w.y & 0xffff0000u);
            b[0] = __uint_as_float(w.z << 16); b[1] = __uint_as_float(w.z & 0xffff0000u); b[2] = __uint_as_float(w.w << 16); b[3] = __uint_as_float(w.w & 0xffff0000u); };
        auto e1 = [&](int r, int c, const f32x4& v0, const f32x4& v1) { f32x4 m0, m1; unpack8(*(const u32x4*)(MG + (size_t)r * 2048 + c), m0, m1); store_bf16x8(Y + (size_t)r * 1024 + c, m0 * v0, m1 * v1); };
        big_gemm(smem, ONSA, WNSA, 16384, 1024, 512, e1);
        auto e2 = [&](int r, int c, const f32x4& v0, const f32x4& v1) { f32x4 m0, m1, y0, y1; unpack8(*(const u32x4*)(MG + (size_t)r * 2048 + 1024 + c), m0, m1); unpack8(*(const u32x4*)(Y + (size_t)r * 1024 + c), y0, y1);
            store_bf16x8(Y + (size_t)r * 1024 + c, y0 + m0 * v0, y1 + m1 * v1); };
        big_gemm(smem, OGM, WGM, 16384, 1024, 512, e2);
    }
    }
    xcd_barrier(xb);

    { PHASE_BEGIN
    {
        auto epi = [&](int r, int c, const f32x4& v0, const f32x4& v1) { const float* xp = p.x + (size_t)r * 1024 + c; float* op = OUT + (size_t)r * 1024 + c;
            *(f32x4*)op = *(const f32x4*)xp + v0; *(f32x4*)(op + 4) = *(const f32x4*)(xp + 4) + v1; };
        big_gemm(smem, Y, WMIX, 16384, 1024, 1024, epi);
    }
    }
    xcd_barrier(xb);

    { PHASE_BEGIN
    for (int r = bid * 8 + wave; r < 16384; r += nb * 8) rmsnorm_row_bf16(OUT + (size_t)r * 1024, p.g_xattn, HN + (size_t)r * 1024, lane);
    }
    xcd_barrier(xb);

    { PHASE_BEGIN
    {
        auto epi = [&](int r, int c, const f32x4& v0, const f32x4& v1) { store_bf16x8(QX + (size_t)r * 1024 + c, v0 * 0.0625f, v1 * 0.0625f); };
        big_gemm(smem, HN, WXQ, 16384, 1024, 1024, epi);
    }
    }
    xcd_barrier(xb);

    { PHASE_BEGIN
    {
        const int c = lane & 15, hg = lane >> 4, rk = 8 * (c >> 2) + (c & 3);
        for (int task = bid * 8 + wave; task < 4096; task += nb * 8) {
            const int h = task & 3, tgrp = task >> 2, b = tgrp >> 9; const size_t bt0 = (size_t)tgrp * 16;
            bf16x8 qf[8];
#pragma unroll
            for (int ks = 0; ks < 8; ++ks) qf[ks] = *(const bf16x8*)(QX + (bt0 + c) * 1024 + h * 256 + ks * 32 + 8 * hg);
            const bf16_t* Kp = KVX + (size_t)(b * 4 + h) * 65536; const bf16_t* Vp = VXT + (size_t)(b * 4 + h) * 65536;
            float m = -1e30f, l = 0.f; f32x4 o[16];
#pragma unroll
            for (int dt = 0; dt < 16; ++dt) o[dt] = (f32x4){0.f, 0.f, 0.f, 0.f};
#pragma unroll 1
            for (int ch = 0; ch < 8; ++ch) {
                const int kb = ch * 32;
                const bf16_t* k0 = Kp + ((ch * 16) * 64 + lane) * 8; const bf16_t* k1 = k0 + 8 * 64 * 8;
                f32x4 s0 = {0.f, 0.f, 0.f, 0.f}, s1 = {0.f, 0.f, 0.f, 0.f};
#pragma unroll
                for (int ks = 0; ks < 8; ++ks) {
                    const bf16x8 a0 = *(const bf16x8*)(k0 + ks * 512), a1 = *(const bf16x8*)(k1 + ks * 512);
                    s0 = __builtin_amdgcn_mfma_f32_16x16x32_bf16(a0, qf[ks], s0, 0, 0, 0); s1 = __builtin_amdgcn_mfma_f32_16x16x32_bf16(a1, qf[ks], s1, 0, 0, 0);
                }
                float sv[8] = {s0[0], s0[1], s0[2], s0[3], s1[0], s1[1], s1[2], s1[3]};
                float cm = sv[0];
#pragma unroll
                for (int j = 1; j < 8; ++j) cm = fmaxf(cm, sv[j]);
                cm = fmaxf(cm, __shfl_xor(cm, 16)); cm = fmaxf(cm, __shfl_xor(cm, 32));
                if (__any(cm > m)) { const float mn = fmaxf(m, cm), sc = __expf(m - mn); l *= sc;
#pragma unroll
                    for (int dt = 0; dt < 16; ++dt) o[dt] *= sc;
                    m = mn; }
                float p[8]; float ps = 0.f;
#pragma unroll
                for (int j = 0; j < 8; ++j) { p[j] = __expf(sv[j] - m); ps += p[j]; }
                l += ps;
                const bf16x8 pb = pack8(p);
#pragma unroll
                for (int dt = 0; dt < 16; ++dt) { const bf16x8 va = *(const bf16x8*)(Vp + ((ch * 16 + dt) * 64 + lane) * 8);
                    o[dt] = __builtin_amdgcn_mfma_f32_16x16x32_bf16(va, pb, o[dt], 0, 0, 0); }
            }
            l += __shfl_xor(l, 16); l += __shfl_xor(l, 32);
            const float inv = 1.0f / l;
            bf16_t* op = OX + (bt0 + c) * 1024 + h * 256 + 4 * hg;
#pragma unroll
            for (int dt = 0; dt < 16; ++dt) store_bf16x4(op + dt * 16, o[dt][0] * inv, o[dt][1] * inv, o[dt][2] * inv, o[dt][3] * inv);
        }
    }
    }
    xcd_barrier(xb);

    { PHASE_BEGIN
    {
        auto epi = [&](int r, int c, const f32x4& v0, const f32x4& v1) { float* op = OUT + (size_t)r * 1024 + c; *(f32x4*)op = *(const f32x4*)op + v0; *(f32x4*)(op + 4) = *(const f32x4*)(op + 4) + v1; };
        big_gemm(smem, OX, WXO, 16384, 1024, 1024, epi);
    }
    }
    xcd_barrier(xb);

    { PHASE_BEGIN
    for (int r = bid * 8 + wave; r < 16384; r += nb * 8) rmsnorm_row_bf16(OUT + (size_t)r * 1024, p.g_peer, HN + (size_t)r * 1024, lane);
    {
        for (int row = bid * 8 + wave; row < 32768; row += nb * 8) {
            const bool isv = row >= 16384; const int rr = isv ? row - 16384 : row;
            const float* src = (isv ? p.peer_v : p.peer_u) + (size_t)rr * 1024 + lane * 16;
            float f[16];
#pragma unroll
            for (int i = 0; i < 4; ++i) { const float4 a = *(const float4*)(src + 4 * i); f[4 * i] = a.x; f[4 * i + 1] = a.y; f[4 * i + 2] = a.z; f[4 * i + 3] = a.w; }
            float am = 0.f;
#pragma unroll
            for (int i = 0; i < 16; ++i) am = fmaxf(am, fabsf(f[i]));
            am = wave_max(am);
            int ex = 0; (void)frexpf(am, &ex);
            if (am == 0.f) ex = 8;
            const float sc = ldexpf(1.0f, 8 - ex);
            uint4 w; unsigned* wp = (unsigned*)&w;
#pragma unroll
            for (int i = 0; i < 4; ++i) { int t = 0; t = __builtin_amdgcn_cvt_pk_fp8_f32(f[4 * i] * sc, f[4 * i + 1] * sc, t, false); t = __builtin_amdgcn_cvt_pk_fp8_f32(f[4 * i + 2] * sc, f[4 * i + 3] * sc, t, true); wp[i] = (unsigned)t; }
            *(uint4*)((isv ? PV8 : PU8) + (size_t)rr * 1024 + lane * 16) = w;
            if (lane == 0) PSC[row] = ldexpf(1.0f, ex - 8);
        }
    }
    }
    xcd_barrier(xb);

    { PHASE_BEGIN
    {
        auto epi = [&](int r, int c, const f32x4& v0, const f32x4& v1) { store_bf16x8(QP + (size_t)r * 2048 + c, v0, v1); };
        big_gemm(smem, HN, WPQ, 16384, 2048, 1024, epi);
    }
    }
    xcd_barrier(xb);

    { PHASE_BEGIN
    {
        const int c = lane & 15, hg = lane >> 4;
        for (int task = bid * 8 + wave; task < 16384; task += nb * 8) {
            const int hp = task & 15, tgrp = task >> 4; const size_t bt0 = (size_t)tgrp * 16;
            bf16x8 qf[4];
#pragma unroll
            for (int ks = 0; ks < 4; ++ks) qf[ks] = *(const bf16x8*)(QP + (bt0 + c) * 2048 + hp * 128 + ks * 32 + 8 * hg);
            const bf16_t* Kp = SUBK + (size_t)hp * 16384 + lane * 8;
            float sc[32];
#pragma unroll
            for (int kt = 0; kt < 8; ++kt) {
                f32x4 a = {0.f, 0.f, 0.f, 0.f};
#pragma unroll
                for (int ks = 0; ks < 4; ++ks) a = __builtin_amdgcn_mfma_f32_16x16x32_bf16(*(const bf16x8*)(Kp + (kt * 4 + ks) * 512), qf[ks], a, 0, 0, 0);
                sc[kt * 4 + 0] = a[0]; sc[kt * 4 + 1] = a[1]; sc[kt * 4 + 2] = a[2]; sc[kt * 4 + 3] = a[3];
            }
            float* hsp = HS + (bt0 + c) * 256 + hp * 16; int* hip_ = HI + (bt0 + c) * 256 + hp * 16;
#pragma unroll 1
            for (int it = 0; it < 16; ++it) {
                float bv = sc[0]; int be = 0;
#pragma unroll
                for (int e = 1; e < 32; ++e) if (sc[e] > bv) { bv = sc[e]; be = e; }
                int key = (be >> 2) * 16 + 4 * hg + (be & 3);
#pragma unroll
                for (int o = 16; o < 64; o <<= 1) { const float ov = __shfl_xor(bv, o); const int ok = __shfl_xor(key, o);
                    const bool take = (ov > bv) || (ov == bv && ok < key); bv = take ? ov : bv; key = take ? ok : key; }
                if (hg == 0) { hsp[it] = bv; hip_[it] = key; }
                const int ew = (((key >> 2) & 3) == hg) ? ((key >> 4) * 4 + (key & 3)) : -1;
#pragma unroll
                for (int e = 0; e < 32; ++e) if (e == ew) sc[e] = -INFINITY;
            }
        }
    }
    }
    xcd_barrier(xb);

    { PHASE_BEGIN
    {
        int* exl = (int*)smem + wave * 256; float* gtl = (float*)(exl + 128);
        for (int tok = bid * 8 + wave; tok < 16384; tok += nb * 8) {
#pragma unroll 1
            for (int hh = 0; hh < 2; ++hh) {
                const int head = hh * 4 + (lane >> 4), i = lane & 15, gb = lane & 48;
                const float* s0p = HS + (size_t)tok * 256 + (2 * head) * 16;
                const float s0i = s0p[i], s1m = s0p[16 + i];
                int pj = 0; float myv = 0.f; int myf = 0;
#pragma unroll 1
                for (int it = 0; it < 16; ++it) {
                    const float s1v = __shfl(s1m, gb + (pj & 15));
                    float bv = pj < 16 ? s0i + s1v : -INFINITY; int bf = i * 16 + pj;
#pragma unroll
                    for (int o = 1; o < 16; o <<= 1) { const float ov = __shfl_xor(bv, o); const int of = __shfl_xor(bf, o);
                        const bool take = (ov > bv) || (ov == bv && of < bf); bv = take ? ov : bv; bf = take ? of : bf; }
                    if (i == it) { myv = bv; myf = bf; }
                    if ((bf >> 4) == i) ++pj;
                }
                const float vmax = __shfl(myv, gb);
                const float e = expf(myv - vmax);
                float se = e;
#pragma unroll
                for (int o = 1; o < 16; o <<= 1) se += __shfl_xor(se, o);
                const int* i0p = HI + (size_t)tok * 256 + (2 * head) * 16;
                exl[head * 16 + i] = i0p[myf >> 4] * 128 + i0p[16 + (myf & 15)];
                gtl[head * 16 + i] = e / se;
            }
            lds_fence();
            float xv[16];
            { float t0_[8], t1_[8]; load8(HN + (size_t)tok * 1024 + lane * 16, t0_); load8(HN + (size_t)tok * 1024 + lane * 16 + 8, t1_);
#pragma unroll
              for (int i = 0; i < 8; ++i) { xv[i] = t0_[i]; xv[8 + i] = t1_[i]; } }
#pragma unroll 1
            for (int e0 = 0; e0 < 128; e0 += 16) {
                uint4 ur[16];
#pragma unroll
                for (int q = 0; q < 16; ++q) ur[q] = *(const uint4*)(PU8 + (size_t)exl[e0 + q] * 1024 + lane * 16);
                float d[16];
#pragma unroll
                for (int q = 0; q < 16; ++q) {
                    const unsigned* wp = (const unsigned*)&ur[q]; float a = 0.f;
#pragma unroll
                    for (int i = 0; i < 4; ++i) { const auto lo = __builtin_amdgcn_cvt_pk_f32_fp8((int)wp[i], false); const auto hi = __builtin_amdgcn_cvt_pk_f32_fp8((int)wp[i], true);
                        a += lo[0] * xv[4 * i] + lo[1] * xv[4 * i + 1] + hi[0] * xv[4 * i + 2] + hi[1] * xv[4 * i + 3]; }
                    d[q] = a;
                }
                {
                    const bool u5 = lane & 32, u4 = lane & 16, u3 = lane & 8, u2 = lane & 4;
                    float e8[8], e4[4], e2[2], e1;
#pragma unroll
                    for (int q = 0; q < 8; ++q) { const float keep = u5 ? d[q + 8] : d[q], send = u5 ? d[q] : d[q + 8]; e8[q] = keep + __shfl_xor(send, 32); }
#pragma unroll
                    for (int q = 0; q < 4; ++q) { const float keep = u4 ? e8[q + 4] : e8[q], send = u4 ? e8[q] : e8[q + 4]; e4[q] = keep + __shfl_xor(send, 16); }
#pragma unroll
                    for (int q = 0; q < 2; ++q) { const float keep = u3 ? e4[q + 2] : e4[q], send = u3 ? e4[q] : e4[q + 2]; e2[q] = keep + __shfl_xor(send, 8); }
                    { const float keep = u2 ? e2[1] : e2[0], send = u2 ? e2[0] : e2[1]; e1 = keep + __shfl_xor(send, 4); }
                    e1 += __shfl_xor(e1, 2); e1 += __shfl_xor(e1, 1);
                    if ((lane & 3) == 0) { const int q = ((lane >> 5) & 1) * 8 + ((lane >> 4) & 1) * 4 + ((lane >> 3) & 1) * 2 + ((lane >> 2) & 1);
                        const int ex_ = exl[e0 + q];
                        gtl[e0 + q] = gtl[e0 + q] * gelu_f(e1 * PSC[ex_]) * PSC[16384 + ex_]; }
                }
            }
            lds_fence();
            float ac[16];
#pragma unroll
            for (int i = 0; i < 16; ++i) ac[i] = 0.f;
#pragma unroll 1
            for (int e0 = 0; e0 < 128; e0 += 16) {
                uint4 vr[16];
#pragma unroll
                for (int q = 0; q < 16; ++q) vr[q] = *(const uint4*)(PV8 + (size_t)exl[e0 + q] * 1024 + lane * 16);
#pragma unroll
                for (int q = 0; q < 16; ++q) { const float cf = gtl[e0 + q]; const unsigned* wp = (const unsigned*)&vr[q];
#pragma unroll
                    for (int i = 0; i < 4; ++i) { const auto lo = __builtin_amdgcn_cvt_pk_f32_fp8((int)wp[i], false); const auto hi = __builtin_amdgcn_cvt_pk_f32_fp8((int)wp[i], true);
                        ac[4 * i] += cf * lo[0]; ac[4 * i + 1] += cf * lo[1]; ac[4 * i + 2] += cf * hi[0]; ac[4 * i + 3] += cf * hi[1]; }
                }
            }
            float ss = 0.f;
            {
                float* hp = OUT + (size_t)tok * 1024 + lane * 16;
#pragma unroll
                for (int i = 0; i < 4; ++i) { const float4 hv = *(const float4*)(hp + 4 * i);
                    ac[4 * i] += hv.x; ac[4 * i + 1] += hv.y; ac[4 * i + 2] += hv.z; ac[4 * i + 3] += hv.w; }
#pragma unroll
                for (int i = 0; i < 16; ++i) ss += ac[i] * ac[i];
                ss = wave_sum(ss);
                const float rr = rsqrtf(ss * (1.0f / 1024.0f) + 1e-6f);
#pragma unroll
                for (int i = 0; i < 4; ++i) { const float4 gg = *(const float4*)(p.g_final + lane * 16 + 4 * i);
                    *(float4*)(hp + 4 * i) = make_float4(ac[4 * i] * rr * gg.x, ac[4 * i + 1] * rr * gg.y, ac[4 * i + 2] * rr * gg.z, ac[4 * i + 3] * rr * gg.w); }
            }
            lds_fence();
        }
    }
    }
}

extern "C" void kernel_launch(void* const* d_in, const int* in_sizes, int n_in, void* d_out, int out_size, void* d_ws, size_t ws_size, hipStream_t stream) {
    static int grid_blocks = 0;
    if (grid_blocks == 0) {
        int dev = 0, cus = 0, per_cu = 0;
        hipGetDevice(&dev);
        hipDeviceGetAttribute(&cus, hipDeviceAttributeMultiprocessorCount, dev);
        if (hipFuncSetAttribute((const void*)fwd_mega, hipFuncAttributeMaxDynamicSharedMemorySize, LDS_BYTES) != hipSuccess) { fprintf(stderr, "hipFuncSetAttribute failed\n"); }
        if (hipOccupancyMaxActiveBlocksPerMultiprocessor(&per_cu, (const void*)fwd_mega, NTHREADS, LDS_BYTES) != hipSuccess || per_cu < 1) { fprintf(stderr, "occupancy query failed (%d)\n", per_cu); per_cu = 1; }
        (void)hipGetLastError();
        if (per_cu > 1) per_cu = 1;
        grid_blocks = cus * per_cu;
        if (ws_size < O_END) { fprintf(stderr, "workspace too small: %zu < %zu\n", ws_size, (size_t)O_END); grid_blocks = -1; }
    }
    if (grid_blocks < 0) return;
    Params p{};
    const float** pp = (const float**)&p;
    for (int i = 0; i < 30; ++i) pp[i] = (const float*)d_in[i];
    p.out = (float*)d_out; p.ws = (unsigned char*)d_ws;
    if (hipMemsetAsync((char*)d_ws + O_BAR, 0, 16384, stream) != hipSuccess) { fprintf(stderr, "memset of barrier words failed\n"); return; }
    void* args[] = {&p};
    hipError_t e = hipLaunchCooperativeKernel((const void*)fwd_mega, dim3(grid_blocks), dim3(NTHREADS), args, LDS_BYTES, stream);
    if (e != hipSuccess) fprintf(stderr, "cooperative launch failed: %s (grid %d)\n", hipGetErrorString(e), grid_blocks);
}
```

```cpp
#include <hip/hip_runtime.h>
#include <cstdio>
#include <cstdint>

typedef unsigned short bf16_t;
typedef short bf16x8 __attribute__((ext_vector_type(8)));
typedef float f32x4 __attribute__((ext_vector_type(4)));
#define DEVI __device__ __forceinline__

__device__ __forceinline__ int tid_opaque() { int t = threadIdx.x; asm volatile("" : "+v"(t)); return t; }
constexpr int NTHREADS = 512;
constexpr int LDS_BYTES = 140 * 1024;

constexpr size_t O_BAR  = 0;
constexpr size_t O_WIN  = 16384;
constexpr size_t O_W1K  = O_WIN  + 4480ull * 1024 * 2;
constexpr size_t O_W1V  = O_W1K  + 256ull * 2048 * 2;
constexpr size_t O_WNSA = O_W1V  + 256ull * 2048 * 2;
constexpr size_t O_WGM  = O_WNSA + 1024ull * 512 * 2;
constexpr size_t O_WMIX = O_WGM  + 1024ull * 512 * 2;
constexpr size_t O_WXQ  = O_WMIX + 1024ull * 1024 * 2;
constexpr size_t O_WXKV = O_WXQ  + 1024ull * 1024 * 2;
constexpr size_t O_WXO  = O_WXKV + 2048ull * 1024 * 2;
constexpr size_t O_WPQ  = O_WXO  + 1024ull * 1024 * 2;
constexpr size_t O_B1   = O_WPQ  + 2048ull * 1024 * 2;
constexpr size_t O_VXT  = O_B1   + 2048;
constexpr size_t O_SUBK = O_VXT  + 8ull * 256 * 256 * 2;
constexpr size_t O_PSC  = O_SUBK + 16ull * 128 * 128 * 2;
constexpr size_t O_HN   = O_PSC  + 2ull * 16384 * 4;
constexpr size_t O_MN   = O_HN   + 16384ull * 1024 * 2;
constexpr size_t O_KVX  = O_MN   + 512ull * 1024 * 2;
constexpr size_t O_GATES= O_KVX  + 512ull * 2048 * 2;
constexpr size_t O_HID  = O_GATES+ 16384ull * 24 * 4;
constexpr size_t O_CMP  = O_HID  + 2ull * 2048 * 256 * 4;
constexpr size_t O_Q    = O_CMP  + 2ull * 4 * 512 * 64 * 4;
constexpr size_t O_KV6  = O_Q    + 16384ull * 512 * 2;
constexpr size_t O_U    = O_KV6  + 6ull * 16384 * 128 * 2;
constexpr size_t O_VG   = O_U    + 16384ull * 512 * 2;
constexpr size_t O_MG   = O_VG   + 16384ull * 512 * 2;
constexpr size_t O_ONSA = O_MG   + 16384ull * 2048 * 2;
constexpr size_t O_OGM  = O_ONSA + 16384ull * 512 * 2;
constexpr size_t O_Q8   = O_OGM  + 16384ull * 512 * 2;
constexpr size_t O_END  = O_Q8   + 16384ull * 512;
constexpr size_t O_Y    = O_Q;
constexpr size_t O_QX   = O_U;
constexpr size_t O_OX   = O_ONSA;
constexpr size_t O_QP   = O_MG;
constexpr size_t O_HS   = O_Q;
constexpr size_t O_HI   = O_Q + 16384ull * 256 * 4;
constexpr size_t O_EX   = O_U;
static_assert(O_END <= 256ull * 1024 * 1024, "workspace too large");

struct Params {
    const float *x, *mem, *g_mix, *w_in, *pe_k, *w1_k, *b1_k, *w2_k, *pe_v, *w1_v, *b1_v, *w2_v, *ln_g, *ln_b, *gws, *gbs,
        *w_nsa_out, *w_gmlp_out, *w_mix_out, *g_xattn, *g_mem, *w_xq, *w_xkv, *w_xo, *g_peer, *w_peer_q, *sub_keys, *peer_u, *peer_v, *g_final;
    float* out;
    unsigned char* ws;
};

DEVI bf16_t f2bf(float f) { unsigned u = __float_as_uint(f); u += 0x7fffu + ((u >> 16) & 1u); return (bf16_t)(u >> 16); }
DEVI float bf2f(bf16_t h) { return __uint_as_float(((unsigned)h) << 16); }
DEVI float tof(float v) { return v; }
DEVI float tof(bf16_t v) { return bf2f(v); }
DEVI float wave_sum(float v) { for (int o = 32; o > 0; o >>= 1) v += __shfl_xor(v, o); return v; }
DEVI float wave_max(float v) { for (int o = 32; o > 0; o >>= 1) v = fmaxf(v, __shfl_xor(v, o)); return v; }
DEVI float gelu_f(float x) { return 0.5f * x * (1.0f + erff(x * 0.70710678118654752f)); }
DEVI float sigmoid_f(float x) { return 1.0f / (1.0f + expf(-x)); }
DEVI void wave_argmax(float& v, int& idx) {
    for (int o = 32; o > 0; o >>= 1) {
        const float ov = __shfl_xor(v, o); const int oi = __shfl_xor(idx, o);
        const bool take = (ov > v) || (ov == v && oi < idx);
        v = take ? ov : v; idx = take ? oi : idx;
    }
}
typedef unsigned u32x4 __attribute__((ext_vector_type(4)));
DEVI unsigned cvt_pk_bf16(float lo, float hi) { unsigned r; asm("v_cvt_pk_bf16_f32 %0, %1, %2" : "=v"(r) : "v"(lo), "v"(hi)); return r; }
DEVI bf16x8 pack8(const float (&p)[8]) { u32x4 u; u.x = cvt_pk_bf16(p[0], p[1]); u.y = cvt_pk_bf16(p[2], p[3]); u.z = cvt_pk_bf16(p[4], p[5]); u.w = cvt_pk_bf16(p[6], p[7]); return __builtin_bit_cast(bf16x8, u); }
DEVI void lds_fence() { asm volatile("s_waitcnt lgkmcnt(0)" ::: "memory"); }
DEVI void load8(const float* p, float (&f)[8]) { const float4 a = *(const float4*)p, b = *(const float4*)(p + 4); f[0]=a.x; f[1]=a.y; f[2]=a.z; f[3]=a.w; f[4]=b.x; f[5]=b.y; f[6]=b.z; f[7]=b.w; }
DEVI void load8(const bf16_t* p, float (&f)[8]) { const uint4 a = *(const uint4*)p;
    f[0] = __uint_as_float(a.x << 16); f[1] = __uint_as_float(a.x & 0xffff0000u); f[2] = __uint_as_float(a.y << 16); f[3] = __uint_as_float(a.y & 0xffff0000u);
    f[4] = __uint_as_float(a.z << 16); f[5] = __uint_as_float(a.z & 0xffff0000u); f[6] = __uint_as_float(a.w << 16); f[7] = __uint_as_float(a.w & 0xffff0000u); }

template <class CMap>
DEVI void transpose_tile(const float* src, int srcN, bf16_t* dst, int K, int tl, CMap cmap, float* tile) {
    const int nkt = K / 64, kt = tl % nkt, nt = tl / nkt, k0 = kt * 64, n0 = nt * 64;
    const int tidq = tid_opaque(), tx = tidq & 63, ty = tidq >> 6;
    const int sc = cmap(n0 + tx);
#pragma unroll
    for (int i = 0; i < 8; ++i) { const int k = k0 + ty + 8 * i; tile[(ty + 8 * i) * 65 + tx] = sc >= 0 ? src[(size_t)k * srcN + sc] : 0.f; }
    __syncthreads();
#pragma unroll
    for (int i = 0; i < 8; ++i) { const int n = n0 + ty + 8 * i; dst[(size_t)n * K + k0 + tx] = f2bf(tile[tx * 65 + ty + 8 * i]); }
    __syncthreads();
}
struct IdMap { DEVI int operator()(int n) const { return n; } };
struct WinMap { DEVI int operator()(int n) const { return n < 1280 ? n : (n < 4352 ? n + 24 : (n < 4376 ? n - 4352 + 1280 : -1)); } };

DEVI void rmsnorm_row_bf16(const float* xrow, const float* g, bf16_t* dst, int lane) {
    float4 v[4]; float ss = 0.f;
#pragma unroll
    for (int i = 0; i < 4; ++i) { v[i] = ((const float4*)xrow)[lane + 64 * i]; ss += v[i].x * v[i].x + v[i].y * v[i].y + v[i].z * v[i].z + v[i].w * v[i].w; }
    ss = wave_sum(ss);
    const float r = rsqrtf(ss * (1.0f / 1024.0f) + 1e-6f);
#pragma unroll
    for (int i = 0; i < 4; ++i) {
        const float4 gg = ((const float4*)g)[lane + 64 * i];
        uint2 w; w.x = (unsigned)f2bf(v[i].x * r * gg.x) | ((unsigned)f2bf(v[i].y * r * gg.y) << 16); w.y = (unsigned)f2bf(v[i].z * r * gg.z) | ((unsigned)f2bf(v[i].w * r * gg.w) << 16);
        ((uint2*)dst)[lane + 64 * i] = w;
    }
}

constexpr int G_LD = 72;
template <class AF>
DEVI void gemm_tile(f32x4 (&acc)[4][2], AF af, int m0, const bf16_t* Bt, int ldb, int K, bf16_t* As, bf16_t* Bs) {
    const int tid = tid_opaque(), lane = tid & 63, wave = tid >> 6, wm = wave >> 2, wn = wave & 3;
    const int r0 = tid >> 3, kc = (tid & 7) * 8;
    uint4 ra0, ra1, rb0, rb1;
    ra0 = *(const uint4*)af(m0 + r0, kc); ra1 = *(const uint4*)af(m0 + r0 + 64, kc);
    rb0 = *(const uint4*)(Bt + (size_t)r0 * ldb + kc); rb1 = *(const uint4*)(Bt + (size_t)(r0 + 64) * ldb + kc);
    for (int k0 = 0; k0 < K; k0 += 64) {
        __syncthreads();
        *(uint4*)(As + r0 * G_LD + kc) = ra0; *(uint4*)(As + (r0 + 64) * G_LD + kc) = ra1;
        *(uint4*)(Bs + r0 * G_LD + kc) = rb0; *(uint4*)(Bs + (r0 + 64) * G_LD + kc) = rb1;
        __syncthreads();
        if (k0 + 64 < K) {
            const int kn = k0 + 64 + kc;
            ra0 = *(const uint4*)af(m0 + r0, kn); ra1 = *(const uint4*)af(m0 + r0 + 64, kn);
            rb0 = *(const uint4*)(Bt + (size_t)r0 * ldb + kn); rb1 = *(const uint4*)(Bt + (size_t)(r0 + 64) * ldb + kn);
        }
#pragma unroll
        for (int ks = 0; ks < 2; ++ks) {
            bf16x8 af_[4], bf_[2];
#pragma unroll
            for (int i = 0; i < 4; ++i) af_[i] = *(const bf16x8*)(As + (wm * 64 + i * 16 + (lane & 15)) * G_LD + ks * 32 + (lane >> 4) * 8);
#pragma unroll
            for (int j = 0; j < 2; ++j) bf_[j] = *(const bf16x8*)(Bs + (wn * 32 + j * 16 + (lane & 15)) * G_LD + ks * 32 + (lane >> 4) * 8);
#pragma unroll
            for (int i = 0; i < 4; ++i)
#pragma unroll
                for (int j = 0; j < 2; ++j) acc[i][j] = __builtin_amdgcn_mfma_f32_16x16x32_bf16(bf_[j], af_[i], acc[i][j], 0, 0, 0);
        }
    }
}
struct RowMajorA { const bf16_t* A; int lda; DEVI const bf16_t* operator()(int row, int k) const { return A + (size_t)row * lda + k; } };
struct CmpA { const bf16_t* KC; int koff;
    DEVI const bf16_t* operator()(int row, int k_) const { const int k = k_ + koff; const int rr = row < 2044 ? row : 2043; const int b = rr / 1022, rem = rr - b * 1022, c = rem >> 1, g = rem & 1;
        return KC + ((size_t)(b * 8192 + 16 * c + (k >> 6)) * 128 + g * 64 + (k & 63)); } };

template <class AF, class Epi>
DEVI void gemm_run(AF af, const bf16_t* Bt, int K, int MT, int NT, Epi epi, unsigned char* smem, int bid, int nb) {
    bf16_t* As = (bf16_t*)smem; bf16_t* Bs = As + 128 * G_LD;
    const int tidq = tid_opaque(), lane = tidq & 63, wave = tidq >> 6, wm = wave >> 2, wn = wave & 3;
    for (int t = bid; t < MT * NT; t += nb) {
        const int mt = t / NT, nt = t % NT;
        f32x4 acc[4][2];
#pragma unroll
        for (int i = 0; i < 4; ++i)
#pragma unroll
            for (int j = 0; j < 2; ++j) acc[i][j] = (f32x4){0.f, 0.f, 0.f, 0.f};
        gemm_tile(acc, af, mt * 128, Bt + (size_t)nt * 128 * K, K, K, As, Bs);
#pragma unroll
        for (int i = 0; i < 4; ++i)
#pragma unroll
            for (int j = 0; j < 2; ++j) epi(mt * 128 + wm * 64 + i * 16 + (lane & 15), nt * 128 + wn * 32 + j * 16 + (lane >> 4) * 4, acc[i][j]);
    }
}
DEVI void store_bf16x4(bf16_t* p, float a, float b, float c, float d) { uint2 w; w.x = (unsigned)f2bf(a) | ((unsigned)f2bf(b) << 16); w.y = (unsigned)f2bf(c) | ((unsigned)f2bf(d) << 16); *(uint2*)p = w; }

namespace pg8 {
#define PG8_LAS __attribute__((address_space(3)))
typedef unsigned short bf16_t;
typedef short bf16x8 __attribute__((ext_vector_type(8)));
typedef float f32x4 __attribute__((ext_vector_type(4)));
typedef unsigned u32x4 __attribute__((ext_vector_type(4)));
constexpr int BM = 256, BK = 64, HALF = 128, HTB = HALF * BK * 2  , STAGE_BYTES = 8 * HTB, NXCD = 8, WGM = 8;

__host__ __device__ __forceinline__ int lds_byte(int r, int c) { const int st = (r >> 4) * 2 + (c >> 5), rr = r & 15, cc = c & 31, ob = rr * 64 + cc * 2; return st * 1024 + (ob ^ (((ob >> 9) & 1) << 5)); }
__host__ __device__ __forceinline__ void stage_rc(int b, int& R, int& C) { const int st = b / 1024, sb = b % 1024, swz = sb ^ (((sb >> 9) & 1) << 5); R = (st >> 1) * 16 + swz / 64; C = (st & 1) * 32 + (swz % 64) / 2; }
__host__ __device__ __forceinline__ int perm32(int rho) { const int n = rho >> 4, i = rho & 15; return 8 * (i >> 2) + 4 * n + (i & 3); }

struct Unit { int pm, pn; };
struct Gemm { const bf16_t* A; const bf16_t* Bt; int M, N, K; };

struct StaticOrder {
    int nM, nN, nwg, G, c;
    __host__ __device__ void init(int M, int N, int G_, int c_) { nM = M / BM; nN = N / BM; nwg = nM * nN; G = G_; c = c_; }
    __host__ __device__ bool next(int i, Unit& u) const {
        const long L = (long)i * G + c; if (L >= nwg) return false;
        int wgid = (int)L; { const int q = nwg / NXCD, r = nwg % NXCD, xcd = wgid % NXCD, off = wgid / NXCD; wgid = (xcd < r ? xcd * (q + 1) : r * (q + 1) + (xcd - r) * q) + off; }
        const int nig = WGM * nN, gid = wgid / nig, fm = gid * WGM, gsz = (nM - fm) < WGM ? (nM - fm) : WGM;
        u.pm = fm + ((wgid % nig) % gsz); u.pn = (wgid % nig) / gsz; return true;
    }
    __device__ __forceinline__ void a_ready(const Unit&) const {}
    __device__ __forceinline__ void done(const Unit&) const {}
};

template <class Epi, class Sched, bool ALIGN_EPI = false, bool SP2 = false>
__device__ __forceinline__ void gemm_phase(PG8_LAS unsigned char* lds, const Gemm g, const Sched& S, const Epi& E) {
    const int tid = tid_opaque(), wid = __builtin_amdgcn_readfirstlane(tid >> 6), lane = tid & 63, wr = wid >> 2, wc = wid & 3, fr = lane & 15, fq = lane >> 4;
    const int K = g.K, nt = K / BK;
    unsigned voffA[2], voffB[2];
#pragma unroll
    for (int i = 0; i < 2; ++i) { int R, C; stage_rc(tid * 16 + i * 8192, R, C); const int Rb = Epi::PERM ? ((R & ~31) + perm32(R & 31)) : R;
        voffA[i] = (unsigned)(R * K + C) * 2u; voffB[i] = (unsigned)(Rb * K + C) * 2u; }
    const size_t kstep = (size_t)(BK * 2);
    const size_t hstep = (size_t)HALF * K * 2;
    const size_t tstep = 2 * hstep;
    const unsigned ldsw = (unsigned)wid * 1024u;
    const int aoff = lds_byte(wr * 64 + fr, fq * 8), boff = lds_byte(wc * 32 + fr, fq * 8);
#define PG8_SA(b, h) (((b) * 2 + (h)) * HTB)
#define PG8_SB(b, h) ((4 + (b) * 2 + (h)) * HTB)
#define PG8_STAGE(bufoff, gbase, voff) do { _Pragma("unroll") for (int _i = 0; _i < 2; ++_i) \
        __builtin_amdgcn_global_load_lds((const unsigned*)((const char*)(gbase) + (voff)[_i]), (PG8_LAS unsigned*)(lds + (bufoff) + ldsw + _i * 8192), 16, 0, 0); } while (0)
#define PG8_LDA(dst, b, h) do { _Pragma("unroll") for (int m = 0; m < 4; ++m) _Pragma("unroll") for (int k = 0; k < 2; ++k) dst[m][k] = *(const PG8_LAS bf16x8*)(lds + PG8_SA(b, h) + aoff + m * 2048 + k * 1024); } while (0)
#define PG8_LDB(dst, b, h) do { _Pragma("unroll") for (int n = 0; n < 2; ++n) _Pragma("unroll") for (int k = 0; k < 2; ++k) dst[n][k] = *(const PG8_LAS bf16x8*)(lds + PG8_SB(b, h) + boff + n * 2048 + k * 1024); } while (0)
#define PG8_MMA(ai, bj, At, Bt) do { __builtin_amdgcn_s_setprio(1); _Pragma("unroll") for (int m = 0; m < 4; ++m) _Pragma("unroll") for (int n = 0; n < 2; ++n) _Pragma("unroll") for (int k = 0; k < 2; ++k) \
        acc[ai][bj][m][n] = __builtin_amdgcn_mfma_f32_16x16x32_bf16(Bt[n][k], At[m][k], acc[ai][bj][m][n], 0, 0, 0); __builtin_amdgcn_s_setprio(0); } while (0)
#define PG8_WAIT_V(n) asm volatile("s_waitcnt vmcnt(" #n ")" ::: "memory")
#define PG8_WAIT_L(n) asm volatile("s_waitcnt lgkmcnt(" #n ")" ::: "memory")
#define PG8_BAR __builtin_amdgcn_s_barrier()
#define PG8_SCHED __builtin_amdgcn_sched_barrier(0)
    Unit cur, nxt; int ui = 0;
    if (!S.next(0, cur)) return;
    f32x4 acc[2][2][4][2];
#pragma unroll
    for (int a = 0; a < 2; ++a)
#pragma unroll
        for (int b = 0; b < 2; ++b)
#pragma unroll
            for (int m = 0; m < 4; ++m)
#pragma unroll
                for (int n = 0; n < 2; ++n) acc[a][b][m][n] = (f32x4){0.f, 0.f, 0.f, 0.f};
    bf16x8 At[4][2], B0[2][2], B1[2][2];
    const char* cA = (const char*)g.A + (size_t)cur.pm * tstep; const char* cB = (const char*)g.Bt + (size_t)cur.pn * tstep;
    S.a_ready(cur);
    if constexpr (SP2) {
        PG8_STAGE(PG8_SB(0, 0), cB, voffB); PG8_STAGE(PG8_SB(0, 1), cB + hstep, voffB); PG8_STAGE(PG8_SA(0, 0), cA, voffA); PG8_STAGE(PG8_SA(0, 1), cA + hstep, voffA);
        if (wr == 1) PG8_BAR;
        PG8_WAIT_V(2); PG8_BAR;
        PG8_STAGE(PG8_SB(1, 0), cB + kstep, voffB); PG8_STAGE(PG8_SA(1, 0), cA + kstep, voffA); PG8_STAGE(PG8_SB(1, 1), cB + hstep + kstep, voffB);
        PG8_WAIT_V(6); PG8_BAR;
    } else {
        PG8_STAGE(PG8_SB(0, 0), cB, voffB); PG8_STAGE(PG8_SA(0, 0), cA, voffA); PG8_STAGE(PG8_SB(0, 1), cB + hstep, voffB); PG8_STAGE(PG8_SA(0, 1), cA + hstep, voffA);
        if (wr == 1) PG8_BAR;
        PG8_WAIT_V(4); PG8_BAR;
        PG8_STAGE(PG8_SB(1, 0), cB + kstep, voffB); PG8_STAGE(PG8_SA(1, 0), cA + kstep, voffA); PG8_STAGE(PG8_SB(1, 1), cB + hstep + kstep, voffB);
        PG8_WAIT_V(6); PG8_BAR;
    }
    for (;;) {
        const bool has_next = S.next(ui + 1, nxt);
        const char* nA = has_next ? (const char*)g.A + (size_t)nxt.pm * tstep : cA; const char* nB = has_next ? (const char*)g.Bt + (size_t)nxt.pn * tstep : cB;
        for (int t = 0; t < nt; t += 2) {
            const bool last = (t == nt - 2);
            const char* a1 = cA + (size_t)(t + 1) * kstep;
            const char* a2 = last ? nA : cA + (size_t)(t + 2) * kstep; const char* b2 = last ? nB : cB + (size_t)(t + 2) * kstep;
            const char* a3 = a2 + kstep; const char* b3 = b2 + kstep;
            if (last && has_next) S.a_ready(nxt);
            if constexpr (SP2) {
            PG8_LDB(B0, 0, 0); PG8_LDB(B1, 0, 1); PG8_SCHED; PG8_LDA(At, 0, 0); PG8_STAGE(PG8_SA(1, 1), a1 + hstep, voffA);
            PG8_WAIT_V(8); PG8_WAIT_L(0); PG8_BAR; PG8_MMA(0, 0, At, B0); PG8_MMA(0, 1, At, B1); PG8_BAR; PG8_SCHED;
            PG8_LDA(At, 0, 1); PG8_STAGE(PG8_SB(0, 0), b2, voffB); PG8_STAGE(PG8_SB(0, 1), b2 + hstep, voffB); PG8_STAGE(PG8_SA(0, 0), a2, voffA);
            PG8_WAIT_V(8); PG8_WAIT_L(0); PG8_BAR; PG8_MMA(1, 0, At, B0); PG8_MMA(1, 1, At, B1); PG8_BAR; PG8_SCHED;
            PG8_LDB(B0, 1, 0); PG8_LDB(B1, 1, 1); PG8_SCHED; PG8_LDA(At, 1, 0); PG8_STAGE(PG8_SA(0, 1), a2 + hstep, voffA);
            PG8_WAIT_V(8); PG8_WAIT_L(0); PG8_BAR; PG8_MMA(0, 0, At, B0); PG8_MMA(0, 1, At, B1); PG8_BAR; PG8_SCHED;
            PG8_LDA(At, 1, 1); PG8_STAGE(PG8_SB(1, 0), b3, voffB); PG8_STAGE(PG8_SB(1, 1), b3 + hstep, voffB); PG8_STAGE(PG8_SA(1, 0), a3, voffA);
            PG8_WAIT_V(8); PG8_WAIT_L(0); PG8_BAR; PG8_MMA(1, 0, At, B0); PG8_MMA(1, 1, At, B1); PG8_BAR; PG8_SCHED;
            } else {
            PG8_LDB(B0, 0, 0); PG8_SCHED; PG8_LDA(At, 0, 0); PG8_STAGE(PG8_SA(1, 1), a1 + hstep, voffA);
            PG8_WAIT_L(8); PG8_BAR; PG8_WAIT_L(0); PG8_MMA(0, 0, At, B0); PG8_BAR; PG8_SCHED;
            PG8_LDB(B1, 0, 1); PG8_STAGE(PG8_SB(0, 0), b2, voffB);
            PG8_BAR; PG8_WAIT_L(0); PG8_MMA(0, 1, At, B1); PG8_BAR;
            PG8_LDA(At, 0, 1); PG8_STAGE(PG8_SA(0, 0), a2, voffA);
            PG8_BAR; PG8_WAIT_L(0); PG8_MMA(1, 0, At, B0); PG8_BAR; PG8_SCHED;
            PG8_STAGE(PG8_SB(0, 1), b2 + hstep, voffB);
            PG8_WAIT_V(6); PG8_BAR; PG8_MMA(1, 1, At, B1); PG8_BAR;
            PG8_LDB(B0, 1, 0); PG8_SCHED; PG8_LDA(At, 1, 0); PG8_STAGE(PG8_SA(0, 1), a2 + hstep, voffA);
            PG8_WAIT_L(8); PG8_BAR; PG8_WAIT_L(0); PG8_MMA(0, 0, At, B0); PG8_BAR; PG8_SCHED;
            PG8_LDB(B1, 1, 1); PG8_STAGE(PG8_SB(1, 0), b3, voffB);
            PG8_BAR; PG8_WAIT_L(0); PG8_MMA(0, 1, At, B1); PG8_BAR;
            PG8_LDA(At, 1, 1); PG8_STAGE(PG8_SA(1, 0), a3, voffA);
            PG8_BAR; PG8_WAIT_L(0); PG8_MMA(1, 0, At, B0); PG8_BAR; PG8_SCHED;
            PG8_STAGE(PG8_SB(1, 1), b3 + hstep, voffB);
            PG8_WAIT_V(6); PG8_BAR; PG8_MMA(1, 1, At, B1); PG8_BAR;
            }
        }
        if constexpr (ALIGN_EPI) { if (wr == 0) PG8_BAR; }
        if constexpr (!Epi::AFTER_DRAIN) { E(acc, cur, wr, wc, fr, fq); S.done(cur); }
        if (!has_next) break;
#pragma unroll
        for (int a = 0; a < 2; ++a)
#pragma unroll
            for (int b = 0; b < 2; ++b)
#pragma unroll
                for (int m = 0; m < 4; ++m)
#pragma unroll
                    for (int n = 0; n < 2; ++n) acc[a][b][m][n] = (f32x4){0.f, 0.f, 0.f, 0.f};
        cur = nxt; cA = nA; cB = nB; ++ui;
        if constexpr (ALIGN_EPI) { if (wr == 1) PG8_BAR; }
    }
    PG8_WAIT_V(0);
    if constexpr (!ALIGN_EPI) { if (wr == 0) PG8_BAR; }
    PG8_BAR;
    if constexpr (Epi::AFTER_DRAIN) { E.fused(acc, cur, wr, wc, fr, fq, lds, wid, lane); S.done(cur); }
#undef PG8_SA
#undef PG8_SB
#undef PG8_STAGE
#undef PG8_LDA
#undef PG8_LDB
#undef PG8_MMA
#undef PG8_WAIT_V
#undef PG8_WAIT_L
#undef PG8_BAR
#undef PG8_SCHED
}
}

template <class F> struct EpiFn {
    static constexpr bool PERM = true, AFTER_DRAIN = false;
    F f;
    DEVI void operator()(const f32x4 (&acc)[2][2][4][2], const pg8::Unit& u, int wr, int wc, int fr, int fq) const {
#pragma unroll
        for (int ai = 0; ai < 2; ++ai)
#pragma unroll
            for (int m = 0; m < 4; ++m) {
                const int row = u.pm * 256 + ai * 128 + wr * 64 + m * 16 + fr;
#pragma unroll
                for (int bj = 0; bj < 2; ++bj) { f(row, u.pn * 256 + bj * 128 + wc * 32 + 8 * fq, acc[ai][bj][m][0], acc[ai][bj][m][1]); __builtin_amdgcn_sched_barrier(0); }
            }
    }
};
template <class F> DEVI EpiFn<F> make_epi(F f) { return EpiFn<F>{f}; }
template <class F>
DEVI void big_gemm(unsigned char* smem, const bf16_t* A, const bf16_t* Bt, int M, int N, int K, F f) {
    pg8::StaticOrder S; S.init(M, N, (int)gridDim.x, (int)blockIdx.x);
    const pg8::Gemm g{A, Bt, M, N, K};
    const auto E = make_epi(f);
    pg8::gemm_phase<EpiFn<F>, pg8::StaticOrder, true, true>((PG8_LAS unsigned char*)smem, g, S, E);
}
DEVI void store_bf16x8(bf16_t* p, const f32x4& a, const f32x4& b) { u32x4 w; w.x = cvt_pk_bf16(a[0], a[1]); w.y = cvt_pk_bf16(a[2], a[3]); w.z = cvt_pk_bf16(b[0], b[1]); w.w = cvt_pk_bf16(b[2], b[3]); *(u32x4*)p = w; }

template <int DH, int R, int NCH, bool PSUM, typename KT, class RowF>
DEVI void attend(const float* qs, float* pl, float* psum, const KT* Kb, const KT* Vb, size_t stride, RowF rowf, float (&o)[R][DH / 64], int lane) {
    float m[R], l[R];
#pragma unroll
    for (int r = 0; r < R; ++r) { m[r] = -1e30f; l[r] = 0.f; }
#pragma unroll 1
    for (int i = 0; i < NCH; ++i) {
        bool valid; const long row = rowf(i, lane, valid);
        if (__ballot(valid) == 0ull) continue;
        const KT* kp = Kb + (size_t)row * stride;
        float a[R];
#pragma unroll
        for (int r = 0; r < R; ++r) a[r] = 0.f;
#pragma unroll 2
        for (int d0 = 0; d0 < DH; d0 += 8) {
            float kf[8]; load8(kp + d0, kf);
#pragma unroll
            for (int r = 0; r < R; ++r) {
                const float4 q0 = *(const float4*)(qs + r * DH + d0), q1 = *(const float4*)(qs + r * DH + d0 + 4);
                a[r] += kf[0] * q0.x + kf[1] * q0.y + kf[2] * q0.z + kf[3] * q0.w + kf[4] * q1.x + kf[5] * q1.y + kf[6] * q1.z + kf[7] * q1.w;
            }
        }
#pragma unroll
        for (int r = 0; r < R; ++r) {
            const float sv = valid ? a[r] : -1e30f;
            const float mn = fmaxf(m[r], wave_max(sv));
            const float pe = valid ? expf(sv - mn) : 0.f;
            l[r] = l[r] * expf(m[r] - mn) + wave_sum(pe);
            m[r] = mn;
        }
    }
    float inv[R];
#pragma unroll
    for (int r = 0; r < R; ++r) inv[r] = 1.0f / fmaxf(l[r], 1e-30f);
#pragma unroll 1
    for (int i = 0; i < NCH; ++i) {
        bool valid; const long row = rowf(i, lane, valid);
        const bool any = __ballot(valid) != 0ull;
        float a[R];
#pragma unroll
        for (int r = 0; r < R; ++r) a[r] = 0.f;
        if (any) {
            const KT* kp = Kb + (size_t)row * stride;
#pragma unroll 2
            for (int d0 = 0; d0 < DH; d0 += 8) {
                float kf[8]; load8(kp + d0, kf);
#pragma unroll
                for (int r = 0; r < R; ++r) {
                    const float4 q0 = *(const float4*)(qs + r * DH + d0), q1 = *(const float4*)(qs + r * DH + d0 + 4);
                    a[r] += kf[0] * q0.x + kf[1] * q0.y + kf[2] * q0.z + kf[3] * q0.w + kf[4] * q1.x + kf[5] * q1.y + kf[6] * q1.z + kf[7] * q1.w;
                }
            }
        }
        float ps = 0.f;
#pragma unroll
        for (int r = 0; r < R; ++r) { const float pv = valid ? expf(a[r] - m[r]) * inv[r] : 0.f; pl[r * 64 + lane] = pv; ps += pv; }
        if (PSUM) psum[i * 64 + lane] = ps;
        lds_fence();
        if (any) {
#pragma unroll 2
            for (int key = 0; key < 64; ++key) {
                bool dummy; const long vrow = rowf(i, key, dummy);
                const KT* vp = Vb + (size_t)vrow * stride;
                float pr[R];
#pragma unroll
                for (int r = 0; r < R; ++r) pr[r] = pl[r * 64 + key];
#pragma unroll
                for (int j = 0; j < DH / 64; ++j) { const float v = tof(vp[lane + 64 * j]);
#pragma unroll
                    for (int r = 0; r < R; ++r) o[r][j] += pr[r] * v; }
            }
        }
        lds_fence();
    }
}


DEVI int nsa_koff(int t, int d) { return ((((t >> 5) * 4 + (((t >> 2) & 1) * 2 + (d >> 5))) * 64) + ((((t & 31) >> 3) << 2) | (t & 3)) + 16 * ((d >> 3) & 3)) * 8 + (d & 7); }
DEVI int nsa_voff(int t, int d) { return ((((t >> 5) * 4 + (d >> 4)) * 64) + (d & 15) + 16 * ((t & 31) >> 3)) * 8 + (t & 7); }
DEVI int xat_koff(int m, int d) { return ((((m >> 5) * 16 + ((m >> 2) & 1) * 8 + (d >> 5)) * 64) + ((((m & 31) >> 3) << 2) | (m & 3)) + 16 * ((d >> 3) & 3)) * 8 + (d & 7); }
DEVI int xat_voff(int m, int d) { return ((((m >> 5) * 16 + (d >> 4)) * 64) + (d & 15) + 16 * ((m & 31) >> 3)) * 8 + (m & 7); }
DEVI int pk_koff(int k, int d) { return ((((k >> 4) * 4 + (d >> 5)) * 64) + (k & 15) + 16 * ((d >> 3) & 3)) * 8 + (d & 7); }
DEVI int nsa_koff8(int t, int d) { return ((((t >> 5) * 2 + ((t >> 2) & 1)) * 64) + ((((t & 31) >> 3) << 2) | (t & 3)) + 16 * ((d >> 3) & 3)) * 16 + (d >> 5) * 8 + (d & 7); }
DEVI int nsa_voff8(int t, int d) { return ((((t >> 5) * 2 + (d >> 5)) * 64) + (d & 15) + 16 * ((t & 31) >> 3)) * 16 + ((d >> 4) & 1) * 8 + (t & 7); }
DEVI void nsa_load_kf(bf16x8 (&ka)[4], const bf16_t* Kp, int ch, int lane) {
#pragma unroll
    for (int f = 0; f < 4; ++f) ka[f] = *(const bf16x8*)(Kp + ((ch * 4 + f) * 64 + lane) * 8);
}
DEVI void nsa_load_k(bf16x8 (&ka)[4], const bf16_t* Kp, int stride, int kb, int rk, int dh) {
    const int o0 = (kb + rk) * stride + dh, o1 = o0 + 4 * stride;
    ka[0] = *(const bf16x8*)(Kp + o0); ka[1] = *(const bf16x8*)(Kp + o0 + 32); ka[2] = *(const bf16x8*)(Kp + o1); ka[3] = *(const bf16x8*)(Kp + o1 + 32);
}
DEVI void nsa_load_v(bf16x8 (&va)[4], const bf16_t* Vp, int vstride, int kb8, int lr) {
    const int o = lr * vstride + kb8;
#pragma unroll
    for (int dt = 0; dt < 4; ++dt) va[dt] = *(const bf16x8*)(Vp + o + dt * 16 * vstride);
}
DEVI void nsa_load_vb(bf16x8 (&va)[4], const bf16_t* Vp, int kb8, int lr) {
    const int o = ((kb8 >> 6) * 64 + lr) * 64 + (kb8 & 63);
#pragma unroll
    for (int dt = 0; dt < 4; ++dt) va[dt] = *(const bf16x8*)(Vp + o + dt * 16 * 64);
}
DEVI void nsa_scores(const bf16x8 (&ka)[4], const bf16x8 (&qf)[2], float (&sv)[8]) {
    f32x4 s0 = {0.f, 0.f, 0.f, 0.f}, s1 = {0.f, 0.f, 0.f, 0.f};
    s0 = __builtin_amdgcn_mfma_f32_16x16x32_bf16(ka[0], qf[0], s0, 0, 0, 0); s1 = __builtin_amdgcn_mfma_f32_16x16x32_bf16(ka[2], qf[0], s1, 0, 0, 0);
    s0 = __builtin_amdgcn_mfma_f32_16x16x32_bf16(ka[1], qf[1], s0, 0, 0, 0); s1 = __builtin_amdgcn_mfma_f32_16x16x32_bf16(ka[3], qf[1], s1, 0, 0, 0);
    sv[0] = s0[0]; sv[1] = s0[1]; sv[2] = s0[2]; sv[3] = s0[3]; sv[4] = s1[0]; sv[5] = s1[1]; sv[6] = s1[2]; sv[7] = s1[3];
}
DEVI unsigned long long pack8_fp8(const float (&p)[8]) {
    int lo = 0, hi = 0;
    lo = __builtin_amdgcn_cvt_pk_fp8_f32(p[0], p[1], lo, false); lo = __builtin_amdgcn_cvt_pk_fp8_f32(p[2], p[3], lo, true);
    hi = __builtin_amdgcn_cvt_pk_fp8_f32(p[4], p[5], hi, false); hi = __builtin_amdgcn_cvt_pk_fp8_f32(p[6], p[7], hi, true);
    return ((unsigned long long)(unsigned)hi << 32) | (unsigned)lo;
}
struct NsaSt { float m, l; f32x4 o[4]; };
struct NsaBuf8 { long ka[4]; long va[4]; int e; };
DEVI void nsa_load8(long (&f)[4], const unsigned char* P, int ch, int lane) {
#pragma unroll
    for (int i = 0; i < 2; ++i) { const uint4 w = *(const uint4*)(P + ((ch * 2 + i) * 64 + lane) * 16);
        f[2 * i] = (long)(((unsigned long long)w.y << 32) | w.x); f[2 * i + 1] = (long)(((unsigned long long)w.w << 32) | w.z); }
}
struct NsaSt8 { float m, l; bool set; f32x4 negm; f32x4 o[4]; };
DEVI void nsa_init8(NsaSt8& st) { st.m = 0.f; st.l = 0.f; st.set = false; st.negm = (f32x4){7.f, 7.f, 7.f, 7.f};
#pragma unroll
    for (int dt = 0; dt < 4; ++dt) st.o[dt] = (f32x4){0.f, 0.f, 0.f, 0.f}; }

struct NsaBuf { bf16x8 ka[4]; bf16x8 va[4]; };
DEVI void nsa_init(NsaSt& st) { st.m = -1e20f; st.l = 0.f;
#pragma unroll
    for (int dt = 0; dt < 4; ++dt) st.o[dt] = (f32x4){0.f, 0.f, 0.f, 0.f}; }
template <bool PV>
DEVI void nsa_chunk(NsaSt& st, float (&sv)[8], int pos0, int lo, int hi, const bf16x8 (&va)[4]) {
    float cm = -1e30f;
#pragma unroll
    for (int j = 0; j < 8; ++j) { const bool ok = (pos0 + j >= lo) && (pos0 + j <= hi); sv[j] = ok ? sv[j] : -1e30f; cm = fmaxf(cm, sv[j]); }
    cm = fmaxf(cm, __shfl_xor(cm, 16)); cm = fmaxf(cm, __shfl_xor(cm, 32));
    if (__any(cm > st.m)) {
        const float mn = fmaxf(st.m, cm), sc = __builtin_amdgcn_exp2f(st.m - mn);
        st.l *= sc;
        if (PV) {
#pragma unroll
            for (int dt = 0; dt < 4; ++dt) st.o[dt] *= sc;
        }
        st.m = mn;
    }
    float p[8]; float ps = 0.f;
#pragma unroll
    for (int j = 0; j < 8; ++j) { p[j] = __builtin_amdgcn_exp2f(sv[j] - st.m); ps += p[j]; }
    st.l += ps;
    if (PV) {
        const bf16x8 pb = pack8(p);
#pragma unroll
        for (int dt = 0; dt < 4; ++dt) st.o[dt] = __builtin_amdgcn_mfma_f32_16x16x32_bf16(va[dt], pb, st.o[dt], 0, 0, 0);
    }
}
template <int MASK>
DEVI void nsa_chunk8(NsaSt8& st, const long (&ka)[4], const long (&qf)[2], const long (&va)[4], int pos0, int hi, bool own) {
    f32x4 s0 = st.negm, s1 = st.negm;
    s0 = __builtin_amdgcn_mfma_f32_16x16x32_fp8_fp8(ka[0], qf[0], s0, 0, 0, 0); s1 = __builtin_amdgcn_mfma_f32_16x16x32_fp8_fp8(ka[2], qf[0], s1, 0, 0, 0);
    s0 = __builtin_amdgcn_mfma_f32_16x16x32_fp8_fp8(ka[1], qf[1], s0, 0, 0, 0); s1 = __builtin_amdgcn_mfma_f32_16x16x32_fp8_fp8(ka[3], qf[1], s1, 0, 0, 0);
    float sv[8] = {s0[0], s0[1], s0[2], s0[3], s1[0], s1[1], s1[2], s1[3]};
    if (MASK == 1) {
#pragma unroll
        for (int j = 0; j < 8; ++j) sv[j] = own ? sv[j] : -1e30f;
    } else if (MASK == 2) {
#pragma unroll
        for (int j = 0; j < 8; ++j) sv[j] = (pos0 + j <= hi) ? sv[j] : -1e30f;
    }
    float cm = fmaxf(fmaxf(fmaxf(sv[0], sv[1]), fmaxf(sv[2], sv[3])), fmaxf(fmaxf(sv[4], sv[5]), fmaxf(sv[6], sv[7])));
    cm = fmaxf(cm, __shfl_xor(cm, 16)); cm = fmaxf(cm, __shfl_xor(cm, 32));
    const bool need = (cm > 7.f) || (!st.set && cm > -1e29f);
    if (__any(need)) {
        const float d = need ? cm - 7.f : 0.f;
        const float sc = need ? (st.set ? __builtin_amdgcn_exp2f(-d) : 0.f) : 1.f;
        st.m += d; st.set = st.set || need;
        const float nm = 7.f - st.m; st.negm = (f32x4){nm, nm, nm, nm};
        st.l *= sc;
#pragma unroll
        for (int dt = 0; dt < 4; ++dt) st.o[dt] *= sc;
#pragma unroll
        for (int j = 0; j < 8; ++j) sv[j] -= d;
    }
    float p[8];
#pragma unroll
    for (int j = 0; j < 8; ++j) p[j] = __builtin_amdgcn_exp2f(sv[j]);
    st.l += ((p[0] + p[1]) + (p[2] + p[3])) + ((p[4] + p[5]) + (p[6] + p[7]));
    const long pb = (long)pack8_fp8(p);
#pragma unroll
    for (int dt = 0; dt < 4; ++dt) st.o[dt] = __builtin_amdgcn_mfma_f32_16x16x32_fp8_fp8(va[dt], pb, st.o[dt], 0, 0, 0);
}
struct NsaBlk8 { long ka[8]; long va[8]; int e; };
template <int MASK>
DEVI void nsa_block8(NsaSt8& st, const NsaBlk8& bf, const long (&qf)[2], int pos0, int hi, bool own) {
    f32x4 s0 = st.negm, s1 = st.negm, s2 = st.negm, s3 = st.negm;
    s0 = __builtin_amdgcn_mfma_f32_16x16x32_fp8_fp8(bf.ka[0], qf[0], s0, 0, 0, 0); s1 = __builtin_amdgcn_mfma_f32_16x16x32_fp8_fp8(bf.ka[2], qf[0], s1, 0, 0, 0);
    s2 = __builtin_amdgcn_mfma_f32_16x16x32_fp8_fp8(bf.ka[4], qf[0], s2, 0, 0, 0); s3 = __builtin_amdgcn_mfma_f32_16x16x32_fp8_fp8(bf.ka[6], qf[0], s3, 0, 0, 0);
    s0 = __builtin_amdgcn_mfma_f32_16x16x32_fp8_fp8(bf.ka[1], qf[1], s0, 0, 0, 0); s1 = __builtin_amdgcn_mfma_f32_16x16x32_fp8_fp8(bf.ka[3], qf[1], s1, 0, 0, 0);
    s2 = __builtin_amdgcn_mfma_f32_16x16x32_fp8_fp8(bf.ka[5], qf[1], s2, 0, 0, 0); s3 = __builtin_amdgcn_mfma_f32_16x16x32_fp8_fp8(bf.ka[7], qf[1], s3, 0, 0, 0);
    float sv[16] = {s0[0], s0[1], s0[2], s0[3], s1[0], s1[1], s1[2], s1[3], s2[0], s2[1], s2[2], s2[3], s3[0], s3[1], s3[2], s3[3]};
    if (MASK == 1) {
#pragma unroll
        for (int j = 0; j < 16; ++j) sv[j] = own ? sv[j] : -1e30f;
    } else if (MASK == 2) {
#pragma unroll
        for (int j = 0; j < 16; ++j) sv[j] = (pos0 + (j & 7) + 32 * (j >> 3) <= hi) ? sv[j] : -1e30f;
    }
    float cm = fmaxf(fmaxf(fmaxf(fmaxf(sv[0], sv[1]), fmaxf(sv[2], sv[3])), fmaxf(fmaxf(sv[4], sv[5]), fmaxf(sv[6], sv[7]))),
                     fmaxf(fmaxf(fmaxf(sv[8], sv[9]), fmaxf(sv[10], sv[11])), fmaxf(fmaxf(sv[12], sv[13]), fmaxf(sv[14], sv[15]))));
    cm = fmaxf(cm, __shfl_xor(cm, 16)); cm = fmaxf(cm, __shfl_xor(cm, 32));
    const bool need = (cm > 7.f) || (!st.set && cm > -1e29f);
    if (__any(need)) {
        const float d = need ? cm - 7.f : 0.f;
        const float sc = need ? (st.set ? __builtin_amdgcn_exp2f(-d) : 0.f) : 1.f;
        st.m += d; st.set = st.set || need;
        const float nm = 7.f - st.m; st.negm = (f32x4){nm, nm, nm, nm};
        st.l *= sc;
#pragma unroll
        for (int dt = 0; dt < 4; ++dt) st.o[dt] *= sc;
#pragma unroll
        for (int j = 0; j < 16; ++j) sv[j] -= d;
    }
    float p[8], q[8];
#pragma unroll
    for (int j = 0; j < 8; ++j) { p[j] = __builtin_amdgcn_exp2f(sv[j]); q[j] = __builtin_amdgcn_exp2f(sv[8 + j]); }
    st.l += (((p[0] + p[1]) + (p[2] + p[3])) + ((p[4] + p[5]) + (p[6] + p[7]))) + (((q[0] + q[1]) + (q[2] + q[3])) + ((q[4] + q[5]) + (q[6] + q[7])));
    const long pb0 = (long)pack8_fp8(p), pb1 = (long)pack8_fp8(q);
#pragma unroll
    for (int dt = 0; dt < 4; ++dt) st.o[dt] = __builtin_amdgcn_mfma_f32_16x16x32_fp8_fp8(bf.va[dt], pb0, st.o[dt], 0, 0, 0);
#pragma unroll
    for (int dt = 0; dt < 4; ++dt) st.o[dt] = __builtin_amdgcn_mfma_f32_16x16x32_fp8_fp8(bf.va[4 + dt], pb1, st.o[dt], 0, 0, 0);
}
template <class LD, class CP>
DEVI void nsa_streamb(int n, LD ld, CP cp) {
    NsaBlk8 A, B;
    if (n > 0) ld(A, 0);
#pragma unroll 1
    for (int i = 0; i < n; i += 2) {
        if (i + 1 < n) ld(B, i + 1);
        cp(A, i);
        if (i + 1 < n) { if (i + 2 < n) ld(A, i + 2); cp(B, i + 1); }
    }
}
DEVI void nsa_fold8(f32x4 (&comb)[4], NsaSt8& st, float gate) {
    float l = st.l; l += __shfl_xor(l, 16); l += __shfl_xor(l, 32);
    const float w = gate / fmaxf(l, 1e-30f);
#pragma unroll
    for (int dt = 0; dt < 4; ++dt) comb[dt] += st.o[dt] * w;
}
template <class LD, class CP>
DEVI void nsa_stream8(int n, LD ld, CP cp) {
    NsaBuf8 A, B, C, D;
    if (n > 0) ld(A, 0);
    if (n > 1) ld(B, 1);
    if (n > 2) ld(C, 2);
#pragma unroll 1
    for (int i = 0; i < n; i += 4) {
        if (i + 3 < n) ld(D, i + 3);
        cp(A, i);
        if (i + 1 < n) { if (i + 4 < n) ld(A, i + 4); cp(B, i + 1); }
        if (i + 2 < n) { if (i + 5 < n) ld(B, i + 5); cp(C, i + 2); }
        if (i + 3 < n) { if (i + 6 < n) ld(C, i + 6); cp(D, i + 3); }
    }
}
DEVI void nsa_fold(f32x4 (&comb)[4], NsaSt& st, float gate) {
    float l = st.l; l += __shfl_xor(l, 16); l += __shfl_xor(l, 32);
    const float w = gate / fmaxf(l, 1e-30f);
#pragma unroll
    for (int dt = 0; dt < 4; ++dt) comb[dt] += st.o[dt] * w;
}
template <class LD, class CP>
DEVI void nsa_stream(int n, LD ld, CP cp) {
    NsaBuf A, B, C;
    if (n > 0) ld(A, 0);
    if (n > 1) ld(B, 1);
#pragma unroll 1
    for (int i = 0; i < n; i += 3) {
        if (i + 2 < n) ld(C, i + 2);
        cp(A, i);
        if (i + 1 < n) { if (i + 3 < n) ld(A, i + 3); cp(B, i + 1); }
        if (i + 2 < n) { if (i + 4 < n) ld(B, i + 4); cp(C, i + 2); }
    }
}
template <class LD, class CP>
DEVI void nsa_stream2(int n, LD ld, CP cp) {
    NsaBuf A, B;
    if (n > 0) ld(A, 0);
#pragma unroll 1
    for (int i = 0; i < n; i += 2) {
        if (i + 1 < n) ld(B, i + 1);
        cp(A, i);
        if (i + 1 < n) { if (i + 2 < n) ld(A, i + 2); cp(B, i + 1); }
    }
}

#define XB_TMO      128
#define XB_XCNT(j)  (256  + 64 * (j))
#define XB_XSUB(j)  (1280 + 64 * (j))
#define XB_XGEN(j)  (2304 + 64 * (j))
#define XB_TOP      3328
#define XB_TOPGEN   3392
#define XCD_BAR_WORDS 3456
#define XB_SPIN_CAP (1u << 22)
#define LAS __attribute__((address_space(3)))
DEVI unsigned xb_ld(unsigned* p)              { return __hip_atomic_load(p, __ATOMIC_RELAXED, __HIP_MEMORY_SCOPE_AGENT); }
DEVI unsigned xb_add(unsigned* p, unsigned v) { return __hip_atomic_fetch_add(p, v, __ATOMIC_RELAXED, __HIP_MEMORY_SCOPE_AGENT); }
DEVI unsigned xb_xcc_id() { return (unsigned)__builtin_amdgcn_s_getreg((3 << 11) | 20) & 0xFu; }
#define XB_SPIN(cond, bar) do { unsigned _sp = 0; while (cond) { __builtin_amdgcn_s_sleep(1); \
    if ((++_sp & 255u) == 0u) { if (xb_ld(&(bar)[XB_TMO])) break; if (_sp > XB_SPIN_CAP) { atomicAdd(&(bar)[XB_TMO], 1u); break; } } } } while (0)
struct XcdBarrier { unsigned* bar; unsigned x; volatile LAS unsigned* st; };
DEVI XcdBarrier xcd_barrier_post(unsigned* bar, volatile LAS unsigned* st) {
    XcdBarrier b; b.bar = bar; b.x = xb_xcc_id(); b.st = st;
    if (threadIdx.x == 0) (void)xb_add(&bar[XB_XCNT(b.x)], 1u);
    return b;
}
DEVI void xcd_barrier_complete(unsigned* bar, unsigned x, unsigned& nloc, unsigned& nx) {
    const unsigned G = gridDim.x * gridDim.y * gridDim.z;
    unsigned sum, cnt, mine, sp = 0u;
    for (;;) {
        sum = 0u; cnt = 0u; mine = 0u;
#pragma unroll
        for (unsigned j = 0; j < 16; ++j) { const unsigned c = xb_ld(&bar[XB_XCNT(j)]); sum += c; cnt += (c > 0u) ? 1u : 0u; mine = (j == x) ? c : mine; }
        if (sum == G) break;
        __builtin_amdgcn_s_sleep(1);
        if ((++sp & 255u) == 0u) { if (xb_ld(&bar[XB_TMO])) break; if (sp > XB_SPIN_CAP) { atomicAdd(&bar[XB_TMO], 1u); break; } }
    }
    nloc = mine > 0u ? mine : 1u; nx = cnt > 0u ? cnt : 1u;
}
DEVI void xcd_barrier(const XcdBarrier& b) {
    asm volatile("s_waitcnt vmcnt(0)" ::: "memory");
    __syncthreads();
    if (threadIdx.x == 0) {
        unsigned* bar = b.bar;
        __builtin_amdgcn_s_waitcnt(0);
        unsigned nloc = b.st[0], nx = b.st[1];
        if (nloc == 0u) { xcd_barrier_complete(bar, b.x, nloc, nx); b.st[0] = nloc; b.st[1] = nx; }
        const unsigned old = xb_add(&bar[XB_XSUB(b.x)], 1u);
        const unsigned gen = old / nloc;
        if (old + 1u == (gen + 1u) * nloc) {
            __builtin_amdgcn_fence(__ATOMIC_RELEASE, "agent");
            asm volatile("s_waitcnt vmcnt(0)" ::: "memory");
            const unsigned og = xb_add(&bar[XB_TOP], 1u);
            const unsigned tg = og / nx;
            if (og + 1u == (tg + 1u) * nx) xb_add(&bar[XB_TOPGEN], 1u);
            else XB_SPIN(xb_ld(&bar[XB_TOPGEN]) == tg, bar);
            __builtin_amdgcn_fence(__ATOMIC_ACQUIRE, "agent");
            xb_add(&bar[XB_XGEN(b.x)], 1u);
            asm volatile("s_waitcnt vmcnt(0)" ::: "memory");
        } else {
            XB_SPIN(xb_ld(&bar[XB_XGEN(b.x)]) == gen, bar);
            __builtin_amdgcn_fence(__ATOMIC_ACQUIRE, "agent");
            asm volatile("s_waitcnt vmcnt(0)" ::: "memory");
        }
    }
    __syncthreads();
}

DEVI void* ldptr(volatile LAS unsigned long long* tab, int i) { const unsigned long long v = tab[i];
    const unsigned lo = __builtin_amdgcn_readfirstlane((unsigned)v), hi = __builtin_amdgcn_readfirstlane((unsigned)(v >> 32)); return (void*)(((unsigned long long)hi << 32) | lo); }

__global__ void __launch_bounds__(NTHREADS) fwd_mega(Params pa) {
    extern __shared__ __attribute__((aligned(16))) unsigned char smem[];
    const int bid = blockIdx.x, nb = gridDim.x, tid = threadIdx.x, lane = tid & 63, wave = tid >> 6;
    volatile LAS unsigned long long* ptab = (volatile LAS unsigned long long*)(smem + LDS_BYTES - 16 - 32 * 8);
    {
        volatile LAS unsigned* st0 = (volatile LAS unsigned*)(smem + LDS_BYTES - 16);
        if (tid < 4) st0[tid] = 0u;
        if (tid == 0) {
            ptab[0] = (unsigned long long)pa.x; ptab[1] = (unsigned long long)pa.mem; ptab[2] = (unsigned long long)pa.g_mix; ptab[3] = (unsigned long long)pa.w_in;
            ptab[4] = (unsigned long long)pa.pe_k; ptab[5] = (unsigned long long)pa.w1_k; ptab[6] = (unsigned long long)pa.b1_k; ptab[7] = (unsigned long long)pa.w2_k;
            ptab[8] = (unsigned long long)pa.pe_v; ptab[9] = (unsigned long long)pa.w1_v; ptab[10] = (unsigned long long)pa.b1_v; ptab[11] = (unsigned long long)pa.w2_v;
            ptab[12] = (unsigned long long)pa.ln_g; ptab[13] = (unsigned long long)pa.ln_b; ptab[14] = (unsigned long long)pa.gws; ptab[15] = (unsigned long long)pa.gbs;
            ptab[16] = (unsigned long long)pa.w_nsa_out; ptab[17] = (unsigned long long)pa.w_gmlp_out; ptab[18] = (unsigned long long)pa.w_mix_out; ptab[19] = (unsigned long long)pa.g_xattn;
            ptab[20] = (unsigned long long)pa.g_mem; ptab[21] = (unsigned long long)pa.w_xq; ptab[22] = (unsigned long long)pa.w_xkv; ptab[23] = (unsigned long long)pa.w_xo;
            ptab[24] = (unsigned long long)pa.g_peer; ptab[25] = (unsigned long long)pa.w_peer_q; ptab[26] = (unsigned long long)pa.sub_keys; ptab[27] = (unsigned long long)pa.peer_u;
            ptab[28] = (unsigned long long)pa.peer_v; ptab[29] = (unsigned long long)pa.g_final; ptab[30] = (unsigned long long)pa.out; ptab[31] = (unsigned long long)pa.ws;
        }
        __syncthreads();
    }
    const XcdBarrier xb = xcd_barrier_post((unsigned*)pa.ws, (volatile LAS unsigned*)(smem + LDS_BYTES - 16));
#define LDP(i) ((const float*)ldptr(ptab, i))
#define PHASE_BEGIN \
    const int tid = tid_opaque(), lane = tid & 63, wave = tid >> 6; (void)lane; (void)wave; \
    Params p; p.x = LDP(0); p.mem = LDP(1); p.g_mix = LDP(2); p.w_in = LDP(3); p.pe_k = LDP(4); p.w1_k = LDP(5); p.b1_k = LDP(6); p.w2_k = LDP(7); p.pe_v = LDP(8); p.w1_v = LDP(9); p.b1_v = LDP(10); p.w2_v = LDP(11); \
    p.ln_g = LDP(12); p.ln_b = LDP(13); p.gws = LDP(14); p.gbs = LDP(15); p.w_nsa_out = LDP(16); p.w_gmlp_out = LDP(17); p.w_mix_out = LDP(18); p.g_xattn = LDP(19); p.g_mem = LDP(20); p.w_xq = LDP(21); p.w_xkv = LDP(22); p.w_xo = LDP(23); \
    p.g_peer = LDP(24); p.w_peer_q = LDP(25); p.sub_keys = LDP(26); p.peer_u = LDP(27); p.peer_v = LDP(28); p.g_final = LDP(29); p.out = (float*)ldptr(ptab, 30); p.ws = (unsigned char*)ldptr(ptab, 31); \
    unsigned char* const ws = p.ws; \
    bf16_t* WIN = (bf16_t*)(ws + O_WIN); bf16_t* W1K = (bf16_t*)(ws + O_W1K); bf16_t* W1V = (bf16_t*)(ws + O_W1V); \
    bf16_t* WNSA = (bf16_t*)(ws + O_WNSA); bf16_t* WGM = (bf16_t*)(ws + O_WGM); bf16_t* WMIX = (bf16_t*)(ws + O_WMIX); \
    bf16_t* WXQ = (bf16_t*)(ws + O_WXQ); bf16_t* WXKV = (bf16_t*)(ws + O_WXKV); bf16_t* WXO = (bf16_t*)(ws + O_WXO); bf16_t* WPQ = (bf16_t*)(ws + O_WPQ); \
    float* B1F = (float*)(ws + O_B1); \
    bf16_t* HN = (bf16_t*)(ws + O_HN); bf16_t* MN = (bf16_t*)(ws + O_MN); bf16_t* KVX = (bf16_t*)(ws + O_KVX); \
    float* GATES = (float*)(ws + O_GATES); float* HID = (float*)(ws + O_HID); \
    bf16_t* Q = (bf16_t*)(ws + O_Q); bf16_t* KV6 = (bf16_t*)(ws + O_KV6); bf16_t* U = (bf16_t*)(ws + O_U); bf16_t* VG = (bf16_t*)(ws + O_VG); \
    bf16_t* MG = (bf16_t*)(ws + O_MG); bf16_t* ONSA = (bf16_t*)(ws + O_ONSA); bf16_t* OGM = (bf16_t*)(ws + O_OGM); \
    bf16_t* Y = (bf16_t*)(ws + O_Y); bf16_t* QX = (bf16_t*)(ws + O_QX); bf16_t* OX = (bf16_t*)(ws + O_OX); bf16_t* QP = (bf16_t*)(ws + O_QP); \
    float* HS = (float*)(ws + O_HS); int* HI = (int*)(ws + O_HI); \
    bf16_t* VXT = (bf16_t*)(ws + O_VXT); bf16_t* SUBK = (bf16_t*)(ws + O_SUBK); \
    bf16_t* KCB = (bf16_t*)(ws + O_CMP); bf16_t* VCT = KCB + 4 * 512 * 64; \
    unsigned char* PU8 = ws + O_U; unsigned char* PV8 = ws + O_U + 16384ull * 1024; \
    float* PSC = (float*)(ws + O_PSC); \
    float* OUT = p.out; \
    (void)WIN; (void)W1K; (void)W1V; (void)WNSA; (void)WGM; (void)WMIX; (void)WXQ; (void)WXKV; (void)WXO; (void)WPQ; (void)B1F; (void)HN; (void)MN; (void)KVX; (void)GATES; (void)HID; (void)Q; (void)KV6; (void)U; (void)VG; \
    (void)MG; (void)ONSA; (void)OGM; (void)Y; (void)QX; (void)OX; (void)QP; (void)HS; (void)HI; (void)VXT; (void)SUBK; (void)KCB; (void)VCT; (void)PU8; (void)PV8; (void)PSC; (void)OUT;

    { PHASE_BEGIN
    {
        float* tile = (float*)smem;
        for (int j = bid; j < 3424; j += nb) {
            int t = j;
            if (t < 1120) { transpose_tile(p.w_in, 4376, WIN, 1024, t, WinMap(), tile); continue; } t -= 1120;
            if (t < 128) { transpose_tile(p.w1_k, 256, W1K, 2048, t, IdMap(), tile); continue; } t -= 128;
            if (t < 128) { transpose_tile(p.w1_v, 256, W1V, 2048, t, IdMap(), tile); continue; } t -= 128;
            if (t < 128) { transpose_tile(p.w_nsa_out, 1024, WNSA, 512, t, IdMap(), tile); continue; } t -= 128;
            if (t < 128) { transpose_tile(p.w_gmlp_out, 1024, WGM, 512, t, IdMap(), tile); continue; } t -= 128;
            if (t < 256) { transpose_tile(p.w_mix_out, 1024, WMIX, 1024, t, IdMap(), tile); continue; } t -= 256;
            if (t < 256) { transpose_tile(p.w_xq, 1024, WXQ, 1024, t, IdMap(), tile); continue; } t -= 256;
            if (t < 512) { transpose_tile(p.w_xkv, 2048, WXKV, 1024, t, IdMap(), tile); continue; } t -= 512;
            if (t < 256) { transpose_tile(p.w_xo, 1024, WXO, 1024, t, IdMap(), tile); continue; } t -= 256;
            transpose_tile(p.w_peer_q, 2048, WPQ, 1024, t, IdMap(), tile);
        }
        for (int r = bid * 8 + wave; r < 16384 + 512; r += nb * 8) {
            if (r < 16384) rmsnorm_row_bf16(p.x + (size_t)r * 1024, p.g_mix, HN + (size_t)r * 1024, lane);
            else rmsnorm_row_bf16(p.mem + (size_t)(r - 16384) * 1024, p.g_mem, MN + (size_t)(r - 16384) * 1024, lane);
        }
        for (int i = bid * NTHREADS + tid; i < 16 * 128 * 128; i += nb * NTHREADS) SUBK[(i & ~16383) + pk_koff((i >> 7) & 127, i & 127)] = f2bf(p.sub_keys[i]);
        for (int i = bid * NTHREADS + tid; i < 2 * 2048 * 256 / 4; i += nb * NTHREADS) ((float4*)HID)[i] = make_float4(0.f, 0.f, 0.f, 0.f);
        if (bid == nb - 1) {
            const int kv = tid >> 8, n = tid & 255;
            const float* pe = kv ? p.pe_v : p.pe_k; const float* w1 = kv ? p.w1_v : p.w1_k; const float* b1 = kv ? p.b1_v : p.b1_k;
            float a = b1[n];
            for (int k = 0; k < 2048; ++k) a += pe[k] * w1[(size_t)k * 256 + n];
            B1F[kv * 256 + n] = a;
        }
    }
    }
    xcd_barrier(xb);

    { PHASE_BEGIN
    {
        auto epi = [&](int r, int c, const f32x4& v0, const f32x4& v1) {
            if (c < 512) { const float qs_ = 0.125f * 1.4426950408889634f; store_bf16x8(Q + (size_t)r * 512 + c, v0 * qs_, v1 * qs_);
                const float q8[8] = {v0[0] * qs_, v0[1] * qs_, v0[2] * qs_, v0[3] * qs_, v1[0] * qs_, v1[1] * qs_, v1[2] * qs_, v1[3] * qs_};
                *(unsigned long long*)(ws + O_Q8 + (size_t)r * 512 + c) = pack8_fp8(q8); }
            else if (c < 1280) { const int w = (c - 512) >> 7, cc = (c - 512) & 127;
                const int b_ = r >> 13, t_ = r & 8191, g_ = cc >> 6, d_ = cc & 63;
                if (w == 5) {
                    bf16_t* vt = KV6 + (size_t)w * 16384 * 128 + (size_t)(b_ * 2 + g_) * 8192 * 64 + nsa_voff(t_, d_);
                    vt[0] = f2bf(v0[0]); vt[8] = f2bf(v0[1]); vt[16] = f2bf(v0[2]); vt[24] = f2bf(v0[3]); vt[32] = f2bf(v1[0]); vt[40] = f2bf(v1[1]); vt[48] = f2bf(v1[2]); vt[56] = f2bf(v1[3]); }
                else if (w == 4) store_bf16x8(KV6 + (size_t)w * 16384 * 128 + (size_t)(b_ * 2 + g_) * 8192 * 64 + nsa_koff(t_, d_), v0, v1);
                else if (w == 3) {
                    const float f8[8] = {v0[0], v0[1], v0[2], v0[3], v1[0], v1[1], v1[2], v1[3]}; const unsigned long long pk = pack8_fp8(f8);
                    unsigned char* vt = (unsigned char*)(KV6 + (size_t)w * 16384 * 128) + (size_t)(b_ * 2 + g_) * 8192 * 64 + nsa_voff8(t_, d_);
#pragma unroll
                    for (int e = 0; e < 8; ++e) vt[e * 16] = (unsigned char)(pk >> (8 * e)); }
                else if (w == 2) {
                    const float f8[8] = {v0[0], v0[1], v0[2], v0[3], v1[0], v1[1], v1[2], v1[3]};
                    *(unsigned long long*)((unsigned char*)(KV6 + (size_t)w * 16384 * 128) + (size_t)(b_ * 2 + g_) * 8192 * 64 + nsa_koff8(t_, d_)) = pack8_fp8(f8); }
                else store_bf16x8(KV6 + ((size_t)w * 16384 + r) * 128 + cc, v0, v1); }
            else if (c < 2304) { bf16_t* dst = c < 1792 ? U + (size_t)r * 512 + (c - 1280) : VG + (size_t)r * 512 + (c - 1792);
                f32x4 a, b;
#pragma unroll
                for (int e = 0; e < 4; ++e) { a[e] = gelu_f(v0[e]); b[e] = gelu_f(v1[e]); }
                store_bf16x8(dst, a, b); }
            else { f32x4 a, b;
#pragma unroll
                for (int e = 0; e < 4; ++e) { a[e] = sigmoid_f(v0[e]); b[e] = sigmoid_f(v1[e]); }
                store_bf16x8(MG + (size_t)r * 2048 + (c - 2304), a, b); }
        };
        big_gemm(smem, HN, WIN, 16384, 4352, 1024, epi);
    }
    }
    xcd_barrier(xb);

    { PHASE_BEGIN
    {
        for (int task = bid; task < 256; task += nb) {
            if (task < 128) {
                const int kv = task >> 6, t = task & 63, mt = t >> 2, nt = (t >> 1) & 1, kh = t & 1;
                bf16_t* As = (bf16_t*)smem; bf16_t* Bs = As + 128 * G_LD;
                const int wm = wave >> 2, wn = wave & 3;
                f32x4 acc[4][2];
#pragma unroll
                for (int i = 0; i < 4; ++i)
#pragma unroll
                    for (int j = 0; j < 2; ++j) acc[i][j] = (f32x4){0.f, 0.f, 0.f, 0.f};
                gemm_tile(acc, CmpA{KV6 + (size_t)kv * 16384 * 128, kh * 1024}, mt * 128, (kv ? W1V : W1K) + (size_t)nt * 128 * 2048 + kh * 1024, 2048, 1024, As, Bs);
#pragma unroll
                for (int i = 0; i < 4; ++i)
#pragma unroll
                    for (int j = 0; j < 2; ++j) {
                        const int r = mt * 128 + wm * 64 + i * 16 + (lane & 15), c = nt * 128 + wn * 32 + j * 16 + (lane >> 4) * 4;
                        if (r < 2044) { float* hp = HID + ((size_t)kv * 2048 + r) * 256 + c;
                            unsafeAtomicAdd(hp, acc[i][j][0]); unsafeAtomicAdd(hp + 1, acc[i][j][1]); unsafeAtomicAdd(hp + 2, acc[i][j][2]); unsafeAtomicAdd(hp + 3, acc[i][j][3]); }
                    }
                __syncthreads();
            } else {
                const int ch = task - 128;
                const size_t row0 = (size_t)ch * 128;
                constexpr int VLD = 136;
                bf16_t* VT = (bf16_t*)smem;
                float* st = (float*)(smem + 512 * VLD * 2);
                for (int r = wave * 16; r < wave * 16 + 16; ++r) {
                    float f[8]; load8(VG + (row0 + r) * 512 + lane * 8, f);
                    float s1 = 0.f;
#pragma unroll
                    for (int e = 0; e < 8; ++e) s1 += f[e];
                    s1 = wave_sum(s1); const float mu = s1 * (1.0f / 512.0f);
                    float s2 = 0.f;
#pragma unroll
                    for (int e = 0; e < 8; ++e) s2 += (f[e] - mu) * (f[e] - mu);
                    s2 = wave_sum(s2);
                    if (lane == 0) { st[r * 2] = mu; st[r * 2 + 1] = rsqrtf(s2 * (1.0f / 512.0f) + 1e-6f); }
                }
                __syncthreads();
                {
                    const int s_ = tid & 127; const float mu = st[s_ * 2], rs = st[s_ * 2 + 1];
#pragma unroll 1
                    for (int i = 0; i < 16; ++i) {
                        const int d0 = ((tid >> 7) + 4 * i) * 8;
                        float f[8]; load8(VG + (row0 + s_) * 512 + d0, f);
#pragma unroll
                        for (int e = 0; e < 8; ++e) VT[(d0 + e) * VLD + s_] = f2bf((f[e] - mu) * rs * p.ln_g[d0 + e] + p.ln_b[d0 + e]);
                    }
                }
                __syncthreads();
                {
                    const int tl = wave * 16 + (lane & 15), hq = lane >> 4, kmax = (wave * 16 + 15) >> 5;
                    for (int g = 0; g < 4; ++g) {
                        bf16x8 wf[4];
#pragma unroll
                        for (int ks = 0; ks < 4; ++ks) {
                            if (ks <= kmax) {
                                const float* wp = p.gws + (size_t)g * 16384 + tl * 128 + ks * 32 + 8 * hq;
                                float f[8]; load8(wp, f);
#pragma unroll
                                for (int e = 0; e < 8; ++e) f[e] = (ks * 32 + 8 * hq + e <= tl) ? f[e] : 0.f;
                                wf[ks] = pack8(f);
                            }
                        }
                        const float bsv = p.gbs[g * 128 + tl];
#pragma unroll 2
                        for (int dt = 0; dt < 8; ++dt) {
                            f32x4 a = {0.f, 0.f, 0.f, 0.f};
                            const bf16_t* vp = VT + (g * 128 + dt * 16 + (lane & 15)) * VLD + 8 * hq;
#pragma unroll
                            for (int ks = 0; ks < 4; ++ks) if (ks <= kmax) a = __builtin_amdgcn_mfma_f32_16x16x32_bf16(*(const bf16x8*)(vp + ks * 32), wf[ks], a, 0, 0, 0);
                            const size_t o = (row0 + tl) * 512 + g * 128 + dt * 16 + 4 * hq;
                            const uint2 uw = *(const uint2*)(U + o);
                            store_bf16x4(OGM + o, __uint_as_float(uw.x << 16) * (a[0] + bsv), __uint_as_float(uw.x & 0xffff0000u) * (a[1] + bsv),
                                         __uint_as_float(uw.y << 16) * (a[2] + bsv), __uint_as_float(uw.y & 0xffff0000u) * (a[3] + bsv));
                        }
                    }
                }
                __syncthreads();
            }
        }
    }
    }
    xcd_barrier(xb);

    { PHASE_BEGIN
    {
        auto epig = [&](int r, int c, const f32x4& v) { if (c < 24) { float* gp = GATES + (size_t)r * 24 + c; gp[0] = sigmoid_f(v[0]); gp[1] = sigmoid_f(v[1]); gp[2] = sigmoid_f(v[2]); gp[3] = sigmoid_f(v[3]); } };
        gemm_run(RowMajorA{HN, 1024}, WIN + (size_t)4352 * 1024, 1024, 128, 1, epig, smem, bid, nb);
        auto epi2 = [&](int r, int c, const f32x4& v) {
            const int b_ = r >> 8, m_ = r & 255;
            if (c < 1024) { const int h_ = c >> 8, d_ = c & 255; store_bf16x4(KVX + (size_t)(b_ * 4 + h_) * 65536 + xat_koff(m_, d_), v[0], v[1], v[2], v[3]); }
            else { const int hd = c - 1024, h_ = hd >> 8, d_ = hd & 255;
                bf16_t* vt = VXT + (size_t)(b_ * 4 + h_) * 65536 + xat_voff(m_, d_);
                vt[0] = f2bf(v[0]); vt[8] = f2bf(v[1]); vt[16] = f2bf(v[2]); vt[24] = f2bf(v[3]); } };
        gemm_run(RowMajorA{MN, 1024}, WXKV, 1024, 4, 16, epi2, smem, bid, nb);
        __syncthreads();
        float* gl = (float*)smem + wave * 256;
        for (int task = bid * 8 + wave; task < 2 * 2044; task += nb * 8) {
            const int kv = task >= 2044 ? 1 : 0, r = task - kv * 2044;
            const float* hp = HID + ((size_t)kv * 2048 + r) * 256; const float* bb = B1F + kv * 256;
#pragma unroll
            for (int i = 0; i < 4; ++i) gl[lane + 64 * i] = gelu_f(hp[lane + 64 * i] + bb[lane + 64 * i]);
            lds_fence();
            const float* w2 = kv ? p.w2_v : p.w2_k;
            float a = 0.f;
#pragma unroll 8
            for (int j = 0; j < 256; ++j) a += gl[j] * w2[j * 64 + lane];
            const int b = r / 1022, rr = r - b * 1022, c = rr >> 1, g = rr & 1, n = lane;
            if (kv == 0) KCB[(size_t)(b * 2 + g) * 512 * 64 + nsa_koff(c, n)] = f2bf(a); else VCT[(size_t)(b * 2 + g) * 512 * 64 + nsa_voff(c, n)] = f2bf(a);
            lds_fence();
        }
        if (bid == 0 && tid < 256) { const int bg = tid >> 6, n = tid & 63; KCB[(size_t)bg * 512 * 64 + nsa_koff(511, n)] = 0; VCT[(size_t)bg * 512 * 64 + nsa_voff(511, n)] = 0; }
    }
    }
    xcd_barrier(xb);

    { PHASE_BEGIN
    {
        float* impL = (float*)smem + wave * 1024;
        int* sidxL = (int*)(impL + 512);
        const bf16_t* KS = KV6 + 2ull * 16384 * 128; const bf16_t* VST = KV6 + 3ull * 16384 * 128;
        const bf16_t* KW = KV6 + 4ull * 16384 * 128; const bf16_t* VWT = KV6 + 5ull * 16384 * 128;
        const int c = lane & 15, h = lane >> 4, tokc = c >> 2, headc = c & 3;
        const int rk = 8 * (c >> 2) + (c & 3), dh = 8 * h;
        for (int task = bid * 8 + wave; task < 8192; task += nb * 8) {
            const int bg = task >> 11, q4 = (bg & 1) ? 2047 - (task & 2047) : (task & 2047), b = bg >> 1, g = bg & 1, t0 = q4 * 4;
            const int tcol = t0 + tokc; const size_t bt0 = (size_t)b * 8192 + t0;
            bf16x8 qf[2];
            { const bf16_t* qp = Q + (bt0 + tokc) * 512 + g * 256 + headc * 64 + dh; qf[0] = *(const bf16x8*)qp; qf[1] = *(const bf16x8*)(qp + 32); }
            const float* gp = GATES + (bt0 + tokc) * 24 + (g * 4 + headc) * 3;
            const float gate0 = gp[0], gate1 = gp[1], gate2 = gp[2];
            f32x4 comb[4];
#pragma unroll
            for (int dt = 0; dt < 4; ++dt) comb[dt] = (f32x4){0.f, 0.f, 0.f, 0.f};
            {
                const int ncvc = tcol >= 31 ? ((tcol - 31) >> 4) + 1 : 0;
                const int ncvmax = (t0 + 3) >= 31 ? ((t0 + 3 - 31) >> 4) + 1 : 0;
                const int nch = (ncvmax + 31) >> 5;
                const bf16_t* Kc = KCB + (size_t)bg * 512 * 64; const bf16_t* Vc = VCT + (size_t)bg * 64 * 512;
                NsaSt st; nsa_init(st);
                {
                    auto ld = [&](NsaBuf& bf, int i) { nsa_load_kf(bf.ka, Kc, i, lane); };
                    auto cp = [&](NsaBuf& bf, int i) { float sv[8]; nsa_scores(bf.ka, qf, sv); nsa_chunk<false>(st, sv, i * 32 + dh, 0, ncvc - 1, bf.va); };
                    nsa_stream2(nch, ld, cp);
                }
                float l = st.l; l += __shfl_xor(l, 16); l += __shfl_xor(l, 32);
                const float inv = 1.0f / fmaxf(l, 1e-30f), mfin = st.m;
                *(float4*)(impL + lane * 8) = make_float4(0.f, 0.f, 0.f, 0.f); *(float4*)(impL + lane * 8 + 4) = make_float4(0.f, 0.f, 0.f, 0.f);
                lds_fence();
                f32x4 oc[4];
#pragma unroll
                for (int dt = 0; dt < 4; ++dt) oc[dt] = (f32x4){0.f, 0.f, 0.f, 0.f};
                float carry = 0.f;
                {
                    auto ld = [&](NsaBuf& bf, int i) { nsa_load_kf(bf.ka, Kc, i, lane); nsa_load_kf(bf.va, Vc, i, lane); };
                    auto cp = [&](NsaBuf& bf, int ch) {
                        float sv[8]; nsa_scores(bf.ka, qf, sv);
                        float p[8];
#pragma unroll
                        for (int j = 0; j < 8; ++j) p[j] = (ch * 32 + dh + j < ncvc) ? __builtin_amdgcn_exp2f(sv[j] - mfin) * inv : 0.f;
                        const float up = __shfl(p[7], (lane + 48) & 63);
                        const float prev7 = (h >= 1) ? up : carry; carry = up;
                        float i0 = p[0] + p[1] + p[2] + 0.5f * p[3] + 0.5f * prev7, i1 = p[4] + p[5] + p[6] + 0.5f * p[7] + 0.5f * p[3];
                        i0 += __shfl_xor(i0, 1); i0 += __shfl_xor(i0, 2); i1 += __shfl_xor(i1, 1); i1 += __shfl_xor(i1, 2);
                        if (headc == 0) { impL[tokc * 128 + 8 * ch + 2 * h] = i0; impL[tokc * 128 + 8 * ch + 2 * h + 1] = i1; }
                        const bf16x8 pb = pack8(p);
#pragma unroll
                        for (int dt = 0; dt < 4; ++dt) oc[dt] = __builtin_amdgcn_mfma_f32_16x16x32_bf16(bf.va[dt], pb, oc[dt], 0, 0, 0);
                    };
                    nsa_stream2(nch, ld, cp);
                }
#pragma unroll
                for (int dt = 0; dt < 4; ++dt) comb[dt] += oc[dt] * gate0;
            }
            lds_fence();
            int nblk;
            {
                const int tok = lane >> 4, sub = lane & 15, cur = t0 >> 6;
                float sc[8];
#pragma unroll
                for (int e = 0; e < 8; ++e) { const int j = sub + 16 * e; const float imp = impL[tok * 128 + j];
                    const bool al = j <= cur, fo = (j == 0) || (j == cur) || (j == cur - 1);
                    sc[e] = (fo && al) ? 1e4f : (al ? imp : -1e30f); }
                float myv = -1e30f; int myi = 0;
#pragma unroll 1
                for (int it = 0; it < 16; ++it) {
                    float bv = sc[0]; int bi = sub;
#pragma unroll
                    for (int e = 1; e < 8; ++e) if (sc[e] > bv) { bv = sc[e]; bi = sub + 16 * e; }
#pragma unroll
                    for (int o = 1; o < 16; o <<= 1) { const float ov = __shfl_xor(bv, o); const int oi = __shfl_xor(bi, o);
                        const bool take = (ov > bv) || (ov == bv && oi < bi); bv = take ? ov : bv; bi = take ? oi : bi; }
                    if (sub == it) { myv = bv; myi = bi; }
#pragma unroll
                    for (int e = 0; e < 8; ++e) if (bi == sub + 16 * e) sc[e] = -INFINITY;
                }
                const bool forced = myv > 5e3f;
                const bool keep = (myv > -0.5e30f) && !(forced && tok > 0);
                const unsigned long long bal = __ballot(keep);
                const int pos = __popcll(bal & ((1ull << lane) - 1ull));
                lds_fence();
                if (keep) sidxL[pos] = ((forced ? 7 : tok) << 16) | myi;
                nblk = __popcll(bal);
            }
            lds_fence();
            {
                NsaSt8 st; nsa_init8(st);
                const unsigned char* Kp = (const unsigned char*)KS + (size_t)bg * 8192 * 64; const unsigned char* Vp = (const unsigned char*)VST + (size_t)bg * 8192 * 64;
                long qf8[2];
                { const unsigned char* qp = ws + O_Q8 + (bt0 + tokc) * 512 + g * 256 + headc * 64 + dh; qf8[0] = *(const long*)qp; qf8[1] = *(const long*)(qp + 32); }
                const int cur_ = t0 >> 6;
                auto ld = [&](NsaBlk8& bf, int i) { const int e = __builtin_amdgcn_readfirstlane(sidxL[i]); const int chn = (e & 0xffff) * 2; bf.e = e;
                    long t4[4];
                    nsa_load8(t4, Kp, chn, lane); bf.ka[0] = t4[0]; bf.ka[1] = t4[1]; bf.ka[2] = t4[2]; bf.ka[3] = t4[3];
                    nsa_load8(t4, Kp, chn + 1, lane); bf.ka[4] = t4[0]; bf.ka[5] = t4[1]; bf.ka[6] = t4[2]; bf.ka[7] = t4[3];
                    nsa_load8(t4, Vp, chn, lane); bf.va[0] = t4[0]; bf.va[1] = t4[1]; bf.va[2] = t4[2]; bf.va[3] = t4[3];
                    nsa_load8(t4, Vp, chn + 1, lane); bf.va[4] = t4[0]; bf.va[5] = t4[1]; bf.va[6] = t4[2]; bf.va[7] = t4[3]; };
                auto cp = [&](NsaBlk8& bf, int i) { const int e = bf.e; const int blk = e & 0xffff, ow = e >> 16;
                    if (blk == cur_) { const int hi = (ow == 7 || ow == tokc) ? tcol : -1; nsa_block8<2>(st, bf, qf8, blk * 64 + dh, hi, false); }
                    else if (ow == 7) nsa_block8<0>(st, bf, qf8, 0, 0, true);
                    else nsa_block8<1>(st, bf, qf8, 0, 0, ow == tokc); };
                nsa_streamb(nblk, ld, cp);
                nsa_fold8(comb, st, gate1);
            }
            {
                NsaSt st; nsa_init(st);
                const bf16_t* Kp = KW + (size_t)bg * 8192 * 64; const bf16_t* Vp = VWT + (size_t)bg * 8192 * 64;
                const int kbf = (t0 > 511 ? t0 - 511 : 0) & ~31, kbl = (t0 + 3) & ~31;
                const int lo = tcol > 511 ? tcol - 511 : 0;
                auto ld = [&](NsaBuf& bf, int i) { const int kb = kbf + i * 32; nsa_load_kf(bf.ka, Kp, kb >> 5, lane); nsa_load_kf(bf.va, Vp, kb >> 5, lane); };
                auto cp = [&](NsaBuf& bf, int i) { const int kb = kbf + i * 32; float sv[8]; nsa_scores(bf.ka, qf, sv); nsa_chunk<true>(st, sv, kb + dh, lo, tcol, bf.va); };
                nsa_stream2(((kbl - kbf) >> 5) + 1, ld, cp);
                nsa_fold(comb, st, gate2);
            }
            {
                bf16_t* op = ONSA + (bt0 + tokc) * 512 + g * 256 + headc * 64 + 4 * h;
#pragma unroll
                for (int dt = 0; dt < 4; ++dt) store_bf16x4(op + dt * 16, comb[dt][0], comb[dt][1], comb[dt][2], comb[dt][3]);
            }
            lds_fence();
        }
    }
    }
    xcd_barrier(xb);

    { PHASE_BEGIN
    {
        auto unpack8 = [](const u32x4& w, f32x4& a, f32x4& b) { a[0] = __uint_as_float(w.x << 16); a[1] = __uint_as_float(w.x & 0xffff0000u); a[2] = __uint_as_float(w.y << 16); a[3] = __uint_as_float(w.y & 0xffff0000u);
            b[0] = __uint_as_float(w.z << 16); b[1] = __uint_as_float(w.z & 0xffff0000u); b[2] = __uint_as_float(w.w << 16); b[3] = __uint_as_float(w.w & 0xffff0000u); };
        auto e1 = [&](int r, int c, const f32x4& v0, const f32x4& v1) { f32x4 m0, m1; unpack8(*(const u32x4*)(MG + (size_t)r * 2048 + c), m0, m1); store_bf16x8(Y + (size_t)r * 1024 + c, m0 * v0, m1 * v1); };
        big_gemm(smem, ONSA, WNSA, 16384, 1024, 512, e1);
        auto e2 = [&](int r, int c, const f32x4& v0, const f32x4& v1) { f32x4 m0, m1, y0, y1; unpack8(*(const u32x4*)(MG + (size_t)r * 2048 + 1024 + c), m0, m1); unpack8(*(const u32x4*)(Y + (size_t)r * 1024 + c), y0, y1);
            store_bf16x8(Y + (size_t)r * 1024 + c, y0 + m0 * v0, y1 + m1 * v1); };
        big_gemm(smem, OGM, WGM, 16384, 1024, 512, e2);
    }
    }
    xcd_barrier(xb);

    { PHASE_BEGIN
    {
        auto epi = [&](int r, int c, const f32x4& v0, const f32x4& v1) { const float* xp = p.x + (size_t)r * 1024 + c; float* op = OUT + (size_t)r * 1024 + c;
            *(f32x4*)op = *(const f32x4*)xp + v0; *(f32x4*)(op + 4) = *(const f32x4*)(xp + 4) + v1; };
        big_gemm(smem, Y, WMIX, 16384, 1024, 1024, epi);
    }
    }
    xcd_barrier(xb);

    { PHASE_BEGIN
    for (int r = bid * 8 + wave; r < 16384; r += nb * 8) rmsnorm_row_bf16(OUT + (size_t)r * 1024, p.g_xattn, HN + (size_t)r * 1024, lane);
    }
    xcd_barrier(xb);

    { PHASE_BEGIN
    {
        auto epi = [&](int r, int c, const f32x4& v0, const f32x4& v1) { store_bf16x8(QX + (size_t)r * 1024 + c, v0 * 0.0625f, v1 * 0.0625f); };
        big_gemm(smem, HN, WXQ, 16384, 1024, 1024, epi);
    }
    }
    xcd_barrier(xb);

    { PHASE_BEGIN
    {
        const int c = lane & 15, hg = lane >> 4, rk = 8 * (c >> 2) + (c & 3);
        for (int task = bid * 8 + wave; task < 4096; task += nb * 8) {
            const int h = task & 3, tgrp = task >> 2, b = tgrp >> 9; const size_t bt0 = (size_t)tgrp * 16;
            bf16x8 qf[8];
#pragma unroll
            for (int ks = 0; ks < 8; ++ks) qf[ks] = *(const bf16x8*)(QX + (bt0 + c) * 1024 + h * 256 + ks * 32 + 8 * hg);
            const bf16_t* Kp = KVX + (size_t)(b * 4 + h) * 65536; const bf16_t* Vp = VXT + (size_t)(b * 4 + h) * 65536;
            float m = -1e30f, l = 0.f; f32x4 o[16];
#pragma unroll
            for (int dt = 0; dt < 16; ++dt) o[dt] = (f32x4){0.f, 0.f, 0.f, 0.f};
#pragma unroll 1
            for (int ch = 0; ch < 8; ++ch) {
                const int kb = ch * 32;
                const bf16_t* k0 = Kp + ((ch * 16) * 64 + lane) * 8; const bf16_t* k1 = k0 + 8 * 64 * 8;
                f32x4 s0 = {0.f, 0.f, 0.f, 0.f}, s1 = {0.f, 0.f, 0.f, 0.f};
#pragma unroll
                for (int ks = 0; ks < 8; ++ks) {
                    const bf16x8 a0 = *(const bf16x8*)(k0 + ks * 512), a1 = *(const bf16x8*)(k1 + ks * 512);
                    s0 = __builtin_amdgcn_mfma_f32_16x16x32_bf16(a0, qf[ks], s0, 0, 0, 0); s1 = __builtin_amdgcn_mfma_f32_16x16x32_bf16(a1, qf[ks], s1, 0, 0, 0);
                }
                float sv[8] = {s0[0], s0[1], s0[2], s0[3], s1[0], s1[1], s1[2], s1[3]};
                float cm = sv[0];
#pragma unroll
                for (int j = 1; j < 8; ++j) cm = fmaxf(cm, sv[j]);
                cm = fmaxf(cm, __shfl_xor(cm, 16)); cm = fmaxf(cm, __shfl_xor(cm, 32));
                if (__any(cm > m)) { const float mn = fmaxf(m, cm), sc = __expf(m - mn); l *= sc;
#pragma unroll
                    for (int dt = 0; dt < 16; ++dt) o[dt] *= sc;
                    m = mn; }
                float p[8]; float ps = 0.f;
#pragma unroll
                for (int j = 0; j < 8; ++j) { p[j] = __expf(sv[j] - m); ps += p[j]; }
                l += ps;
                const bf16x8 pb = pack8(p);
#pragma unroll
                for (int dt = 0; dt < 16; ++dt) { const bf16x8 va = *(const bf16x8*)(Vp + ((ch * 16 + dt) * 64 + lane) * 8);
                    o[dt] = __builtin_amdgcn_mfma_f32_16x16x32_bf16(va, pb, o[dt], 0, 0, 0); }
            }
            l += __shfl_xor(l, 16); l += __shfl_xor(l, 32);
            const float inv = 1.0f / l;
            bf16_t* op = OX + (bt0 + c) * 1024 + h * 256 + 4 * hg;
#pragma unroll
            for (int dt = 0; dt < 16; ++dt) store_bf16x4(op + dt * 16, o[dt][0] * inv, o[dt][1] * inv, o[dt][2] * inv, o[dt][3] * inv);
        }
    }
    }
    xcd_barrier(xb);

    { PHASE_BEGIN
    {
        auto epi = [&](int r, int c, const f32x4& v0, const f32x4& v1) { float* op = OUT + (size_t)r * 1024 + c; *(f32x4*)op = *(const f32x4*)op + v0; *(f32x4*)(op + 4) = *(const f32x4*)(op + 4) + v1; };
        big_gemm(smem, OX, WXO, 16384, 1024, 1024, epi);
    }
    }
    xcd_barrier(xb);

    { PHASE_BEGIN
    for (int r = bid * 8 + wave; r < 16384; r += nb * 8) rmsnorm_row_bf16(OUT + (size_t)r * 1024, p.g_peer, HN + (size_t)r * 1024, lane);
    {
        for (int row = bid * 8 + wave; row < 32768; row += nb * 8) {
            const bool isv = row >= 16384; const int rr = isv ? row - 16384 : row;
            const float* src = (isv ? p.peer_v : p.peer_u) + (size_t)rr * 1024 + lane * 16;
            float f[16];
#pragma unroll
            for (int i = 0; i < 4; ++i) { const float4 a = *(const float4*)(src + 4 * i); f[4 * i] = a.x; f[4 * i + 1] = a.y; f[4 * i + 2] = a.z; f[4 * i + 3] = a.w; }
            float am = 0.f;
#pragma unroll
            for (int i = 0; i < 16; ++i) am = fmaxf(am, fabsf(f[i]));
            am = wave_max(am);
            int ex = 0; (void)frexpf(am, &ex);
            if (am == 0.f) ex = 8;
            const float sc = ldexpf(1.0f, 8 - ex);
            uint4 w; unsigned* wp = (unsigned*)&w;
#pragma unroll
            for (int i = 0; i < 4; ++i) { int t = 0; t = __builtin_amdgcn_cvt_pk_fp8_f32(f[4 * i] * sc, f[4 * i + 1] * sc, t, false); t = __builtin_amdgcn_cvt_pk_fp8_f32(f[4 * i + 2] * sc, f[4 * i + 3] * sc, t, true); wp[i] = (unsigned)t; }
            *(uint4*)((isv ? PV8 : PU8) + (size_t)rr * 1024 + lane * 16) = w;
            if (lane == 0) PSC[row] = ldexpf(1.0f, ex - 8);
        }
    }
    }
    xcd_barrier(xb);

    { PHASE_BEGIN
    {
        auto epi = [&](int r, int c, const f32x4& v0, const f32x4& v1) { store_bf16x8(QP + (size_t)r * 2048 + c, v0, v1); };
        big_gemm(smem, HN, WPQ, 16384, 2048, 1024, epi);
    }
    }
    xcd_barrier(xb);

    { PHASE_BEGIN
    {
        const int c = lane & 15, hg = lane >> 4;
        for (int task = bid * 8 + wave; task < 16384; task += nb * 8) {
            const int hp = task & 15, tgrp = task >> 4; const size_t bt0 = (size_t)tgrp * 16;
            bf16x8 qf[4];
#pragma unroll
            for (int ks = 0; ks < 4; ++ks) qf[ks] = *(const bf16x8*)(QP + (bt0 + c) * 2048 + hp * 128 + ks * 32 + 8 * hg);
            const bf16_t* Kp = SUBK + (size_t)hp * 16384 + lane * 8;
            float sc[32];
#pragma unroll
            for (int kt = 0; kt < 8; ++kt) {
                f32x4 a = {0.f, 0.f, 0.f, 0.f};
#pragma unroll
                for (int ks = 0; ks < 4; ++ks) a = __builtin_amdgcn_mfma_f32_16x16x32_bf16(*(const bf16x8*)(Kp + (kt * 4 + ks) * 512), qf[ks], a, 0, 0, 0);
                sc[kt * 4 + 0] = a[0]; sc[kt * 4 + 1] = a[1]; sc[kt * 4 + 2] = a[2]; sc[kt * 4 + 3] = a[3];
            }
            float* hsp = HS + (bt0 + c) * 256 + hp * 16; int* hip_ = HI + (bt0 + c) * 256 + hp * 16;
#pragma unroll 1
            for (int it = 0; it < 16; ++it) {
                float bv = sc[0]; int be = 0;
#pragma unroll
                for (int e = 1; e < 32; ++e) if (sc[e] > bv) { bv = sc[e]; be = e; }
                int key = (be >> 2) * 16 + 4 * hg + (be & 3);
#pragma unroll
                for (int o = 16; o < 64; o <<= 1) { const float ov = __shfl_xor(bv, o); const int ok = __shfl_xor(key, o);
                    const bool take = (ov > bv) || (ov == bv && ok < key); bv = take ? ov : bv; key = take ? ok : key; }
                if (hg == 0) { hsp[it] = bv; hip_[it] = key; }
                const int ew = (((key >> 2) & 3) == hg) ? ((key >> 4) * 4 + (key & 3)) : -1;
#pragma unroll
                for (int e = 0; e < 32; ++e) if (e == ew) sc[e] = -INFINITY;
            }
        }
    }
    }
    xcd_barrier(xb);

    { PHASE_BEGIN
    {
        int* exl = (int*)smem + wave * 256; float* gtl = (float*)(exl + 128);
        for (int tok = bid * 8 + wave; tok < 16384; tok += nb * 8) {
#pragma unroll 1
            for (int hh = 0; hh < 2; ++hh) {
                const int head = hh * 4 + (lane >> 4), i = lane & 15, gb = lane & 48;
                const float* s0p = HS + (size_t)tok * 256 + (2 * head) * 16;
                const float s0i = s0p[i], s1m = s0p[16 + i];
                int pj = 0; float myv = 0.f; int myf = 0;
#pragma unroll 1
                for (int it = 0; it < 16; ++it) {
                    const float s1v = __shfl(s1m, gb + (pj & 15));
                    float bv = pj < 16 ? s0i + s1v : -INFINITY; int bf = i * 16 + pj;
#pragma unroll
                    for (int o = 1; o < 16; o <<= 1) { const float ov = __shfl_xor(bv, o); const int of = __shfl_xor(bf, o);
                        const bool take = (ov > bv) || (ov == bv && of < bf); bv = take ? ov : bv; bf = take ? of : bf; }
                    if (i == it) { myv = bv; myf = bf; }
                    if ((bf >> 4) == i) ++pj;
                }
                const float vmax = __shfl(myv, gb);
                const float e = expf(myv - vmax);
                float se = e;
#pragma unroll
                for (int o = 1; o < 16; o <<= 1) se += __shfl_xor(se, o);
                const int* i0p = HI + (size_t)tok * 256 + (2 * head) * 16;
                exl[head * 16 + i] = i0p[myf >> 4] * 128 + i0p[16 + (myf & 15)];
                gtl[head * 16 + i] = e / se;
            }
            lds_fence();
            float xv[16];
            { float t0_[8], t1_[8]; load8(HN + (size_t)tok * 1024 + lane * 16, t0_); load8(HN + (size_t)tok * 1024 + lane * 16 + 8, t1_);
#pragma unroll
              for (int i = 0; i < 8; ++i) { xv[i] = t0_[i]; xv[8 + i] = t1_[i]; } }
#pragma unroll 1
            for (int e0 = 0; e0 < 128; e0 += 16) {
                uint4 ur[16];
#pragma unroll
                for (int q = 0; q < 16; ++q) ur[q] = *(const uint4*)(PU8 + (size_t)exl[e0 + q] * 1024 + lane * 16);
                float d[16];
#pragma unroll
                for (int q = 0; q < 16; ++q) {
                    const unsigned* wp = (const unsigned*)&ur[q]; float a = 0.f;
#pragma unroll
                    for (int i = 0; i < 4; ++i) { const auto lo = __builtin_amdgcn_cvt_pk_f32_fp8((int)wp[i], false); const auto hi = __builtin_amdgcn_cvt_pk_f32_fp8((int)wp[i], true);
                        a += lo[0] * xv[4 * i] + lo[1] * xv[4 * i + 1] + hi[0] * xv[4 * i + 2] + hi[1] * xv[4 * i + 3]; }
                    d[q] = a;
                }
                {
                    const bool u5 = lane & 32, u4 = lane & 16, u3 = lane & 8, u2 = lane & 4;
                    float e8[8], e4[4], e2[2], e1;
#pragma unroll
                    for (int q = 0; q < 8; ++q) { const float keep = u5 ? d[q + 8] : d[q], send = u5 ? d[q] : d[q + 8]; e8[q] = keep + __shfl_xor(send, 32); }
#pragma unroll
                    for (int q = 0; q < 4; ++q) { const float keep = u4 ? e8[q + 4] : e8[q], send = u4 ? e8[q] : e8[q + 4]; e4[q] = keep + __shfl_xor(send, 16); }
#pragma unroll
                    for (int q = 0; q < 2; ++q) { const float keep = u3 ? e4[q + 2] : e4[q], send = u3 ? e4[q] : e4[q + 2]; e2[q] = keep + __shfl_xor(send, 8); }
                    { const float keep = u2 ? e2[1] : e2[0], send = u2 ? e2[0] : e2[1]; e1 = keep + __shfl_xor(send, 4); }
                    e1 += __shfl_xor(e1, 2); e1 += __shfl_xor(e1, 1);
                    if ((lane & 3) == 0) { const int q = ((lane >> 5) & 1) * 8 + ((lane >> 4) & 1) * 4 + ((lane >> 3) & 1) * 2 + ((lane >> 2) & 1);
                        const int ex_ = exl[e0 + q];
                        gtl[e0 + q] = gtl[e0 + q] * gelu_f(e1 * PSC[ex_]) * PSC[16384 + ex_]; }
                }
            }
            lds_fence();
            float ac[16];
#pragma unroll
            for (int i = 0; i < 16; ++i) ac[i] = 0.f;
#pragma unroll 1
            for (int e0 = 0; e0 < 128; e0 += 16) {
                uint4 vr[16];
#pragma unroll
                for (int q = 0; q < 16; ++q) vr[q] = *(const uint4*)(PV8 + (size_t)exl[e0 + q] * 1024 + lane * 16);
#pragma unroll
                for (int q = 0; q < 16; ++q) { const float cf = gtl[e0 + q]; const unsigned* wp = (const unsigned*)&vr[q];
#pragma unroll
                    for (int i = 0; i < 4; ++i) { const auto lo = __builtin_amdgcn_cvt_pk_f32_fp8((int)wp[i], false); const auto hi = __builtin_amdgcn_cvt_pk_f32_fp8((int)wp[i], true);
                        ac[4 * i] += cf * lo[0]; ac[4 * i + 1] += cf * lo[1]; ac[4 * i + 2] += cf * hi[0]; ac[4 * i + 3] += cf * hi[1]; }
                }
            }
            float ss = 0.f;
            {
                float* hp = OUT + (size_t)tok * 1024 + lane * 16;
#pragma unroll
                for (int i = 0; i < 4; ++i) { const float4 hv = *(const float4*)(hp + 4 * i);
                    ac[4 * i] += hv.x; ac[4 * i + 1] += hv.y; ac[4 * i + 2] += hv.z; ac[4 * i + 3] += hv.w; }
#pragma unroll
                for (int i = 0; i < 16; ++i) ss += ac[i] * ac[i];
                ss = wave_sum(ss);
                const float rr = rsqrtf(ss * (1.0f / 1024.0f) + 1e-6f);
#pragma unroll
                for (int i = 0; i < 4; ++i) { const float4 gg = *(const float4*)(p.g_final + lane * 16 + 4 * i);
                    *(float4*)(hp + 4 * i) = make_float4(ac[4 * i] * rr * gg.x, ac[4 * i + 1] * rr * gg.y, ac[4 * i + 2] * rr * gg.z, ac[4 * i + 3] * rr * gg.w); }
            }
            lds_fence();
        }
    }
    }
}

extern "C" void kernel_launch(void* const* d_in, const int* in_sizes, int n_in, void* d_out, int out_size, void* d_ws, size_t ws_size, hipStream_t stream) {
    static int grid_blocks = 0;
    if (grid_blocks == 0) {
        int dev = 0, cus = 0, per_cu = 0;
        hipGetDevice(&dev);
        hipDeviceGetAttribute(&cus, hipDeviceAttributeMultiprocessorCount, dev);
        if (hipFuncSetAttribute((const void*)fwd_mega, hipFuncAttributeMaxDynamicSharedMemorySize, LDS_BYTES) != hipSuccess) { fprintf(stderr, "hipFuncSetAttribute failed\n"); }
        if (hipOccupancyMaxActiveBlocksPerMultiprocessor(&per_cu, (const void*)fwd_mega, NTHREADS, LDS_BYTES) != hipSuccess || per_cu < 1) { fprintf(stderr, "occupancy query failed (%d)\n", per_cu); per_cu = 1; }
        (void)hipGetLastError();
        if (per_cu > 1) per_cu = 1;
        grid_blocks = cus * per_cu;
        if (ws_size < O_END) { fprintf(stderr, "workspace too small: %zu < %zu\n", ws_size, (size_t)O_END); grid_blocks = -1; }
    }
    if (grid_blocks < 0) return;
    Params p{};
    const float** pp = (const float**)&p;
    for (int i = 0; i < 30; ++i) pp[i] = (const float*)d_in[i];
    p.out = (float*)d_out; p.ws = (unsigned char*)d_ws;
    if (hipMemsetAsync((char*)d_ws + O_BAR, 0, 16384, stream) != hipSuccess) { fprintf(stderr, "memset of barrier words failed\n"); return; }
    void* args[] = {&p};
    hipError_t e = hipLaunchCooperativeKernel((const void*)fwd_mega, dim3(grid_blocks), dim3(NTHREADS), args, LDS_BYTES, stream);
    if (e != hipSuccess) fprintf(stderr, "cooperative launch failed: %s (grid %d)\n", hipGetErrorString(e), grid_blocks);
}
```

```cpp
#include <hip/hip_runtime.h>
#include <cstdio>
#include <cstdint>

typedef unsigned short bf16_t;
typedef short bf16x8 __attribute__((ext_vector_type(8)));
typedef float f32x4 __attribute__((ext_vector_type(4)));
#define DEVI __device__ __forceinline__

__device__ __forceinline__ int tid_opaque() { int t = threadIdx.x; asm volatile("" : "+v"(t)); return t; }
constexpr int NTHREADS = 512;
constexpr int LDS_BYTES = 140 * 1024;

constexpr size_t O_BAR  = 0;
constexpr size_t O_WIN  = 16384;
constexpr size_t O_W1K  = O_WIN  + 4480ull * 1024 * 2;
constexpr size_t O_W1V  = O_W1K  + 256ull * 2048 * 2;
constexpr size_t O_WNSA = O_W1V  + 256ull * 2048 * 2;
constexpr size_t O_WGM  = O_WNSA + 1024ull * 512 * 2;
constexpr size_t O_WMIX = O_WGM  + 1024ull * 512 * 2;
constexpr size_t O_WXQ  = O_WMIX + 1024ull * 1024 * 2;
constexpr size_t O_WXKV = O_WXQ  + 1024ull * 1024 * 2;
constexpr size_t O_WXO  = O_WXKV + 2048ull * 1024 * 2;
constexpr size_t O_WPQ  = O_WXO  + 1024ull * 1024 * 2;
constexpr size_t O_B1   = O_WPQ  + 2048ull * 1024 * 2;
constexpr size_t O_VXT  = O_B1   + 2048;
constexpr size_t O_SUBK = O_VXT  + 8ull * 256 * 256 * 2;
constexpr size_t O_PSC  = O_SUBK + 16ull * 128 * 128 * 2;
constexpr size_t O_HN   = O_PSC  + 2ull * 16384 * 4;
constexpr size_t O_MN   = O_HN   + 16384ull * 1024 * 2;
constexpr size_t O_KVX  = O_MN   + 512ull * 1024 * 2;
constexpr size_t O_GATES= O_KVX  + 512ull * 2048 * 2;
constexpr size_t O_HID  = O_GATES+ 16384ull * 24 * 4;
constexpr size_t O_CMP  = O_HID  + 2ull * 2048 * 256 * 4;
constexpr size_t O_Q    = O_CMP  + 2ull * 4 * 512 * 64 * 4;
constexpr size_t O_KV6  = O_Q    + 16384ull * 512 * 2;
constexpr size_t O_U    = O_KV6  + 6ull * 16384 * 128 * 2;
constexpr size_t O_VG   = O_U    + 16384ull * 512 * 2;
constexpr size_t O_MG   = O_VG   + 16384ull * 512 * 2;
constexpr size_t O_ONSA = O_MG   + 16384ull * 2048 * 2;
constexpr size_t O_OGM  = O_ONSA + 16384ull * 512 * 2;
constexpr size_t O_Q8   = O_OGM  + 16384ull * 512 * 2;
constexpr size_t O_END  = O_Q8   + 16384ull * 512;
constexpr size_t O_Y    = O_Q;
constexpr size_t O_QX   = O_U;
constexpr size_t O_OX   = O_ONSA;
constexpr size_t O_QP   = O_MG;
constexpr size_t O_HS   = O_Q;
constexpr size_t O_HI   = O_Q + 16384ull * 256 * 4;
constexpr size_t O_EX   = O_U;
static_assert(O_END <= 256ull * 1024 * 1024, "workspace too large");

struct Params {
    const float *x, *mem, *g_mix, *w_in, *pe_k, *w1_k, *b1_k, *w2_k, *pe_v, *w1_v, *b1_v, *w2_v, *ln_g, *ln_b, *gws, *gbs,
        *w_nsa_out, *w_gmlp_out, *w_mix_out, *g_xattn, *g_mem, *w_xq, *w_xkv, *w_xo, *g_peer, *w_peer_q, *sub_keys, *peer_u, *peer_v, *g_final;
    float* out;
    unsigned char* ws;
};

DEVI bf16_t f2bf(float f) { unsigned u = __float_as_uint(f); u += 0x7fffu + ((u >> 16) & 1u); return (bf16_t)(u >> 16); }
DEVI float bf2f(bf16_t h) { return __uint_as_float(((unsigned)h) << 16); }
DEVI float tof(float v) { return v; }
DEVI float tof(bf16_t v) { return bf2f(v); }
DEVI float wave_sum(float v) { for (int o = 32; o > 0; o >>= 1) v += __shfl_xor(v, o); return v; }
DEVI float wave_max(float v) { for (int o = 32; o > 0; o >>= 1) v = fmaxf(v, __shfl_xor(v, o)); return v; }
DEVI float gelu_f(float x) { return 0.5f * x * (1.0f + erff(x * 0.70710678118654752f)); }
DEVI float sigmoid_f(float x) { return 1.0f / (1.0f + expf(-x)); }
DEVI void wave_argmax(float& v, int& idx) {
    for (int o = 32; o > 0; o >>= 1) {
        const float ov = __shfl_xor(v, o); const int oi = __shfl_xor(idx, o);
        const bool take = (ov > v) || (ov == v && oi < idx);
        v = take ? ov : v; idx = take ? oi : idx;
    }
}
typedef unsigned u32x4 __attribute__((ext_vector_type(4)));
DEVI unsigned cvt_pk_bf16(float lo, float hi) { unsigned r; asm("v_cvt_pk_bf16_f32 %0, %1, %2" : "=v"(r) : "v"(lo), "v"(hi)); return r; }
DEVI bf16x8 pack8(const float (&p)[8]) { u32x4 u; u.x = cvt_pk_bf16(p[0], p[1]); u.y = cvt_pk_bf16(p[2], p[3]); u.z = cvt_pk_bf16(p[4], p[5]); u.w = cvt_pk_bf16(p[6], p[7]); return __builtin_bit_cast(bf16x8, u); }
DEVI void lds_fence() { asm volatile("s_waitcnt lgkmcnt(0)" ::: "memory"); }
DEVI void load8(const float* p, float (&f)[8]) { const float4 a = *(const float4*)p, b = *(const float4*)(p + 4); f[0]=a.x; f[1]=a.y; f[2]=a.z; f[3]=a.w; f[4]=b.x; f[5]=b.y; f[6]=b.z; f[7]=b.w; }
DEVI void load8(const bf16_t* p, float (&f)[8]) { const uint4 a = *(const uint4*)p;
    f[0] = __uint_as_float(a.x << 16); f[1] = __uint_as_float(a.x & 0xffff0000u); f[2] = __uint_as_float(a.y << 16); f[3] = __uint_as_float(a.y & 0xffff0000u);
    f[4] = __uint_as_float(a.z << 16); f[5] = __uint_as_float(a.z & 0xffff0000u); f[6] = __uint_as_float(a.w << 16); f[7] = __uint_as_float(a.w & 0xffff0000u); }

template <class CMap>
DEVI void transpose_tile(const float* src, int srcN, bf16_t* dst, int K, int tl, CMap cmap, float* tile) {
    const int nkt = K / 64, kt = tl % nkt, nt = tl / nkt, k0 = kt * 64, n0 = nt * 64;
    const int tidq = tid_opaque(), tx = tidq & 63, ty = tidq >> 6;
    const int sc = cmap(n0 + tx);
#pragma unroll
    for (int i = 0; i < 8; ++i) { const int k = k0 + ty + 8 * i; tile[(ty + 8 * i) * 65 + tx] = sc >= 0 ? src[(size_t)k * srcN + sc] : 0.f; }
    __syncthreads();
#pragma unroll
    for (int i = 0; i < 8; ++i) { const int n = n0 + ty + 8 * i; dst[(size_t)n * K + k0 + tx] = f2bf(tile[tx * 65 + ty + 8 * i]); }
    __syncthreads();
}
struct IdMap { DEVI int operator()(int n) const { return n; } };
struct WinMap { DEVI int operator()(int n) const { return n < 1280 ? n : (n < 4352 ? n + 24 : (n < 4376 ? n - 4352 + 1280 : -1)); } };

DEVI void rmsnorm_row_bf16(const float* xrow, const float* g, bf16_t* dst, int lane) {
    float4 v[4]; float ss = 0.f;
#pragma unroll
    for (int i = 0; i < 4; ++i) { v[i] = ((const float4*)xrow)[lane + 64 * i]; ss += v[i].x * v[i].x + v[i].y * v[i].y + v[i].z * v[i].z + v[i].w * v[i].w; }
    ss = wave_sum(ss);
    const float r = rsqrtf(ss * (1.0f / 1024.0f) + 1e-6f);
#pragma unroll
    for (int i = 0; i < 4; ++i) {
        const float4 gg = ((const float4*)g)[lane + 64 * i];
        uint2 w; w.x = (unsigned)f2bf(v[i].x * r * gg.x) | ((unsigned)f2bf(v[i].y * r * gg.y) << 16); w.y = (unsigned)f2bf(v[i].z * r * gg.z) | ((unsigned)f2bf(v[i].w * r * gg.w) << 16);
        ((uint2*)dst)[lane + 64 * i] = w;
    }
}

constexpr int G_LD = 72;
template <class AF>
DEVI void gemm_tile(f32x4 (&acc)[4][2], AF af, int m0, const bf16_t* Bt, int ldb, int K, bf16_t* As, bf16_t* Bs) {
    const int tid = tid_opaque(), lane = tid & 63, wave = tid >> 6, wm = wave >> 2, wn = wave & 3;
    const int r0 = tid >> 3, kc = (tid & 7) * 8;
    uint4 ra0, ra1, rb0, rb1;
    ra0 = *(const uint4*)af(m0 + r0, kc); ra1 = *(const uint4*)af(m0 + r0 + 64, kc);
    rb0 = *(const uint4*)(Bt + (size_t)r0 * ldb + kc); rb1 = *(const uint4*)(Bt + (size_t)(r0 + 64) * ldb + kc);
    for (int k0 = 0; k0 < K; k0 += 64) {
        __syncthreads();
        *(uint4*)(As + r0 * G_LD + kc) = ra0; *(uint4*)(As + (r0 + 64) * G_LD + kc) = ra1;
        *(uint4*)(Bs + r0 * G_LD + kc) = rb0; *(uint4*)(Bs + (r0 + 64) * G_LD + kc) = rb1;
        __syncthreads();
        if (k0 + 64 < K) {
            const int kn = k0 + 64 + kc;
            ra0 = *(const uint4*)af(m0 + r0, kn); ra1 = *(const uint4*)af(m0 + r0 + 64, kn);
            rb0 = *(const uint4*)(Bt + (size_t)r0 * ldb + kn); rb1 = *(const uint4*)(Bt + (size_t)(r0 + 64) * ldb + kn);
        }
#pragma unroll
        for (int ks = 0; ks < 2; ++ks) {
            bf16x8 af_[4], bf_[2];
#pragma unroll
            for (int i = 0; i < 4; ++i) af_[i] = *(const bf16x8*)(As + (wm * 64 + i * 16 + (lane & 15)) * G_LD + ks * 32 + (lane >> 4) * 8);
#pragma unroll
            for (int j = 0; j < 2; ++j) bf_[j] = *(const bf16x8*)(Bs + (wn * 32 + j * 16 + (lane & 15)) * G_LD + ks * 32 + (lane >> 4) * 8);
#pragma unroll
            for (int i = 0; i < 4; ++i)
#pragma unroll
                for (int j = 0; j < 2; ++j) acc[i][j] = __builtin_amdgcn_mfma_f32_16x16x32_bf16(bf_[j], af_[i], acc[i][j], 0, 0, 0);
        }
    }
}
struct RowMajorA { const bf16_t* A; int lda; DEVI const bf16_t* operator()(int row, int k) const { return A + (size_t)row * lda + k; } };
struct CmpA { const bf16_t* KC; int koff;
    DEVI const bf16_t* operator()(int row, int k_) const { const int k = k_ + koff; const int rr = row < 2044 ? row : 2043; const int b = rr / 1022, rem = rr - b * 1022, c = rem >> 1, g = rem & 1;
        return KC + ((size_t)(b * 8192 + 16 * c + (k >> 6)) * 128 + g * 64 + (k & 63)); } };

template <class AF, class Epi>
DEVI void gemm_run(AF af, const bf16_t* Bt, int K, int MT, int NT, Epi epi, unsigned char* smem, int bid, int nb) {
    bf16_t* As = (bf16_t*)smem; bf16_t* Bs = As + 128 * G_LD;
    const int tidq = tid_opaque(), lane = tidq & 63, wave = tidq >> 6, wm = wave >> 2, wn = wave & 3;
    for (int t = bid; t < MT * NT; t += nb) {
        const int mt = t / NT, nt = t % NT;
        f32x4 acc[4][2];
#pragma unroll
        for (int i = 0; i < 4; ++i)
#pragma unroll
            for (int j = 0; j < 2; ++j) acc[i][j] = (f32x4){0.f, 0.f, 0.f, 0.f};
        gemm_tile(acc, af, mt * 128, Bt + (size_t)nt * 128 * K, K, K, As, Bs);
#pragma unroll
        for (int i = 0; i < 4; ++i)
#pragma unroll
            for (int j = 0; j < 2; ++j) epi(mt * 128 + wm * 64 + i * 16 + (lane & 15), nt * 128 + wn * 32 + j * 16 + (lane >> 4) * 4, acc[i][j]);
    }
}
DEVI void store_bf16x4(bf16_t* p, float a, float b, float c, float d) { uint2 w; w.x = (unsigned)f2bf(a) | ((unsigned)f2bf(b) << 16); w.y = (unsigned)f2bf(c) | ((unsigned)f2bf(d) << 16); *(uint2*)p = w; }

namespace pg8 {
#define PG8_LAS __attribute__((address_space(3)))
typedef unsigned short bf16_t;
typedef short bf16x8 __attribute__((ext_vector_type(8)));
typedef float f32x4 __attribute__((ext_vector_type(4)));
typedef unsigned u32x4 __attribute__((ext_vector_type(4)));
constexpr int BM = 256, BK = 64, HALF = 128, HTB = HALF * BK * 2  , STAGE_BYTES = 8 * HTB, NXCD = 8, WGM = 8;

__host__ __device__ __forceinline__ int lds_byte(int r, int c) { const int st = (r >> 4) * 2 + (c >> 5), rr = r & 15, cc = c & 31, ob = rr * 64 + cc * 2; return st * 1024 + (ob ^ (((ob >> 9) & 1) << 5)); }
__host__ __device__ __forceinline__ void stage_rc(int b, int& R, int& C) { const int st = b / 1024, sb = b % 1024, swz = sb ^ (((sb >> 9) & 1) << 5); R = (st >> 1) * 16 + swz / 64; C = (st & 1) * 32 + (swz % 64) / 2; }
__host__ __device__ __forceinline__ int perm32(int rho) { const int n = rho >> 4, i = rho & 15; return 8 * (i >> 2) + 4 * n + (i & 3); }

struct Unit { int pm, pn; };
struct Gemm { const bf16_t* A; const bf16_t* Bt; int M, N, K; };

struct StaticOrder {
    int nM, nN, nwg, G, c;
    __host__ __device__ void init(int M, int N, int G_, int c_) { nM = M / BM; nN = N / BM; nwg = nM * nN; G = G_; c = c_; }
    __host__ __device__ bool next(int i, Unit& u) const {
        const long L = (long)i * G + c; if (L >= nwg) return false;
        int wgid = (int)L; { const int q = nwg / NXCD, r = nwg % NXCD, xcd = wgid % NXCD, off = wgid / NXCD; wgid = (xcd < r ? xcd * (q + 1) : r * (q + 1) + (xcd - r) * q) + off; }
        const int nig = WGM * nN, gid = wgid / nig, fm = gid * WGM, gsz = (nM - fm) < WGM ? (nM - fm) : WGM;
        u.pm = fm + ((wgid % nig) % gsz); u.pn = (wgid % nig) / gsz; return true;
    }
    __device__ __forceinline__ void a_ready(const Unit&) const {}
    __device__ __forceinline__ void done(const Unit&) const {}
};

template <class Epi, class Sched, bool ALIGN_EPI = false, bool SP2 = false>
__device__ __forceinline__ void gemm_phase(PG8_LAS unsigned char* lds, const Gemm g, const Sched& S, const Epi& E) {
    const int tid = tid_opaque(), wid = __builtin_amdgcn_readfirstlane(tid >> 6), lane = tid & 63, wr = wid >> 2, wc = wid & 3, fr = lane & 15, fq = lane >> 4;
    const int K = g.K, nt = K / BK;
    unsigned voffA[2], voffB[2];
#pragma unroll
    for (int i = 0; i < 2; ++i) { int R, C; stage_rc(tid * 16 + i * 8192, R, C); const int Rb = Epi::PERM ? ((R & ~31) + perm32(R & 31)) : R;
        voffA[i] = (unsigned)(R * K + C) * 2u; voffB[i] = (unsigned)(Rb * K + C) * 2u; }
    const size_t kstep = (size_t)(BK * 2);
    const size_t hstep = (size_t)HALF * K * 2;
    const size_t tstep = 2 * hstep;
    const unsigned ldsw = (unsigned)wid * 1024u;
    const int aoff = lds_byte(wr * 64 + fr, fq * 8), boff = lds_byte(wc * 32 + fr, fq * 8);
#define PG8_SA(b, h) (((b) * 2 + (h)) * HTB)
#define PG8_SB(b, h) ((4 + (b) * 2 + (h)) * HTB)
#define PG8_STAGE(bufoff, gbase, voff) do { _Pragma("unroll") for (int _i = 0; _i < 2; ++_i) \
        __builtin_amdgcn_global_load_lds((const unsigned*)((const char*)(gbase) + (voff)[_i]), (PG8_LAS unsigned*)(lds + (bufoff) + ldsw + _i * 8192), 16, 0, 0); } while (0)
#define PG8_LDA(dst, b, h) do { _Pragma("unroll") for (int m = 0; m < 4; ++m) _Pragma("unroll") for (int k = 0; k < 2; ++k) dst[m][k] = *(const PG8_LAS bf16x8*)(lds + PG8_SA(b, h) + aoff + m * 2048 + k * 1024); } while (0)
#define PG8_LDB(dst, b, h) do { _Pragma("unroll") for (int n = 0; n < 2; ++n) _Pragma("unroll") for (int k = 0; k < 2; ++k) dst[n][k] = *(const PG8_LAS bf16x8*)(lds + PG8_SB(b, h) + boff + n * 2048 + k * 1024); } while (0)
#define PG8_MMA(ai, bj, At, Bt) do { __builtin_amdgcn_s_setprio(1); _Pragma("unroll") for (int m = 0; m < 4; ++m) _Pragma("unroll") for (int n = 0; n < 2; ++n) _Pragma("unroll") for (int k = 0; k < 2; ++k) \
        acc[ai][bj][m][n] = __builtin_amdgcn_mfma_f32_16x16x32_bf16(Bt[n][k], At[m][k], acc[ai][bj][m][n], 0, 0, 0); __builtin_amdgcn_s_setprio(0); } while (0)
#define PG8_WAIT_V(n) asm volatile("s_waitcnt vmcnt(" #n ")" ::: "memory")
#define PG8_WAIT_L(n) asm volatile("s_waitcnt lgkmcnt(" #n ")" ::: "memory")
#define PG8_BAR __builtin_amdgcn_s_barrier()
#define PG8_SCHED __builtin_amdgcn_sched_barrier(0)
    Unit cur, nxt; int ui = 0;
    if (!S.next(0, cur)) return;
    f32x4 acc[2][2][4][2];
#pragma unroll
    for (int a = 0; a < 2; ++a)
#pragma unroll
        for (int b = 0; b < 2; ++b)
#pragma unroll
            for (int m = 0; m < 4; ++m)
#pragma unroll
                for (int n = 0; n < 2; ++n) acc[a][b][m][n] = (f32x4){0.f, 0.f, 0.f, 0.f};
    bf16x8 At[4][2], B0[2][2], B1[2][2];
    const char* cA = (const char*)g.A + (size_t)cur.pm * tstep; const char* cB = (const char*)g.Bt + (size_t)cur.pn * tstep;
    S.a_ready(cur);
    if constexpr (SP2) {
        PG8_STAGE(PG8_SB(0, 0), cB, voffB); PG8_STAGE(PG8_SB(0, 1), cB + hstep, voffB); PG8_STAGE(PG8_SA(0, 0), cA, voffA); PG8_STAGE(PG8_SA(0, 1), cA + hstep, voffA);
        if (wr == 1) PG8_BAR;
        PG8_WAIT_V(2); PG8_BAR;
        PG8_STAGE(PG8_SB(1, 0), cB + kstep, voffB); PG8_STAGE(PG8_SA(1, 0), cA + kstep, voffA); PG8_STAGE(PG8_SB(1, 1), cB + hstep + kstep, voffB);
        PG8_WAIT_V(6); PG8_BAR;
    } else {
        PG8_STAGE(PG8_SB(0, 0), cB, voffB); PG8_STAGE(PG8_SA(0, 0), cA, voffA); PG8_STAGE(PG8_SB(0, 1), cB + hstep, voffB); PG8_STAGE(PG8_SA(0, 1), cA + hstep, voffA);
        if (wr == 1) PG8_BAR;
        PG8_WAIT_V(4); PG8_BAR;
        PG8_STAGE(PG8_SB(1, 0), cB + kstep, voffB); PG8_STAGE(PG8_SA(1, 0), cA + kstep, voffA); PG8_STAGE(PG8_SB(1, 1), cB + hstep + kstep, voffB);
        PG8_WAIT_V(6); PG8_BAR;
    }
    for (;;) {
        const bool has_next = S.next(ui + 1, nxt);
        const char* nA = has_next ? (const char*)g.A + (size_t)nxt.pm * tstep : cA; const char* nB = has_next ? (const char*)g.Bt + (size_t)nxt.pn * tstep : cB;
        for (int t = 0; t < nt; t += 2) {
            const bool last = (t == nt - 2);
            const char* a1 = cA + (size_t)(t + 1) * kstep;
            const char* a2 = last ? nA : cA + (size_t)(t + 2) * kstep; const char* b2 = last ? nB : cB + (size_t)(t + 2) * kstep;
            const char* a3 = a2 + kstep; const char* b3 = b2 + kstep;
            if (last && has_next) S.a_ready(nxt);
            if constexpr (SP2) {
            PG8_LDB(B0, 0, 0); PG8_LDB(B1, 0, 1); PG8_SCHED; PG8_LDA(At, 0, 0); PG8_STAGE(PG8_SA(1, 1), a1 + hstep, voffA);
            PG8_WAIT_V(8); PG8_WAIT_L(0); PG8_BAR; PG8_MMA(0, 0, At, B0); PG8_MMA(0, 1, At, B1); PG8_BAR; PG8_SCHED;
            PG8_LDA(At, 0, 1); PG8_STAGE(PG8_SB(0, 0), b2, voffB); PG8_STAGE(PG8_SB(0, 1), b2 + hstep, voffB); PG8_STAGE(PG8_SA(0, 0), a2, voffA);
            PG8_WAIT_V(8); PG8_WAIT_L(0); PG8_BAR; PG8_MMA(1, 0, At, B0); PG8_MMA(1, 1, At, B1); PG8_BAR; PG8_SCHED;
            PG8_LDB(B0, 1, 0); PG8_LDB(B1, 1, 1); PG8_SCHED; PG8_LDA(At, 1, 0); PG8_STAGE(PG8_SA(0, 1), a2 + hstep, voffA);
            PG8_WAIT_V(8); PG8_WAIT_L(0); PG8_BAR; PG8_MMA(0, 0, At, B0); PG8_MMA(0, 1, At, B1); PG8_BAR; PG8_SCHED;
            PG8_LDA(At, 1, 1); PG8_STAGE(PG8_SB(1, 0), b3, voffB); PG8_STAGE(PG8_SB(1, 1), b3 + hstep, voffB); PG8_STAGE(PG8_SA(1, 0), a3, voffA);
            PG8_WAIT_V(8); PG8_WAIT_L(0); PG8_BAR; PG8_MMA(1, 0, At, B0); PG8_MMA(1, 1, At, B1); PG8_BAR; PG8_SCHED;
            } else {
            PG8_LDB(B0, 0, 0); PG8_SCHED; PG8_LDA(At, 0, 0); PG8_STAGE(PG8_SA(1, 1), a1 + hstep, voffA);
            PG8_WAIT_L(8); PG8_BAR; PG8_WAIT_L(0); PG8_MMA(0, 0, At, B0); PG8_BAR; PG8_SCHED;
            PG8_LDB(B1, 0, 1); PG8_STAGE(PG8_SB(0, 0), b2, voffB);
            PG8_BAR; PG8_WAIT_L(0); PG8_MMA(0, 1, At, B1); PG8_BAR;
            PG8_LDA(At, 0, 1); PG8_STAGE(PG8_SA(0, 0), a2, voffA);
            PG8_BAR; PG8_WAIT_L(0); PG8_MMA(1, 0, At, B0); PG8_BAR; PG8_SCHED;
            PG8_STAGE(PG8_SB(0, 1), b2 + hstep, voffB);
            PG8_WAIT_V(6); PG8_BAR; PG8_MMA(1, 1, At, B1); PG8_BAR;
            PG8_LDB(B0, 1, 0); PG8_SCHED; PG8_LDA(At, 1, 0); PG8_STAGE(PG8_SA(0, 1), a2 + hstep, voffA);
            PG8_WAIT_L(8); PG8_BAR; PG8_WAIT_L(0); PG8_MMA(0, 0, At, B0); PG8_BAR; PG8_SCHED;
            PG8_LDB(B1, 1, 1); PG8_STAGE(PG8_SB(1, 0), b3, voffB);
            PG8_BAR; PG8_WAIT_L(0); PG8_MMA(0, 1, At, B1); PG8_BAR;
            PG8_LDA(At, 1, 1); PG8_STAGE(PG8_SA(1, 0), a3, voffA);
            PG8_BAR; PG8_WAIT_L(0); PG8_MMA(1, 0, At, B0); PG8_BAR; PG8_SCHED;
            PG8_STAGE(PG8_SB(1, 1), b3 + hstep, voffB);
            PG8_WAIT_V(6); PG8_BAR; PG8_MMA(1, 1, At, B1); PG8_BAR;
            }
        }
        if constexpr (ALIGN_EPI) { if (wr == 0) PG8_BAR; }
        if constexpr (!Epi::AFTER_DRAIN) { E(acc, cur, wr, wc, fr, fq); S.done(cur); }
        if (!has_next) break;
#pragma unroll
        for (int a = 0; a < 2; ++a)
#pragma unroll
            for (int b = 0; b < 2; ++b)
#pragma unroll
                for (int m = 0; m < 4; ++m)
#pragma unroll
                    for (int n = 0; n < 2; ++n) acc[a][b][m][n] = (f32x4){0.f, 0.f, 0.f, 0.f};
        cur = nxt; cA = nA; cB = nB; ++ui;
        if constexpr (ALIGN_EPI) { if (wr == 1) PG8_BAR; }
    }
    PG8_WAIT_V(0);
    if constexpr (!ALIGN_EPI) { if (wr == 0) PG8_BAR; }
    PG8_BAR;
    if constexpr (Epi::AFTER_DRAIN) { E.fused(acc, cur, wr, wc, fr, fq, lds, wid, lane); S.done(cur); }
#undef PG8_SA
#undef PG8_SB
#undef PG8_STAGE
#undef PG8_LDA
#undef PG8_LDB
#undef PG8_MMA
#undef PG8_WAIT_V
#undef PG8_WAIT_L
#undef PG8_BAR
#undef PG8_SCHED
}
}

template <class F> struct EpiFn {
    static constexpr bool PERM = true, AFTER_DRAIN = false;
    F f;
    DEVI void operator()(const f32x4 (&acc)[2][2][4][2], const pg8::Unit& u, int wr, int wc, int fr, int fq) const {
#pragma unroll
        for (int ai = 0; ai < 2; ++ai)
#pragma unroll
            for (int m = 0; m < 4; ++m) {
                const int row = u.pm * 256 + ai * 128 + wr * 64 + m * 16 + fr;
#pragma unroll
                for (int bj = 0; bj < 2; ++bj) { f(row, u.pn * 256 + bj * 128 + wc * 32 + 8 * fq, acc[ai][bj][m][0], acc[ai][bj][m][1]); __builtin_amdgcn_sched_barrier(0); }
            }
    }
};
template <class F> DEVI EpiFn<F> make_epi(F f) { return EpiFn<F>{f}; }
template <class F>
DEVI void big_gemm(unsigned char* smem, const bf16_t* A, const bf16_t* Bt, int M, int N, int K, F f) {
    pg8::StaticOrder S; S.init(M, N, (int)gridDim.x, (int)blockIdx.x);
    const pg8::Gemm g{A, Bt, M, N, K};
    const auto E = make_epi(f);
    pg8::gemm_phase<EpiFn<F>, pg8::StaticOrder, true, true>((PG8_LAS unsigned char*)smem, g, S, E);
}
DEVI void store_bf16x8(bf16_t* p, const f32x4& a, const f32x4& b) { u32x4 w; w.x = cvt_pk_bf16(a[0], a[1]); w.y = cvt_pk_bf16(a[2], a[3]); w.z = cvt_pk_bf16(b[0], b[1]); w.w = cvt_pk_bf16(b[2], b[3]); *(u32x4*)p = w; }

template <int DH, int R, int NCH, bool PSUM, typename KT, class RowF>
DEVI void attend(const float* qs, float* pl, float* psum, const KT* Kb, const KT* Vb, size_t stride, RowF rowf, float (&o)[R][DH / 64], int lane) {
    float m[R], l[R];
#pragma unroll
    for (int r = 0; r < R; ++r) { m[r] = -1e30f; l[r] = 0.f; }
#pragma unroll 1
    for (int i = 0; i < NCH; ++i) {
        bool valid; const long row = rowf(i, lane, valid);
        if (__ballot(valid) == 0ull) continue;
        const KT* kp = Kb + (size_t)row * stride;
        float a[R];
#pragma unroll
        for (int r = 0; r < R; ++r) a[r] = 0.f;
#pragma unroll 2
        for (int d0 = 0; d0 < DH; d0 += 8) {
            float kf[8]; load8(kp + d0, kf);
#pragma unroll
            for (int r = 0; r < R; ++r) {
                const float4 q0 = *(const float4*)(qs + r * DH + d0), q1 = *(const float4*)(qs + r * DH + d0 + 4);
                a[r] += kf[0] * q0.x + kf[1] * q0.y + kf[2] * q0.z + kf[3] * q0.w + kf[4] * q1.x + kf[5] * q1.y + kf[6] * q1.z + kf[7] * q1.w;
            }
        }
#pragma unroll
        for (int r = 0; r < R; ++r) {
            const float sv = valid ? a[r] : -1e30f;
            const float mn = fmaxf(m[r], wave_max(sv));
            const float pe = valid ? expf(sv - mn) : 0.f;
            l[r] = l[r] * expf(m[r] - mn) + wave_sum(pe);
            m[r] = mn;
        }
    }
    float inv[R];
#pragma unroll
    for (int r = 0; r < R; ++r) inv[r] = 1.0f / fmaxf(l[r], 1e-30f);
#pragma unroll 1
    for (int i = 0; i < NCH; ++i) {
        bool valid; const long row = rowf(i, lane, valid);
        const bool any = __ballot(valid) != 0ull;
        float a[R];
#pragma unroll
        for (int r = 0; r < R; ++r) a[r] = 0.f;
        if (any) {
            const KT* kp = Kb + (size_t)row * stride;
#pragma unroll 2
            for (int d0 = 0; d0 < DH; d0 += 8) {
                float kf[8]; load8(kp + d0, kf);
#pragma unroll
                for (int r = 0; r < R; ++r) {
                    const float4 q0 = *(const float4*)(qs + r * DH + d0), q1 = *(const float4*)(qs + r * DH + d0 + 4);
                    a[r] += kf[0] * q0.x + kf[1] * q0.y + kf[2] * q0.z + kf[3] * q0.w + kf[4] * q1.x + kf[5] * q1.y + kf[6] * q1.z + kf[7] * q1.w;
                }
            }
        }
        float ps = 0.f;
#pragma unroll
        for (int r = 0; r < R; ++r) { const float pv = valid ? expf(a[r] - m[r]) * inv[r] : 0.f; pl[r * 64 + lane] = pv; ps += pv; }
        if (PSUM) psum[i * 64 + lane] = ps;
        lds_fence();
        if (any) {
#pragma unroll 2
            for (int key = 0; key < 64; ++key) {
                bool dummy; const long vrow = rowf(i, key, dummy);
                const KT* vp = Vb + (size_t)vrow * stride;
                float pr[R];
#pragma unroll
                for (int r = 0; r < R; ++r) pr[r] = pl[r * 64 + key];
#pragma unroll
                for (int j = 0; j < DH / 64; ++j) { const float v = tof(vp[lane + 64 * j]);
#pragma unroll
                    for (int r = 0; r < R; ++r) o[r][j] += pr[r] * v; }
            }
        }
        lds_fence();
    }
}


DEVI int nsa_koff(int t, int d) { return ((((t >> 5) * 4 + (((t >> 2) & 1) * 2 + (d >> 5))) * 64) + ((((t & 31) >> 3) << 2) | (t & 3)) + 16 * ((d >> 3) & 3)) * 8 + (d & 7); }
DEVI int nsa_voff(int t, int d) { return ((((t >> 5) * 4 + (d >> 4)) * 64) + (d & 15) + 16 * ((t & 31) >> 3)) * 8 + (t & 7); }
DEVI int xat_koff(int m, int d) { return ((((m >> 5) * 16 + ((m >> 2) & 1) * 8 + (d >> 5)) * 64) + ((((m & 31) >> 3) << 2) | (m & 3)) + 16 * ((d >> 3) & 3)) * 8 + (d & 7); }
DEVI int xat_voff(int m, int d) { return ((((m >> 5) * 16 + (d >> 4)) * 64) + (d & 15) + 16 * ((m & 31) >> 3)) * 8 + (m & 7); }
DEVI int pk_koff(int k, int d) { return ((((k >> 4) * 4 + (d >> 5)) * 64) + (k & 15) + 16 * ((d >> 3) & 3)) * 8 + (d & 7); }
DEVI int nsa_koff8(int t, int d) { return ((((t >> 5) * 2 + ((t >> 2) & 1)) * 64) + ((((t & 31) >> 3) << 2) | (t & 3)) + 16 * ((d >> 3) & 3)) * 16 + (d >> 5) * 8 + (d & 7); }
DEVI int nsa_voff8(int t, int d) { return ((((t >> 5) * 2 + (d >> 5)) * 64) + (d & 15) + 16 * ((t & 31) >> 3)) * 16 + ((d >> 4) & 1) * 8 + (t & 7); }
DEVI void nsa_load_kf(bf16x8 (&ka)[4], const bf16_t* Kp, int ch, int lane) {
#pragma unroll
    for (int f = 0; f < 4; ++f) ka[f] = *(const bf16x8*)(Kp + ((ch * 4 + f) * 64 + lane) * 8);
}
DEVI void nsa_load_k(bf16x8 (&ka)[4], const bf16_t* Kp, int stride, int kb, int rk, int dh) {
    const int o0 = (kb + rk) * stride + dh, o1 = o0 + 4 * stride;
    ka[0] = *(const bf16x8*)(Kp + o0); ka[1] = *(const bf16x8*)(Kp + o0 + 32); ka[2] = *(const bf16x8*)(Kp + o1); ka[3] = *(const bf16x8*)(Kp + o1 + 32);
}
DEVI void nsa_load_v(bf16x8 (&va)[4], const bf16_t* Vp, int vstride, int kb8, int lr) {
    const int o = lr * vstride + kb8;
#pragma unroll
    for (int dt = 0; dt < 4; ++dt) va[dt] = *(const bf16x8*)(Vp + o + dt * 16 * vstride);
}
DEVI void nsa_load_vb(bf16x8 (&va)[4], const bf16_t* Vp, int kb8, int lr) {
    const int o = ((kb8 >> 6) * 64 + lr) * 64 + (kb8 & 63);
#pragma unroll
    for (int dt = 0; dt < 4; ++dt) va[dt] = *(const bf16x8*)(Vp + o + dt * 16 * 64);
}
DEVI void nsa_scores(const bf16x8 (&ka)[4], const bf16x8 (&qf)[2], float (&sv)[8]) {
    f32x4 s0 = {0.f, 0.f, 0.f, 0.f}, s1 = {0.f, 0.f, 0.f, 0.f};
    s0 = __builtin_amdgcn_mfma_f32_16x16x32_bf16(ka[0], qf[0], s0, 0, 0, 0); s1 = __builtin_amdgcn_mfma_f32_16x16x32_bf16(ka[2], qf[0], s1, 0, 0, 0);
    s0 = __builtin_amdgcn_mfma_f32_16x16x32_bf16(ka[1], qf[1], s0, 0, 0, 0); s1 = __builtin_amdgcn_mfma_f32_16x16x32_bf16(ka[3], qf[1], s1, 0, 0, 0);
    sv[0] = s0[0]; sv[1] = s0[1]; sv[2] = s0[2]; sv[3] = s0[3]; sv[4] = s1[0]; sv[5] = s1[1]; sv[6] = s1[2]; sv[7] = s1[3];
}
DEVI unsigned long long pack8_fp8(const float (&p)[8]) {
    int lo = 0, hi = 0;
    lo = __builtin_amdgcn_cvt_pk_fp8_f32(p[0], p[1], lo, false); lo = __builtin_amdgcn_cvt_pk_fp8_f32(p[2], p[3], lo, true);
    hi = __builtin_amdgcn_cvt_pk_fp8_f32(p[4], p[5], hi, false); hi = __builtin_amdgcn_cvt_pk_fp8_f32(p[6], p[7], hi, true);
    return ((unsigned long long)(unsigned)hi << 32) | (unsigned)lo;
}
struct NsaSt { float m, l; f32x4 o[4]; };
struct NsaBuf8 { long ka[4]; long va[4]; int e; };
DEVI void nsa_load8(long (&f)[4], const unsigned char* P, int ch, int lane) {
#pragma unroll
    for (int i = 0; i < 2; ++i) { const uint4 w = *(const uint4*)(P + ((ch * 2 + i) * 64 + lane) * 16);
        f[2 * i] = (long)(((unsigned long long)w.y << 32) | w.x); f[2 * i + 1] = (long)(((unsigned long long)w.w << 32) | w.z); }
}
struct NsaSt8 { float m, l; bool set; f32x4 negm; f32x4 o[4]; };
DEVI void nsa_init8(NsaSt8& st) { st.m = 0.f; st.l = 0.f; st.set = false; st.negm = (f32x4){7.f, 7.f, 7.f, 7.f};
#pragma unroll
    for (int dt = 0; dt < 4; ++dt) st.o[dt] = (f32x4){0.f, 0.f, 0.f, 0.f}; }

struct NsaBuf { bf16x8 ka[4]; bf16x8 va[4]; };
DEVI void nsa_init(NsaSt& st) { st.m = -1e20f; st.l = 0.f;
#pragma unroll
    for (int dt = 0; dt < 4; ++dt) st.o[dt] = (f32x4){0.f, 0.f, 0.f, 0.f}; }
template <bool PV>
DEVI void nsa_chunk(NsaSt& st, float (&sv)[8], int pos0, int lo, int hi, const bf16x8 (&va)[4]) {
    float cm = -1e30f;
#pragma unroll
    for (int j = 0; j < 8; ++j) { const bool ok = (pos0 + j >= lo) && (pos0 + j <= hi); sv[j] = ok ? sv[j] : -1e30f; cm = fmaxf(cm, sv[j]); }
    cm = fmaxf(cm, __shfl_xor(cm, 16)); cm = fmaxf(cm, __shfl_xor(cm, 32));
    if (__any(cm > st.m)) {
        const float mn = fmaxf(st.m, cm), sc = __builtin_amdgcn_exp2f(st.m - mn);
        st.l *= sc;
        if (PV) {
#pragma unroll
            for (int dt = 0; dt < 4; ++dt) st.o[dt] *= sc;
        }
        st.m = mn;
    }
    float p[8]; float ps = 0.f;
#pragma unroll
    for (int j = 0; j < 8; ++j) { p[j] = __builtin_amdgcn_exp2f(sv[j] - st.m); ps += p[j]; }
    st.l += ps;
    if (PV) {
        const bf16x8 pb = pack8(p);
#pragma unroll
        for (int dt = 0; dt < 4; ++dt) st.o[dt] = __builtin_amdgcn_mfma_f32_16x16x32_bf16(va[dt], pb, st.o[dt], 0, 0, 0);
    }
}
template <int MASK>
DEVI void nsa_chunk8(NsaSt8& st, const long (&ka)[4], const long (&qf)[2], const long (&va)[4], int pos0, int hi, bool own) {
    f32x4 s0 = st.negm, s1 = st.negm;
    s0 = __builtin_amdgcn_mfma_f32_16x16x32_fp8_fp8(ka[0], qf[0], s0, 0, 0, 0); s1 = __builtin_amdgcn_mfma_f32_16x16x32_fp8_fp8(ka[2], qf[0], s1, 0, 0, 0);
    s0 = __builtin_amdgcn_mfma_f32_16x16x32_fp8_fp8(ka[1], qf[1], s0, 0, 0, 0); s1 = __builtin_amdgcn_mfma_f32_16x16x32_fp8_fp8(ka[3], qf[1], s1, 0, 0, 0);
    float sv[8] = {s0[0], s0[1], s0[2], s0[3], s1[0], s1[1], s1[2], s1[3]};
    if (MASK == 1) {
#pragma unroll
        for (int j = 0; j < 8; ++j) sv[j] = own ? sv[j] : -1e30f;
    } else if (MASK == 2) {
#pragma unroll
        for (int j = 0; j < 8; ++j) sv[j] = (pos0 + j <= hi) ? sv[j] : -1e30f;
    }
    float cm = fmaxf(fmaxf(fmaxf(sv[0], sv[1]), fmaxf(sv[2], sv[3])), fmaxf(fmaxf(sv[4], sv[5]), fmaxf(sv[6], sv[7])));
    cm = fmaxf(cm, __shfl_xor(cm, 16)); cm = fmaxf(cm, __shfl_xor(cm, 32));
    const bool need = (cm > 7.f) || (!st.set && cm > -1e29f);
    if (__any(need)) {
        const float d = need ? cm - 7.f : 0.f;
        const float sc = need ? (st.set ? __builtin_amdgcn_exp2f(-d) : 0.f) : 1.f;
        st.m += d; st.set = st.set || need;
        const float nm = 7.f - st.m; st.negm = (f32x4){nm, nm, nm, nm};
        st.l *= sc;
#pragma unroll
        for (int dt = 0; dt < 4; ++dt) st.o[dt] *= sc;
#pragma unroll
        for (int j = 0; j < 8; ++j) sv[j] -= d;
    }
    float p[8];
#pragma unroll
    for (int j = 0; j < 8; ++j) p[j] = __builtin_amdgcn_exp2f(sv[j]);
    st.l += ((p[0] + p[1]) + (p[2] + p[3])) + ((p[4] + p[5]) + (p[6] + p[7]));
    const long pb = (long)pack8_fp8(p);
#pragma unroll
    for (int dt = 0; dt < 4; ++dt) st.o[dt] = __builtin_amdgcn_mfma_f32_16x16x32_fp8_fp8(va[dt], pb, st.o[dt], 0, 0, 0);
}
struct NsaBlk8 { long ka[8]; long va[8]; int e; };
template <int MASK>
DEVI void nsa_block8(NsaSt8& st, const NsaBlk8& bf, const long (&qf)[2], int pos0, int hi, bool own) {
    f32x4 s0 = st.negm, s1 = st.negm, s2 = st.negm, s3 = st.negm;
    s0 = __builtin_amdgcn_mfma_f32_16x16x32_fp8_fp8(bf.ka[0], qf[0], s0, 0, 0, 0); s1 = __builtin_amdgcn_mfma_f32_16x16x32_fp8_fp8(bf.ka[2], qf[0], s1, 0, 0, 0);
    s2 = __builtin_amdgcn_mfma_f32_16x16x32_fp8_fp8(bf.ka[4], qf[0], s2, 0, 0, 0); s3 = __builtin_amdgcn_mfma_f32_16x16x32_fp8_fp8(bf.ka[6], qf[0], s3, 0, 0, 0);
    s0 = __builtin_amdgcn_mfma_f32_16x16x32_fp8_fp8(bf.ka[1], qf[1], s0, 0, 0, 0); s1 = __builtin_amdgcn_mfma_f32_16x16x32_fp8_fp8(bf.ka[3], qf[1], s1, 0, 0, 0);
    s2 = __builtin_amdgcn_mfma_f32_16x16x32_fp8_fp8(bf.ka[5], qf[1], s2, 0, 0, 0); s3 = __builtin_amdgcn_mfma_f32_16x16x32_fp8_fp8(bf.ka[7], qf[1], s3, 0, 0, 0);
    float sv[16] = {s0[0], s0[1], s0[2], s0[3], s1[0], s1[1], s1[2], s1[3], s2[0], s2[1], s2[2], s2[3], s3[0], s3[1], s3[2], s3[3]};
    if (MASK == 1) {
#pragma unroll
        for (int j = 0; j < 16; ++j) sv[j] = own ? sv[j] : -1e30f;
    } else if (MASK == 2) {
#pragma unroll
        for (int j = 0; j < 16; ++j) sv[j] = (pos0 + (j & 7) + 32 * (j >> 3) <= hi) ? sv[j] : -1e30f;
    }
    float cm = fmaxf(fmaxf(fmaxf(fmaxf(sv[0], sv[1]), fmaxf(sv[2], sv[3])), fmaxf(fmaxf(sv[4], sv[5]), fmaxf(sv[6], sv[7]))),
                     fmaxf(fmaxf(fmaxf(sv[8], sv[9]), fmaxf(sv[10], sv[11])), fmaxf(fmaxf(sv[12], sv[13]), fmaxf(sv[14], sv[15]))));
    cm = fmaxf(cm, __shfl_xor(cm, 16)); cm = fmaxf(cm, __shfl_xor(cm, 32));
    const bool need = (cm > 7.f) || (!st.set && cm > -1e29f);
    if (__any(need)) {
        const float d = need ? cm - 7.f : 0.f;
        const float sc = need ? (st.set ? __builtin_amdgcn_exp2f(-d) : 0.f) : 1.f;
        st.m += d; st.set = st.set || need;
        const float nm = 7.f - st.m; st.negm = (f32x4){nm, nm, nm, nm};
        st.l *= sc;
#pragma unroll
        for (int dt = 0; dt < 4; ++dt) st.o[dt] *= sc;
#pragma unroll
        for (int j = 0; j < 16; ++j) sv[j] -= d;
    }
    float p[8], q[8];
#pragma unroll
    for (int j = 0; j < 8; ++j) { p[j] = __builtin_amdgcn_exp2f(sv[j]); q[j] = __builtin_amdgcn_exp2f(sv[8 + j]); }
    st.l += (((p[0] + p[1]) + (p[2] + p[3])) + ((p[4] + p[5]) + (p[6] + p[7]))) + (((q[0] + q[1]) + (q[2] + q[3])) + ((q[4] + q[5]) + (q[6] + q[7])));
    const long pb0 = (long)pack8_fp8(p), pb1 = (long)pack8_fp8(q);
#pragma unroll
    for (int dt = 0; dt < 4; ++dt) st.o[dt] = __builtin_amdgcn_mfma_f32_16x16x32_fp8_fp8(bf.va[dt], pb0, st.o[dt], 0, 0, 0);
#pragma unroll
    for (int dt = 0; dt < 4; ++dt) st.o[dt] = __builtin_amdgcn_mfma_f32_16x16x32_fp8_fp8(bf.va[4 + dt], pb1, st.o[dt], 0, 0, 0);
}
template <class LD, class CP>
DEVI void nsa_streamb(int n, LD ld, CP cp) {
    NsaBlk8 A, B;
    if (n > 0) ld(A, 0);
#pragma unroll 1
    for (int i = 0; i < n; i += 2) {
        if (i + 1 < n) ld(B, i + 1);
        cp(A, i);
        if (i + 1 < n) { if (i + 2 < n) ld(A, i + 2); cp(B, i + 1); }
    }
}
DEVI void nsa_fold8(f32x4 (&comb)[4], NsaSt8& st, float gate) {
    float l = st.l; l += __shfl_xor(l, 16); l += __shfl_xor(l, 32);
    const float w = gate / fmaxf(l, 1e-30f);
#pragma unroll
    for (int dt = 0; dt < 4; ++dt) comb[dt] += st.o[dt] * w;
}
template <class LD, class CP>
DEVI void nsa_stream8(int n, LD ld, CP cp) {
    NsaBuf8 A, B, C, D;
    if (n > 0) ld(A, 0);
    if (n > 1) ld(B, 1);
    if (n > 2) ld(C, 2);
#pragma unroll 1
    for (int i = 0; i < n; i += 4) {
        if (i + 3 < n) ld(D, i + 3);
        cp(A, i);
        if (i + 1 < n) { if (i + 4 < n) ld(A, i + 4); cp(B, i + 1); }
        if (i + 2 < n) { if (i + 5 < n) ld(B, i + 5); cp(C, i + 2); }
        if (i + 3 < n) { if (i + 6 < n) ld(C, i + 6); cp(D, i + 3); }
    }
}
DEVI void nsa_fold(f32x4 (&comb)[4], NsaSt& st, float gate) {
    float l = st.l; l += __shfl_xor(l, 16); l += __shfl_xor(l, 32);
    const float w = gate / fmaxf(l, 1e-30f);
#pragma unroll
    for (int dt = 0; dt < 4; ++dt) comb[dt] += st.o[dt] * w;
}
template <class LD, class CP>
DEVI void nsa_stream(int n, LD ld, CP cp) {
    NsaBuf A, B, C;
    if (n > 0) ld(A, 0);
    if (n > 1) ld(B, 1);
#pragma unroll 1
    for (int i = 0; i < n; i += 3) {
        if (i + 2 < n) ld(C, i + 2);
        cp(A, i);
        if (i + 1 < n) { if (i + 3 < n) ld(A, i + 3); cp(B, i + 1); }
        if (i + 2 < n) { if (i + 4 < n) ld(B, i + 4); cp(C, i + 2); }
    }
}
template <class LD, class CP>
DEVI void nsa_stream2(int n, LD ld, CP cp) {
    NsaBuf A, B;
    if (n > 0) ld(A, 0);
#pragma unroll 1
    for (int i = 0; i < n; i += 2) {
        if (i + 1 < n) ld(B, i + 1);
        cp(A, i);
        if (i + 1 < n) { if (i + 2 < n) ld(A, i + 2); cp(B, i + 1); }
    }
}

#define XB_TMO      128
#define XB_XCNT(j)  (256  + 64 * (j))
#define XB_XSUB(j)  (1280 + 64 * (j))
#define XB_XGEN(j)  (2304 + 64 * (j))
#define XB_TOP      3328
#define XB_TOPGEN   3392
#define XCD_BAR_WORDS 3456
#define XB_SPIN_CAP (1u << 22)
#define LAS __attribute__((address_space(3)))
DEVI unsigned xb_ld(unsigned* p)              { return __hip_atomic_load(p, __ATOMIC_RELAXED, __HIP_MEMORY_SCOPE_AGENT); }
DEVI unsigned xb_add(unsigned* p, unsigned v) { return __hip_atomic_fetch_add(p, v, __ATOMIC_RELAXED, __HIP_MEMORY_SCOPE_AGENT); }
DEVI unsigned xb_xcc_id() { return (unsigned)__builtin_amdgcn_s_getreg((3 << 11) | 20) & 0xFu; }
#define XB_SPIN(cond, bar) do { unsigned _sp = 0; while (cond) { __builtin_amdgcn_s_sleep(1); \
    if ((++_sp & 255u) == 0u) { if (xb_ld(&(bar)[XB_TMO])) break; if (_sp > XB_SPIN_CAP) { atomicAdd(&(bar)[XB_TMO], 1u); break; } } } } while (0)
struct XcdBarrier { unsigned* bar; unsigned x; volatile LAS unsigned* st; };
DEVI XcdBarrier xcd_barrier_post(unsigned* bar, volatile LAS unsigned* st) {
    XcdBarrier b; b.bar = bar; b.x = xb_xcc_id(); b.st = st;
    if (threadIdx.x == 0) (void)xb_add(&bar[XB_XCNT(b.x)], 1u);
    return b;
}
DEVI void xcd_barrier_complete(unsigned* bar, unsigned x, unsigned& nloc, unsigned& nx) {
    const unsigned G = gridDim.x * gridDim.y * gridDim.z;
    unsigned sum, cnt, mine, sp = 0u;
    for (;;) {
        sum = 0u; cnt = 0u; mine = 0u;
#pragma unroll
        for (unsigned j = 0; j < 16; ++j) { const unsigned c = xb_ld(&bar[XB_XCNT(j)]); sum += c; cnt += (c > 0u) ? 1u : 0u; mine = (j == x) ? c : mine; }
        if (sum == G) break;
        __builtin_amdgcn_s_sleep(1);
        if ((++sp & 255u) == 0u) { if (xb_ld(&bar[XB_TMO])) break; if (sp > XB_SPIN_CAP) { atomicAdd(&bar[XB_TMO], 1u); break; } }
    }
    nloc = mine > 0u ? mine : 1u; nx = cnt > 0u ? cnt : 1u;
}
DEVI void xcd_barrier(const XcdBarrier& b) {
    asm volatile("s_waitcnt vmcnt(0)" ::: "memory");
    __syncthreads();
    if (threadIdx.x == 0) {
        unsigned* bar = b.bar;
        __builtin_amdgcn_s_waitcnt(0);
        unsigned nloc = b.st[0], nx = b.st[1];
        if (nloc == 0u) { xcd_barrier_complete(bar, b.x, nloc, nx); b.st[0] = nloc; b.st[1] = nx; }
        const unsigned old = xb_add(&bar[XB_XSUB(b.x)], 1u);
        const unsigned gen = old / nloc;
        if (old + 1u == (gen + 1u) * nloc) {
            __builtin_amdgcn_fence(__ATOMIC_RELEASE, "agent");
            asm volatile("s_waitcnt vmcnt(0)" ::: "memory");
            const unsigned og = xb_add(&bar[XB_TOP], 1u);
            const unsigned tg = og / nx;
            if (og + 1u == (tg + 1u) * nx) xb_add(&bar[XB_TOPGEN], 1u);
            else XB_SPIN(xb_ld(&bar[XB_TOPGEN]) == tg, bar);
            __builtin_amdgcn_fence(__ATOMIC_ACQUIRE, "agent");
            xb_add(&bar[XB_XGEN(b.x)], 1u);
            asm volatile("s_waitcnt vmcnt(0)" ::: "memory");
        } else {
            XB_SPIN(xb_ld(&bar[XB_XGEN(b.x)]) == gen, bar);
            __builtin_amdgcn_fence(__ATOMIC_ACQUIRE, "agent");
            asm volatile("s_waitcnt vmcnt(0)" ::: "memory");
        }
    }
    __syncthreads();
}

DEVI void* ldptr(volatile LAS unsigned long long* tab, int i) { const unsigned long long v = tab[i];
    const unsigned lo = __builtin_amdgcn_readfirstlane((unsigned)v), hi = __builtin_amdgcn_readfirstlane((unsigned)(v >> 32)); return (void*)(((unsigned long long)hi << 32) | lo); }


DEVI unsigned key_pack(float f, int idx) { const unsigned u = __float_as_uint(f); const unsigned o = (u & 0x80000000u) ? ~u : (u | 0x80000000u); return (o & 0xFFFFFF80u) | (unsigned)(127 - idx); }
DEVI float key_val(unsigned k) { const unsigned o = k & 0xFFFFFF80u; return __uint_as_float((o & 0x80000000u) ? (o & 0x7FFFFFFFu) : ~o); }
DEVI void ce_desc(unsigned& a, unsigned& b) { const unsigned hi = a > b ? a : b, lo = a > b ? b : a; a = hi; b = lo; }
template <int N> DEVI void bitonic_sort_desc(unsigned (&a)[N]) {
#pragma unroll
    for (int k = 2; k <= N; k <<= 1)
#pragma unroll
        for (int j = k >> 1; j > 0; j >>= 1)
#pragma unroll
            for (int i = 0; i < N; ++i) { const int l = i ^ j; if (l > i) { if ((i & k) == 0) ce_desc(a[i], a[l]); else ce_desc(a[l], a[i]); } }
}
template <int N> DEVI void bitonic_merge_desc(unsigned (&a)[N]) {
#pragma unroll
    for (int j = N >> 1; j > 0; j >>= 1)
#pragma unroll
        for (int i = 0; i < N; ++i) { const int l = i ^ j; if (l > i) ce_desc(a[i], a[l]); }
}

__global__ void __launch_bounds__(NTHREADS) fwd_mega(Params pa) {
    extern __shared__ __attribute__((aligned(16))) unsigned char smem[];
    const int bid = blockIdx.x, nb = gridDim.x, tid = threadIdx.x, lane = tid & 63, wave = tid >> 6;
    volatile LAS unsigned long long* ptab = (volatile LAS unsigned long long*)(smem + LDS_BYTES - 16 - 32 * 8);
    {
        volatile LAS unsigned* st0 = (volatile LAS unsigned*)(smem + LDS_BYTES - 16);
        if (tid < 4) st0[tid] = 0u;
        if (tid == 0) {
            ptab[0] = (unsigned long long)pa.x; ptab[1] = (unsigned long long)pa.mem; ptab[2] = (unsigned long long)pa.g_mix; ptab[3] = (unsigned long long)pa.w_in;
            ptab[4] = (unsigned long long)pa.pe_k; ptab[5] = (unsigned long long)pa.w1_k; ptab[6] = (unsigned long long)pa.b1_k; ptab[7] = (unsigned long long)pa.w2_k;
            ptab[8] = (unsigned long long)pa.pe_v; ptab[9] = (unsigned long long)pa.w1_v; ptab[10] = (unsigned long long)pa.b1_v; ptab[11] = (unsigned long long)pa.w2_v;
            ptab[12] = (unsigned long long)pa.ln_g; ptab[13] = (unsigned long long)pa.ln_b; ptab[14] = (unsigned long long)pa.gws; ptab[15] = (unsigned long long)pa.gbs;
            ptab[16] = (unsigned long long)pa.w_nsa_out; ptab[17] = (unsigned long long)pa.w_gmlp_out; ptab[18] = (unsigned long long)pa.w_mix_out; ptab[19] = (unsigned long long)pa.g_xattn;
            ptab[20] = (unsigned long long)pa.g_mem; ptab[21] = (unsigned long long)pa.w_xq; ptab[22] = (unsigned long long)pa.w_xkv; ptab[23] = (unsigned long long)pa.w_xo;
            ptab[24] = (unsigned long long)pa.g_peer; ptab[25] = (unsigned long long)pa.w_peer_q; ptab[26] = (unsigned long long)pa.sub_keys; ptab[27] = (unsigned long long)pa.peer_u;
            ptab[28] = (unsigned long long)pa.peer_v; ptab[29] = (unsigned long long)pa.g_final; ptab[30] = (unsigned long long)pa.out; ptab[31] = (unsigned long long)pa.ws;
        }
        __syncthreads();
    }
    const XcdBarrier xb = xcd_barrier_post((unsigned*)pa.ws, (volatile LAS unsigned*)(smem + LDS_BYTES - 16));
#define LDP(i) ((const float*)ldptr(ptab, i))
#define PHASE_BEGIN \
    const int tid = tid_opaque(), lane = tid & 63, wave = tid >> 6; (void)lane; (void)wave; \
    Params p; p.x = LDP(0); p.mem = LDP(1); p.g_mix = LDP(2); p.w_in = LDP(3); p.pe_k = LDP(4); p.w1_k = LDP(5); p.b1_k = LDP(6); p.w2_k = LDP(7); p.pe_v = LDP(8); p.w1_v = LDP(9); p.b1_v = LDP(10); p.w2_v = LDP(11); \
    p.ln_g = LDP(12); p.ln_b = LDP(13); p.gws = LDP(14); p.gbs = LDP(15); p.w_nsa_out = LDP(16); p.w_gmlp_out = LDP(17); p.w_mix_out = LDP(18); p.g_xattn = LDP(19); p.g_mem = LDP(20); p.w_xq = LDP(21); p.w_xkv = LDP(22); p.w_xo = LDP(23); \
    p.g_peer = LDP(24); p.w_peer_q = LDP(25); p.sub_keys = LDP(26); p.peer_u = LDP(27); p.peer_v = LDP(28); p.g_final = LDP(29); p.out = (float*)ldptr(ptab, 30); p.ws = (unsigned char*)ldptr(ptab, 31); \
    unsigned char* const ws = p.ws; \
    bf16_t* WIN = (bf16_t*)(ws + O_WIN); bf16_t* W1K = (bf16_t*)(ws + O_W1K); bf16_t* W1V = (bf16_t*)(ws + O_W1V); \
    bf16_t* WNSA = (bf16_t*)(ws + O_WNSA); bf16_t* WGM = (bf16_t*)(ws + O_WGM); bf16_t* WMIX = (bf16_t*)(ws + O_WMIX); \
    bf16_t* WXQ = (bf16_t*)(ws + O_WXQ); bf16_t* WXKV = (bf16_t*)(ws + O_WXKV); bf16_t* WXO = (bf16_t*)(ws + O_WXO); bf16_t* WPQ = (bf16_t*)(ws + O_WPQ); \
    float* B1F = (float*)(ws + 14336); \
    bf16_t* HN = (bf16_t*)(ws + O_HN); bf16_t* MN = (bf16_t*)(ws + O_MN); bf16_t* KVX = (bf16_t*)(ws + O_KVX); \
    float* GATES = (float*)(ws + O_GATES); float* HID = (float*)(ws + O_HID); \
    bf16_t* Q = (bf16_t*)(ws + O_Q); bf16_t* KV6 = (bf16_t*)(ws + O_KV6); bf16_t* U = (bf16_t*)(ws + O_U); bf16_t* VG = (bf16_t*)(ws + O_VG); \
    bf16_t* MG = (bf16_t*)(ws + O_MG); bf16_t* ONSA = (bf16_t*)(ws + O_ONSA); bf16_t* OGM = (bf16_t*)(ws + O_OGM); \
    bf16_t* Y = (bf16_t*)(ws + O_Y); bf16_t* QX = (bf16_t*)(ws + O_QX); bf16_t* OX = (bf16_t*)(ws + O_OX); bf16_t* QP = (bf16_t*)(ws + O_QP); \
    float* HS = (float*)(ws + O_HS); int* HI = (int*)(ws + O_HI); \
    bf16_t* VXT = (bf16_t*)(ws + O_VXT); bf16_t* SUBK = (bf16_t*)(ws + O_SUBK); \
    bf16_t* KCB = (bf16_t*)(ws + O_CMP); bf16_t* VCT = KCB + 4 * 512 * 64; \
    unsigned char* PU8 = ws + O_U; unsigned char* PV8 = ws + O_U + 16384ull * 1024; \
    float* PSC = (float*)(ws + O_PSC); \
    float* OUT = p.out; \
    (void)WIN; (void)W1K; (void)W1V; (void)WNSA; (void)WGM; (void)WMIX; (void)WXQ; (void)WXKV; (void)WXO; (void)WPQ; (void)B1F; (void)HN; (void)MN; (void)KVX; (void)GATES; (void)HID; (void)Q; (void)KV6; (void)U; (void)VG; \
    (void)MG; (void)ONSA; (void)OGM; (void)Y; (void)QX; (void)OX; (void)QP; (void)HS; (void)HI; (void)VXT; (void)SUBK; (void)KCB; (void)VCT; (void)PU8; (void)PV8; (void)PSC; (void)OUT;

    { PHASE_BEGIN
    {
        float* tile = (float*)smem;
        for (int j = bid; j < 3424; j += nb) {
            int t = j;
            if (t < 1120) { transpose_tile(p.w_in, 4376, WIN, 1024, t, WinMap(), tile); continue; } t -= 1120;
            if (t < 128) { transpose_tile(p.w1_k, 256, W1K, 2048, t, IdMap(), tile); continue; } t -= 128;
            if (t < 128) { transpose_tile(p.w1_v, 256, W1V, 2048, t, IdMap(), tile); continue; } t -= 128;
            if (t < 128) { transpose_tile(p.w_nsa_out, 1024, WNSA, 512, t, IdMap(), tile); continue; } t -= 128;
            if (t < 128) { transpose_tile(p.w_gmlp_out, 1024, WGM, 512, t, IdMap(), tile); continue; } t -= 128;
            if (t < 256) { transpose_tile(p.w_mix_out, 1024, WMIX, 1024, t, IdMap(), tile); continue; } t -= 256;
            if (t < 256) { transpose_tile(p.w_xq, 1024, WXQ, 1024, t, IdMap(), tile); continue; } t -= 256;
            if (t < 512) { transpose_tile(p.w_xkv, 2048, WXKV, 1024, t, IdMap(), tile); continue; } t -= 512;
            if (t < 256) { transpose_tile(p.w_xo, 1024, WXO, 1024, t, IdMap(), tile); continue; } t -= 256;
            transpose_tile(p.w_peer_q, 2048, WPQ, 1024, t, IdMap(), tile);
        }
        for (int r = bid * 8 + wave; r < 16384 + 512; r += nb * 8) {
            if (r < 16384) rmsnorm_row_bf16(p.x + (size_t)r * 1024, p.g_mix, HN + (size_t)r * 1024, lane);
            else rmsnorm_row_bf16(p.mem + (size_t)(r - 16384) * 1024, p.g_mem, MN + (size_t)(r - 16384) * 1024, lane);
        }
        for (int i = bid * NTHREADS + tid; i < 16 * 128 * 128; i += nb * NTHREADS) SUBK[(i & ~16383) + pk_koff((i >> 7) & 127, i & 127)] = f2bf(p.sub_keys[i]);
        for (int i = bid * NTHREADS + tid; i < 2 * 2048 * 256 / 4; i += nb * NTHREADS) ((float4*)HID)[i] = make_float4(0.f, 0.f, 0.f, 0.f);
        {
            const int wt = bid * 8 + wave;
            if (wt < 128) {
                const int kv = wt >> 6, ng = (wt >> 4) & 3, kc = wt & 15, n = ng * 64 + lane;
                const float* pe = (kv ? p.pe_v : p.pe_k) + kc * 128; const float* w1 = (kv ? p.w1_v : p.w1_k) + (size_t)kc * 128 * 256 + n;
                float a = 0.f;
#pragma unroll 16
                for (int k = 0; k < 128; ++k) a += pe[k] * w1[(size_t)k * 256];
                unsafeAtomicAdd(B1F + kv * 256 + n, a);
            }
        }
    }
    }
    xcd_barrier(xb);

    { PHASE_BEGIN
    {
        auto epi = [&](int r, int c, const f32x4& v0, const f32x4& v1) {
            if (c < 512) { const float qs_ = 0.125f * 1.4426950408889634f; store_bf16x8(Q + (size_t)r * 512 + c, v0 * qs_, v1 * qs_);
                const float q8[8] = {v0[0] * qs_, v0[1] * qs_, v0[2] * qs_, v0[3] * qs_, v1[0] * qs_, v1[1] * qs_, v1[2] * qs_, v1[3] * qs_};
                *(unsigned long long*)(ws + O_Q8 + (size_t)r * 512 + c) = pack8_fp8(q8); }
            else if (c < 1280) { const int w = (c - 512) >> 7, cc = (c - 512) & 127;
                const int b_ = r >> 13, t_ = r & 8191, g_ = cc >> 6, d_ = cc & 63;
                if (w == 5) {
                    bf16_t* vt = KV6 + (size_t)w * 16384 * 128 + (size_t)(b_ * 2 + g_) * 8192 * 64 + nsa_voff(t_, d_);
                    vt[0] = f2bf(v0[0]); vt[8] = f2bf(v0[1]); vt[16] = f2bf(v0[2]); vt[24] = f2bf(v0[3]); vt[32] = f2bf(v1[0]); vt[40] = f2bf(v1[1]); vt[48] = f2bf(v1[2]); vt[56] = f2bf(v1[3]); }
                else if (w == 4) store_bf16x8(KV6 + (size_t)w * 16384 * 128 + (size_t)(b_ * 2 + g_) * 8192 * 64 + nsa_koff(t_, d_), v0, v1);
                else if (w == 3) {
                    const float f8[8] = {v0[0], v0[1], v0[2], v0[3], v1[0], v1[1], v1[2], v1[3]}; const unsigned long long pk = pack8_fp8(f8);
                    unsigned char* vt = (unsigned char*)(KV6 + (size_t)w * 16384 * 128) + (size_t)(b_ * 2 + g_) * 8192 * 64 + nsa_voff8(t_, d_);
#pragma unroll
                    for (int e = 0; e < 8; ++e) vt[e * 16] = (unsigned char)(pk >> (8 * e)); }
                else if (w == 2) {
                    const float f8[8] = {v0[0], v0[1], v0[2], v0[3], v1[0], v1[1], v1[2], v1[3]};
                    *(unsigned long long*)((unsigned char*)(KV6 + (size_t)w * 16384 * 128) + (size_t)(b_ * 2 + g_) * 8192 * 64 + nsa_koff8(t_, d_)) = pack8_fp8(f8); }
                else store_bf16x8(KV6 + ((size_t)w * 16384 + r) * 128 + cc, v0, v1); }
            else if (c < 2304) { bf16_t* dst = c < 1792 ? U + (size_t)r * 512 + (c - 1280) : VG + (size_t)r * 512 + (c - 1792);
                f32x4 a, b;
#pragma unroll
                for (int e = 0; e < 4; ++e) { a[e] = gelu_f(v0[e]); b[e] = gelu_f(v1[e]); }
                store_bf16x8(dst, a, b); }
            else { f32x4 a, b;
#pragma unroll
                for (int e = 0; e < 4; ++e) { a[e] = sigmoid_f(v0[e]); b[e] = sigmoid_f(v1[e]); }
                store_bf16x8(MG + (size_t)r * 2048 + (c - 2304), a, b); }
        };
        big_gemm(smem, HN, WIN, 16384, 4352, 1024, epi);
    }
    }
    xcd_barrier(xb);

    { PHASE_BEGIN
    {
        for (int task = bid; task < 256; task += nb) {
            if (task < 128) {
                const int kv = task >> 6, t = task & 63, mt = t >> 2, nt = (t >> 1) & 1, kh = t & 1;
                bf16_t* As = (bf16_t*)smem; bf16_t* Bs = As + 128 * G_LD;
                const int wm = wave >> 2, wn = wave & 3;
                f32x4 acc[4][2];
#pragma unroll
                for (int i = 0; i < 4; ++i)
#pragma unroll
                    for (int j = 0; j < 2; ++j) acc[i][j] = (f32x4){0.f, 0.f, 0.f, 0.f};
                gemm_tile(acc, CmpA{KV6 + (size_t)kv * 16384 * 128, kh * 1024}, mt * 128, (kv ? W1V : W1K) + (size_t)nt * 128 * 2048 + kh * 1024, 2048, 1024, As, Bs);
#pragma unroll
                for (int i = 0; i < 4; ++i)
#pragma unroll
                    for (int j = 0; j < 2; ++j) {
                        const int r = mt * 128 + wm * 64 + i * 16 + (lane & 15), c = nt * 128 + wn * 32 + j * 16 + (lane >> 4) * 4;
                        if (r < 2044) { float* hp = HID + ((size_t)kv * 2048 + r) * 256 + c;
                            unsafeAtomicAdd(hp, acc[i][j][0]); unsafeAtomicAdd(hp + 1, acc[i][j][1]); unsafeAtomicAdd(hp + 2, acc[i][j][2]); unsafeAtomicAdd(hp + 3, acc[i][j][3]); }
                    }
                __syncthreads();
            } else {
                const int ch = task - 128;
                const size_t row0 = (size_t)ch * 128;
                constexpr int VLD = 136;
                bf16_t* VT = (bf16_t*)smem;
                float* st = (float*)(smem + 512 * VLD * 2);
                for (int r = wave * 16; r < wave * 16 + 16; ++r) {
                    float f[8]; load8(VG + (row0 + r) * 512 + lane * 8, f);
                    float s1 = 0.f;
#pragma unroll
                    for (int e = 0; e < 8; ++e) s1 += f[e];
                    s1 = wave_sum(s1); const float mu = s1 * (1.0f / 512.0f);
                    float s2 = 0.f;
#pragma unroll
                    for (int e = 0; e < 8; ++e) s2 += (f[e] - mu) * (f[e] - mu);
                    s2 = wave_sum(s2);
                    if (lane == 0) { st[r * 2] = mu; st[r * 2 + 1] = rsqrtf(s2 * (1.0f / 512.0f) + 1e-6f); }
                }
                __syncthreads();
                {
                    const int s_ = tid & 127; const float mu = st[s_ * 2], rs = st[s_ * 2 + 1];
#pragma unroll 1
                    for (int i = 0; i < 16; ++i) {
                        const int d0 = ((tid >> 7) + 4 * i) * 8;
                        float f[8]; load8(VG + (row0 + s_) * 512 + d0, f);
#pragma unroll
                        for (int e = 0; e < 8; ++e) VT[(d0 + e) * VLD + s_] = f2bf((f[e] - mu) * rs * p.ln_g[d0 + e] + p.ln_b[d0 + e]);
                    }
                }
                __syncthreads();
                {
                    const int tl = wave * 16 + (lane & 15), hq = lane >> 4, kmax = (wave * 16 + 15) >> 5;
                    for (int g = 0; g < 4; ++g) {
                        bf16x8 wf[4];
#pragma unroll
                        for (int ks = 0; ks < 4; ++ks) {
                            if (ks <= kmax) {
                                const float* wp = p.gws + (size_t)g * 16384 + tl * 128 + ks * 32 + 8 * hq;
                                float f[8]; load8(wp, f);
#pragma unroll
                                for (int e = 0; e < 8; ++e) f[e] = (ks * 32 + 8 * hq + e <= tl) ? f[e] : 0.f;
                                wf[ks] = pack8(f);
                            }
                        }
                        const float bsv = p.gbs[g * 128 + tl];
#pragma unroll 2
                        for (int dt = 0; dt < 8; ++dt) {
                            f32x4 a = {0.f, 0.f, 0.f, 0.f};
                            const bf16_t* vp = VT + (g * 128 + dt * 16 + (lane & 15)) * VLD + 8 * hq;
#pragma unroll
                            for (int ks = 0; ks < 4; ++ks) if (ks <= kmax) a = __builtin_amdgcn_mfma_f32_16x16x32_bf16(*(const bf16x8*)(vp + ks * 32), wf[ks], a, 0, 0, 0);
                            const size_t o = (row0 + tl) * 512 + g * 128 + dt * 16 + 4 * hq;
                            const uint2 uw = *(const uint2*)(U + o);
                            store_bf16x4(OGM + o, __uint_as_float(uw.x << 16) * (a[0] + bsv), __uint_as_float(uw.x & 0xffff0000u) * (a[1] + bsv),
                                         __uint_as_float(uw.y << 16) * (a[2] + bsv), __uint_as_float(uw.y & 0xffff0000u) * (a[3] + bsv));
                        }
                    }
                }
                __syncthreads();
            }
        }
    }
    }
    xcd_barrier(xb);

    { PHASE_BEGIN
    {
        auto epig = [&](int r, int c, const f32x4& v) { if (c < 24) { float* gp = GATES + (size_t)r * 24 + c; gp[0] = sigmoid_f(v[0]); gp[1] = sigmoid_f(v[1]); gp[2] = sigmoid_f(v[2]); gp[3] = sigmoid_f(v[3]); } };
        gemm_run(RowMajorA{HN, 1024}, WIN + (size_t)4352 * 1024, 1024, 128, 1, epig, smem, bid, nb);
        auto epi2 = [&](int r, int c, const f32x4& v) {
            const int b_ = r >> 8, m_ = r & 255;
            if (c < 1024) { const int h_ = c >> 8, d_ = c & 255; store_bf16x4(KVX + (size_t)(b_ * 4 + h_) * 65536 + xat_koff(m_, d_), v[0], v[1], v[2], v[3]); }
            else { const int hd = c - 1024, h_ = hd >> 8, d_ = hd & 255;
                bf16_t* vt = VXT + (size_t)(b_ * 4 + h_) * 65536 + xat_voff(m_, d_);
                vt[0] = f2bf(v[0]); vt[8] = f2bf(v[1]); vt[16] = f2bf(v[2]); vt[24] = f2bf(v[3]); } };
        gemm_run(RowMajorA{MN, 1024}, WXKV, 1024, 4, 16, epi2, smem, bid, nb);
        __syncthreads();
        float* gl = (float*)smem + wave * 256;
        for (int task = bid * 8 + wave; task < 2 * 2044; task += nb * 8) {
            const int kv = task >= 2044 ? 1 : 0, r = task - kv * 2044;
            const float* hp = HID + ((size_t)kv * 2048 + r) * 256; const float* bb = B1F + kv * 256; const float* b1 = kv ? p.b1_v : p.b1_k;
#pragma unroll
            for (int i = 0; i < 4; ++i) gl[lane + 64 * i] = gelu_f(hp[lane + 64 * i] + bb[lane + 64 * i] + b1[lane + 64 * i]);
            lds_fence();
            const float* w2 = kv ? p.w2_v : p.w2_k;
            float a = 0.f;
#pragma unroll 8
            for (int j = 0; j < 256; ++j) a += gl[j] * w2[j * 64 + lane];
            const int b = r / 1022, rr = r - b * 1022, c = rr >> 1, g = rr & 1, n = lane;
            if (kv == 0) KCB[(size_t)(b * 2 + g) * 512 * 64 + nsa_koff(c, n)] = f2bf(a); else VCT[(size_t)(b * 2 + g) * 512 * 64 + nsa_voff(c, n)] = f2bf(a);
            lds_fence();
        }
        if (bid == 0 && tid < 256) { const int bg = tid >> 6, n = tid & 63; KCB[(size_t)bg * 512 * 64 + nsa_koff(511, n)] = 0; VCT[(size_t)bg * 512 * 64 + nsa_voff(511, n)] = 0; }
    }
    }
    xcd_barrier(xb);

    { PHASE_BEGIN
    {
        float* impL = (float*)smem + wave * 1024;
        int* sidxL = (int*)(impL + 512);
        const bf16_t* KS = KV6 + 2ull * 16384 * 128; const bf16_t* VST = KV6 + 3ull * 16384 * 128;
        const bf16_t* KW = KV6 + 4ull * 16384 * 128; const bf16_t* VWT = KV6 + 5ull * 16384 * 128;
        const int c = lane & 15, h = lane >> 4, tokc = c >> 2, headc = c & 3;
        const int rk = 8 * (c >> 2) + (c & 3), dh = 8 * h;
        for (int task = bid * 8 + wave; task < 8192; task += nb * 8) {
            const int bg = task >> 11, q4 = (bg & 1) ? 2047 - (task & 2047) : (task & 2047), b = bg >> 1, g = bg & 1, t0 = q4 * 4;
            const int tcol = t0 + tokc; const size_t bt0 = (size_t)b * 8192 + t0;
            bf16x8 qf[2];
            { const bf16_t* qp = Q + (bt0 + tokc) * 512 + g * 256 + headc * 64 + dh; qf[0] = *(const bf16x8*)qp; qf[1] = *(const bf16x8*)(qp + 32); }
            const float* gp = GATES + (bt0 + tokc) * 24 + (g * 4 + headc) * 3;
            const float gate0 = gp[0], gate1 = gp[1], gate2 = gp[2];
            f32x4 comb[4];
#pragma unroll
            for (int dt = 0; dt < 4; ++dt) comb[dt] = (f32x4){0.f, 0.f, 0.f, 0.f};
            {
                const int ncvc = tcol >= 31 ? ((tcol - 31) >> 4) + 1 : 0;
                const int ncvmax = (t0 + 3) >= 31 ? ((t0 + 3 - 31) >> 4) + 1 : 0;
                const int nch = (ncvmax + 31) >> 5;
                const bf16_t* Kc = KCB + (size_t)bg * 512 * 64; const bf16_t* Vc = VCT + (size_t)bg * 64 * 512;
                NsaSt st; nsa_init(st);
                {
                    auto ld = [&](NsaBuf& bf, int i) { nsa_load_kf(bf.ka, Kc, i, lane); };
                    auto cp = [&](NsaBuf& bf, int i) { float sv[8]; nsa_scores(bf.ka, qf, sv); nsa_chunk<false>(st, sv, i * 32 + dh, 0, ncvc - 1, bf.va); };
                    nsa_stream2(nch, ld, cp);
                }
                float l = st.l; l += __shfl_xor(l, 16); l += __shfl_xor(l, 32);
                const float inv = 1.0f / fmaxf(l, 1e-30f), mfin = st.m;
                *(float4*)(impL + lane * 8) = make_float4(0.f, 0.f, 0.f, 0.f); *(float4*)(impL + lane * 8 + 4) = make_float4(0.f, 0.f, 0.f, 0.f);
                lds_fence();
                f32x4 oc[4];
#pragma unroll
                for (int dt = 0; dt < 4; ++dt) oc[dt] = (f32x4){0.f, 0.f, 0.f, 0.f};
                float carry = 0.f;
                {
                    auto ld = [&](NsaBuf& bf, int i) { nsa_load_kf(bf.ka, Kc, i, lane); nsa_load_kf(bf.va, Vc, i, lane); };
                    auto cp = [&](NsaBuf& bf, int ch) {
                        float sv[8]; nsa_scores(bf.ka, qf, sv);
                        float p[8];
#pragma unroll
                        for (int j = 0; j < 8; ++j) p[j] = (ch * 32 + dh + j < ncvc) ? __builtin_amdgcn_exp2f(sv[j] - mfin) * inv : 0.f;
                        const float up = __shfl(p[7], (lane + 48) & 63);
                        const float prev7 = (h >= 1) ? up : carry; carry = up;
                        float i0 = p[0] + p[1] + p[2] + 0.5f * p[3] + 0.5f * prev7, i1 = p[4] + p[5] + p[6] + 0.5f * p[7] + 0.5f * p[3];
                        i0 += __shfl_xor(i0, 1); i0 += __shfl_xor(i0, 2); i1 += __shfl_xor(i1, 1); i1 += __shfl_xor(i1, 2);
                        if (headc == 0) { impL[tokc * 128 + 8 * ch + 2 * h] = i0; impL[tokc * 128 + 8 * ch + 2 * h + 1] = i1; }
                        const bf16x8 pb = pack8(p);
#pragma unroll
                        for (int dt = 0; dt < 4; ++dt) oc[dt] = __builtin_amdgcn_mfma_f32_16x16x32_bf16(bf.va[dt], pb, oc[dt], 0, 0, 0);
                    };
                    nsa_stream2(nch, ld, cp);
                }
#pragma unroll
                for (int dt = 0; dt < 4; ++dt) comb[dt] += oc[dt] * gate0;
            }
            lds_fence();
            int nblk;
            {
                const int tok = lane >> 4, sub = lane & 15, cur = t0 >> 6;
                float sc[8];
#pragma unroll
                for (int e = 0; e < 8; ++e) { const int j = sub + 16 * e; const float imp = impL[tok * 128 + j];
                    const bool al = j <= cur, fo = (j == 0) || (j == cur) || (j == cur - 1);
                    sc[e] = (fo && al) ? 1e4f : (al ? imp : -1e30f); }
                unsigned k8[8];
#pragma unroll
                for (int e = 0; e < 8; ++e) k8[e] = key_pack(sc[e], sub + 16 * e);
                bitonic_sort_desc<8>(k8);
                unsigned k16[16];
#pragma unroll
                for (int e = 0; e < 8; ++e) { k16[e] = k8[e]; k16[15 - e] = (unsigned)__shfl_xor((int)k8[e], 1); }
                bitonic_merge_desc<16>(k16);
#pragma unroll
                for (int o = 2; o < 16; o <<= 1) {
                    unsigned pk[16];
#pragma unroll
                    for (int e = 0; e < 16; ++e) pk[e] = (unsigned)__shfl_xor((int)k16[e], o);
#pragma unroll
                    for (int e = 0; e < 16; ++e) k16[e] = k16[e] > pk[15 - e] ? k16[e] : pk[15 - e];
                    bitonic_merge_desc<16>(k16);
                }
                unsigned mk = k16[0];
#pragma unroll
                for (int e = 1; e < 16; ++e) mk = (sub == e) ? k16[e] : mk;
                const float myv = key_val(mk); const int myi = 127 - (int)(mk & 127u);
                const bool forced = myv > 5e3f;
                const bool keep = (myv > -0.5e30f) && !(forced && tok > 0);
                const unsigned long long bal = __ballot(keep);
                const int pos = __popcll(bal & ((1ull << lane) - 1ull));
                lds_fence();
                if (keep) sidxL[pos] = ((forced ? 7 : tok) << 16) | myi;
                nblk = __popcll(bal);
            }
            lds_fence();
            {
                NsaSt8 st; nsa_init8(st);
                const unsigned char* Kp = (const unsigned char*)KS + (size_t)bg * 8192 * 64; const unsigned char* Vp = (const unsigned char*)VST + (size_t)bg * 8192 * 64;
                long qf8[2];
                { const unsigned char* qp = ws + O_Q8 + (bt0 + tokc) * 512 + g * 256 + headc * 64 + dh; qf8[0] = *(const long*)qp; qf8[1] = *(const long*)(qp + 32); }
                const int cur_ = t0 >> 6;
                auto ld = [&](NsaBlk8& bf, int i) { const int e = __builtin_amdgcn_readfirstlane(sidxL[i]); const int chn = (e & 0xffff) * 2; bf.e = e;
                    long t4[4];
                    nsa_load8(t4, Kp, chn, lane); bf.ka[0] = t4[0]; bf.ka[1] = t4[1]; bf.ka[2] = t4[2]; bf.ka[3] = t4[3];
                    nsa_load8(t4, Kp, chn + 1, lane); bf.ka[4] = t4[0]; bf.ka[5] = t4[1]; bf.ka[6] = t4[2]; bf.ka[7] = t4[3];
                    nsa_load8(t4, Vp, chn, lane); bf.va[0] = t4[0]; bf.va[1] = t4[1]; bf.va[2] = t4[2]; bf.va[3] = t4[3];
                    nsa_load8(t4, Vp, chn + 1, lane); bf.va[4] = t4[0]; bf.va[5] = t4[1]; bf.va[6] = t4[2]; bf.va[7] = t4[3]; };
                auto cp = [&](NsaBlk8& bf, int i) { const int e = bf.e; const int blk = e & 0xffff, ow = e >> 16;
                    if (blk == cur_) { const int hi = (ow == 7 || ow == tokc) ? tcol : -1; nsa_block8<2>(st, bf, qf8, blk * 64 + dh, hi, false); }
                    else if (ow == 7) nsa_block8<0>(st, bf, qf8, 0, 0, true);
                    else nsa_block8<1>(st, bf, qf8, 0, 0, ow == tokc); };
                nsa_streamb(nblk, ld, cp);
                nsa_fold8(comb, st, gate1);
            }
            {
                NsaSt st; nsa_init(st);
                const bf16_t* Kp = KW + (size_t)bg * 8192 * 64; const bf16_t* Vp = VWT + (size_t)bg * 8192 * 64;
                const int kbf = (t0 > 511 ? t0 - 511 : 0) & ~31, kbl = (t0 + 3) & ~31;
                const int lo = tcol > 511 ? tcol - 511 : 0;
                auto ld = [&](NsaBuf& bf, int i) { const int kb = kbf + i * 32; nsa_load_kf(bf.ka, Kp, kb >> 5, lane); nsa_load_kf(bf.va, Vp, kb >> 5, lane); };
                auto cp = [&](NsaBuf& bf, int i) { const int kb = kbf + i * 32; float sv[8]; nsa_scores(bf.ka, qf, sv); nsa_chunk<true>(st, sv, kb + dh, lo, tcol, bf.va); };
                nsa_stream2(((kbl - kbf) >> 5) + 1, ld, cp);
                nsa_fold(comb, st, gate2);
            }
            {
                bf16_t* op = ONSA + (bt0 + tokc) * 512 + g * 256 + headc * 64 + 4 * h;
#pragma unroll
                for (int dt = 0; dt < 4; ++dt) store_bf16x4(op + dt * 16, comb[dt][0], comb[dt][1], comb[dt][2], comb[dt][3]);
            }
            lds_fence();
        }
    }
    }
    xcd_barrier(xb);

    { PHASE_BEGIN
    {
        auto unpack8 = [](const u32x4& w, f32x4& a, f32x4& b) { a[0] = __uint_as_float(w.x << 16); a[1] = __uint_as_float(w.x & 0xffff0000u); a[2] = __uint_as_float(w.y << 16); a[3] = __uint_as_float(w.y & 0xffff0000u);
            b[0] = __uint_as_float(w.z << 16); b[1] = __uint_as_float(w.z & 0xffff0000u); b[2] = __uint_as_float(w.w << 16); b[3] = __uint_as_float(w.w & 0xffff0000u); };
        auto e1 = [&](int r, int c, const f32x4& v0, const f32x4& v1) { f32x4 m0, m1; unpack8(*(const u32x4*)(MG + (size_t)r * 2048 + c), m0, m1); store_bf16x8(Y + (size_t)r * 1024 + c, m0 * v0, m1 * v1); };
        big_gemm(smem, ONSA, WNSA, 16384, 1024, 512, e1);
        auto e2 = [&](int r, int c, const f32x4& v0, const f32x4& v1) { f32x4 m0, m1, y0, y1; unpack8(*(const u32x4*)(MG + (size_t)r * 2048 + 1024 + c), m0, m1); unpack8(*(const u32x4*)(Y + (size_t)r * 1024 + c), y0, y1);
            store_bf16x8(Y + (size_t)r * 1024 + c, y0 + m0 * v0, y1 + m1 * v1); };
        big_gemm(smem, OGM, WGM, 16384, 1024, 512, e2);
    }
    }
    xcd_barrier(xb);

    { PHASE_BEGIN
    {
        auto epi = [&](int r, int c, const f32x4& v0, const f32x4& v1) { const float* xp = p.x + (size_t)r * 1024 + c; float* op = OUT + (size_t)r * 1024 + c;
            *(f32x4*)op = *(const f32x4*)xp + v0; *(f32x4*)(op + 4) = *(const f32x4*)(xp + 4) + v1; };
        big_gemm(smem, Y, WMIX, 16384, 1024, 1024, epi);
    }
    }
    xcd_barrier(xb);

    { PHASE_BEGIN
    for (int r = bid * 8 + wave; r < 16384; r += nb * 8) rmsnorm_row_bf16(OUT + (size_t)r * 1024, p.g_xattn, HN + (size_t)r * 1024, lane);
    }
    xcd_barrier(xb);

    { PHASE_BEGIN
    {
        auto epi = [&](int r, int c, const f32x4& v0, const f32x4& v1) { store_bf16x8(QX + (size_t)r * 1024 + c, v0 * 0.0625f, v1 * 0.0625f); };
        big_gemm(smem, HN, WXQ, 16384, 1024, 1024, epi);
    }
    }
    xcd_barrier(xb);

    { PHASE_BEGIN
    {
        const int c = lane & 15, hg = lane >> 4, rk = 8 * (c >> 2) + (c & 3);
        for (int task = bid * 8 + wave; task < 4096; task += nb * 8) {
            const int h = task & 3, tgrp = task >> 2, b = tgrp >> 9; const size_t bt0 = (size_t)tgrp * 16;
            bf16x8 qf[8];
#pragma unroll
            for (int ks = 0; ks < 8; ++ks) qf[ks] = *(const bf16x8*)(QX + (bt0 + c) * 1024 + h * 256 + ks * 32 + 8 * hg);
            const bf16_t* Kp = KVX + (size_t)(b * 4 + h) * 65536; const bf16_t* Vp = VXT + (size_t)(b * 4 + h) * 65536;
            float m = -1e30f, l = 0.f; f32x4 o[16];
#pragma unroll
            for (int dt = 0; dt < 16; ++dt) o[dt] = (f32x4){0.f, 0.f, 0.f, 0.f};
#pragma unroll 1
            for (int ch = 0; ch < 8; ++ch) {
                const int kb = ch * 32;
                const bf16_t* k0 = Kp + ((ch * 16) * 64 + lane) * 8; const bf16_t* k1 = k0 + 8 * 64 * 8;
                f32x4 s0 = {0.f, 0.f, 0.f, 0.f}, s1 = {0.f, 0.f, 0.f, 0.f};
#pragma unroll
                for (int ks = 0; ks < 8; ++ks) {
                    const bf16x8 a0 = *(const bf16x8*)(k0 + ks * 512), a1 = *(const bf16x8*)(k1 + ks * 512);
                    s0 = __builtin_amdgcn_mfma_f32_16x16x32_bf16(a0, qf[ks], s0, 0, 0, 0); s1 = __builtin_amdgcn_mfma_f32_16x16x32_bf16(a1, qf[ks], s1, 0, 0, 0);
                }
                float sv[8] = {s0[0], s0[1], s0[2], s0[3], s1[0], s1[1], s1[2], s1[3]};
                float cm = sv[0];
#pragma unroll
                for (int j = 1; j < 8; ++j) cm = fmaxf(cm, sv[j]);
                cm = fmaxf(cm, __shfl_xor(cm, 16)); cm = fmaxf(cm, __shfl_xor(cm, 32));
                if (__any(cm > m)) { const float mn = fmaxf(m, cm), sc = __expf(m - mn); l *= sc;
#pragma unroll
                    for (int dt = 0; dt < 16; ++dt) o[dt] *= sc;
                    m = mn; }
                float p[8]; float ps = 0.f;
#pragma unroll
                for (int j = 0; j < 8; ++j) { p[j] = __expf(sv[j] - m); ps += p[j]; }
                l += ps;
                const bf16x8 pb = pack8(p);
#pragma unroll
                for (int dt = 0; dt < 16; ++dt) { const bf16x8 va = *(const bf16x8*)(Vp + ((ch * 16 + dt) * 64 + lane) * 8);
                    o[dt] = __builtin_amdgcn_mfma_f32_16x16x32_bf16(va, pb, o[dt], 0, 0, 0); }
            }
            l += __shfl_xor(l, 16); l += __shfl_xor(l, 32);
            const float inv = 1.0f / l;
            bf16_t* op = OX + (bt0 + c) * 1024 + h * 256 + 4 * hg;
#pragma unroll
            for (int dt = 0; dt < 16; ++dt) store_bf16x4(op + dt * 16, o[dt][0] * inv, o[dt][1] * inv, o[dt][2] * inv, o[dt][3] * inv);
        }
    }
    }
    xcd_barrier(xb);

    { PHASE_BEGIN
    {
        auto epi = [&](int r, int c, const f32x4& v0, const f32x4& v1) { float* op = OUT + (size_t)r * 1024 + c; *(f32x4*)op = *(const f32x4*)op + v0; *(f32x4*)(op + 4) = *(const f32x4*)(op + 4) + v1; };
        big_gemm(smem, OX, WXO, 16384, 1024, 1024, epi);
    }
    }
    xcd_barrier(xb);

    { PHASE_BEGIN
    for (int r = bid * 8 + wave; r < 16384; r += nb * 8) rmsnorm_row_bf16(OUT + (size_t)r * 1024, p.g_peer, HN + (size_t)r * 1024, lane);
    {
        for (int row = bid * 8 + wave; row < 32768; row += nb * 8) {
            const bool isv = row >= 16384; const int rr = isv ? row - 16384 : row;
            const float* src = (isv ? p.peer_v : p.peer_u) + (size_t)rr * 1024 + lane * 16;
            float f[16];
#pragma unroll
            for (int i = 0; i < 4; ++i) { const float4 a = *(const float4*)(src + 4 * i); f[4 * i] = a.x; f[4 * i + 1] = a.y; f[4 * i + 2] = a.z; f[4 * i + 3] = a.w; }
            float am = 0.f;
#pragma unroll
            for (int i = 0; i < 16; ++i) am = fmaxf(am, fabsf(f[i]));
            am = wave_max(am);
            int ex = 0; (void)frexpf(am, &ex);
            if (am == 0.f) ex = 8;
            const float sc = ldexpf(1.0f, 8 - ex);
            uint4 w; unsigned* wp = (unsigned*)&w;
#pragma unroll
            for (int i = 0; i < 4; ++i) { int t = 0; t = __builtin_amdgcn_cvt_pk_fp8_f32(f[4 * i] * sc, f[4 * i + 1] * sc, t, false); t = __builtin_amdgcn_cvt_pk_fp8_f32(f[4 * i + 2] * sc, f[4 * i + 3] * sc, t, true); wp[i] = (unsigned)t; }
            *(uint4*)((isv ? PV8 : PU8) + (size_t)rr * 1024 + lane * 16) = w;
            if (lane == 0) PSC[row] = ldexpf(1.0f, ex - 8);
        }
    }
    }
    xcd_barrier(xb);

    { PHASE_BEGIN
    {
        auto epi = [&](int r, int c, const f32x4& v0, const f32x4& v1) { store_bf16x8(QP + (size_t)r * 2048 + c, v0, v1); };
        big_gemm(smem, HN, WPQ, 16384, 2048, 1024, epi);
    }
    }
    xcd_barrier(xb);

    { PHASE_BEGIN
    {
        const int c = lane & 15, hg = lane >> 4;
        for (int task = bid * 8 + wave; task < 16384; task += nb * 8) {
            const int hp = task & 15, tgrp = task >> 4; const size_t bt0 = (size_t)tgrp * 16;
            bf16x8 qf[4];
#pragma unroll
            for (int ks = 0; ks < 4; ++ks) qf[ks] = *(const bf16x8*)(QP + (bt0 + c) * 2048 + hp * 128 + ks * 32 + 8 * hg);
            const bf16_t* Kp = SUBK + (size_t)hp * 16384 + lane * 8;
            float sc[32];
#pragma unroll
            for (int kt = 0; kt < 8; ++kt) {
                f32x4 a = {0.f, 0.f, 0.f, 0.f};
#pragma unroll
                for (int ks = 0; ks < 4; ++ks) a = __builtin_amdgcn_mfma_f32_16x16x32_bf16(*(const bf16x8*)(Kp + (kt * 4 + ks) * 512), qf[ks], a, 0, 0, 0);
                sc[kt * 4 + 0] = a[0]; sc[kt * 4 + 1] = a[1]; sc[kt * 4 + 2] = a[2]; sc[kt * 4 + 3] = a[3];
            }
            unsigned ka_[16], kb_[16];
#pragma unroll
            for (int e = 0; e < 16; ++e) { ka_[e] = key_pack(sc[e], (e >> 2) * 16 + 4 * hg + (e & 3)); kb_[e] = key_pack(sc[16 + e], ((16 + e) >> 2) * 16 + 4 * hg + (e & 3)); }
            bitonic_sort_desc<16>(ka_); bitonic_sort_desc<16>(kb_);
#pragma unroll
            for (int e = 0; e < 16; ++e) ka_[e] = ka_[e] > kb_[15 - e] ? ka_[e] : kb_[15 - e];
            bitonic_merge_desc<16>(ka_);
#pragma unroll
            for (int o = 16; o < 64; o <<= 1) {
#pragma unroll
                for (int e = 0; e < 16; ++e) kb_[e] = (unsigned)__shfl_xor((int)ka_[e], o);
#pragma unroll
                for (int e = 0; e < 16; ++e) ka_[e] = ka_[e] > kb_[15 - e] ? ka_[e] : kb_[15 - e];
                bitonic_merge_desc<16>(ka_);
            }
            if (hg == 0) {
                float* hsp = HS + (bt0 + c) * 256 + hp * 16; int* hip_ = HI + (bt0 + c) * 256 + hp * 16;
#pragma unroll
                for (int e = 0; e < 16; e += 4) {
                    *(float4*)(hsp + e) = make_float4(key_val(ka_[e]), key_val(ka_[e + 1]), key_val(ka_[e + 2]), key_val(ka_[e + 3]));
                    *(int4*)(hip_ + e) = make_int4(127 - (int)(ka_[e] & 127u), 127 - (int)(ka_[e + 1] & 127u), 127 - (int)(ka_[e + 2] & 127u), 127 - (int)(ka_[e + 3] & 127u));
                }
            }
        }
    }
    }
    xcd_barrier(xb);

    { PHASE_BEGIN
    {
        int* exl = (int*)smem + wave * 256; float* gtl = (float*)(exl + 128);
        for (int tok = bid * 8 + wave; tok < 16384; tok += nb * 8) {
#pragma unroll 1
            for (int hh = 0; hh < 2; ++hh) {
                const int head = hh * 4 + (lane >> 4), i = lane & 15, gb = lane & 48;
                const float* s0p = HS + (size_t)tok * 256 + (2 * head) * 16;
                const float s0i = s0p[i], s1m = s0p[16 + i];
                int pj = 0; float myv = 0.f; int myf = 0;
#pragma unroll 1
                for (int it = 0; it < 16; ++it) {
                    const float s1v = __shfl(s1m, gb + (pj & 15));
                    float bv = pj < 16 ? s0i + s1v : -INFINITY; int bf = i * 16 + pj;
#pragma unroll
                    for (int o = 1; o < 16; o <<= 1) { const float ov = __shfl_xor(bv, o); const int of = __shfl_xor(bf, o);
                        const bool take = (ov > bv) || (ov == bv && of < bf); bv = take ? ov : bv; bf = take ? of : bf; }
                    if (i == it) { myv = bv; myf = bf; }
                    if ((bf >> 4) == i) ++pj;
                }
                const float vmax = __shfl(myv, gb);
                const float e = expf(myv - vmax);
                float se = e;
#pragma unroll
                for (int o = 1; o < 16; o <<= 1) se += __shfl_xor(se, o);
                const int* i0p = HI + (size_t)tok * 256 + (2 * head) * 16;
                exl[head * 16 + i] = i0p[myf >> 4] * 128 + i0p[16 + (myf & 15)];
                gtl[head * 16 + i] = e / se;
            }
            lds_fence();
            float xv[16];
            { float t0_[8], t1_[8]; load8(HN + (size_t)tok * 1024 + lane * 16, t0_); load8(HN + (size_t)tok * 1024 + lane * 16 + 8, t1_);
#pragma unroll
              for (int i = 0; i < 8; ++i) { xv[i] = t0_[i]; xv[8 + i] = t1_[i]; } }
#pragma unroll 1
            for (int e0 = 0; e0 < 128; e0 += 16) {
                uint4 ur[16];
#pragma unroll
                for (int q = 0; q < 16; ++q) ur[q] = *(const uint4*)(PU8 + (size_t)exl[e0 + q] * 1024 + lane * 16);
                float d[16];
#pragma unroll
                for (int q = 0; q < 16; ++q) {
                    const unsigned* wp = (const unsigned*)&ur[q]; float a = 0.f;
#pragma unroll
                    for (int i = 0; i < 4; ++i) { const auto lo = __builtin_amdgcn_cvt_pk_f32_fp8((int)wp[i], false); const auto hi = __builtin_amdgcn_cvt_pk_f32_fp8((int)wp[i], true);
                        a += lo[0] * xv[4 * i] + lo[1] * xv[4 * i + 1] + hi[0] * xv[4 * i + 2] + hi[1] * xv[4 * i + 3]; }
                    d[q] = a;
                }
                {
                    const bool u5 = lane & 32, u4 = lane & 16, u3 = lane & 8, u2 = lane & 4;
                    float e8[8], e4[4], e2[2], e1;
#pragma unroll
                    for (int q = 0; q < 8; ++q) { const float keep = u5 ? d[q + 8] : d[q], send = u5 ? d[q] : d[q + 8]; e8[q] = keep + __shfl_xor(send, 32); }
#pragma unroll
                    for (int q = 0; q < 4; ++q) { const float keep = u4 ? e8[q + 4] : e8[q], send = u4 ? e8[q] : e8[q + 4]; e4[q] = keep + __shfl_xor(send, 16); }
#pragma unroll
                    for (int q = 0; q < 2; ++q) { const float keep = u3 ? e4[q + 2] : e4[q], send = u3 ? e4[q] : e4[q + 2]; e2[q] = keep + __shfl_xor(send, 8); }
                    { const float keep = u2 ? e2[1] : e2[0], send = u2 ? e2[0] : e2[1]; e1 = keep + __shfl_xor(send, 4); }
                    e1 += __shfl_xor(e1, 2); e1 += __shfl_xor(e1, 1);
                    if ((lane & 3) == 0) { const int q = ((lane >> 5) & 1) * 8 + ((lane >> 4) & 1) * 4 + ((lane >> 3) & 1) * 2 + ((lane >> 2) & 1);
                        const int ex_ = exl[e0 + q];
                        gtl[e0 + q] = gtl[e0 + q] * gelu_f(e1 * PSC[ex_]) * PSC[16384 + ex_]; }
                }
            }
            lds_fence();
            float ac[16];
#pragma unroll
            for (int i = 0; i < 16; ++i) ac[i] = 0.f;
#pragma unroll 1
            for (int e0 = 0; e0 < 128; e0 += 16) {
                uint4 vr[16];
#pragma unroll
                for (int q = 0; q < 16; ++q) vr[q] = *(const uint4*)(PV8 + (size_t)exl[e0 + q] * 1024 + lane * 16);
#pragma unroll
                for (int q = 0; q < 16; ++q) { const float cf = gtl[e0 + q]; const unsigned* wp = (const unsigned*)&vr[q];
#pragma unroll
                    for (int i = 0; i < 4; ++i) { const auto lo = __builtin_amdgcn_cvt_pk_f32_fp8((int)wp[i], false); const auto hi = __builtin_amdgcn_cvt_pk_f32_fp8((int)wp[i], true);
                        ac[4 * i] += cf * lo[0]; ac[4 * i + 1] += cf * lo[1]; ac[4 * i + 2] += cf * hi[0]; ac[4 * i + 3] += cf * hi[1]; }
                }
            }
            float ss = 0.f;
            {
                float* hp = OUT + (size_t)tok * 1024 + lane * 16;
#pragma unroll
                for (int i = 0; i < 4; ++i) { const float4 hv = *(const float4*)(hp + 4 * i);
                    ac[4 * i] += hv.x; ac[4 * i + 1] += hv.y; ac[4 * i + 2] += hv.z; ac[4 * i + 3] += hv.w; }
#pragma unroll
                for (int i = 0; i < 16; ++i) ss += ac[i] * ac[i];
                ss = wave_sum(ss);
                const float rr = rsqrtf(ss * (1.0f / 1024.0f) + 1e-6f);
#pragma unroll
                for (int i = 0; i < 4; ++i) { const float4 gg = *(const float4*)(p.g_final + lane * 16 + 4 * i);
                    *(float4*)(hp + 4 * i) = make_float4(ac[4 * i] * rr * gg.x, ac[4 * i + 1] * rr * gg.y, ac[4 * i + 2] * rr * gg.z, ac[4 * i + 3] * rr * gg.w); }
            }
            lds_fence();
        }
    }
    }
}

extern "C" void kernel_launch(void* const* d_in, const int* in_sizes, int n_in, void* d_out, int out_size, void* d_ws, size_t ws_size, hipStream_t stream) {
    static int grid_blocks = 0;
    if (grid_blocks == 0) {
        int dev = 0, cus = 0, per_cu = 0;
        hipGetDevice(&dev);
        hipDeviceGetAttribute(&cus, hipDeviceAttributeMultiprocessorCount, dev);
        if (hipFuncSetAttribute((const void*)fwd_mega, hipFuncAttributeMaxDynamicSharedMemorySize, LDS_BYTES) != hipSuccess) { fprintf(stderr, "hipFuncSetAttribute failed\n"); }
        if (hipOccupancyMaxActiveBlocksPerMultiprocessor(&per_cu, (const void*)fwd_mega, NTHREADS, LDS_BYTES) != hipSuccess || per_cu < 1) { fprintf(stderr, "occupancy query failed (%d)\n", per_cu); per_cu = 1; }
        (void)hipGetLastError();
        if (per_cu > 1) per_cu = 1;
        grid_blocks = cus * per_cu;
        if (ws_size < O_END) { fprintf(stderr, "workspace too small: %zu < %zu\n", ws_size, (size_t)O_END); grid_blocks = -1; }
    }
    if (grid_blocks < 0) return;
    Params p{};
    const float** pp = (const float**)&p;
    for (int i = 0; i < 30; ++i) pp[i] = (const float*)d_in[i];
    p.out = (float*)d_out; p.ws = (unsigned char*)d_ws;
    if (hipMemsetAsync((char*)d_ws + O_BAR, 0, 16384, stream) != hipSuccess) { fprintf(stderr, "memset of barrier words failed\n"); return; }
    void* args[] = {&p};
    hipError_t e = hipLaunchKernel((const void*)fwd_mega, dim3(grid_blocks), dim3(NTHREADS), args, LDS_BYTES, stream);
    if (e != hipSuccess) fprintf(stderr, "launch failed: %s (grid %d)\n", hipGetErrorString(e), grid_blocks);
}
```

```cpp
#include <hip/hip_runtime.h>
#include <cstdio>
#include <cstdint>

typedef unsigned short bf16_t;
typedef short bf16x8 __attribute__((ext_vector_type(8)));
typedef float f32x4 __attribute__((ext_vector_type(4)));
#define DEVI __device__ __forceinline__

__device__ __forceinline__ int tid_opaque() { int t = threadIdx.x; asm volatile("" : "+v"(t)); return t; }
constexpr int NTHREADS = 512;
constexpr int LDS_BYTES = 140 * 1024;

constexpr size_t O_BAR  = 0;
constexpr size_t O_WIN  = 16384;
constexpr size_t O_W1K  = O_WIN  + 4480ull * 1024 * 2;
constexpr size_t O_W1V  = O_W1K  + 256ull * 2048 * 2;
constexpr size_t O_WNSA = O_W1V  + 256ull * 2048 * 2;
constexpr size_t O_WGM  = O_WNSA + 1024ull * 512 * 2;
constexpr size_t O_WMIX = O_WGM  + 1024ull * 512 * 2;
constexpr size_t O_WXQ  = O_WMIX + 1024ull * 1024 * 2;
constexpr size_t O_WXKV = O_WXQ  + 1024ull * 1024 * 2;
constexpr size_t O_WXO  = O_WXKV + 2048ull * 1024 * 2;
constexpr size_t O_WPQ  = O_WXO  + 1024ull * 1024 * 2;
constexpr size_t O_B1   = O_WPQ  + 2048ull * 1024 * 2;
constexpr size_t O_VXT  = O_B1   + 2048;
constexpr size_t O_SUBK = O_VXT  + 8ull * 256 * 256 * 2;
constexpr size_t O_PSC  = O_SUBK + 16ull * 128 * 128 * 2;
constexpr size_t O_SS   = O_PSC  + 2ull * 16384 * 4;
constexpr size_t O_HN   = O_SS   + 2ull * 16384 * 4;
constexpr size_t O_MN   = O_HN   + 16384ull * 1024 * 2;
constexpr size_t O_KVX  = O_MN   + 512ull * 1024 * 2;
constexpr size_t O_GATES= O_KVX  + 512ull * 2048 * 2;
constexpr size_t O_HID  = O_GATES+ 16384ull * 24 * 4;
constexpr size_t O_CMP  = O_HID  + 2ull * 2048 * 256 * 4;
constexpr size_t O_Q    = O_CMP  + 2ull * 4 * 512 * 64 * 4;
constexpr size_t O_KV6  = O_Q    + 16384ull * 512 * 2;
constexpr size_t O_U    = O_KV6  + 6ull * 16384 * 128 * 2;
constexpr size_t O_VG   = O_U    + 16384ull * 512 * 2;
constexpr size_t O_MG   = O_VG   + 16384ull * 512 * 2;
constexpr size_t O_ONSA = O_MG   + 16384ull * 2048 * 2;
constexpr size_t O_OGM  = O_ONSA + 16384ull * 512 * 2;
constexpr size_t O_Q8   = O_OGM  + 16384ull * 512 * 2;
constexpr size_t O_END  = O_Q8   + 16384ull * 512;
constexpr size_t O_Y    = O_Q;
constexpr size_t O_QX   = O_U;
constexpr size_t O_OX   = O_ONSA;
constexpr size_t O_QP   = O_MG;
constexpr size_t O_HS   = O_Q;
constexpr size_t O_HI   = O_Q + 16384ull * 256 * 4;
constexpr size_t O_EX   = O_U;
static_assert(O_END <= 256ull * 1024 * 1024, "workspace too large");

struct Params {
    const float *x, *mem, *g_mix, *w_in, *pe_k, *w1_k, *b1_k, *w2_k, *pe_v, *w1_v, *b1_v, *w2_v, *ln_g, *ln_b, *gws, *gbs,
        *w_nsa_out, *w_gmlp_out, *w_mix_out, *g_xattn, *g_mem, *w_xq, *w_xkv, *w_xo, *g_peer, *w_peer_q, *sub_keys, *peer_u, *peer_v, *g_final;
    float* out;
    unsigned char* ws;
};

DEVI bf16_t f2bf(float f) { unsigned u = __float_as_uint(f); u += 0x7fffu + ((u >> 16) & 1u); return (bf16_t)(u >> 16); }
DEVI float bf2f(bf16_t h) { return __uint_as_float(((unsigned)h) << 16); }
DEVI float tof(float v) { return v; }
DEVI float tof(bf16_t v) { return bf2f(v); }
DEVI float wave_sum(float v);
DEVI float wave_max(float v);

DEVI float xmax16(float x) { const auto r = __builtin_amdgcn_permlane16_swap(__float_as_uint(x), __float_as_uint(x), false, false); return fmaxf(__uint_as_float(r[0]), __uint_as_float(r[1])); }
DEVI float xmax32(float x) { const auto r = __builtin_amdgcn_permlane32_swap(__float_as_uint(x), __float_as_uint(x), false, false); return fmaxf(__uint_as_float(r[0]), __uint_as_float(r[1])); }
DEVI float xsum16(float x) { const auto r = __builtin_amdgcn_permlane16_swap(__float_as_uint(x), __float_as_uint(x), false, false); return __uint_as_float(r[0]) + __uint_as_float(r[1]); }
DEVI float xsum32(float x) { const auto r = __builtin_amdgcn_permlane32_swap(__float_as_uint(x), __float_as_uint(x), false, false); return __uint_as_float(r[0]) + __uint_as_float(r[1]); }
DEVI unsigned xchg16(unsigned x, int lane) { const auto r = __builtin_amdgcn_permlane16_swap(x, x, false, false); return (lane & 16) ? r[0] : r[1]; }
DEVI unsigned xchg32(unsigned x, int lane) { const auto r = __builtin_amdgcn_permlane32_swap(x, x, false, false); return (lane & 32) ? r[0] : r[1]; }
DEVI float wave_sum(float v) { v = xsum32(v); v = xsum16(v); for (int o = 8; o > 0; o >>= 1) v += __shfl_xor(v, o); return v; }
DEVI float wave_max(float v) { v = xmax32(v); v = xmax16(v); for (int o = 8; o > 0; o >>= 1) v = fmaxf(v, __shfl_xor(v, o)); return v; }
DEVI float gelu_f(float x) { return 0.5f * x * (1.0f + erff(x * 0.70710678118654752f)); }
DEVI float sigmoid_f(float x) { return 1.0f / (1.0f + expf(-x)); }
DEVI void wave_argmax(float& v, int& idx) {
    for (int o = 32; o > 0; o >>= 1) {
        const float ov = __shfl_xor(v, o); const int oi = __shfl_xor(idx, o);
        const bool take = (ov > v) || (ov == v && oi < idx);
        v = take ? ov : v; idx = take ? oi : idx;
    }
}
typedef unsigned u32x4 __attribute__((ext_vector_type(4)));
DEVI unsigned cvt_pk_bf16(float lo, float hi) { unsigned r; asm("v_cvt_pk_bf16_f32 %0, %1, %2" : "=v"(r) : "v"(lo), "v"(hi)); return r; }
DEVI bf16x8 pack8(const float (&p)[8]) { u32x4 u; u.x = cvt_pk_bf16(p[0], p[1]); u.y = cvt_pk_bf16(p[2], p[3]); u.z = cvt_pk_bf16(p[4], p[5]); u.w = cvt_pk_bf16(p[6], p[7]); return __builtin_bit_cast(bf16x8, u); }
DEVI void lds_fence() { asm volatile("s_waitcnt lgkmcnt(0)" ::: "memory"); }
DEVI void load8(const float* p, float (&f)[8]) { const float4 a = *(const float4*)p, b = *(const float4*)(p + 4); f[0]=a.x; f[1]=a.y; f[2]=a.z; f[3]=a.w; f[4]=b.x; f[5]=b.y; f[6]=b.z; f[7]=b.w; }
DEVI void load8(const bf16_t* p, float (&f)[8]) { const uint4 a = *(const uint4*)p;
    f[0] = __uint_as_float(a.x << 16); f[1] = __uint_as_float(a.x & 0xffff0000u); f[2] = __uint_as_float(a.y << 16); f[3] = __uint_as_float(a.y & 0xffff0000u);
    f[4] = __uint_as_float(a.z << 16); f[5] = __uint_as_float(a.z & 0xffff0000u); f[6] = __uint_as_float(a.w << 16); f[7] = __uint_as_float(a.w & 0xffff0000u); }

template <class CMap>
DEVI void transpose_tile(const float* src, int srcN, bf16_t* dst, int K, int tl, CMap cmap, float* tile, const float* kscale = nullptr) {
    const int nkt = K / 64, kt = tl % nkt, nt = tl / nkt, k0 = kt * 64, n0 = nt * 64;
    const int tidq = tid_opaque(), tx = tidq & 63, ty = tidq >> 6;
    const int sc = cmap(n0 + tx);
#pragma unroll
    for (int i = 0; i < 8; ++i) { const int k = k0 + ty + 8 * i; tile[(ty + 8 * i) * 65 + tx] = sc >= 0 ? src[(size_t)k * srcN + sc] * (kscale ? kscale[k] : 1.0f) : 0.f; }
    __syncthreads();
#pragma unroll
    for (int i = 0; i < 8; ++i) { const int n = n0 + ty + 8 * i; dst[(size_t)n * K + k0 + tx] = f2bf(tile[tx * 65 + ty + 8 * i]); }
    __syncthreads();
}

template <class CMap>
DEVI void transpose_wave(const float* src, int srcN, bf16_t* dst, int K, int tl, CMap cmap, int lane, const float* kscale = nullptr) {
    const int nkt = K / 64, kt = tl % nkt, nt = tl / nkt, k0 = kt * 64, n = nt * 64 + lane;
    const int sc = cmap(n);
    const float* sp = src + (size_t)k0 * srcN + (sc >= 0 ? sc : 0);
    float v[64];
#pragma unroll
    for (int i = 0; i < 64; ++i) v[i] = sp[(size_t)i * srcN];
    if (kscale) {
#pragma unroll
        for (int i = 0; i < 64; ++i) v[i] *= kscale[k0 + i];
    }
    if (sc < 0) {
#pragma unroll
        for (int i = 0; i < 64; ++i) v[i] = 0.f;
    }
    bf16_t* dp = dst + (size_t)n * K + k0;
#pragma unroll
    for (int i = 0; i < 64; i += 8) { u32x4 w; w.x = cvt_pk_bf16(v[i], v[i + 1]); w.y = cvt_pk_bf16(v[i + 2], v[i + 3]); w.z = cvt_pk_bf16(v[i + 4], v[i + 5]); w.w = cvt_pk_bf16(v[i + 6], v[i + 7]); *(u32x4*)(dp + i) = w; }
}
struct IdMap { DEVI int operator()(int n) const { return n; } };
struct WinMap { DEVI int operator()(int n) const { return n < 1280 ? n : (n < 4352 ? n + 24 : (n < 4376 ? n - 4352 + 1280 : -1)); } };

DEVI void rmsnorm_row_bf16(const float* xrow, const float* g, bf16_t* dst, int lane) {
    float4 v[4]; float ss = 0.f;
#pragma unroll
    for (int i = 0; i < 4; ++i) { v[i] = ((const float4*)xrow)[lane + 64 * i]; ss += v[i].x * v[i].x + v[i].y * v[i].y + v[i].z * v[i].z + v[i].w * v[i].w; }
    ss = wave_sum(ss);
    const float r = rsqrtf(ss * (1.0f / 1024.0f) + 1e-6f);
#pragma unroll
    for (int i = 0; i < 4; ++i) {
        const float4 gg = ((const float4*)g)[lane + 64 * i];
        uint2 w; w.x = (unsigned)f2bf(v[i].x * r * gg.x) | ((unsigned)f2bf(v[i].y * r * gg.y) << 16); w.y = (unsigned)f2bf(v[i].z * r * gg.z) | ((unsigned)f2bf(v[i].w * r * gg.w) << 16);
        ((uint2*)dst)[lane + 64 * i] = w;
    }
}

constexpr int G_LD = 72;
template <class AF>
DEVI void gemm_tile(f32x4 (&acc)[4][2], AF af, int m0, const bf16_t* Bt, int ldb, int K, bf16_t* As, bf16_t* Bs) {
    const int tid = tid_opaque(), lane = tid & 63, wave = tid >> 6, wm = wave >> 2, wn = wave & 3;
    const int r0 = tid >> 3, kc = (tid & 7) * 8;
    uint4 ra0, ra1, rb0, rb1;
    ra0 = *(const uint4*)af(m0 + r0, kc); ra1 = *(const uint4*)af(m0 + r0 + 64, kc);
    rb0 = *(const uint4*)(Bt + (size_t)r0 * ldb + kc); rb1 = *(const uint4*)(Bt + (size_t)(r0 + 64) * ldb + kc);
    for (int k0 = 0; k0 < K; k0 += 64) {
        __syncthreads();
        *(uint4*)(As + r0 * G_LD + kc) = ra0; *(uint4*)(As + (r0 + 64) * G_LD + kc) = ra1;
        *(uint4*)(Bs + r0 * G_LD + kc) = rb0; *(uint4*)(Bs + (r0 + 64) * G_LD + kc) = rb1;
        __syncthreads();
        if (k0 + 64 < K) {
            const int kn = k0 + 64 + kc;
            ra0 = *(const uint4*)af(m0 + r0, kn); ra1 = *(const uint4*)af(m0 + r0 + 64, kn);
            rb0 = *(const uint4*)(Bt + (size_t)r0 * ldb + kn); rb1 = *(const uint4*)(Bt + (size_t)(r0 + 64) * ldb + kn);
        }
#pragma unroll
        for (int ks = 0; ks < 2; ++ks) {
            bf16x8 af_[4], bf_[2];
#pragma unroll
            for (int i = 0; i < 4; ++i) af_[i] = *(const bf16x8*)(As + (wm * 64 + i * 16 + (lane & 15)) * G_LD + ks * 32 + (lane >> 4) * 8);
#pragma unroll
            for (int j = 0; j < 2; ++j) bf_[j] = *(const bf16x8*)(Bs + (wn * 32 + j * 16 + (lane & 15)) * G_LD + ks * 32 + (lane >> 4) * 8);
#pragma unroll
            for (int i = 0; i < 4; ++i)
#pragma unroll
                for (int j = 0; j < 2; ++j) acc[i][j] = __builtin_amdgcn_mfma_f32_16x16x32_bf16(bf_[j], af_[i], acc[i][j], 0, 0, 0);
        }
    }
}
struct RowMajorA { const bf16_t* A; int lda; DEVI const bf16_t* operator()(int row, int k) const { return A + (size_t)row * lda + k; } };
struct CmpA { const bf16_t* KC; int koff;
    DEVI const bf16_t* operator()(int row, int k_) const { const int k = k_ + koff; const int rr = row < 2044 ? row : 2043; const int b = rr / 1022, rem = rr - b * 1022, c = rem >> 1, g = rem & 1;
        return KC + ((size_t)(b * 8192 + 16 * c + (k >> 6)) * 128 + g * 64 + (k & 63)); } };

template <class AF, class Epi>
DEVI void gemm_run(AF af, const bf16_t* Bt, int K, int MT, int NT, Epi epi, unsigned char* smem, int bid, int nb) {
    bf16_t* As = (bf16_t*)smem; bf16_t* Bs = As + 128 * G_LD;
    const int tidq = tid_opaque(), lane = tidq & 63, wave = tidq >> 6, wm = wave >> 2, wn = wave & 3;
    for (int t = bid; t < MT * NT; t += nb) {
        const int mt = t / NT, nt = t % NT;
        f32x4 acc[4][2];
#pragma unroll
        for (int i = 0; i < 4; ++i)
#pragma unroll
            for (int j = 0; j < 2; ++j) acc[i][j] = (f32x4){0.f, 0.f, 0.f, 0.f};
        gemm_tile(acc, af, mt * 128, Bt + (size_t)nt * 128 * K, K, K, As, Bs);
#pragma unroll
        for (int i = 0; i < 4; ++i)
#pragma unroll
            for (int j = 0; j < 2; ++j) epi(mt * 128 + wm * 64 + i * 16 + (lane & 15), nt * 128 + wn * 32 + j * 16 + (lane >> 4) * 4, acc[i][j]);
    }
}
DEVI void store_bf16x4(bf16_t* p, float a, float b, float c, float d) { uint2 w; w.x = (unsigned)f2bf(a) | ((unsigned)f2bf(b) << 16); w.y = (unsigned)f2bf(c) | ((unsigned)f2bf(d) << 16); *(uint2*)p = w; }

namespace pg8 {
#define PG8_LAS __attribute__((address_space(3)))
typedef unsigned short bf16_t;
typedef short bf16x8 __attribute__((ext_vector_type(8)));
typedef float f32x4 __attribute__((ext_vector_type(4)));
typedef unsigned u32x4 __attribute__((ext_vector_type(4)));
constexpr int BM = 256, BK = 64, HALF = 128, HTB = HALF * BK * 2  , STAGE_BYTES = 8 * HTB, NXCD = 8, WGM = 8;

__host__ __device__ __forceinline__ int lds_byte(int r, int c) { const int st = (r >> 4) * 2 + (c >> 5), rr = r & 15, cc = c & 31, ob = rr * 64 + cc * 2; return st * 1024 + (ob ^ (((ob >> 9) & 1) << 5)); }
__host__ __device__ __forceinline__ void stage_rc(int b, int& R, int& C) { const int st = b / 1024, sb = b % 1024, swz = sb ^ (((sb >> 9) & 1) << 5); R = (st >> 1) * 16 + swz / 64; C = (st & 1) * 32 + (swz % 64) / 2; }
__host__ __device__ __forceinline__ int perm32(int rho) { const int n = rho >> 4, i = rho & 15; return 8 * (i >> 2) + 4 * n + (i & 3); }

struct Unit { int pm, pn; };
struct Gemm { const bf16_t* A; const bf16_t* Bt; int M, N, K; };

struct StaticOrder {
    int nM, nN, nwg, G, c;
    __host__ __device__ void init(int M, int N, int G_, int c_) { nM = M / BM; nN = N / BM; nwg = nM * nN; G = G_; c = c_; }
    __host__ __device__ bool next(int i, Unit& u) const {
        const long L = (long)i * G + c; if (L >= nwg) return false;
        int wgid = (int)L; { const int q = nwg / NXCD, r = nwg % NXCD, xcd = wgid % NXCD, off = wgid / NXCD; wgid = (xcd < r ? xcd * (q + 1) : r * (q + 1) + (xcd - r) * q) + off; }
        const int nig = WGM * nN, gid = wgid / nig, fm = gid * WGM, gsz = (nM - fm) < WGM ? (nM - fm) : WGM;
        u.pm = fm + ((wgid % nig) % gsz); u.pn = (wgid % nig) / gsz; return true;
    }
    __device__ __forceinline__ void a_ready(const Unit&) const {}
    __device__ __forceinline__ void done(const Unit&) const {}
};

template <class Epi, class Sched, bool ALIGN_EPI = false, bool SP2 = false>
__device__ __forceinline__ void gemm_phase(PG8_LAS unsigned char* lds, const Gemm g, const Sched& S, const Epi& E) {
    const int tid = tid_opaque(), wid = __builtin_amdgcn_readfirstlane(tid >> 6), lane = tid & 63, wr = wid >> 2, wc = wid & 3, fr = lane & 15, fq = lane >> 4;
    const int K = g.K, nt = K / BK;
    unsigned voffA[2], voffB[2];
#pragma unroll
    for (int i = 0; i < 2; ++i) { int R, C; stage_rc(tid * 16 + i * 8192, R, C); const int Rb = Epi::PERM ? ((R & ~31) + perm32(R & 31)) : R;
        voffA[i] = (unsigned)(R * K + C) * 2u; voffB[i] = (unsigned)(Rb * K + C) * 2u; }
    const size_t kstep = (size_t)(BK * 2);
    const size_t hstep = (size_t)HALF * K * 2;
    const size_t tstep = 2 * hstep;
    const unsigned ldsw = (unsigned)wid * 1024u;
    const int aoff = lds_byte(wr * 64 + fr, fq * 8), boff = lds_byte(wc * 32 + fr, fq * 8);
#define PG8_SA(b, h) (((b) * 2 + (h)) * HTB)
#define PG8_SB(b, h) ((4 + (b) * 2 + (h)) * HTB)
#define PG8_STAGE(bufoff, gbase, voff) do { _Pragma("unroll") for (int _i = 0; _i < 2; ++_i) \
        __builtin_amdgcn_global_load_lds((const unsigned*)((const char*)(gbase) + (voff)[_i]), (PG8_LAS unsigned*)(lds + (bufoff) + ldsw + _i * 8192), 16, 0, 0); } while (0)
#define PG8_LDA(dst, b, h) do { _Pragma("unroll") for (int m = 0; m < 4; ++m) _Pragma("unroll") for (int k = 0; k < 2; ++k) dst[m][k] = *(const PG8_LAS bf16x8*)(lds + PG8_SA(b, h) + aoff + m * 2048 + k * 1024); } while (0)
#define PG8_LDB(dst, b, h) do { _Pragma("unroll") for (int n = 0; n < 2; ++n) _Pragma("unroll") for (int k = 0; k < 2; ++k) dst[n][k] = *(const PG8_LAS bf16x8*)(lds + PG8_SB(b, h) + boff + n * 2048 + k * 1024); } while (0)
#define PG8_MMA(ai, bj, At, Bt) do { __builtin_amdgcn_s_setprio(1); _Pragma("unroll") for (int m = 0; m < 4; ++m) _Pragma("unroll") for (int n = 0; n < 2; ++n) _Pragma("unroll") for (int k = 0; k < 2; ++k) \
        acc[ai][bj][m][n] = __builtin_amdgcn_mfma_f32_16x16x32_bf16(Bt[n][k], At[m][k], acc[ai][bj][m][n], 0, 0, 0); __builtin_amdgcn_s_setprio(0); } while (0)
#define PG8_WAIT_V(n) asm volatile("s_waitcnt vmcnt(" #n ")" ::: "memory")
#define PG8_WAIT_L(n) asm volatile("s_waitcnt lgkmcnt(" #n ")" ::: "memory")
#define PG8_BAR __builtin_amdgcn_s_barrier()
#define PG8_SCHED __builtin_amdgcn_sched_barrier(0)
    Unit cur, nxt; int ui = 0;
    if (!S.next(0, cur)) return;
    f32x4 acc[2][2][4][2];
#pragma unroll
    for (int a = 0; a < 2; ++a)
#pragma unroll
        for (int b = 0; b < 2; ++b)
#pragma unroll
            for (int m = 0; m < 4; ++m)
#pragma unroll
                for (int n = 0; n < 2; ++n) acc[a][b][m][n] = (f32x4){0.f, 0.f, 0.f, 0.f};
    bf16x8 At[4][2], B0[2][2], B1[2][2];
    const char* cA = (const char*)g.A + (size_t)cur.pm * tstep; const char* cB = (const char*)g.Bt + (size_t)cur.pn * tstep;
    S.a_ready(cur);
    if constexpr (SP2) {
        PG8_STAGE(PG8_SB(0, 0), cB, voffB); PG8_STAGE(PG8_SB(0, 1), cB + hstep, voffB); PG8_STAGE(PG8_SA(0, 0), cA, voffA); PG8_STAGE(PG8_SA(0, 1), cA + hstep, voffA);
        if (wr == 1) PG8_BAR;
        PG8_WAIT_V(2); PG8_BAR;
        PG8_STAGE(PG8_SB(1, 0), cB + kstep, voffB); PG8_STAGE(PG8_SA(1, 0), cA + kstep, voffA); PG8_STAGE(PG8_SB(1, 1), cB + hstep + kstep, voffB);
        PG8_WAIT_V(6); PG8_BAR;
    } else {
        PG8_STAGE(PG8_SB(0, 0), cB, voffB); PG8_STAGE(PG8_SA(0, 0), cA, voffA); PG8_STAGE(PG8_SB(0, 1), cB + hstep, voffB); PG8_STAGE(PG8_SA(0, 1), cA + hstep, voffA);
        if (wr == 1) PG8_BAR;
        PG8_WAIT_V(4); PG8_BAR;
        PG8_STAGE(PG8_SB(1, 0), cB + kstep, voffB); PG8_STAGE(PG8_SA(1, 0), cA + kstep, voffA); PG8_STAGE(PG8_SB(1, 1), cB + hstep + kstep, voffB);
        PG8_WAIT_V(6); PG8_BAR;
    }
    for (;;) {
        const bool has_next = S.next(ui + 1, nxt);
        const char* nA = has_next ? (const char*)g.A + (size_t)nxt.pm * tstep : cA; const char* nB = has_next ? (const char*)g.Bt + (size_t)nxt.pn * tstep : cB;
        for (int t = 0; t < nt; t += 2) {
            const bool last = (t == nt - 2);
            const char* a1 = cA + (size_t)(t + 1) * kstep;
            const char* a2 = last ? nA : cA + (size_t)(t + 2) * kstep; const char* b2 = last ? nB : cB + (size_t)(t + 2) * kstep;
            const char* a3 = a2 + kstep; const char* b3 = b2 + kstep;
            if (last && has_next) S.a_ready(nxt);
            if constexpr (SP2) {
            PG8_LDB(B0, 0, 0); PG8_LDB(B1, 0, 1); PG8_SCHED; PG8_LDA(At, 0, 0); PG8_STAGE(PG8_SA(1, 1), a1 + hstep, voffA);
            PG8_WAIT_V(8); PG8_WAIT_L(0); PG8_BAR; PG8_MMA(0, 0, At, B0); PG8_MMA(0, 1, At, B1); PG8_BAR; PG8_SCHED;
            PG8_LDA(At, 0, 1); PG8_STAGE(PG8_SB(0, 0), b2, voffB); PG8_STAGE(PG8_SB(0, 1), b2 + hstep, voffB); PG8_STAGE(PG8_SA(0, 0), a2, voffA);
            PG8_WAIT_V(8); PG8_WAIT_L(0); PG8_BAR; PG8_MMA(1, 0, At, B0); PG8_MMA(1, 1, At, B1); PG8_BAR; PG8_SCHED;
            PG8_LDB(B0, 1, 0); PG8_LDB(B1, 1, 1); PG8_SCHED; PG8_LDA(At, 1, 0); PG8_STAGE(PG8_SA(0, 1), a2 + hstep, voffA);
            PG8_WAIT_V(8); PG8_WAIT_L(0); PG8_BAR; PG8_MMA(0, 0, At, B0); PG8_MMA(0, 1, At, B1); PG8_BAR; PG8_SCHED;
            PG8_LDA(At, 1, 1); PG8_STAGE(PG8_SB(1, 0), b3, voffB); PG8_STAGE(PG8_SB(1, 1), b3 + hstep, voffB); PG8_STAGE(PG8_SA(1, 0), a3, voffA);
            PG8_WAIT_V(8); PG8_WAIT_L(0); PG8_BAR; PG8_MMA(1, 0, At, B0); PG8_MMA(1, 1, At, B1); PG8_BAR; PG8_SCHED;
            } else {
            PG8_LDB(B0, 0, 0); PG8_SCHED; PG8_LDA(At, 0, 0); PG8_STAGE(PG8_SA(1, 1), a1 + hstep, voffA);
            PG8_WAIT_L(8); PG8_BAR; PG8_WAIT_L(0); PG8_MMA(0, 0, At, B0); PG8_BAR; PG8_SCHED;
            PG8_LDB(B1, 0, 1); PG8_STAGE(PG8_SB(0, 0), b2, voffB);
            PG8_BAR; PG8_WAIT_L(0); PG8_MMA(0, 1, At, B1); PG8_BAR;
            PG8_LDA(At, 0, 1); PG8_STAGE(PG8_SA(0, 0), a2, voffA);
            PG8_BAR; PG8_WAIT_L(0); PG8_MMA(1, 0, At, B0); PG8_BAR; PG8_SCHED;
            PG8_STAGE(PG8_SB(0, 1), b2 + hstep, voffB);
            PG8_WAIT_V(6); PG8_BAR; PG8_MMA(1, 1, At, B1); PG8_BAR;
            PG8_LDB(B0, 1, 0); PG8_SCHED; PG8_LDA(At, 1, 0); PG8_STAGE(PG8_SA(0, 1), a2 + hstep, voffA);
            PG8_WAIT_L(8); PG8_BAR; PG8_WAIT_L(0); PG8_MMA(0, 0, At, B0); PG8_BAR; PG8_SCHED;
            PG8_LDB(B1, 1, 1); PG8_STAGE(PG8_SB(1, 0), b3, voffB);
            PG8_BAR; PG8_WAIT_L(0); PG8_MMA(0, 1, At, B1); PG8_BAR;
            PG8_LDA(At, 1, 1); PG8_STAGE(PG8_SA(1, 0), a3, voffA);
            PG8_BAR; PG8_WAIT_L(0); PG8_MMA(1, 0, At, B0); PG8_BAR; PG8_SCHED;
            PG8_STAGE(PG8_SB(1, 1), b3 + hstep, voffB);
            PG8_WAIT_V(6); PG8_BAR; PG8_MMA(1, 1, At, B1); PG8_BAR;
            }
        }
        if constexpr (ALIGN_EPI) { if (wr == 0) PG8_BAR; }
        if constexpr (!Epi::AFTER_DRAIN) { E(acc, cur, wr, wc, fr, fq); S.done(cur); }
        if (!has_next) break;
#pragma unroll
        for (int a = 0; a < 2; ++a)
#pragma unroll
            for (int b = 0; b < 2; ++b)
#pragma unroll
                for (int m = 0; m < 4; ++m)
#pragma unroll
                    for (int n = 0; n < 2; ++n) acc[a][b][m][n] = (f32x4){0.f, 0.f, 0.f, 0.f};
        cur = nxt; cA = nA; cB = nB; ++ui;
        if constexpr (ALIGN_EPI) { if (wr == 1) PG8_BAR; }
    }
    PG8_WAIT_V(0);
    if constexpr (!ALIGN_EPI) { if (wr == 0) PG8_BAR; }
    PG8_BAR;
    if constexpr (Epi::AFTER_DRAIN) { E.fused(acc, cur, wr, wc, fr, fq, lds, wid, lane); S.done(cur); }
#undef PG8_SA
#undef PG8_SB
#undef PG8_STAGE
#undef PG8_LDA
#undef PG8_LDB
#undef PG8_MMA
#undef PG8_WAIT_V
#undef PG8_WAIT_L
#undef PG8_BAR
#undef PG8_SCHED
}
}

template <class F> struct EpiFn {
    static constexpr bool PERM = true, AFTER_DRAIN = false;
    F f;
    DEVI void operator()(const f32x4 (&acc)[2][2][4][2], const pg8::Unit& u, int wr, int wc, int fr, int fq) const {
#pragma unroll
        for (int ai = 0; ai < 2; ++ai)
#pragma unroll
            for (int m = 0; m < 4; ++m) {
                const int row = u.pm * 256 + ai * 128 + wr * 64 + m * 16 + fr;
#pragma unroll
                for (int bj = 0; bj < 2; ++bj) { f(row, u.pn * 256 + bj * 128 + wc * 32 + 8 * fq, acc[ai][bj][m][0], acc[ai][bj][m][1]); __builtin_amdgcn_sched_barrier(0); }
            }
    }
};
template <class F> DEVI EpiFn<F> make_epi(F f) { return EpiFn<F>{f}; }
template <class F>
DEVI void big_gemm(unsigned char* smem, const bf16_t* A, const bf16_t* Bt, int M, int N, int K, F f) {
    pg8::StaticOrder S; S.init(M, N, (int)gridDim.x, (int)blockIdx.x);
    const pg8::Gemm g{A, Bt, M, N, K};
    const auto E = make_epi(f);
    pg8::gemm_phase<EpiFn<F>, pg8::StaticOrder, true, true>((PG8_LAS unsigned char*)smem, g, S, E);
}
DEVI void store_bf16x8(bf16_t* p, const f32x4& a, const f32x4& b) { u32x4 w; w.x = cvt_pk_bf16(a[0], a[1]); w.y = cvt_pk_bf16(a[2], a[3]); w.z = cvt_pk_bf16(b[0], b[1]); w.w = cvt_pk_bf16(b[2], b[3]); *(u32x4*)p = w; }

template <int DH, int R, int NCH, bool PSUM, typename KT, class RowF>
DEVI void attend(const float* qs, float* pl, float* psum, const KT* Kb, const KT* Vb, size_t stride, RowF rowf, float (&o)[R][DH / 64], int lane) {
    float m[R], l[R];
#pragma unroll
    for (int r = 0; r < R; ++r) { m[r] = -1e30f; l[r] = 0.f; }
#pragma unroll 1
    for (int i = 0; i < NCH; ++i) {
        bool valid; const long row = rowf(i, lane, valid);
        if (__ballot(valid) == 0ull) continue;
        const KT* kp = Kb + (size_t)row * stride;
        float a[R];
#pragma unroll
        for (int r = 0; r < R; ++r) a[r] = 0.f;
#pragma unroll 2
        for (int d0 = 0; d0 < DH; d0 += 8) {
            float kf[8]; load8(kp + d0, kf);
#pragma unroll
            for (int r = 0; r < R; ++r) {
                const float4 q0 = *(const float4*)(qs + r * DH + d0), q1 = *(const float4*)(qs + r * DH + d0 + 4);
                a[r] += kf[0] * q0.x + kf[1] * q0.y + kf[2] * q0.z + kf[3] * q0.w + kf[4] * q1.x + kf[5] * q1.y + kf[6] * q1.z + kf[7] * q1.w;
            }
        }
#pragma unroll
        for (int r = 0; r < R; ++r) {
            const float sv = valid ? a[r] : -1e30f;
            const float mn = fmaxf(m[r], wave_max(sv));
            const float pe = valid ? expf(sv - mn) : 0.f;
            l[r] = l[r] * expf(m[r] - mn) + wave_sum(pe);
            m[r] = mn;
        }
    }
    float inv[R];
#pragma unroll
    for (int r = 0; r < R; ++r) inv[r] = 1.0f / fmaxf(l[r], 1e-30f);
#pragma unroll 1
    for (int i = 0; i < NCH; ++i) {
        bool valid; const long row = rowf(i, lane, valid);
        const bool any = __ballot(valid) != 0ull;
        float a[R];
#pragma unroll
        for (int r = 0; r < R; ++r) a[r] = 0.f;
        if (any) {
            const KT* kp = Kb + (size_t)row * stride;
#pragma unroll 2
            for (int d0 = 0; d0 < DH; d0 += 8) {
                float kf[8]; load8(kp + d0, kf);
#pragma unroll
                for (int r = 0; r < R; ++r) {
                    const float4 q0 = *(const float4*)(qs + r * DH + d0), q1 = *(const float4*)(qs + r * DH + d0 + 4);
                    a[r] += kf[0] * q0.x + kf[1] * q0.y + kf[2] * q0.z + kf[3] * q0.w + kf[4] * q1.x + kf[5] * q1.y + kf[6] * q1.z + kf[7] * q1.w;
                }
            }
        }
        float ps = 0.f;
#pragma unroll
        for (int r = 0; r < R; ++r) { const float pv = valid ? expf(a[r] - m[r]) * inv[r] : 0.f; pl[r * 64 + lane] = pv; ps += pv; }
        if (PSUM) psum[i * 64 + lane] = ps;
        lds_fence();
        if (any) {
#pragma unroll 2
            for (int key = 0; key < 64; ++key) {
                bool dummy; const long vrow = rowf(i, key, dummy);
                const KT* vp = Vb + (size_t)vrow * stride;
                float pr[R];
#pragma unroll
                for (int r = 0; r < R; ++r) pr[r] = pl[r * 64 + key];
#pragma unroll
                for (int j = 0; j < DH / 64; ++j) { const float v = tof(vp[lane + 64 * j]);
#pragma unroll
                    for (int r = 0; r < R; ++r) o[r][j] += pr[r] * v; }
            }
        }
        lds_fence();
    }
}


DEVI int nsa_koff(int t, int d) { return ((((t >> 5) * 4 + (((t >> 2) & 1) * 2 + (d >> 5))) * 64) + ((((t & 31) >> 3) << 2) | (t & 3)) + 16 * ((d >> 3) & 3)) * 8 + (d & 7); }
DEVI int nsa_voff(int t, int d) { return ((((t >> 5) * 4 + (d >> 4)) * 64) + (d & 15) + 16 * ((t & 31) >> 3)) * 8 + (t & 7); }
DEVI int xat_koff(int m, int d) { return ((((m >> 5) * 16 + ((m >> 2) & 1) * 8 + (d >> 5)) * 64) + ((((m & 31) >> 3) << 2) | (m & 3)) + 16 * ((d >> 3) & 3)) * 8 + (d & 7); }
DEVI int xat_voff(int m, int d) { return ((((m >> 5) * 16 + (d >> 4)) * 64) + (d & 15) + 16 * ((m & 31) >> 3)) * 8 + (m & 7); }
DEVI int pk_koff(int k, int d) { return ((((k >> 4) * 4 + (d >> 5)) * 64) + (k & 15) + 16 * ((d >> 3) & 3)) * 8 + (d & 7); }
DEVI int nsa_koff8(int t, int d) { return ((((t >> 5) * 2 + ((t >> 2) & 1)) * 64) + ((((t & 31) >> 3) << 2) | (t & 3)) + 16 * ((d >> 3) & 3)) * 16 + (d >> 5) * 8 + (d & 7); }
DEVI int nsa_voff8(int t, int d) { return ((((t >> 5) * 2 + (d >> 5)) * 64) + (d & 15) + 16 * ((t & 31) >> 3)) * 16 + ((d >> 4) & 1) * 8 + (t & 7); }
DEVI void nsa_load_kf(bf16x8 (&ka)[4], const bf16_t* Kp, int ch, int lane) {
#pragma unroll
    for (int f = 0; f < 4; ++f) ka[f] = *(const bf16x8*)(Kp + ((ch * 4 + f) * 64 + lane) * 8);
}
DEVI void nsa_load_k(bf16x8 (&ka)[4], const bf16_t* Kp, int stride, int kb, int rk, int dh) {
    const int o0 = (kb + rk) * stride + dh, o1 = o0 + 4 * stride;
    ka[0] = *(const bf16x8*)(Kp + o0); ka[1] = *(const bf16x8*)(Kp + o0 + 32); ka[2] = *(const bf16x8*)(Kp + o1); ka[3] = *(const bf16x8*)(Kp + o1 + 32);
}
DEVI void nsa_load_v(bf16x8 (&va)[4], const bf16_t* Vp, int vstride, int kb8, int lr) {
    const int o = lr * vstride + kb8;
#pragma unroll
    for (int dt = 0; dt < 4; ++dt) va[dt] = *(const bf16x8*)(Vp + o + dt * 16 * vstride);
}
DEVI void nsa_load_vb(bf16x8 (&va)[4], const bf16_t* Vp, int kb8, int lr) {
    const int o = ((kb8 >> 6) * 64 + lr) * 64 + (kb8 & 63);
#pragma unroll
    for (int dt = 0; dt < 4; ++dt) va[dt] = *(const bf16x8*)(Vp + o + dt * 16 * 64);
}
DEVI void nsa_scores(const bf16x8 (&ka)[4], const bf16x8 (&qf)[2], float (&sv)[8]) {
    f32x4 s0 = {0.f, 0.f, 0.f, 0.f}, s1 = {0.f, 0.f, 0.f, 0.f};
    s0 = __builtin_amdgcn_mfma_f32_16x16x32_bf16(ka[0], qf[0], s0, 0, 0, 0); s1 = __builtin_amdgcn_mfma_f32_16x16x32_bf16(ka[2], qf[0], s1, 0, 0, 0);
    s0 = __builtin_amdgcn_mfma_f32_16x16x32_bf16(ka[1], qf[1], s0, 0, 0, 0); s1 = __builtin_amdgcn_mfma_f32_16x16x32_bf16(ka[3], qf[1], s1, 0, 0, 0);
    sv[0] = s0[0]; sv[1] = s0[1]; sv[2] = s0[2]; sv[3] = s0[3]; sv[4] = s1[0]; sv[5] = s1[1]; sv[6] = s1[2]; sv[7] = s1[3];
}
DEVI unsigned long long pack8_fp8(const float (&p)[8]) {
    int lo = 0, hi = 0;
    lo = __builtin_amdgcn_cvt_pk_fp8_f32(p[0], p[1], lo, false); lo = __builtin_amdgcn_cvt_pk_fp8_f32(p[2], p[3], lo, true);
    hi = __builtin_amdgcn_cvt_pk_fp8_f32(p[4], p[5], hi, false); hi = __builtin_amdgcn_cvt_pk_fp8_f32(p[6], p[7], hi, true);
    return ((unsigned long long)(unsigned)hi << 32) | (unsigned)lo;
}
struct NsaSt { float m, l; f32x4 o[4]; };
struct NsaBuf8 { long ka[4]; long va[4]; int e; };
DEVI void nsa_load8(long (&f)[4], const unsigned char* P, int ch, int lane) {
#pragma unroll
    for (int i = 0; i < 2; ++i) { const uint4 w = *(const uint4*)(P + ((ch * 2 + i) * 64 + lane) * 16);
        f[2 * i] = (long)(((unsigned long long)w.y << 32) | w.x); f[2 * i + 1] = (long)(((unsigned long long)w.w << 32) | w.z); }
}
struct NsaSt8 { float m, l; bool set; f32x4 negm; f32x4 o[4]; };
DEVI void nsa_init8(NsaSt8& st) { st.m = 0.f; st.l = 0.f; st.set = false; st.negm = (f32x4){7.f, 7.f, 7.f, 7.f};
#pragma unroll
    for (int dt = 0; dt < 4; ++dt) st.o[dt] = (f32x4){0.f, 0.f, 0.f, 0.f}; }

struct NsaBuf { bf16x8 ka[4]; bf16x8 va[4]; };
DEVI void nsa_init(NsaSt& st) { st.m = -1e20f; st.l = 0.f;
#pragma unroll
    for (int dt = 0; dt < 4; ++dt) st.o[dt] = (f32x4){0.f, 0.f, 0.f, 0.f}; }
template <bool PV>
DEVI void nsa_chunk(NsaSt& st, float (&sv)[8], int pos0, int lo, int hi, const bf16x8 (&va)[4]) {
    float cm = -1e30f;
#pragma unroll
    for (int j = 0; j < 8; ++j) { const bool ok = (pos0 + j >= lo) && (pos0 + j <= hi); sv[j] = ok ? sv[j] : -1e30f; cm = fmaxf(cm, sv[j]); }
    cm = xmax16(cm); cm = xmax32(cm);
    if (__any(cm > st.m)) {
        const float mn = fmaxf(st.m, cm), sc = __builtin_amdgcn_exp2f(st.m - mn);
        st.l *= sc;
        if (PV) {
#pragma unroll
            for (int dt = 0; dt < 4; ++dt) st.o[dt] *= sc;
        }
        st.m = mn;
    }
    float p[8]; float ps = 0.f;
#pragma unroll
    for (int j = 0; j < 8; ++j) { p[j] = __builtin_amdgcn_exp2f(sv[j] - st.m); ps += p[j]; }
    st.l += ps;
    if (PV) {
        const bf16x8 pb = pack8(p);
#pragma unroll
        for (int dt = 0; dt < 4; ++dt) st.o[dt] = __builtin_amdgcn_mfma_f32_16x16x32_bf16(va[dt], pb, st.o[dt], 0, 0, 0);
    }
}
template <int MASK>
DEVI void nsa_chunk8(NsaSt8& st, const long (&ka)[4], const long (&qf)[2], const long (&va)[4], int pos0, int hi, bool own) {
    f32x4 s0 = st.negm, s1 = st.negm;
    s0 = __builtin_amdgcn_mfma_f32_16x16x32_fp8_fp8(ka[0], qf[0], s0, 0, 0, 0); s1 = __builtin_amdgcn_mfma_f32_16x16x32_fp8_fp8(ka[2], qf[0], s1, 0, 0, 0);
    s0 = __builtin_amdgcn_mfma_f32_16x16x32_fp8_fp8(ka[1], qf[1], s0, 0, 0, 0); s1 = __builtin_amdgcn_mfma_f32_16x16x32_fp8_fp8(ka[3], qf[1], s1, 0, 0, 0);
    float sv[8] = {s0[0], s0[1], s0[2], s0[3], s1[0], s1[1], s1[2], s1[3]};
    if (MASK == 1) {
#pragma unroll
        for (int j = 0; j < 8; ++j) sv[j] = own ? sv[j] : -1e30f;
    } else if (MASK == 2) {
#pragma unroll
        for (int j = 0; j < 8; ++j) sv[j] = (pos0 + j <= hi) ? sv[j] : -1e30f;
    }
    float cm = fmaxf(fmaxf(fmaxf(sv[0], sv[1]), fmaxf(sv[2], sv[3])), fmaxf(fmaxf(sv[4], sv[5]), fmaxf(sv[6], sv[7])));
    cm = xmax16(cm); cm = xmax32(cm);
    const bool need = (cm > 7.f) || (!st.set && cm > -1e29f);
    if (__any(need)) {
        const float d = need ? cm - 7.f : 0.f;
        const float sc = need ? (st.set ? __builtin_amdgcn_exp2f(-d) : 0.f) : 1.f;
        st.m += d; st.set = st.set || need;
        const float nm = 7.f - st.m; st.negm = (f32x4){nm, nm, nm, nm};
        st.l *= sc;
#pragma unroll
        for (int dt = 0; dt < 4; ++dt) st.o[dt] *= sc;
#pragma unroll
        for (int j = 0; j < 8; ++j) sv[j] -= d;
    }
    float p[8];
#pragma unroll
    for (int j = 0; j < 8; ++j) p[j] = __builtin_amdgcn_exp2f(sv[j]);
    st.l += ((p[0] + p[1]) + (p[2] + p[3])) + ((p[4] + p[5]) + (p[6] + p[7]));
    const long pb = (long)pack8_fp8(p);
#pragma unroll
    for (int dt = 0; dt < 4; ++dt) st.o[dt] = __builtin_amdgcn_mfma_f32_16x16x32_fp8_fp8(va[dt], pb, st.o[dt], 0, 0, 0);
}
struct NsaBlk8 { long ka[8]; long va[8]; int e; };
template <int MASK>
DEVI void nsa_block8(NsaSt8& st, const NsaBlk8& bf, const long (&qf)[2], int pos0, int hi, bool own) {
    f32x4 s0 = st.negm, s1 = st.negm, s2 = st.negm, s3 = st.negm;
    s0 = __builtin_amdgcn_mfma_f32_16x16x32_fp8_fp8(bf.ka[0], qf[0], s0, 0, 0, 0); s1 = __builtin_amdgcn_mfma_f32_16x16x32_fp8_fp8(bf.ka[2], qf[0], s1, 0, 0, 0);
    s2 = __builtin_amdgcn_mfma_f32_16x16x32_fp8_fp8(bf.ka[4], qf[0], s2, 0, 0, 0); s3 = __builtin_amdgcn_mfma_f32_16x16x32_fp8_fp8(bf.ka[6], qf[0], s3, 0, 0, 0);
    s0 = __builtin_amdgcn_mfma_f32_16x16x32_fp8_fp8(bf.ka[1], qf[1], s0, 0, 0, 0); s1 = __builtin_amdgcn_mfma_f32_16x16x32_fp8_fp8(bf.ka[3], qf[1], s1, 0, 0, 0);
    s2 = __builtin_amdgcn_mfma_f32_16x16x32_fp8_fp8(bf.ka[5], qf[1], s2, 0, 0, 0); s3 = __builtin_amdgcn_mfma_f32_16x16x32_fp8_fp8(bf.ka[7], qf[1], s3, 0, 0, 0);
    float sv[16] = {s0[0], s0[1], s0[2], s0[3], s1[0], s1[1], s1[2], s1[3], s2[0], s2[1], s2[2], s2[3], s3[0], s3[1], s3[2], s3[3]};
    if (MASK == 1) {
#pragma unroll
        for (int j = 0; j < 16; ++j) sv[j] = own ? sv[j] : -1e30f;
    } else if (MASK == 2) {
#pragma unroll
        for (int j = 0; j < 16; ++j) sv[j] = (pos0 + (j & 7) + 32 * (j >> 3) <= hi) ? sv[j] : -1e30f;
    }
    float cm = fmaxf(fmaxf(fmaxf(fmaxf(sv[0], sv[1]), fmaxf(sv[2], sv[3])), fmaxf(fmaxf(sv[4], sv[5]), fmaxf(sv[6], sv[7]))),
                     fmaxf(fmaxf(fmaxf(sv[8], sv[9]), fmaxf(sv[10], sv[11])), fmaxf(fmaxf(sv[12], sv[13]), fmaxf(sv[14], sv[15]))));
    cm = xmax16(cm); cm = xmax32(cm);
    const bool need = (cm > 7.f) || (!st.set && cm > -1e29f);
    if (__any(need)) {
        const float d = need ? cm - 7.f : 0.f;
        const float sc = need ? (st.set ? __builtin_amdgcn_exp2f(-d) : 0.f) : 1.f;
        st.m += d; st.set = st.set || need;
        const float nm = 7.f - st.m; st.negm = (f32x4){nm, nm, nm, nm};
        st.l *= sc;
#pragma unroll
        for (int dt = 0; dt < 4; ++dt) st.o[dt] *= sc;
#pragma unroll
        for (int j = 0; j < 16; ++j) sv[j] -= d;
    }
    float p[8], q[8];
#pragma unroll
    for (int j = 0; j < 8; ++j) { p[j] = __builtin_amdgcn_exp2f(sv[j]); q[j] = __builtin_amdgcn_exp2f(sv[8 + j]); }
    st.l += (((p[0] + p[1]) + (p[2] + p[3])) + ((p[4] + p[5]) + (p[6] + p[7]))) + (((q[0] + q[1]) + (q[2] + q[3])) + ((q[4] + q[5]) + (q[6] + q[7])));
    const long pb0 = (long)pack8_fp8(p), pb1 = (long)pack8_fp8(q);
#pragma unroll
    for (int dt = 0; dt < 4; ++dt) st.o[dt] = __builtin_amdgcn_mfma_f32_16x16x32_fp8_fp8(bf.va[dt], pb0, st.o[dt], 0, 0, 0);
#pragma unroll
    for (int dt = 0; dt < 4; ++dt) st.o[dt] = __builtin_amdgcn_mfma_f32_16x16x32_fp8_fp8(bf.va[4 + dt], pb1, st.o[dt], 0, 0, 0);
}
template <class LD, class CP>
DEVI void nsa_streamb(int n, LD ld, CP cp) {
    NsaBlk8 A, B;
    if (n > 0) ld(A, 0);
#pragma unroll 1
    for (int i = 0; i < n; i += 2) {
        if (i + 1 < n) ld(B, i + 1);
        cp(A, i);
        if (i + 1 < n) { if (i + 2 < n) ld(A, i + 2); cp(B, i + 1); }
    }
}
DEVI void nsa_fold8(f32x4 (&comb)[4], NsaSt8& st, float gate) {
    float l = st.l; l = xsum16(l); l = xsum32(l);
    const float w = gate / fmaxf(l, 1e-30f);
#pragma unroll
    for (int dt = 0; dt < 4; ++dt) comb[dt] += st.o[dt] * w;
}
template <class LD, class CP>
DEVI void nsa_stream8(int n, LD ld, CP cp) {
    NsaBuf8 A, B, C, D;
    if (n > 0) ld(A, 0);
    if (n > 1) ld(B, 1);
    if (n > 2) ld(C, 2);
#pragma unroll 1
    for (int i = 0; i < n; i += 4) {
        if (i + 3 < n) ld(D, i + 3);
        cp(A, i);
        if (i + 1 < n) { if (i + 4 < n) ld(A, i + 4); cp(B, i + 1); }
        if (i + 2 < n) { if (i + 5 < n) ld(B, i + 5); cp(C, i + 2); }
        if (i + 3 < n) { if (i + 6 < n) ld(C, i + 6); cp(D, i + 3); }
    }
}
DEVI void nsa_fold(f32x4 (&comb)[4], NsaSt& st, float gate) {
    float l = st.l; l = xsum16(l); l = xsum32(l);
    const float w = gate / fmaxf(l, 1e-30f);
#pragma unroll
    for (int dt = 0; dt < 4; ++dt) comb[dt] += st.o[dt] * w;
}
template <class LD, class CP>
DEVI void nsa_stream(int n, LD ld, CP cp) {
    NsaBuf A, B, C;
    if (n > 0) ld(A, 0);
    if (n > 1) ld(B, 1);
#pragma unroll 1
    for (int i = 0; i < n; i += 3) {
        if (i + 2 < n) ld(C, i + 2);
        cp(A, i);
        if (i + 1 < n) { if (i + 3 < n) ld(A, i + 3); cp(B, i + 1); }
        if (i + 2 < n) { if (i + 4 < n) ld(B, i + 4); cp(C, i + 2); }
    }
}
template <class LD, class CP>
DEVI void nsa_stream2(int n, LD ld, CP cp) {
    NsaBuf A, B;
    if (n > 0) ld(A, 0);
#pragma unroll 1
    for (int i = 0; i < n; i += 2) {
        if (i + 1 < n) ld(B, i + 1);
        cp(A, i);
        if (i + 1 < n) { if (i + 2 < n) ld(A, i + 2); cp(B, i + 1); }
    }
}

#define XB_TMO      128
#define XB_XCNT(j)  (256  + 64 * (j))
#define XB_XSUB(j)  (1280 + 64 * (j))
#define XB_XGEN(j)  (2304 + 64 * (j))
#define XB_TOP      3328
#define XB_TOPGEN   3392
#define XCD_BAR_WORDS 3456
#define XB_SPIN_CAP (1u << 22)
#define LAS __attribute__((address_space(3)))
DEVI unsigned xb_ld(unsigned* p)              { return __hip_atomic_load(p, __ATOMIC_RELAXED, __HIP_MEMORY_SCOPE_AGENT); }
DEVI unsigned xb_add(unsigned* p, unsigned v) { return __hip_atomic_fetch_add(p, v, __ATOMIC_RELAXED, __HIP_MEMORY_SCOPE_AGENT); }
DEVI unsigned xb_xcc_id() { return (unsigned)__builtin_amdgcn_s_getreg((3 << 11) | 20) & 0xFu; }
#define XB_SPIN(cond, bar) do { unsigned _sp = 0; while (cond) { __builtin_amdgcn_s_sleep(1); \
    if ((++_sp & 255u) == 0u) { if (xb_ld(&(bar)[XB_TMO])) break; if (_sp > XB_SPIN_CAP) { atomicAdd(&(bar)[XB_TMO], 1u); break; } } } } while (0)
struct XcdBarrier { unsigned* bar; unsigned x; volatile LAS unsigned* st; };
DEVI XcdBarrier xcd_barrier_post(unsigned* bar, volatile LAS unsigned* st) {
    XcdBarrier b; b.bar = bar; b.x = xb_xcc_id(); b.st = st;
    if (threadIdx.x == 0) (void)xb_add(&bar[XB_XCNT(b.x)], 1u);
    return b;
}
DEVI void xcd_barrier_complete(unsigned* bar, unsigned x, unsigned& nloc, unsigned& nx) {
    const unsigned G = gridDim.x * gridDim.y * gridDim.z;
    unsigned sum, cnt, mine, sp = 0u;
    for (;;) {
        sum = 0u; cnt = 0u; mine = 0u;
#pragma unroll
        for (unsigned j = 0; j < 16; ++j) { const unsigned c = xb_ld(&bar[XB_XCNT(j)]); sum += c; cnt += (c > 0u) ? 1u : 0u; mine = (j == x) ? c : mine; }
        if (sum == G) break;
        __builtin_amdgcn_s_sleep(1);
        if ((++sp & 255u) == 0u) { if (xb_ld(&bar[XB_TMO])) break; if (sp > XB_SPIN_CAP) { atomicAdd(&bar[XB_TMO], 1u); break; } }
    }
    nloc = mine > 0u ? mine : 1u; nx = cnt > 0u ? cnt : 1u;
}
DEVI void xcd_barrier(const XcdBarrier& b) {
    asm volatile("s_waitcnt vmcnt(0)" ::: "memory");
    __syncthreads();
    if (threadIdx.x == 0) {
        unsigned* bar = b.bar;
        __builtin_amdgcn_s_waitcnt(0);
        unsigned nloc = b.st[0], nx = b.st[1];
        if (nloc == 0u) { xcd_barrier_complete(bar, b.x, nloc, nx); b.st[0] = nloc; b.st[1] = nx; }
        const unsigned old = xb_add(&bar[XB_XSUB(b.x)], 1u);
        const unsigned gen = old / nloc;
        if (old + 1u == (gen + 1u) * nloc) {
            __builtin_amdgcn_fence(__ATOMIC_RELEASE, "agent");
            asm volatile("s_waitcnt vmcnt(0)" ::: "memory");
            const unsigned og = xb_add(&bar[XB_TOP], 1u);
            const unsigned tg = og / nx;
            if (og + 1u == (tg + 1u) * nx) xb_add(&bar[XB_TOPGEN], 1u);
            else XB_SPIN(xb_ld(&bar[XB_TOPGEN]) == tg, bar);
            __builtin_amdgcn_fence(__ATOMIC_ACQUIRE, "agent");
            xb_add(&bar[XB_XGEN(b.x)], 1u);
            asm volatile("s_waitcnt vmcnt(0)" ::: "memory");
        } else {
            XB_SPIN(xb_ld(&bar[XB_XGEN(b.x)]) == gen, bar);
            __builtin_amdgcn_fence(__ATOMIC_ACQUIRE, "agent");
            asm volatile("s_waitcnt vmcnt(0)" ::: "memory");
        }
    }
    __syncthreads();
}

DEVI void* ldptr(volatile LAS unsigned long long* tab, int i) { const unsigned long long v = tab[i];
    const unsigned lo = __builtin_amdgcn_readfirstlane((unsigned)v), hi = __builtin_amdgcn_readfirstlane((unsigned)(v >> 32)); return (void*)(((unsigned long long)hi << 32) | lo); }


DEVI unsigned key_pack(float f, int idx) { const unsigned u = __float_as_uint(f); const unsigned o = (u & 0x80000000u) ? ~u : (u | 0x80000000u); return (o & 0xFFFFFF80u) | (unsigned)(127 - idx); }
DEVI float key_val(unsigned k) { const unsigned o = k & 0xFFFFFF80u; return __uint_as_float((o & 0x80000000u) ? (o & 0x7FFFFFFFu) : ~o); }
DEVI void ce_desc(unsigned& a, unsigned& b) { const unsigned hi = a > b ? a : b, lo = a > b ? b : a; a = hi; b = lo; }
template <int N> DEVI void bitonic_sort_desc(unsigned (&a)[N]) {
#pragma unroll
    for (int k = 2; k <= N; k <<= 1)
#pragma unroll
        for (int j = k >> 1; j > 0; j >>= 1)
#pragma unroll
            for (int i = 0; i < N; ++i) { const int l = i ^ j; if (l > i) { if ((i & k) == 0) ce_desc(a[i], a[l]); else ce_desc(a[l], a[i]); } }
}
template <int N> DEVI void bitonic_merge_desc(unsigned (&a)[N]) {
#pragma unroll
    for (int j = N >> 1; j > 0; j >>= 1)
#pragma unroll
        for (int i = 0; i < N; ++i) { const int l = i ^ j; if (l > i) ce_desc(a[i], a[l]); }
}

__global__ void __launch_bounds__(NTHREADS) fwd_mega(Params pa) {
    extern __shared__ __attribute__((aligned(16))) unsigned char smem[];
    const int bid = blockIdx.x, nb = gridDim.x, tid = threadIdx.x, lane = tid & 63, wave = tid >> 6;
    volatile LAS unsigned long long* ptab = (volatile LAS unsigned long long*)(smem + LDS_BYTES - 16 - 32 * 8);
    {
        volatile LAS unsigned* st0 = (volatile LAS unsigned*)(smem + LDS_BYTES - 16);
        if (tid < 4) st0[tid] = 0u;
        if (tid == 0) {
            ptab[0] = (unsigned long long)pa.x; ptab[1] = (unsigned long long)pa.mem; ptab[2] = (unsigned long long)pa.g_mix; ptab[3] = (unsigned long long)pa.w_in;
            ptab[4] = (unsigned long long)pa.pe_k; ptab[5] = (unsigned long long)pa.w1_k; ptab[6] = (unsigned long long)pa.b1_k; ptab[7] = (unsigned long long)pa.w2_k;
            ptab[8] = (unsigned long long)pa.pe_v; ptab[9] = (unsigned long long)pa.w1_v; ptab[10] = (unsigned long long)pa.b1_v; ptab[11] = (unsigned long long)pa.w2_v;
            ptab[12] = (unsigned long long)pa.ln_g; ptab[13] = (unsigned long long)pa.ln_b; ptab[14] = (unsigned long long)pa.gws; ptab[15] = (unsigned long long)pa.gbs;
            ptab[16] = (unsigned long long)pa.w_nsa_out; ptab[17] = (unsigned long long)pa.w_gmlp_out; ptab[18] = (unsigned long long)pa.w_mix_out; ptab[19] = (unsigned long long)pa.g_xattn;
            ptab[20] = (unsigned long long)pa.g_mem; ptab[21] = (unsigned long long)pa.w_xq; ptab[22] = (unsigned long long)pa.w_xkv; ptab[23] = (unsigned long long)pa.w_xo;
            ptab[24] = (unsigned long long)pa.g_peer; ptab[25] = (unsigned long long)pa.w_peer_q; ptab[26] = (unsigned long long)pa.sub_keys; ptab[27] = (unsigned long long)pa.peer_u;
            ptab[28] = (unsigned long long)pa.peer_v; ptab[29] = (unsigned long long)pa.g_final; ptab[30] = (unsigned long long)pa.out; ptab[31] = (unsigned long long)pa.ws;
        }
        __syncthreads();
    }
    const XcdBarrier xb = xcd_barrier_post((unsigned*)pa.ws, (volatile LAS unsigned*)(smem + LDS_BYTES - 16));
#define LDP(i) ((const float*)ldptr(ptab, i))
#define PHASE_BEGIN \
    const int tid = tid_opaque(), lane = tid & 63, wave = tid >> 6; (void)lane; (void)wave; \
    Params p; p.x = LDP(0); p.mem = LDP(1); p.g_mix = LDP(2); p.w_in = LDP(3); p.pe_k = LDP(4); p.w1_k = LDP(5); p.b1_k = LDP(6); p.w2_k = LDP(7); p.pe_v = LDP(8); p.w1_v = LDP(9); p.b1_v = LDP(10); p.w2_v = LDP(11); \
    p.ln_g = LDP(12); p.ln_b = LDP(13); p.gws = LDP(14); p.gbs = LDP(15); p.w_nsa_out = LDP(16); p.w_gmlp_out = LDP(17); p.w_mix_out = LDP(18); p.g_xattn = LDP(19); p.g_mem = LDP(20); p.w_xq = LDP(21); p.w_xkv = LDP(22); p.w_xo = LDP(23); \
    p.g_peer = LDP(24); p.w_peer_q = LDP(25); p.sub_keys = LDP(26); p.peer_u = LDP(27); p.peer_v = LDP(28); p.g_final = LDP(29); p.out = (float*)ldptr(ptab, 30); p.ws = (unsigned char*)ldptr(ptab, 31); \
    unsigned char* const ws = p.ws; \
    bf16_t* WIN = (bf16_t*)(ws + O_WIN); bf16_t* W1K = (bf16_t*)(ws + O_W1K); bf16_t* W1V = (bf16_t*)(ws + O_W1V); \
    bf16_t* WNSA = (bf16_t*)(ws + O_WNSA); bf16_t* WGM = (bf16_t*)(ws + O_WGM); bf16_t* WMIX = (bf16_t*)(ws + O_WMIX); \
    bf16_t* WXQ = (bf16_t*)(ws + O_WXQ); bf16_t* WXKV = (bf16_t*)(ws + O_WXKV); bf16_t* WXO = (bf16_t*)(ws + O_WXO); bf16_t* WPQ = (bf16_t*)(ws + O_WPQ); \
    float* B1F = (float*)(ws + 14336); \
    bf16_t* HN = (bf16_t*)(ws + O_HN); bf16_t* MN = (bf16_t*)(ws + O_MN); bf16_t* KVX = (bf16_t*)(ws + O_KVX); \
    float* GATES = (float*)(ws + O_GATES); float* HID = (float*)(ws + O_HID); \
    bf16_t* Q = (bf16_t*)(ws + O_Q); bf16_t* KV6 = (bf16_t*)(ws + O_KV6); bf16_t* U = (bf16_t*)(ws + O_U); bf16_t* VG = (bf16_t*)(ws + O_VG); \
    bf16_t* MG = (bf16_t*)(ws + O_MG); bf16_t* ONSA = (bf16_t*)(ws + O_ONSA); bf16_t* OGM = (bf16_t*)(ws + O_OGM); \
    bf16_t* Y = (bf16_t*)(ws + O_Y); bf16_t* QX = (bf16_t*)(ws + O_QX); bf16_t* OX = (bf16_t*)(ws + O_OX); bf16_t* QP = (bf16_t*)(ws + O_QP); \
    float* HS = (float*)(ws + O_HS); int* HI = (int*)(ws + O_HI); \
    bf16_t* VXT = (bf16_t*)(ws + O_VXT); bf16_t* SUBK = (bf16_t*)(ws + O_SUBK); \
    bf16_t* KCB = (bf16_t*)(ws + O_CMP); bf16_t* VCT = KCB + 4 * 512 * 64; \
    unsigned char* PU8 = ws + O_U; unsigned char* PV8 = ws + O_U + 16384ull * 1024; \
    float* PSC = (float*)(ws + O_PSC); float* SS = (float*)(ws + O_SS); (void)SS; \
    float* OUT = p.out; \
    (void)WIN; (void)W1K; (void)W1V; (void)WNSA; (void)WGM; (void)WMIX; (void)WXQ; (void)WXKV; (void)WXO; (void)WPQ; (void)B1F; (void)HN; (void)MN; (void)KVX; (void)GATES; (void)HID; (void)Q; (void)KV6; (void)U; (void)VG; \
    (void)MG; (void)ONSA; (void)OGM; (void)Y; (void)QX; (void)OX; (void)QP; (void)HS; (void)HI; (void)VXT; (void)SUBK; (void)KCB; (void)VCT; (void)PU8; (void)PV8; (void)PSC; (void)OUT;

    { PHASE_BEGIN
    {
        for (int j = bid * 8 + wave; j < 3424; j += nb * 8) {
            int t = j;
            if (t < 1120) { transpose_wave(p.w_in, 4376, WIN, 1024, t, WinMap(), lane); continue; } t -= 1120;
            if (t < 128) { transpose_wave(p.w1_k, 256, W1K, 2048, t, IdMap(), lane); continue; } t -= 128;
            if (t < 128) { transpose_wave(p.w1_v, 256, W1V, 2048, t, IdMap(), lane); continue; } t -= 128;
            if (t < 128) { transpose_wave(p.w_nsa_out, 1024, WNSA, 512, t, IdMap(), lane); continue; } t -= 128;
            if (t < 128) { transpose_wave(p.w_gmlp_out, 1024, WGM, 512, t, IdMap(), lane); continue; } t -= 128;
            if (t < 256) { transpose_wave(p.w_mix_out, 1024, WMIX, 1024, t, IdMap(), lane); continue; } t -= 256;
            if (t < 256) { transpose_wave(p.w_xq, 1024, WXQ, 1024, t, IdMap(), lane, p.g_xattn); continue; } t -= 256;
            if (t < 512) { transpose_wave(p.w_xkv, 2048, WXKV, 1024, t, IdMap(), lane); continue; } t -= 512;
            if (t < 256) { transpose_wave(p.w_xo, 1024, WXO, 1024, t, IdMap(), lane); continue; } t -= 256;
            transpose_wave(p.w_peer_q, 2048, WPQ, 1024, t, IdMap(), lane, p.g_peer);
        }
        for (int r = bid * 8 + wave; r < 16384 + 512; r += nb * 8) {
            if (r < 16384) rmsnorm_row_bf16(p.x + (size_t)r * 1024, p.g_mix, HN + (size_t)r * 1024, lane);
            else rmsnorm_row_bf16(p.mem + (size_t)(r - 16384) * 1024, p.g_mem, MN + (size_t)(r - 16384) * 1024, lane);
        }
        for (int i = bid * NTHREADS + tid; i < 2 * 16384; i += nb * NTHREADS) SS[i] = 0.f;
        for (int i = bid * NTHREADS + tid; i < 16 * 128 * 128; i += nb * NTHREADS) SUBK[(i & ~16383) + pk_koff((i >> 7) & 127, i & 127)] = f2bf(p.sub_keys[i]);
        for (int i = bid * NTHREADS + tid; i < 2 * 2048 * 256 / 4; i += nb * NTHREADS) ((float4*)HID)[i] = make_float4(0.f, 0.f, 0.f, 0.f);
        {
            const int wt = bid * 8 + wave;
            if (wt < 128) {
                const int kv = wt >> 6, ng = (wt >> 4) & 3, kc = wt & 15, n = ng * 64 + lane;
                const float* pe = (kv ? p.pe_v : p.pe_k) + kc * 128; const float* w1 = (kv ? p.w1_v : p.w1_k) + (size_t)kc * 128 * 256 + n;
                float a = 0.f;
#pragma unroll 16
                for (int k = 0; k < 128; ++k) a += pe[k] * w1[(size_t)k * 256];
                unsafeAtomicAdd(B1F + kv * 256 + n, a);
            }
        }
    }
    }
    xcd_barrier(xb);

    { PHASE_BEGIN
    {
        auto epi = [&](int r, int c, const f32x4& v0, const f32x4& v1) {
            if (c < 512) { const float qs_ = 0.125f * 1.4426950408889634f; store_bf16x8(Q + (size_t)r * 512 + c, v0 * qs_, v1 * qs_);
                const float q8[8] = {v0[0] * qs_, v0[1] * qs_, v0[2] * qs_, v0[3] * qs_, v1[0] * qs_, v1[1] * qs_, v1[2] * qs_, v1[3] * qs_};
                *(unsigned long long*)(ws + O_Q8 + (size_t)r * 512 + c) = pack8_fp8(q8); }
            else if (c < 1280) { const int w = (c - 512) >> 7, cc = (c - 512) & 127;
                const int b_ = r >> 13, t_ = r & 8191, g_ = cc >> 6, d_ = cc & 63;
                if (w == 5) {
                    bf16_t* vt = KV6 + (size_t)w * 16384 * 128 + (size_t)(b_ * 2 + g_) * 8192 * 64 + nsa_voff(t_, d_);
                    vt[0] = f2bf(v0[0]); vt[8] = f2bf(v0[1]); vt[16] = f2bf(v0[2]); vt[24] = f2bf(v0[3]); vt[32] = f2bf(v1[0]); vt[40] = f2bf(v1[1]); vt[48] = f2bf(v1[2]); vt[56] = f2bf(v1[3]); }
                else if (w == 4) store_bf16x8(KV6 + (size_t)w * 16384 * 128 + (size_t)(b_ * 2 + g_) * 8192 * 64 + nsa_koff(t_, d_), v0, v1);
                else if (w == 3) {
                    const float f8[8] = {v0[0], v0[1], v0[2], v0[3], v1[0], v1[1], v1[2], v1[3]}; const unsigned long long pk = pack8_fp8(f8);
                    unsigned char* vt = (unsigned char*)(KV6 + (size_t)w * 16384 * 128) + (size_t)(b_ * 2 + g_) * 8192 * 64 + nsa_voff8(t_, d_);
#pragma unroll
                    for (int e = 0; e < 8; ++e) vt[e * 16] = (unsigned char)(pk >> (8 * e)); }
                else if (w == 2) {
                    const float f8[8] = {v0[0], v0[1], v0[2], v0[3], v1[0], v1[1], v1[2], v1[3]};
                    *(unsigned long long*)((unsigned char*)(KV6 + (size_t)w * 16384 * 128) + (size_t)(b_ * 2 + g_) * 8192 * 64 + nsa_koff8(t_, d_)) = pack8_fp8(f8); }
                else store_bf16x8(KV6 + ((size_t)w * 16384 + r) * 128 + cc, v0, v1); }
            else if (c < 2304) { bf16_t* dst = c < 1792 ? U + (size_t)r * 512 + (c - 1280) : VG + (size_t)r * 512 + (c - 1792);
                f32x4 a, b;
#pragma unroll
                for (int e = 0; e < 4; ++e) { a[e] = gelu_f(v0[e]); b[e] = gelu_f(v1[e]); }
                store_bf16x8(dst, a, b); }
            else { f32x4 a, b;
#pragma unroll
                for (int e = 0; e < 4; ++e) { a[e] = sigmoid_f(v0[e]); b[e] = sigmoid_f(v1[e]); }
                store_bf16x8(MG + (size_t)r * 2048 + (c - 2304), a, b); }
        };
        big_gemm(smem, HN, WIN, 16384, 4352, 1024, epi);
        if (bid >= 64) {
            const int tl = bid - 64;
            bf16_t* As = (bf16_t*)smem; bf16_t* Bs = As + 128 * G_LD;
            const int wm = wave >> 2, wn = wave & 3;
            f32x4 acc[4][2];
#pragma unroll
            for (int i = 0; i < 4; ++i)
#pragma unroll
                for (int j = 0; j < 2; ++j) acc[i][j] = (f32x4){0.f, 0.f, 0.f, 0.f};
            if (tl < 128) {
                gemm_tile(acc, RowMajorA{HN, 1024}, tl * 128, WIN + (size_t)4352 * 1024, 1024, 1024, As, Bs);
#pragma unroll
                for (int i = 0; i < 4; ++i)
#pragma unroll
                    for (int j = 0; j < 2; ++j) { const int r = tl * 128 + wm * 64 + i * 16 + (lane & 15), c = wn * 32 + j * 16 + (lane >> 4) * 4;
                        if (c < 24) { float* gp = GATES + (size_t)r * 24 + c; gp[0] = sigmoid_f(acc[i][j][0]); gp[1] = sigmoid_f(acc[i][j][1]); gp[2] = sigmoid_f(acc[i][j][2]); gp[3] = sigmoid_f(acc[i][j][3]); } }
            } else if (tl < 192) {
                const int t2 = tl - 128, mt = t2 >> 4, nt = t2 & 15;
                gemm_tile(acc, RowMajorA{MN, 1024}, mt * 128, WXKV + (size_t)nt * 128 * 1024, 1024, 1024, As, Bs);
#pragma unroll
                for (int i = 0; i < 4; ++i)
#pragma unroll
                    for (int j = 0; j < 2; ++j) { const int r = mt * 128 + wm * 64 + i * 16 + (lane & 15), c = nt * 128 + wn * 32 + j * 16 + (lane >> 4) * 4;
                        const int b_ = r >> 8, m_ = r & 255; const f32x4 v = acc[i][j];
                        if (c < 1024) { const int h_ = c >> 8, d_ = c & 255; store_bf16x4(KVX + (size_t)(b_ * 4 + h_) * 65536 + xat_koff(m_, d_), v[0], v[1], v[2], v[3]); }
                        else { const int hd = c - 1024, h_ = hd >> 8, d_ = hd & 255;
                            bf16_t* vt = VXT + (size_t)(b_ * 4 + h_) * 65536 + xat_voff(m_, d_);
                            vt[0] = f2bf(v[0]); vt[8] = f2bf(v[1]); vt[16] = f2bf(v[2]); vt[24] = f2bf(v[3]); } }
            }
        }
    }
    }
    xcd_barrier(xb);

    { PHASE_BEGIN
    {
        for (int task = bid; task < 256; task += nb) {
            if (task < 128) {
                const int kv = task >> 6, t = task & 63, mt = t >> 2, nt = (t >> 1) & 1, kh = t & 1;
                bf16_t* As = (bf16_t*)smem; bf16_t* Bs = As + 128 * G_LD;
                const int wm = wave >> 2, wn = wave & 3;
                f32x4 acc[4][2];
#pragma unroll
                for (int i = 0; i < 4; ++i)
#pragma unroll
                    for (int j = 0; j < 2; ++j) acc[i][j] = (f32x4){0.f, 0.f, 0.f, 0.f};
                gemm_tile(acc, CmpA{KV6 + (size_t)kv * 16384 * 128, kh * 1024}, mt * 128, (kv ? W1V : W1K) + (size_t)nt * 128 * 2048 + kh * 1024, 2048, 1024, As, Bs);
#pragma unroll
                for (int i = 0; i < 4; ++i)
#pragma unroll
                    for (int j = 0; j < 2; ++j) {
                        const int r = mt * 128 + wm * 64 + i * 16 + (lane & 15), c = nt * 128 + wn * 32 + j * 16 + (lane >> 4) * 4;
                        if (r < 2044) { float* hp = HID + ((size_t)kv * 2048 + r) * 256 + c;
                            unsafeAtomicAdd(hp, acc[i][j][0]); unsafeAtomicAdd(hp + 1, acc[i][j][1]); unsafeAtomicAdd(hp + 2, acc[i][j][2]); unsafeAtomicAdd(hp + 3, acc[i][j][3]); }
                    }
                __syncthreads();
            } else {
                const int ch = task - 128;
                const size_t row0 = (size_t)ch * 128;
                constexpr int VLD = 136;
                bf16_t* VT = (bf16_t*)smem;
                float* st = (float*)(smem + 512 * VLD * 2);
                for (int r = wave * 16; r < wave * 16 + 16; ++r) {
                    float f[8]; load8(VG + (row0 + r) * 512 + lane * 8, f);
                    float s1 = 0.f;
#pragma unroll
                    for (int e = 0; e < 8; ++e) s1 += f[e];
                    s1 = wave_sum(s1); const float mu = s1 * (1.0f / 512.0f);
                    float s2 = 0.f;
#pragma unroll
                    for (int e = 0; e < 8; ++e) s2 += (f[e] - mu) * (f[e] - mu);
                    s2 = wave_sum(s2);
                    if (lane == 0) { st[r * 2] = mu; st[r * 2 + 1] = rsqrtf(s2 * (1.0f / 512.0f) + 1e-6f); }
                }
                __syncthreads();
                {
                    const int s_ = tid & 127; const float mu = st[s_ * 2], rs = st[s_ * 2 + 1];
#pragma unroll 1
                    for (int i = 0; i < 16; ++i) {
                        const int d0 = ((tid >> 7) + 4 * i) * 8;
                        float f[8]; load8(VG + (row0 + s_) * 512 + d0, f);
#pragma unroll
                        for (int e = 0; e < 8; ++e) VT[(d0 + e) * VLD + s_] = f2bf((f[e] - mu) * rs * p.ln_g[d0 + e] + p.ln_b[d0 + e]);
                    }
                }
                __syncthreads();
                {
                    const int tl = wave * 16 + (lane & 15), hq = lane >> 4, kmax = (wave * 16 + 15) >> 5;
                    for (int g = 0; g < 4; ++g) {
                        bf16x8 wf[4];
#pragma unroll
                        for (int ks = 0; ks < 4; ++ks) {
                            if (ks <= kmax) {
                                const float* wp = p.gws + (size_t)g * 16384 + tl * 128 + ks * 32 + 8 * hq;
                                float f[8]; load8(wp, f);
#pragma unroll
                                for (int e = 0; e < 8; ++e) f[e] = (ks * 32 + 8 * hq + e <= tl) ? f[e] : 0.f;
                                wf[ks] = pack8(f);
                            }
                        }
                        const float bsv = p.gbs[g * 128 + tl];
#pragma unroll 2
                        for (int dt = 0; dt < 8; ++dt) {
                            f32x4 a = {0.f, 0.f, 0.f, 0.f};
                            const bf16_t* vp = VT + (g * 128 + dt * 16 + (lane & 15)) * VLD + 8 * hq;
#pragma unroll
                            for (int ks = 0; ks < 4; ++ks) if (ks <= kmax) a = __builtin_amdgcn_mfma_f32_16x16x32_bf16(*(const bf16x8*)(vp + ks * 32), wf[ks], a, 0, 0, 0);
                            const size_t o = (row0 + tl) * 512 + g * 128 + dt * 16 + 4 * hq;
                            const uint2 uw = *(const uint2*)(U + o);
                            store_bf16x4(OGM + o, __uint_as_float(uw.x << 16) * (a[0] + bsv), __uint_as_float(uw.x & 0xffff0000u) * (a[1] + bsv),
                                         __uint_as_float(uw.y << 16) * (a[2] + bsv), __uint_as_float(uw.y & 0xffff0000u) * (a[3] + bsv));
                        }
                    }
                }
                __syncthreads();
            }
        }
    }
    }
    xcd_barrier(xb);

    { PHASE_BEGIN
    {
        __syncthreads();
        float* gl = (float*)smem + wave * 256;
        for (int task = bid * 8 + wave; task < 2 * 2044; task += nb * 8) {
            const int kv = task >= 2044 ? 1 : 0, r = task - kv * 2044;
            const float* hp = HID + ((size_t)kv * 2048 + r) * 256; const float* bb = B1F + kv * 256; const float* b1 = kv ? p.b1_v : p.b1_k;
#pragma unroll
            for (int i = 0; i < 4; ++i) gl[lane + 64 * i] = gelu_f(hp[lane + 64 * i] + bb[lane + 64 * i] + b1[lane + 64 * i]);
            lds_fence();
            const float* w2 = kv ? p.w2_v : p.w2_k;
            float a = 0.f;
#pragma unroll 8
            for (int j = 0; j < 256; ++j) a += gl[j] * w2[j * 64 + lane];
            const int b = r / 1022, rr = r - b * 1022, c = rr >> 1, g = rr & 1, n = lane;
            if (kv == 0) KCB[(size_t)(b * 2 + g) * 512 * 64 + nsa_koff(c, n)] = f2bf(a); else VCT[(size_t)(b * 2 + g) * 512 * 64 + nsa_voff(c, n)] = f2bf(a);
            lds_fence();
        }
        if (bid == 0 && tid < 256) { const int bg = tid >> 6, n = tid & 63; KCB[(size_t)bg * 512 * 64 + nsa_koff(511, n)] = 0; VCT[(size_t)bg * 512 * 64 + nsa_voff(511, n)] = 0; }
    }
    }
    xcd_barrier(xb);

    { PHASE_BEGIN
    {
        float* impL = (float*)smem + wave * 1024;
        int* sidxL = (int*)(impL + 512);
        const bf16_t* KS = KV6 + 2ull * 16384 * 128; const bf16_t* VST = KV6 + 3ull * 16384 * 128;
        const bf16_t* KW = KV6 + 4ull * 16384 * 128; const bf16_t* VWT = KV6 + 5ull * 16384 * 128;
        const int c = lane & 15, h = lane >> 4, tokc = c >> 2, headc = c & 3;
        const int rk = 8 * (c >> 2) + (c & 3), dh = 8 * h;
        for (int task = bid * 8 + wave; task < 8192; task += nb * 8) {
            const int bg = task >> 11, q4 = (bg & 1) ? 2047 - (task & 2047) : (task & 2047), b = bg >> 1, g = bg & 1, t0 = q4 * 4;
            const int tcol = t0 + tokc; const size_t bt0 = (size_t)b * 8192 + t0;
            bf16x8 qf[2];
            { const bf16_t* qp = Q + (bt0 + tokc) * 512 + g * 256 + headc * 64 + dh; qf[0] = *(const bf16x8*)qp; qf[1] = *(const bf16x8*)(qp + 32); }
            const float* gp = GATES + (bt0 + tokc) * 24 + (g * 4 + headc) * 3;
            const float gate0 = gp[0], gate1 = gp[1], gate2 = gp[2];
            f32x4 comb[4];
#pragma unroll
            for (int dt = 0; dt < 4; ++dt) comb[dt] = (f32x4){0.f, 0.f, 0.f, 0.f};
            {
                const int ncvc = tcol >= 31 ? ((tcol - 31) >> 4) + 1 : 0;
                const int ncvmax = (t0 + 3) >= 31 ? ((t0 + 3 - 31) >> 4) + 1 : 0;
                const int nch = (ncvmax + 31) >> 5;
                const bf16_t* Kc = KCB + (size_t)bg * 512 * 64; const bf16_t* Vc = VCT + (size_t)bg * 64 * 512;
                NsaSt st; nsa_init(st);
                {
                    auto ld = [&](NsaBuf& bf, int i) { nsa_load_kf(bf.ka, Kc, i, lane); };
                    auto cp = [&](NsaBuf& bf, int i) { float sv[8]; nsa_scores(bf.ka, qf, sv); nsa_chunk<false>(st, sv, i * 32 + dh, 0, ncvc - 1, bf.va); };
                    nsa_stream2(nch, ld, cp);
                }
                float l = st.l; l = xsum16(l); l = xsum32(l);
                const float inv = 1.0f / fmaxf(l, 1e-30f), mfin = st.m;
                *(float4*)(impL + lane * 8) = make_float4(0.f, 0.f, 0.f, 0.f); *(float4*)(impL + lane * 8 + 4) = make_float4(0.f, 0.f, 0.f, 0.f);
                lds_fence();
                f32x4 oc[4];
#pragma unroll
                for (int dt = 0; dt < 4; ++dt) oc[dt] = (f32x4){0.f, 0.f, 0.f, 0.f};
                float carry = 0.f;
                {
                    auto ld = [&](NsaBuf& bf, int i) { nsa_load_kf(bf.ka, Kc, i, lane); nsa_load_kf(bf.va, Vc, i, lane); };
                    auto cp = [&](NsaBuf& bf, int ch) {
                        float sv[8]; nsa_scores(bf.ka, qf, sv);
                        float p[8];
#pragma unroll
                        for (int j = 0; j < 8; ++j) p[j] = (ch * 32 + dh + j < ncvc) ? __builtin_amdgcn_exp2f(sv[j] - mfin) * inv : 0.f;
                        const float up = __shfl(p[7], (lane + 48) & 63);
                        const float prev7 = (h >= 1) ? up : carry; carry = up;
                        float i0 = p[0] + p[1] + p[2] + 0.5f * p[3] + 0.5f * prev7, i1 = p[4] + p[5] + p[6] + 0.5f * p[7] + 0.5f * p[3];
                        i0 += __shfl_xor(i0, 1); i0 += __shfl_xor(i0, 2); i1 += __shfl_xor(i1, 1); i1 += __shfl_xor(i1, 2);
                        if (headc == 0) { impL[tokc * 128 + 8 * ch + 2 * h] = i0; impL[tokc * 128 + 8 * ch + 2 * h + 1] = i1; }
                        const bf16x8 pb = pack8(p);
#pragma unroll
                        for (int dt = 0; dt < 4; ++dt) oc[dt] = __builtin_amdgcn_mfma_f32_16x16x32_bf16(bf.va[dt], pb, oc[dt], 0, 0, 0);
                    };
                    nsa_stream2(nch, ld, cp);
                }
#pragma unroll
                for (int dt = 0; dt < 4; ++dt) comb[dt] += oc[dt] * gate0;
            }
            lds_fence();
            int nblk;
            {
                const int tok = lane >> 4, sub = lane & 15, cur = t0 >> 6;
                float sc[8];
#pragma unroll
                for (int e = 0; e < 8; ++e) { const int j = sub + 16 * e; const float imp = impL[tok * 128 + j];
                    const bool al = j <= cur, fo = (j == 0) || (j == cur) || (j == cur - 1);
                    sc[e] = (fo && al) ? 1e4f : (al ? imp : -1e30f); }
                unsigned k8[8];
#pragma unroll
                for (int e = 0; e < 8; ++e) k8[e] = key_pack(sc[e], sub + 16 * e);
                bitonic_sort_desc<8>(k8);
                unsigned k16[16];
#pragma unroll
                for (int e = 0; e < 8; ++e) { k16[e] = k8[e]; k16[15 - e] = (unsigned)__shfl_xor((int)k8[e], 1); }
                bitonic_merge_desc<16>(k16);
#pragma unroll
                for (int o = 2; o < 16; o <<= 1) {
                    unsigned pk[16];
#pragma unroll
                    for (int e = 0; e < 16; ++e) pk[e] = (unsigned)__shfl_xor((int)k16[e], o);
#pragma unroll
                    for (int e = 0; e < 16; ++e) k16[e] = k16[e] > pk[15 - e] ? k16[e] : pk[15 - e];
                    bitonic_merge_desc<16>(k16);
                }
                unsigned mk = k16[0];
#pragma unroll
                for (int e = 1; e < 16; ++e) mk = (sub == e) ? k16[e] : mk;
                const float myv = key_val(mk); const int myi = 127 - (int)(mk & 127u);
                const bool forced = myv > 5e3f;
                const bool keep = (myv > -0.5e30f) && !(forced && tok > 0);
                const unsigned long long bal = __ballot(keep);
                const int pos = __popcll(bal & ((1ull << lane) - 1ull));
                lds_fence();
                if (keep) sidxL[pos] = ((forced ? 7 : tok) << 16) | myi;
                nblk = __popcll(bal);
            }
            lds_fence();
            {
                NsaSt8 st; nsa_init8(st);
                const unsigned char* Kp = (const unsigned char*)KS + (size_t)bg * 8192 * 64; const unsigned char* Vp = (const unsigned char*)VST + (size_t)bg * 8192 * 64;
                long qf8[2];
                { const unsigned char* qp = ws + O_Q8 + (bt0 + tokc) * 512 + g * 256 + headc * 64 + dh; qf8[0] = *(const long*)qp; qf8[1] = *(const long*)(qp + 32); }
                const int cur_ = t0 >> 6;
                auto ld = [&](NsaBlk8& bf, int i) { const int e = __builtin_amdgcn_readfirstlane(sidxL[i]); const int chn = (e & 0xffff) * 2; bf.e = e;
                    long t4[4];
                    nsa_load8(t4, Kp, chn, lane); bf.ka[0] = t4[0]; bf.ka[1] = t4[1]; bf.ka[2] = t4[2]; bf.ka[3] = t4[3];
                    nsa_load8(t4, Kp, chn + 1, lane); bf.ka[4] = t4[0]; bf.ka[5] = t4[1]; bf.ka[6] = t4[2]; bf.ka[7] = t4[3];
                    nsa_load8(t4, Vp, chn, lane); bf.va[0] = t4[0]; bf.va[1] = t4[1]; bf.va[2] = t4[2]; bf.va[3] = t4[3];
                    nsa_load8(t4, Vp, chn + 1, lane); bf.va[4] = t4[0]; bf.va[5] = t4[1]; bf.va[6] = t4[2]; bf.va[7] = t4[3]; };
                auto cp = [&](NsaBlk8& bf, int i) { const int e = bf.e; const int blk = e & 0xffff, ow = e >> 16;
                    if (blk == cur_) { const int hi = (ow == 7 || ow == tokc) ? tcol : -1; nsa_block8<2>(st, bf, qf8, blk * 64 + dh, hi, false); }
                    else if (ow == 7) nsa_block8<0>(st, bf, qf8, 0, 0, true);
                    else nsa_block8<1>(st, bf, qf8, 0, 0, ow == tokc); };
                nsa_streamb(nblk, ld, cp);
                nsa_fold8(comb, st, gate1);
            }
            {
                NsaSt st; nsa_init(st);
                const bf16_t* Kp = KW + (size_t)bg * 8192 * 64; const bf16_t* Vp = VWT + (size_t)bg * 8192 * 64;
                const int kbf = (t0 > 511 ? t0 - 511 : 0) & ~31, kbl = (t0 + 3) & ~31;
                const int lo = tcol > 511 ? tcol - 511 : 0;
                auto ld = [&](NsaBuf& bf, int i) { const int kb = kbf + i * 32; nsa_load_kf(bf.ka, Kp, kb >> 5, lane); nsa_load_kf(bf.va, Vp, kb >> 5, lane); };
                auto cp = [&](NsaBuf& bf, int i) { const int kb = kbf + i * 32; float sv[8]; nsa_scores(bf.ka, qf, sv); nsa_chunk<true>(st, sv, kb + dh, lo, tcol, bf.va); };
                nsa_stream2(((kbl - kbf) >> 5) + 1, ld, cp);
                nsa_fold(comb, st, gate2);
            }
            {
                bf16_t* op = ONSA + (bt0 + tokc) * 512 + g * 256 + headc * 64 + 4 * h;
#pragma unroll
                for (int dt = 0; dt < 4; ++dt) store_bf16x4(op + dt * 16, comb[dt][0], comb[dt][1], comb[dt][2], comb[dt][3]);
            }
            lds_fence();
        }
    }
    }
    xcd_barrier(xb);

    { PHASE_BEGIN
    {
        auto unpack8 = [](const u32x4& w, f32x4& a, f32x4& b) { a[0] = __uint_as_float(w.x << 16); a[1] = __uint_as_float(w.x & 0xffff0000u); a[2] = __uint_as_float(w.y << 16); a[3] = __uint_as_float(w.y & 0xffff0000u);
            b[0] = __uint_as_float(w.z << 16); b[1] = __uint_as_float(w.z & 0xffff0000u); b[2] = __uint_as_float(w.w << 16); b[3] = __uint_as_float(w.w & 0xffff0000u); };
        auto e1 = [&](int r, int c, const f32x4& v0, const f32x4& v1) { f32x4 m0, m1; unpack8(*(const u32x4*)(MG + (size_t)r * 2048 + c), m0, m1); store_bf16x8(Y + (size_t)r * 1024 + c, m0 * v0, m1 * v1); };
        big_gemm(smem, ONSA, WNSA, 16384, 1024, 512, e1);
        auto e2 = [&](int r, int c, const f32x4& v0, const f32x4& v1) { f32x4 m0, m1, y0, y1; unpack8(*(const u32x4*)(MG + (size_t)r * 2048 + 1024 + c), m0, m1); unpack8(*(const u32x4*)(Y + (size_t)r * 1024 + c), y0, y1);
            store_bf16x8(Y + (size_t)r * 1024 + c, y0 + m0 * v0, y1 + m1 * v1); };
        big_gemm(smem, OGM, WGM, 16384, 1024, 512, e2);
    }
    }
    xcd_barrier(xb);

    { PHASE_BEGIN
    {
        auto epi = [&](int r, int c, const f32x4& v0, const f32x4& v1) { const float* xp = p.x + (size_t)r * 1024 + c; float* op = OUT + (size_t)r * 1024 + c;
            const f32x4 h0 = *(const f32x4*)xp + v0, h1 = *(const f32x4*)(xp + 4) + v1;
            *(f32x4*)op = h0; *(f32x4*)(op + 4) = h1; store_bf16x8(HN + (size_t)r * 1024 + c, h0, h1);
            float ss = (h0[0] * h0[0] + h0[1] * h0[1]) + (h0[2] * h0[2] + h0[3] * h0[3]) + (h1[0] * h1[0] + h1[1] * h1[1]) + (h1[2] * h1[2] + h1[3] * h1[3]);
            ss = xsum16(ss); ss = xsum32(ss);
            if (lane < 16) unsafeAtomicAdd(SS + r, ss); };
        big_gemm(smem, Y, WMIX, 16384, 1024, 1024, epi);
    }
    }
    xcd_barrier(xb);

    { PHASE_BEGIN
    {
        auto epi = [&](int r, int c, const f32x4& v0, const f32x4& v1) { const float rs = rsqrtf(SS[r] * (1.0f / 1024.0f) + 1e-6f) * 0.0625f; store_bf16x8(QX + (size_t)r * 1024 + c, v0 * rs, v1 * rs); };
        big_gemm(smem, HN, WXQ, 16384, 1024, 1024, epi);
    }
    }
    xcd_barrier(xb);

    { PHASE_BEGIN
    {
        const int c = lane & 15, hg = lane >> 4;
        for (int task = bid; task < 512; task += nb) {
            const int h = task & 3, tg = task >> 2, b = tg >> 6; const size_t bt0 = (size_t)tg * 128 + wave * 16;
            const uint4* Kg = (const uint4*)(KVX + (size_t)(b * 4 + h) * 65536); const uint4* Vg = (const uint4*)(VXT + (size_t)(b * 4 + h) * 65536);
            __syncthreads();
#pragma unroll 4
            for (int i = tid; i < 8192; i += NTHREADS) ((uint4*)smem)[i] = Kg[i];
            bf16x8 qf[8];
#pragma unroll
            for (int ks = 0; ks < 8; ++ks) qf[ks] = *(const bf16x8*)(QX + (bt0 + c) * 1024 + h * 256 + ks * 32 + 8 * hg);
            __syncthreads();
            float sv[8][8];
#pragma unroll
            for (int ch = 0; ch < 8; ++ch) {
                f32x4 s0 = {0.f, 0.f, 0.f, 0.f}, s1 = {0.f, 0.f, 0.f, 0.f};
#pragma unroll
                for (int ks = 0; ks < 8; ++ks) {
                    const bf16x8 a0 = *(const bf16x8*)(smem + ((ch * 16 + ks) * 64 + lane) * 16), a1 = *(const bf16x8*)(smem + ((ch * 16 + 8 + ks) * 64 + lane) * 16);
                    s0 = __builtin_amdgcn_mfma_f32_16x16x32_bf16(a0, qf[ks], s0, 0, 0, 0); s1 = __builtin_amdgcn_mfma_f32_16x16x32_bf16(a1, qf[ks], s1, 0, 0, 0);
                }
                sv[ch][0] = s0[0]; sv[ch][1] = s0[1]; sv[ch][2] = s0[2]; sv[ch][3] = s0[3]; sv[ch][4] = s1[0]; sv[ch][5] = s1[1]; sv[ch][6] = s1[2]; sv[ch][7] = s1[3];
            }
            float m = sv[0][0];
#pragma unroll
            for (int ch = 0; ch < 8; ++ch)
#pragma unroll
                for (int j = 0; j < 8; ++j) m = fmaxf(m, sv[ch][j]);
            m = xmax16(m); m = xmax32(m);
            float l = 0.f; bf16x8 pb[8];
#pragma unroll
            for (int ch = 0; ch < 8; ++ch) { float pp[8];
#pragma unroll
                for (int j = 0; j < 8; ++j) { pp[j] = __expf(sv[ch][j] - m); l += pp[j]; }
                pb[ch] = pack8(pp); }
            l = xsum16(l); l = xsum32(l);
            const float inv = 1.0f / l;
            __syncthreads();
#pragma unroll 4
            for (int i = tid; i < 8192; i += NTHREADS) ((uint4*)smem)[i] = Vg[i];
            __syncthreads();
            bf16_t* op = OX + (bt0 + c) * 1024 + h * 256 + 4 * hg;
#pragma unroll 4
            for (int dt = 0; dt < 16; ++dt) {
                f32x4 o = {0.f, 0.f, 0.f, 0.f};
#pragma unroll
                for (int ch = 0; ch < 8; ++ch) o = __builtin_amdgcn_mfma_f32_16x16x32_bf16(*(const bf16x8*)(smem + ((ch * 16 + dt) * 64 + lane) * 16), pb[ch], o, 0, 0, 0);
                store_bf16x4(op + dt * 16, o[0] * inv, o[1] * inv, o[2] * inv, o[3] * inv);
            }
        }
        __syncthreads();
    }
    }
    xcd_barrier(xb);

    { PHASE_BEGIN
    {
        auto epi = [&](int r, int c, const f32x4& v0, const f32x4& v1) { float* op = OUT + (size_t)r * 1024 + c;
            const f32x4 h0 = *(const f32x4*)op + v0, h1 = *(const f32x4*)(op + 4) + v1;
            *(f32x4*)op = h0; *(f32x4*)(op + 4) = h1; store_bf16x8(HN + (size_t)r * 1024 + c, h0, h1);
            float ss = (h0[0] * h0[0] + h0[1] * h0[1]) + (h0[2] * h0[2] + h0[3] * h0[3]) + (h1[0] * h1[0] + h1[1] * h1[1]) + (h1[2] * h1[2] + h1[3] * h1[3]);
            ss = xsum16(ss); ss = xsum32(ss);
            if (lane < 16) unsafeAtomicAdd(SS + 16384 + r, ss); };
        big_gemm(smem, OX, WXO, 16384, 1024, 1024, epi);
    }
    {
        for (int row = bid * 8 + wave; row < 32768; row += nb * 8) {
            const bool isv = row >= 16384; const int rr = isv ? row - 16384 : row;
            const float* src = (isv ? p.peer_v : p.peer_u) + (size_t)rr * 1024 + lane * 16;
            float f[16];
#pragma unroll
            for (int i = 0; i < 4; ++i) { const float4 a = *(const float4*)(src + 4 * i); f[4 * i] = a.x; f[4 * i + 1] = a.y; f[4 * i + 2] = a.z; f[4 * i + 3] = a.w; }
            float am = 0.f;
#pragma unroll
            for (int i = 0; i < 16; ++i) am = fmaxf(am, fabsf(f[i]));
            am = wave_max(am);
            int ex = 0; (void)frexpf(am, &ex);
            if (am == 0.f) ex = 8;
            const float sc = ldexpf(1.0f, 8 - ex);
            uint4 w; unsigned* wp = (unsigned*)&w;
#pragma unroll
            for (int i = 0; i < 4; ++i) { int t = 0; t = __builtin_amdgcn_cvt_pk_fp8_f32(f[4 * i] * sc, f[4 * i + 1] * sc, t, false); t = __builtin_amdgcn_cvt_pk_fp8_f32(f[4 * i + 2] * sc, f[4 * i + 3] * sc, t, true); wp[i] = (unsigned)t; }
            *(uint4*)((isv ? PV8 : PU8) + (size_t)rr * 1024 + lane * 16) = w;
            if (lane == 0) PSC[row] = ldexpf(1.0f, ex - 8);
        }
    }
    }
    xcd_barrier(xb);

    { PHASE_BEGIN
    {
        auto epi = [&](int r, int c, const f32x4& v0, const f32x4& v1) { const float rs = rsqrtf(SS[16384 + r] * (1.0f / 1024.0f) + 1e-6f); store_bf16x8(QP + (size_t)r * 2048 + c, v0 * rs, v1 * rs); };
        big_gemm(smem, HN, WPQ, 16384, 2048, 1024, epi);
    }
    }
    xcd_barrier(xb);

    { PHASE_BEGIN
    {
        const int c = lane & 15, hg = lane >> 4;
        for (int task = bid * 8 + wave; task < 16384; task += nb * 8) {
            const int hp = task & 15, tgrp = task >> 4; const size_t bt0 = (size_t)tgrp * 16;
            bf16x8 qf[4];
#pragma unroll
            for (int ks = 0; ks < 4; ++ks) qf[ks] = *(const bf16x8*)(QP + (bt0 + c) * 2048 + hp * 128 + ks * 32 + 8 * hg);
            const bf16_t* Kp = SUBK + (size_t)hp * 16384 + lane * 8;
            float sc[32];
#pragma unroll
            for (int kt = 0; kt < 8; ++kt) {
                f32x4 a = {0.f, 0.f, 0.f, 0.f};
#pragma unroll
                for (int ks = 0; ks < 4; ++ks) a = __builtin_amdgcn_mfma_f32_16x16x32_bf16(*(const bf16x8*)(Kp + (kt * 4 + ks) * 512), qf[ks], a, 0, 0, 0);
                sc[kt * 4 + 0] = a[0]; sc[kt * 4 + 1] = a[1]; sc[kt * 4 + 2] = a[2]; sc[kt * 4 + 3] = a[3];
            }
            unsigned ka_[16], kb_[16];
#pragma unroll
            for (int e = 0; e < 16; ++e) { ka_[e] = key_pack(sc[e], (e >> 2) * 16 + 4 * hg + (e & 3)); kb_[e] = key_pack(sc[16 + e], ((16 + e) >> 2) * 16 + 4 * hg + (e & 3)); }
            bitonic_sort_desc<16>(ka_); bitonic_sort_desc<16>(kb_);
#pragma unroll
            for (int e = 0; e < 16; ++e) ka_[e] = ka_[e] > kb_[15 - e] ? ka_[e] : kb_[15 - e];
            bitonic_merge_desc<16>(ka_);
#pragma unroll
            for (int e = 0; e < 16; ++e) kb_[e] = xchg16(ka_[e], lane);
#pragma unroll
            for (int e = 0; e < 16; ++e) ka_[e] = ka_[e] > kb_[15 - e] ? ka_[e] : kb_[15 - e];
            bitonic_merge_desc<16>(ka_);
#pragma unroll
            for (int e = 0; e < 16; ++e) kb_[e] = xchg32(ka_[e], lane);
#pragma unroll
            for (int e = 0; e < 16; ++e) ka_[e] = ka_[e] > kb_[15 - e] ? ka_[e] : kb_[15 - e];
            bitonic_merge_desc<16>(ka_);
            if (hg == 0) {
                float* hsp = HS + (bt0 + c) * 256 + hp * 16; int* hip_ = HI + (bt0 + c) * 256 + hp * 16;
#pragma unroll
                for (int e = 0; e < 16; e += 4) {
                    *(float4*)(hsp + e) = make_float4(key_val(ka_[e]), key_val(ka_[e + 1]), key_val(ka_[e + 2]), key_val(ka_[e + 3]));
                    *(int4*)(hip_ + e) = make_int4(127 - (int)(ka_[e] & 127u), 127 - (int)(ka_[e + 1] & 127u), 127 - (int)(ka_[e + 2] & 127u), 127 - (int)(ka_[e + 3] & 127u));
                }
            }
        }
    }
    }
    xcd_barrier(xb);

    { PHASE_BEGIN
    {
        int* exl = (int*)smem + wave * 256; float* gtl = (float*)(exl + 128);
        for (int tok = bid * 8 + wave; tok < 16384; tok += nb * 8) {
#pragma unroll 1
            for (int hh = 0; hh < 2; ++hh) {
                const int head = hh * 4 + (lane >> 4), i = lane & 15, gb = lane & 48;
                const float* s0p = HS + (size_t)tok * 256 + (2 * head) * 16;
                const float s0i = s0p[i], s1m = s0p[16 + i];
                int pj = 0; float myv = 0.f; int myf = 0;
#pragma unroll 1
                for (int it = 0; it < 16; ++it) {
                    const float s1v = __shfl(s1m, gb + (pj & 15));
                    float bv = pj < 16 ? s0i + s1v : -INFINITY; int bf = i * 16 + pj;
#pragma unroll
                    for (int o = 1; o < 16; o <<= 1) { const float ov = __shfl_xor(bv, o); const int of = __shfl_xor(bf, o);
                        const bool take = (ov > bv) || (ov == bv && of < bf); bv = take ? ov : bv; bf = take ? of : bf; }
                    if (i == it) { myv = bv; myf = bf; }
                    if ((bf >> 4) == i) ++pj;
                }
                const float vmax = __shfl(myv, gb);
                const float e = expf(myv - vmax);
                float se = e;
#pragma unroll
                for (int o = 1; o < 16; o <<= 1) se += __shfl_xor(se, o);
                const int* i0p = HI + (size_t)tok * 256 + (2 * head) * 16;
                exl[head * 16 + i] = i0p[myf >> 4] * 128 + i0p[16 + (myf & 15)];
                gtl[head * 16 + i] = e / se;
            }
            lds_fence();
            float xv[16];
            { const float rs2 = rsqrtf(SS[16384 + tok] * (1.0f / 1024.0f) + 1e-6f);
              const float* hp2 = OUT + (size_t)tok * 1024 + lane * 16; const float* gpp = p.g_peer + lane * 16;
#pragma unroll
              for (int i = 0; i < 4; ++i) { const float4 hv = *(const float4*)(hp2 + 4 * i), gv = *(const float4*)(gpp + 4 * i);
                  xv[4 * i] = hv.x * rs2 * gv.x; xv[4 * i + 1] = hv.y * rs2 * gv.y; xv[4 * i + 2] = hv.z * rs2 * gv.z; xv[4 * i + 3] = hv.w * rs2 * gv.w; } }
#pragma unroll 1
            for (int e0 = 0; e0 < 128; e0 += 16) {
                uint4 ur[16];
#pragma unroll
                for (int q = 0; q < 16; ++q) ur[q] = *(const uint4*)(PU8 + (size_t)exl[e0 + q] * 1024 + lane * 16);
                float d[16];
#pragma unroll
                for (int q = 0; q < 16; ++q) {
                    const unsigned* wp = (const unsigned*)&ur[q]; float a = 0.f;
#pragma unroll
                    for (int i = 0; i < 4; ++i) { const auto lo = __builtin_amdgcn_cvt_pk_f32_fp8((int)wp[i], false); const auto hi = __builtin_amdgcn_cvt_pk_f32_fp8((int)wp[i], true);
                        a += lo[0] * xv[4 * i] + lo[1] * xv[4 * i + 1] + hi[0] * xv[4 * i + 2] + hi[1] * xv[4 * i + 3]; }
                    d[q] = a;
                }
                {
                    const bool u5 = lane & 32, u4 = lane & 16, u3 = lane & 8, u2 = lane & 4;
                    float e8[8], e4[4], e2[2], e1;
#pragma unroll
                    for (int q = 0; q < 8; ++q) { const float keep = u5 ? d[q + 8] : d[q], send = u5 ? d[q] : d[q + 8]; e8[q] = keep + __uint_as_float(xchg32(__float_as_uint(send), lane)); }
#pragma unroll
                    for (int q = 0; q < 4; ++q) { const float keep = u4 ? e8[q + 4] : e8[q], send = u4 ? e8[q] : e8[q + 4]; e4[q] = keep + __uint_as_float(xchg16(__float_as_uint(send), lane)); }
#pragma unroll
                    for (int q = 0; q < 2; ++q) { const float keep = u3 ? e4[q + 2] : e4[q], send = u3 ? e4[q] : e4[q + 2]; e2[q] = keep + __shfl_xor(send, 8); }
                    { const float keep = u2 ? e2[1] : e2[0], send = u2 ? e2[0] : e2[1]; e1 = keep + __shfl_xor(send, 4); }
                    e1 += __shfl_xor(e1, 2); e1 += __shfl_xor(e1, 1);
                    if ((lane & 3) == 0) { const int q = ((lane >> 5) & 1) * 8 + ((lane >> 4) & 1) * 4 + ((lane >> 3) & 1) * 2 + ((lane >> 2) & 1);
                        const int ex_ = exl[e0 + q];
                        gtl[e0 + q] = gtl[e0 + q] * gelu_f(e1 * PSC[ex_]) * PSC[16384 + ex_]; }
                }
            }
            lds_fence();
            float ac[16];
#pragma unroll
            for (int i = 0; i < 16; ++i) ac[i] = 0.f;
#pragma unroll 1
            for (int e0 = 0; e0 < 128; e0 += 16) {
                uint4 vr[16];
#pragma unroll
                for (int q = 0; q < 16; ++q) vr[q] = *(const uint4*)(PV8 + (size_t)exl[e0 + q] * 1024 + lane * 16);
#pragma unroll
                for (int q = 0; q < 16; ++q) { const float cf = gtl[e0 + q]; const unsigned* wp = (const unsigned*)&vr[q];
#pragma unroll
                    for (int i = 0; i < 4; ++i) { const auto lo = __builtin_amdgcn_cvt_pk_f32_fp8((int)wp[i], false); const auto hi = __builtin_amdgcn_cvt_pk_f32_fp8((int)wp[i], true);
                        ac[4 * i] += cf * lo[0]; ac[4 * i + 1] += cf * lo[1]; ac[4 * i + 2] += cf * hi[0]; ac[4 * i + 3] += cf * hi[1]; }
                }
            }
            float ss = 0.f;
            {
                float* hp = OUT + (size_t)tok * 1024 + lane * 16;
#pragma unroll
                for (int i = 0; i < 4; ++i) { const float4 hv = *(const float4*)(hp + 4 * i);
                    ac[4 * i] += hv.x; ac[4 * i + 1] += hv.y; ac[4 * i + 2] += hv.z; ac[4 * i + 3] += hv.w; }
#pragma unroll
                for (int i = 0; i < 16; ++i) ss += ac[i] * ac[i];
                ss = wave_sum(ss);
                const float rr = rsqrtf(ss * (1.0f / 1024.0f) + 1e-6f);
#pragma unroll
                for (int i = 0; i < 4; ++i) { const float4 gg = *(const float4*)(p.g_final + lane * 16 + 4 * i);
                    *(float4*)(hp + 4 * i) = make_float4(ac[4 * i] * rr * gg.x, ac[4 * i + 1] * rr * gg.y, ac[4 * i + 2] * rr * gg.z, ac[4 * i + 3] * rr * gg.w); }
            }
            lds_fence();
        }
    }
    }
}

extern "C" void kernel_launch(void* const* d_in, const int* in_sizes, int n_in, void* d_out, int out_size, void* d_ws, size_t ws_size, hipStream_t stream) {
    static int grid_blocks = 0;
    if (grid_blocks == 0) {
        int dev = 0, cus = 0, per_cu = 0;
        hipGetDevice(&dev);
        hipDeviceGetAttribute(&cus, hipDeviceAttributeMultiprocessorCount, dev);
        if (hipFuncSetAttribute((const void*)fwd_mega, hipFuncAttributeMaxDynamicSharedMemorySize, LDS_BYTES) != hipSuccess) { fprintf(stderr, "hipFuncSetAttribute failed\n"); }
        if (hipOccupancyMaxActiveBlocksPerMultiprocessor(&per_cu, (const void*)fwd_mega, NTHREADS, LDS_BYTES) != hipSuccess || per_cu < 1) { fprintf(stderr, "occupancy query failed (%d)\n", per_cu); per_cu = 1; }
        (void)hipGetLastError();
        if (per_cu > 1) per_cu = 1;
        grid_blocks = cus * per_cu;
        if (ws_size < O_END) { fprintf(stderr, "workspace too small: %zu < %zu\n", ws_size, (size_t)O_END); grid_blocks = -1; }
    }
    if (grid_blocks < 0) return;
    Params p{};
    const float** pp = (const float**)&p;
    for (int i = 0; i < 30; ++i) pp[i] = (const float*)d_in[i];
    p.out = (float*)d_out; p.ws = (unsigned char*)d_ws;
    if (hipMemsetAsync((char*)d_ws + O_BAR, 0, 16384, stream) != hipSuccess) { fprintf(stderr, "memset of barrier words failed\n"); return; }
    void* args[] = {&p};
    hipError_t e = hipLaunchKernel((const void*)fwd_mega, dim3(grid_blocks), dim3(NTHREADS), args, LDS_BYTES, stream);
    if (e != hipSuccess) fprintf(stderr, "launch failed: %s (grid %d)\n", hipGetErrorString(e), grid_blocks);
}
```

```cpp
#include <hip/hip_runtime.h>
#include <cstdio>
#include <cstdint>

typedef unsigned short bf16_t;
typedef short bf16x8 __attribute__((ext_vector_type(8)));
typedef float f32x4 __attribute__((ext_vector_type(4)));
#define DEVI __device__ __forceinline__

__device__ __forceinline__ int tid_opaque() { int t = threadIdx.x; asm volatile("" : "+v"(t)); return t; }
constexpr int NTHREADS = 512;
constexpr int LDS_BYTES = 140 * 1024;

constexpr size_t O_BAR  = 0;
constexpr size_t O_WIN  = 16384;
constexpr size_t O_W1K  = O_WIN  + 4480ull * 1024 * 2;
constexpr size_t O_W1V  = O_W1K  + 256ull * 2048 * 2;
constexpr size_t O_WNSA = O_W1V  + 256ull * 2048 * 2;
constexpr size_t O_WGM  = O_WNSA + 1024ull * 512 * 2;
constexpr size_t O_WMIX = O_WGM  + 1024ull * 512 * 2;
constexpr size_t O_WXQ  = O_WMIX + 1024ull * 1024 * 2;
constexpr size_t O_WXKV = O_WXQ  + 1024ull * 1024 * 2;
constexpr size_t O_WXO  = O_WXKV + 2048ull * 1024 * 2;
constexpr size_t O_WPQ  = O_WXO  + 1024ull * 1024 * 2;
constexpr size_t O_B1   = O_WPQ  + 2048ull * 1024 * 2;
constexpr size_t O_VXT  = O_B1   + 2048;
constexpr size_t O_SUBK = O_VXT  + 8ull * 256 * 256 * 2;
constexpr size_t O_PSC  = O_SUBK + 16ull * 128 * 128 * 2;
constexpr size_t O_SS   = O_PSC  + 2ull * 16384 * 4;
constexpr size_t O_HN   = O_SS   + 3ull * 16384 * 4;
constexpr size_t O_MN   = O_HN   + 16384ull * 1024 * 2;
constexpr size_t O_KVX  = O_MN   + 512ull * 1024 * 2;
constexpr size_t O_GATES= O_KVX  + 512ull * 2048 * 2;
constexpr size_t O_HID  = O_GATES+ 16384ull * 24 * 4;
constexpr size_t O_CMP  = O_HID  + 2ull * 2048 * 256 * 4;
constexpr size_t O_Q    = O_CMP  + 2ull * 4 * 512 * 64 * 4;
constexpr size_t O_KV6  = O_Q    + 16384ull * 512 * 2;
constexpr size_t O_U    = O_KV6  + 6ull * 16384 * 128 * 2;
constexpr size_t O_VG   = O_U    + 16384ull * 512 * 2;
constexpr size_t O_MG   = O_VG   + 16384ull * 512 * 2;
constexpr size_t O_ONSA = O_MG   + 16384ull * 2048 * 2;
constexpr size_t O_OGM  = O_ONSA + 16384ull * 512 * 2;
constexpr size_t O_Q8   = O_OGM  + 16384ull * 512 * 2;
constexpr size_t O_END  = O_Q8   + 16384ull * 512;
constexpr size_t O_Y    = O_Q;
constexpr size_t O_QX   = O_U;
constexpr size_t O_OX   = O_ONSA;
constexpr size_t O_QP   = O_MG;
constexpr size_t O_HS   = O_Q;
constexpr size_t O_HI   = O_Q + 16384ull * 256 * 4;
constexpr size_t O_EX   = O_U;
static_assert(O_END <= 256ull * 1024 * 1024, "workspace too large");

struct Params {
    const float *x, *mem, *g_mix, *w_in, *pe_k, *w1_k, *b1_k, *w2_k, *pe_v, *w1_v, *b1_v, *w2_v, *ln_g, *ln_b, *gws, *gbs,
        *w_nsa_out, *w_gmlp_out, *w_mix_out, *g_xattn, *g_mem, *w_xq, *w_xkv, *w_xo, *g_peer, *w_peer_q, *sub_keys, *peer_u, *peer_v, *g_final;
    float* out;
    unsigned char* ws;
};

DEVI bf16_t f2bf(float f) { unsigned u = __float_as_uint(f); u += 0x7fffu + ((u >> 16) & 1u); return (bf16_t)(u >> 16); }
DEVI float bf2f(bf16_t h) { return __uint_as_float(((unsigned)h) << 16); }
DEVI float tof(float v) { return v; }
DEVI float tof(bf16_t v) { return bf2f(v); }
DEVI float wave_sum(float v);
DEVI float wave_max(float v);

DEVI float xmax16(float x) { const auto r = __builtin_amdgcn_permlane16_swap(__float_as_uint(x), __float_as_uint(x), false, false); return fmaxf(__uint_as_float(r[0]), __uint_as_float(r[1])); }
DEVI float xmax32(float x) { const auto r = __builtin_amdgcn_permlane32_swap(__float_as_uint(x), __float_as_uint(x), false, false); return fmaxf(__uint_as_float(r[0]), __uint_as_float(r[1])); }
DEVI float xsum16(float x) { const auto r = __builtin_amdgcn_permlane16_swap(__float_as_uint(x), __float_as_uint(x), false, false); return __uint_as_float(r[0]) + __uint_as_float(r[1]); }
DEVI float xsum32(float x) { const auto r = __builtin_amdgcn_permlane32_swap(__float_as_uint(x), __float_as_uint(x), false, false); return __uint_as_float(r[0]) + __uint_as_float(r[1]); }
DEVI unsigned xchg16(unsigned x, int lane) { const auto r = __builtin_amdgcn_permlane16_swap(x, x, false, false); return (lane & 16) ? r[0] : r[1]; }
DEVI unsigned xchg32(unsigned x, int lane) { const auto r = __builtin_amdgcn_permlane32_swap(x, x, false, false); return (lane & 32) ? r[0] : r[1]; }
DEVI float wave_sum(float v) { v = xsum32(v); v = xsum16(v); for (int o = 8; o > 0; o >>= 1) v += __shfl_xor(v, o); return v; }
DEVI float wave_max(float v) { v = xmax32(v); v = xmax16(v); for (int o = 8; o > 0; o >>= 1) v = fmaxf(v, __shfl_xor(v, o)); return v; }
DEVI float gelu_f(float x) { return 0.5f * x * (1.0f + erff(x * 0.70710678118654752f)); }
DEVI float sigmoid_f(float x) { return 1.0f / (1.0f + expf(-x)); }
DEVI void wave_argmax(float& v, int& idx) {
    for (int o = 32; o > 0; o >>= 1) {
        const float ov = __shfl_xor(v, o); const int oi = __shfl_xor(idx, o);
        const bool take = (ov > v) || (ov == v && oi < idx);
        v = take ? ov : v; idx = take ? oi : idx;
    }
}
typedef unsigned u32x4 __attribute__((ext_vector_type(4)));
DEVI unsigned cvt_pk_bf16(float lo, float hi) { unsigned r; asm("v_cvt_pk_bf16_f32 %0, %1, %2" : "=v"(r) : "v"(lo), "v"(hi)); return r; }
DEVI bf16x8 pack8(const float (&p)[8]) { u32x4 u; u.x = cvt_pk_bf16(p[0], p[1]); u.y = cvt_pk_bf16(p[2], p[3]); u.z = cvt_pk_bf16(p[4], p[5]); u.w = cvt_pk_bf16(p[6], p[7]); return __builtin_bit_cast(bf16x8, u); }
DEVI void lds_fence() { asm volatile("s_waitcnt lgkmcnt(0)" ::: "memory"); }
DEVI void load8(const float* p, float (&f)[8]) { const float4 a = *(const float4*)p, b = *(const float4*)(p + 4); f[0]=a.x; f[1]=a.y; f[2]=a.z; f[3]=a.w; f[4]=b.x; f[5]=b.y; f[6]=b.z; f[7]=b.w; }
DEVI void load8(const bf16_t* p, float (&f)[8]) { const uint4 a = *(const uint4*)p;
    f[0] = __uint_as_float(a.x << 16); f[1] = __uint_as_float(a.x & 0xffff0000u); f[2] = __uint_as_float(a.y << 16); f[3] = __uint_as_float(a.y & 0xffff0000u);
    f[4] = __uint_as_float(a.z << 16); f[5] = __uint_as_float(a.z & 0xffff0000u); f[6] = __uint_as_float(a.w << 16); f[7] = __uint_as_float(a.w & 0xffff0000u); }

template <class CMap>
DEVI void transpose_tile(const float* src, int srcN, bf16_t* dst, int K, int tl, CMap cmap, float* tile, const float* kscale = nullptr) {
    const int nkt = K / 64, kt = tl % nkt, nt = tl / nkt, k0 = kt * 64, n0 = nt * 64;
    const int tidq = tid_opaque(), tx = tidq & 63, ty = tidq >> 6;
    const int sc = cmap(n0 + tx);
#pragma unroll
    for (int i = 0; i < 8; ++i) { const int k = k0 + ty + 8 * i; tile[(ty + 8 * i) * 65 + tx] = sc >= 0 ? src[(size_t)k * srcN + sc] * (kscale ? kscale[k] : 1.0f) : 0.f; }
    __syncthreads();
#pragma unroll
    for (int i = 0; i < 8; ++i) { const int n = n0 + ty + 8 * i; dst[(size_t)n * K + k0 + tx] = f2bf(tile[tx * 65 + ty + 8 * i]); }
    __syncthreads();
}

template <class CMap>
DEVI void transpose_wave(const float* src, int srcN, bf16_t* dst, int K, int tl, CMap cmap, int lane, const float* kscale = nullptr) {
    const int nkt = K / 64, kt = tl % nkt, nt = tl / nkt, k0 = kt * 64, n = nt * 64 + lane;
    const int sc = cmap(n);
    const float* sp = src + (size_t)k0 * srcN + (sc >= 0 ? sc : 0);
    float v[64];
#pragma unroll
    for (int i = 0; i < 64; ++i) v[i] = sp[(size_t)i * srcN];
    if (kscale) {
#pragma unroll
        for (int i = 0; i < 64; ++i) v[i] *= kscale[k0 + i];
    }
    if (sc < 0) {
#pragma unroll
        for (int i = 0; i < 64; ++i) v[i] = 0.f;
    }
    bf16_t* dp = dst + (size_t)n * K + k0;
#pragma unroll
    for (int i = 0; i < 64; i += 8) { u32x4 w; w.x = cvt_pk_bf16(v[i], v[i + 1]); w.y = cvt_pk_bf16(v[i + 2], v[i + 3]); w.z = cvt_pk_bf16(v[i + 4], v[i + 5]); w.w = cvt_pk_bf16(v[i + 6], v[i + 7]); *(u32x4*)(dp + i) = w; }
}
struct IdMap { DEVI int operator()(int n) const { return n; } };
struct WinMap { DEVI int operator()(int n) const { return n < 1280 ? n : (n < 4352 ? n + 24 : (n < 4376 ? n - 4352 + 1280 : -1)); } };

DEVI void rmsnorm_row_bf16(const float* xrow, const float* g, bf16_t* dst, int lane) {
    float4 v[4]; float ss = 0.f;
#pragma unroll
    for (int i = 0; i < 4; ++i) { v[i] = ((const float4*)xrow)[lane + 64 * i]; ss += v[i].x * v[i].x + v[i].y * v[i].y + v[i].z * v[i].z + v[i].w * v[i].w; }
    ss = wave_sum(ss);
    const float r = rsqrtf(ss * (1.0f / 1024.0f) + 1e-6f);
#pragma unroll
    for (int i = 0; i < 4; ++i) {
        const float4 gg = ((const float4*)g)[lane + 64 * i];
        uint2 w; w.x = (unsigned)f2bf(v[i].x * r * gg.x) | ((unsigned)f2bf(v[i].y * r * gg.y) << 16); w.y = (unsigned)f2bf(v[i].z * r * gg.z) | ((unsigned)f2bf(v[i].w * r * gg.w) << 16);
        ((uint2*)dst)[lane + 64 * i] = w;
    }
}

constexpr int G_LD = 72;
template <class AF>
DEVI void gemm_tile(f32x4 (&acc)[4][2], AF af, int m0, const bf16_t* Bt, int ldb, int K, bf16_t* As, bf16_t* Bs) {
    const int tid = tid_opaque(), lane = tid & 63, wave = tid >> 6, wm = wave >> 2, wn = wave & 3;
    const int r0 = tid >> 3, kc = (tid & 7) * 8;
    uint4 ra0, ra1, rb0, rb1;
    ra0 = *(const uint4*)af(m0 + r0, kc); ra1 = *(const uint4*)af(m0 + r0 + 64, kc);
    rb0 = *(const uint4*)(Bt + (size_t)r0 * ldb + kc); rb1 = *(const uint4*)(Bt + (size_t)(r0 + 64) * ldb + kc);
    for (int k0 = 0; k0 < K; k0 += 64) {
        __syncthreads();
        *(uint4*)(As + r0 * G_LD + kc) = ra0; *(uint4*)(As + (r0 + 64) * G_LD + kc) = ra1;
        *(uint4*)(Bs + r0 * G_LD + kc) = rb0; *(uint4*)(Bs + (r0 + 64) * G_LD + kc) = rb1;
        __syncthreads();
        if (k0 + 64 < K) {
            const int kn = k0 + 64 + kc;
            ra0 = *(const uint4*)af(m0 + r0, kn); ra1 = *(const uint4*)af(m0 + r0 + 64, kn);
            rb0 = *(const uint4*)(Bt + (size_t)r0 * ldb + kn); rb1 = *(const uint4*)(Bt + (size_t)(r0 + 64) * ldb + kn);
        }
#pragma unroll
        for (int ks = 0; ks < 2; ++ks) {
            bf16x8 af_[4], bf_[2];
#pragma unroll
            for (int i = 0; i < 4; ++i) af_[i] = *(const bf16x8*)(As + (wm * 64 + i * 16 + (lane & 15)) * G_LD + ks * 32 + (lane >> 4) * 8);
#pragma unroll
            for (int j = 0; j < 2; ++j) bf_[j] = *(const bf16x8*)(Bs + (wn * 32 + j * 16 + (lane & 15)) * G_LD + ks * 32 + (lane >> 4) * 8);
#pragma unroll
            for (int i = 0; i < 4; ++i)
#pragma unroll
                for (int j = 0; j < 2; ++j) acc[i][j] = __builtin_amdgcn_mfma_f32_16x16x32_bf16(bf_[j], af_[i], acc[i][j], 0, 0, 0);
        }
    }
}
struct RowMajorA { const bf16_t* A; int lda; DEVI const bf16_t* operator()(int row, int k) const { return A + (size_t)row * lda + k; } };
struct CmpA { const bf16_t* KC; int koff;
    DEVI const bf16_t* operator()(int row, int k_) const { const int k = k_ + koff; const int rr = row < 2044 ? row : 2043; const int b = rr / 1022, rem = rr - b * 1022, c = rem >> 1, g = rem & 1;
        return KC + ((size_t)(b * 8192 + 16 * c + (k >> 6)) * 128 + g * 64 + (k & 63)); } };

template <class AF, class Epi>
DEVI void gemm_run(AF af, const bf16_t* Bt, int K, int MT, int NT, Epi epi, unsigned char* smem, int bid, int nb) {
    bf16_t* As = (bf16_t*)smem; bf16_t* Bs = As + 128 * G_LD;
    const int tidq = tid_opaque(), lane = tidq & 63, wave = tidq >> 6, wm = wave >> 2, wn = wave & 3;
    for (int t = bid; t < MT * NT; t += nb) {
        const int mt = t / NT, nt = t % NT;
        f32x4 acc[4][2];
#pragma unroll
        for (int i = 0; i < 4; ++i)
#pragma unroll
            for (int j = 0; j < 2; ++j) acc[i][j] = (f32x4){0.f, 0.f, 0.f, 0.f};
        gemm_tile(acc, af, mt * 128, Bt + (size_t)nt * 128 * K, K, K, As, Bs);
#pragma unroll
        for (int i = 0; i < 4; ++i)
#pragma unroll
            for (int j = 0; j < 2; ++j) epi(mt * 128 + wm * 64 + i * 16 + (lane & 15), nt * 128 + wn * 32 + j * 16 + (lane >> 4) * 4, acc[i][j]);
    }
}
DEVI void store_bf16x4(bf16_t* p, float a, float b, float c, float d) { uint2 w; w.x = (unsigned)f2bf(a) | ((unsigned)f2bf(b) << 16); w.y = (unsigned)f2bf(c) | ((unsigned)f2bf(d) << 16); *(uint2*)p = w; }

namespace pg8 {
#define PG8_LAS __attribute__((address_space(3)))
typedef unsigned short bf16_t;
typedef short bf16x8 __attribute__((ext_vector_type(8)));
typedef float f32x4 __attribute__((ext_vector_type(4)));
typedef unsigned u32x4 __attribute__((ext_vector_type(4)));
constexpr int BM = 256, BK = 64, HALF = 128, HTB = HALF * BK * 2  , STAGE_BYTES = 8 * HTB, NXCD = 8, WGM = 8;

__host__ __device__ __forceinline__ int lds_byte(int r, int c) { const int st = (r >> 4) * 2 + (c >> 5), rr = r & 15, cc = c & 31, ob = rr * 64 + cc * 2; return st * 1024 + (ob ^ (((ob >> 9) & 1) << 5)); }
__host__ __device__ __forceinline__ void stage_rc(int b, int& R, int& C) { const int st = b / 1024, sb = b % 1024, swz = sb ^ (((sb >> 9) & 1) << 5); R = (st >> 1) * 16 + swz / 64; C = (st & 1) * 32 + (swz % 64) / 2; }
__host__ __device__ __forceinline__ int perm32(int rho) { const int n = rho >> 4, i = rho & 15; return 8 * (i >> 2) + 4 * n + (i & 3); }

struct Unit { int pm, pn; };
struct Gemm { const bf16_t* A; const bf16_t* Bt; int M, N, K; };

struct StaticOrder {
    int nM, nN, nwg, G, c;
    __host__ __device__ void init(int M, int N, int G_, int c_) { nM = M / BM; nN = N / BM; nwg = nM * nN; G = G_; c = c_; }
    __host__ __device__ bool next(int i, Unit& u) const {
        const long L = (long)i * G + c; if (L >= nwg) return false;
        int wgid = (int)L; { const int q = nwg / NXCD, r = nwg % NXCD, xcd = wgid % NXCD, off = wgid / NXCD; wgid = (xcd < r ? xcd * (q + 1) : r * (q + 1) + (xcd - r) * q) + off; }
        const int nig = WGM * nN, gid = wgid / nig, fm = gid * WGM, gsz = (nM - fm) < WGM ? (nM - fm) : WGM;
        u.pm = fm + ((wgid % nig) % gsz); u.pn = (wgid % nig) / gsz; return true;
    }
    __device__ __forceinline__ void a_ready(const Unit&) const {}
    __device__ __forceinline__ void done(const Unit&) const {}
};

template <class Epi, class Sched, bool ALIGN_EPI = false, bool SP2 = false>
__device__ __forceinline__ void gemm_phase(PG8_LAS unsigned char* lds, const Gemm g, const Sched& S, const Epi& E) {
    const int tid = tid_opaque(), wid = __builtin_amdgcn_readfirstlane(tid >> 6), lane = tid & 63, wr = wid >> 2, wc = wid & 3, fr = lane & 15, fq = lane >> 4;
    const int K = g.K, nt = K / BK;
    unsigned voffA[2], voffB[2];
#pragma unroll
    for (int i = 0; i < 2; ++i) { int R, C; stage_rc(tid * 16 + i * 8192, R, C); const int Rb = Epi::PERM ? ((R & ~31) + perm32(R & 31)) : R;
        voffA[i] = (unsigned)(R * K + C) * 2u; voffB[i] = (unsigned)(Rb * K + C) * 2u; }
    const size_t kstep = (size_t)(BK * 2);
    const size_t hstep = (size_t)HALF * K * 2;
    const size_t tstep = 2 * hstep;
    const unsigned ldsw = (unsigned)wid * 1024u;
    const int aoff = lds_byte(wr * 64 + fr, fq * 8), boff = lds_byte(wc * 32 + fr, fq * 8);
#define PG8_SA(b, h) (((b) * 2 + (h)) * HTB)
#define PG8_SB(b, h) ((4 + (b) * 2 + (h)) * HTB)
#define PG8_STAGE(bufoff, gbase, voff) do { _Pragma("unroll") for (int _i = 0; _i < 2; ++_i) \
        __builtin_amdgcn_global_load_lds((const unsigned*)((const char*)(gbase) + (voff)[_i]), (PG8_LAS unsigned*)(lds + (bufoff) + ldsw + _i * 8192), 16, 0, 0); } while (0)
#define PG8_LDA(dst, b, h) do { _Pragma("unroll") for (int m = 0; m < 4; ++m) _Pragma("unroll") for (int k = 0; k < 2; ++k) dst[m][k] = *(const PG8_LAS bf16x8*)(lds + PG8_SA(b, h) + aoff + m * 2048 + k * 1024); } while (0)
#define PG8_LDB(dst, b, h) do { _Pragma("unroll") for (int n = 0; n < 2; ++n) _Pragma("unroll") for (int k = 0; k < 2; ++k) dst[n][k] = *(const PG8_LAS bf16x8*)(lds + PG8_SB(b, h) + boff + n * 2048 + k * 1024); } while (0)
#define PG8_MMA(ai, bj, At, Bt) do { __builtin_amdgcn_s_setprio(1); _Pragma("unroll") for (int m = 0; m < 4; ++m) _Pragma("unroll") for (int n = 0; n < 2; ++n) _Pragma("unroll") for (int k = 0; k < 2; ++k) \
        acc[ai][bj][m][n] = __builtin_amdgcn_mfma_f32_16x16x32_bf16(Bt[n][k], At[m][k], acc[ai][bj][m][n], 0, 0, 0); __builtin_amdgcn_s_setprio(0); } while (0)
#define PG8_WAIT_V(n) asm volatile("s_waitcnt vmcnt(" #n ")" ::: "memory")
#define PG8_WAIT_L(n) asm volatile("s_waitcnt lgkmcnt(" #n ")" ::: "memory")
#define PG8_BAR __builtin_amdgcn_s_barrier()
#define PG8_SCHED __builtin_amdgcn_sched_barrier(0)
    Unit cur, nxt; int ui = 0;
    if (!S.next(0, cur)) return;
    f32x4 acc[2][2][4][2];
#pragma unroll
    for (int a = 0; a < 2; ++a)
#pragma unroll
        for (int b = 0; b < 2; ++b)
#pragma unroll
            for (int m = 0; m < 4; ++m)
#pragma unroll
                for (int n = 0; n < 2; ++n) acc[a][b][m][n] = (f32x4){0.f, 0.f, 0.f, 0.f};
    bf16x8 At[4][2], B0[2][2], B1[2][2];
    const char* cA = (const char*)g.A + (size_t)cur.pm * tstep; const char* cB = (const char*)g.Bt + (size_t)cur.pn * tstep;
    S.a_ready(cur);
    if constexpr (SP2) {
        PG8_STAGE(PG8_SB(0, 0), cB, voffB); PG8_STAGE(PG8_SB(0, 1), cB + hstep, voffB); PG8_STAGE(PG8_SA(0, 0), cA, voffA); PG8_STAGE(PG8_SA(0, 1), cA + hstep, voffA);
        if (wr == 1) PG8_BAR;
        PG8_WAIT_V(2); PG8_BAR;
        PG8_STAGE(PG8_SB(1, 0), cB + kstep, voffB); PG8_STAGE(PG8_SA(1, 0), cA + kstep, voffA); PG8_STAGE(PG8_SB(1, 1), cB + hstep + kstep, voffB);
        PG8_WAIT_V(6); PG8_BAR;
    } else {
        PG8_STAGE(PG8_SB(0, 0), cB, voffB); PG8_STAGE(PG8_SA(0, 0), cA, voffA); PG8_STAGE(PG8_SB(0, 1), cB + hstep, voffB); PG8_STAGE(PG8_SA(0, 1), cA + hstep, voffA);
        if (wr == 1) PG8_BAR;
        PG8_WAIT_V(4); PG8_BAR;
        PG8_STAGE(PG8_SB(1, 0), cB + kstep, voffB); PG8_STAGE(PG8_SA(1, 0), cA + kstep, voffA); PG8_STAGE(PG8_SB(1, 1), cB + hstep + kstep, voffB);
        PG8_WAIT_V(6); PG8_BAR;
    }
    for (;;) {
        const bool has_next = S.next(ui + 1, nxt);
        const char* nA = has_next ? (const char*)g.A + (size_t)nxt.pm * tstep : cA; const char* nB = has_next ? (const char*)g.Bt + (size_t)nxt.pn * tstep : cB;
        for (int t = 0; t < nt; t += 2) {
            const bool last = (t == nt - 2);
            const char* a1 = cA + (size_t)(t + 1) * kstep;
            const char* a2 = last ? nA : cA + (size_t)(t + 2) * kstep; const char* b2 = last ? nB : cB + (size_t)(t + 2) * kstep;
            const char* a3 = a2 + kstep; const char* b3 = b2 + kstep;
            if (last && has_next) S.a_ready(nxt);
            if constexpr (SP2) {
            PG8_LDB(B0, 0, 0); PG8_LDB(B1, 0, 1); PG8_SCHED; PG8_LDA(At, 0, 0); PG8_STAGE(PG8_SA(1, 1), a1 + hstep, voffA);
            PG8_WAIT_V(8); PG8_WAIT_L(0); PG8_BAR; PG8_MMA(0, 0, At, B0); PG8_MMA(0, 1, At, B1); PG8_BAR; PG8_SCHED;
            PG8_LDA(At, 0, 1); PG8_STAGE(PG8_SB(0, 0), b2, voffB); PG8_STAGE(PG8_SB(0, 1), b2 + hstep, voffB); PG8_STAGE(PG8_SA(0, 0), a2, voffA);
            PG8_WAIT_V(8); PG8_WAIT_L(0); PG8_BAR; PG8_MMA(1, 0, At, B0); PG8_MMA(1, 1, At, B1); PG8_BAR; PG8_SCHED;
            PG8_LDB(B0, 1, 0); PG8_LDB(B1, 1, 1); PG8_SCHED; PG8_LDA(At, 1, 0); PG8_STAGE(PG8_SA(0, 1), a2 + hstep, voffA);
            PG8_WAIT_V(8); PG8_WAIT_L(0); PG8_BAR; PG8_MMA(0, 0, At, B0); PG8_MMA(0, 1, At, B1); PG8_BAR; PG8_SCHED;
            PG8_LDA(At, 1, 1); PG8_STAGE(PG8_SB(1, 0), b3, voffB); PG8_STAGE(PG8_SB(1, 1), b3 + hstep, voffB); PG8_STAGE(PG8_SA(1, 0), a3, voffA);
            PG8_WAIT_V(8); PG8_WAIT_L(0); PG8_BAR; PG8_MMA(1, 0, At, B0); PG8_MMA(1, 1, At, B1); PG8_BAR; PG8_SCHED;
            } else {
            PG8_LDB(B0, 0, 0); PG8_SCHED; PG8_LDA(At, 0, 0); PG8_STAGE(PG8_SA(1, 1), a1 + hstep, voffA);
            PG8_WAIT_L(8); PG8_BAR; PG8_WAIT_L(0); PG8_MMA(0, 0, At, B0); PG8_BAR; PG8_SCHED;
            PG8_LDB(B1, 0, 1); PG8_STAGE(PG8_SB(0, 0), b2, voffB);
            PG8_BAR; PG8_WAIT_L(0); PG8_MMA(0, 1, At, B1); PG8_BAR;
            PG8_LDA(At, 0, 1); PG8_STAGE(PG8_SA(0, 0), a2, voffA);
            PG8_BAR; PG8_WAIT_L(0); PG8_MMA(1, 0, At, B0); PG8_BAR; PG8_SCHED;
            PG8_STAGE(PG8_SB(0, 1), b2 + hstep, voffB);
            PG8_WAIT_V(6); PG8_BAR; PG8_MMA(1, 1, At, B1); PG8_BAR;
            PG8_LDB(B0, 1, 0); PG8_SCHED; PG8_LDA(At, 1, 0); PG8_STAGE(PG8_SA(0, 1), a2 + hstep, voffA);
            PG8_WAIT_L(8); PG8_BAR; PG8_WAIT_L(0); PG8_MMA(0, 0, At, B0); PG8_BAR; PG8_SCHED;
            PG8_LDB(B1, 1, 1); PG8_STAGE(PG8_SB(1, 0), b3, voffB);
            PG8_BAR; PG8_WAIT_L(0); PG8_MMA(0, 1, At, B1); PG8_BAR;
            PG8_LDA(At, 1, 1); PG8_STAGE(PG8_SA(1, 0), a3, voffA);
            PG8_BAR; PG8_WAIT_L(0); PG8_MMA(1, 0, At, B0); PG8_BAR; PG8_SCHED;
            PG8_STAGE(PG8_SB(1, 1), b3 + hstep, voffB);
            PG8_WAIT_V(6); PG8_BAR; PG8_MMA(1, 1, At, B1); PG8_BAR;
            }
        }
        if constexpr (ALIGN_EPI) { if (wr == 0) PG8_BAR; }
        if constexpr (!Epi::AFTER_DRAIN) { E(acc, cur, wr, wc, fr, fq); S.done(cur); }
        if (!has_next) break;
#pragma unroll
        for (int a = 0; a < 2; ++a)
#pragma unroll
            for (int b = 0; b < 2; ++b)
#pragma unroll
                for (int m = 0; m < 4; ++m)
#pragma unroll
                    for (int n = 0; n < 2; ++n) acc[a][b][m][n] = (f32x4){0.f, 0.f, 0.f, 0.f};
        cur = nxt; cA = nA; cB = nB; ++ui;
        if constexpr (ALIGN_EPI) { if (wr == 1) PG8_BAR; }
    }
    PG8_WAIT_V(0);
    if constexpr (!ALIGN_EPI) { if (wr == 0) PG8_BAR; }
    PG8_BAR;
    if constexpr (Epi::AFTER_DRAIN) { E.fused(acc, cur, wr, wc, fr, fq, lds, wid, lane); S.done(cur); }
#undef PG8_SA
#undef PG8_SB
#undef PG8_STAGE
#undef PG8_LDA
#undef PG8_LDB
#undef PG8_MMA
#undef PG8_WAIT_V
#undef PG8_WAIT_L
#undef PG8_BAR
#undef PG8_SCHED
}
}

template <class F> struct EpiFn {
    static constexpr bool PERM = true, AFTER_DRAIN = false;
    F f;
    DEVI void operator()(const f32x4 (&acc)[2][2][4][2], const pg8::Unit& u, int wr, int wc, int fr, int fq) const {
#pragma unroll
        for (int ai = 0; ai < 2; ++ai)
#pragma unroll
            for (int m = 0; m < 4; ++m) {
                const int row = u.pm * 256 + ai * 128 + wr * 64 + m * 16 + fr;
#pragma unroll
                for (int bj = 0; bj < 2; ++bj) { f(row, u.pn * 256 + bj * 128 + wc * 32 + 8 * fq, acc[ai][bj][m][0], acc[ai][bj][m][1]); __builtin_amdgcn_sched_barrier(0); }
            }
    }
};
template <class F> DEVI EpiFn<F> make_epi(F f) { return EpiFn<F>{f}; }
template <class F>
DEVI void big_gemm(unsigned char* smem, const bf16_t* A, const bf16_t* Bt, int M, int N, int K, F f) {
    pg8::StaticOrder S; S.init(M, N, (int)gridDim.x, (int)blockIdx.x);
    const pg8::Gemm g{A, Bt, M, N, K};
    const auto E = make_epi(f);
    pg8::gemm_phase<EpiFn<F>, pg8::StaticOrder, true, true>((PG8_LAS unsigned char*)smem, g, S, E);
}
DEVI void store_bf16x8(bf16_t* p, const f32x4& a, const f32x4& b) { u32x4 w; w.x = cvt_pk_bf16(a[0], a[1]); w.y = cvt_pk_bf16(a[2], a[3]); w.z = cvt_pk_bf16(b[0], b[1]); w.w = cvt_pk_bf16(b[2], b[3]); *(u32x4*)p = w; }

template <int DH, int R, int NCH, bool PSUM, typename KT, class RowF>
DEVI void attend(const float* qs, float* pl, float* psum, const KT* Kb, const KT* Vb, size_t stride, RowF rowf, float (&o)[R][DH / 64], int lane) {
    float m[R], l[R];
#pragma unroll
    for (int r = 0; r < R; ++r) { m[r] = -1e30f; l[r] = 0.f; }
#pragma unroll 1
    for (int i = 0; i < NCH; ++i) {
        bool valid; const long row = rowf(i, lane, valid);
        if (__ballot(valid) == 0ull) continue;
        const KT* kp = Kb + (size_t)row * stride;
        float a[R];
#pragma unroll
        for (int r = 0; r < R; ++r) a[r] = 0.f;
#pragma unroll 2
        for (int d0 = 0; d0 < DH; d0 += 8) {
            float kf[8]; load8(kp + d0, kf);
#pragma unroll
            for (int r = 0; r < R; ++r) {
                const float4 q0 = *(const float4*)(qs + r * DH + d0), q1 = *(const float4*)(qs + r * DH + d0 + 4);
                a[r] += kf[0] * q0.x + kf[1] * q0.y + kf[2] * q0.z + kf[3] * q0.w + kf[4] * q1.x + kf[5] * q1.y + kf[6] * q1.z + kf[7] * q1.w;
            }
        }
#pragma unroll
        for (int r = 0; r < R; ++r) {
            const float sv = valid ? a[r] : -1e30f;
            const float mn = fmaxf(m[r], wave_max(sv));
            const float pe = valid ? expf(sv - mn) : 0.f;
            l[r] = l[r] * expf(m[r] - mn) + wave_sum(pe);
            m[r] = mn;
        }
    }
    float inv[R];
#pragma unroll
    for (int r = 0; r < R; ++r) inv[r] = 1.0f / fmaxf(l[r], 1e-30f);
#pragma unroll 1
    for (int i = 0; i < NCH; ++i) {
        bool valid; const long row = rowf(i, lane, valid);
        const bool any = __ballot(valid) != 0ull;
        float a[R];
#pragma unroll
        for (int r = 0; r < R; ++r) a[r] = 0.f;
        if (any) {
            const KT* kp = Kb + (size_t)row * stride;
#pragma unroll 2
            for (int d0 = 0; d0 < DH; d0 += 8) {
                float kf[8]; load8(kp + d0, kf);
#pragma unroll
                for (int r = 0; r < R; ++r) {
                    const float4 q0 = *(const float4*)(qs + r * DH + d0), q1 = *(const float4*)(qs + r * DH + d0 + 4);
                    a[r] += kf[0] * q0.x + kf[1] * q0.y + kf[2] * q0.z + kf[3] * q0.w + kf[4] * q1.x + kf[5] * q1.y + kf[6] * q1.z + kf[7] * q1.w;
                }
            }
        }
        float ps = 0.f;
#pragma unroll
        for (int r = 0; r < R; ++r) { const float pv = valid ? expf(a[r] - m[r]) * inv[r] : 0.f; pl[r * 64 + lane] = pv; ps += pv; }
        if (PSUM) psum[i * 64 + lane] = ps;
        lds_fence();
        if (any) {
#pragma unroll 2
            for (int key = 0; key < 64; ++key) {
                bool dummy; const long vrow = rowf(i, key, dummy);
                const KT* vp = Vb + (size_t)vrow * stride;
                float pr[R];
#pragma unroll
                for (int r = 0; r < R; ++r) pr[r] = pl[r * 64 + key];
#pragma unroll
                for (int j = 0; j < DH / 64; ++j) { const float v = tof(vp[lane + 64 * j]);
#pragma unroll
                    for (int r = 0; r < R; ++r) o[r][j] += pr[r] * v; }
            }
        }
        lds_fence();
    }
}


DEVI int nsa_koff(int t, int d) { return ((((t >> 5) * 4 + (((t >> 2) & 1) * 2 + (d >> 5))) * 64) + ((((t & 31) >> 3) << 2) | (t & 3)) + 16 * ((d >> 3) & 3)) * 8 + (d & 7); }
DEVI int nsa_voff(int t, int d) { return ((((t >> 5) * 4 + (d >> 4)) * 64) + (d & 15) + 16 * ((t & 31) >> 3)) * 8 + (t & 7); }
DEVI int xat_koff(int m, int d) { return ((((m >> 5) * 16 + ((m >> 2) & 1) * 8 + (d >> 5)) * 64) + ((((m & 31) >> 3) << 2) | (m & 3)) + 16 * ((d >> 3) & 3)) * 8 + (d & 7); }
DEVI int xat_voff(int m, int d) { return ((((m >> 5) * 16 + (d >> 4)) * 64) + (d & 15) + 16 * ((m & 31) >> 3)) * 8 + (m & 7); }
DEVI int pk_koff(int k, int d) { return ((((k >> 4) * 4 + (d >> 5)) * 64) + (k & 15) + 16 * ((d >> 3) & 3)) * 8 + (d & 7); }
DEVI int nsa_koff8(int t, int d) { return ((((t >> 5) * 2 + ((t >> 2) & 1)) * 64) + ((((t & 31) >> 3) << 2) | (t & 3)) + 16 * ((d >> 3) & 3)) * 16 + (d >> 5) * 8 + (d & 7); }
DEVI int nsa_voff8(int t, int d) { return ((((t >> 5) * 2 + (d >> 5)) * 64) + (d & 15) + 16 * ((t & 31) >> 3)) * 16 + ((d >> 4) & 1) * 8 + (t & 7); }
DEVI void nsa_load_kf(bf16x8 (&ka)[4], const bf16_t* Kp, int ch, int lane) {
#pragma unroll
    for (int f = 0; f < 4; ++f) ka[f] = *(const bf16x8*)(Kp + ((ch * 4 + f) * 64 + lane) * 8);
}
DEVI void nsa_load_k(bf16x8 (&ka)[4], const bf16_t* Kp, int stride, int kb, int rk, int dh) {
    const int o0 = (kb + rk) * stride + dh, o1 = o0 + 4 * stride;
    ka[0] = *(const bf16x8*)(Kp + o0); ka[1] = *(const bf16x8*)(Kp + o0 + 32); ka[2] = *(const bf16x8*)(Kp + o1); ka[3] = *(const bf16x8*)(Kp + o1 + 32);
}
DEVI void nsa_load_v(bf16x8 (&va)[4], const bf16_t* Vp, int vstride, int kb8, int lr) {
    const int o = lr * vstride + kb8;
#pragma unroll
    for (int dt = 0; dt < 4; ++dt) va[dt] = *(const bf16x8*)(Vp + o + dt * 16 * vstride);
}
DEVI void nsa_load_vb(bf16x8 (&va)[4], const bf16_t* Vp, int kb8, int lr) {
    const int o = ((kb8 >> 6) * 64 + lr) * 64 + (kb8 & 63);
#pragma unroll
    for (int dt = 0; dt < 4; ++dt) va[dt] = *(const bf16x8*)(Vp + o + dt * 16 * 64);
}
DEVI void nsa_scores(const bf16x8 (&ka)[4], const bf16x8 (&qf)[2], float (&sv)[8]) {
    f32x4 s0 = {0.f, 0.f, 0.f, 0.f}, s1 = {0.f, 0.f, 0.f, 0.f};
    s0 = __builtin_amdgcn_mfma_f32_16x16x32_bf16(ka[0], qf[0], s0, 0, 0, 0); s1 = __builtin_amdgcn_mfma_f32_16x16x32_bf16(ka[2], qf[0], s1, 0, 0, 0);
    s0 = __builtin_amdgcn_mfma_f32_16x16x32_bf16(ka[1], qf[1], s0, 0, 0, 0); s1 = __builtin_amdgcn_mfma_f32_16x16x32_bf16(ka[3], qf[1], s1, 0, 0, 0);
    sv[0] = s0[0]; sv[1] = s0[1]; sv[2] = s0[2]; sv[3] = s0[3]; sv[4] = s1[0]; sv[5] = s1[1]; sv[6] = s1[2]; sv[7] = s1[3];
}
DEVI unsigned long long pack8_fp8(const float (&p)[8]) {
    int lo = 0, hi = 0;
    lo = __builtin_amdgcn_cvt_pk_fp8_f32(p[0], p[1], lo, false); lo = __builtin_amdgcn_cvt_pk_fp8_f32(p[2], p[3], lo, true);
    hi = __builtin_amdgcn_cvt_pk_fp8_f32(p[4], p[5], hi, false); hi = __builtin_amdgcn_cvt_pk_fp8_f32(p[6], p[7], hi, true);
    return ((unsigned long long)(unsigned)hi << 32) | (unsigned)lo;
}
struct NsaSt { float m, l; f32x4 o[4]; };
struct NsaBuf8 { long ka[4]; long va[4]; int e; };
DEVI void nsa_load8(long (&f)[4], const unsigned char* P, int ch, int lane) {
#pragma unroll
    for (int i = 0; i < 2; ++i) { const uint4 w = *(const uint4*)(P + ((ch * 2 + i) * 64 + lane) * 16);
        f[2 * i] = (long)(((unsigned long long)w.y << 32) | w.x); f[2 * i + 1] = (long)(((unsigned long long)w.w << 32) | w.z); }
}
struct NsaSt8 { float m, l; bool set; f32x4 negm; f32x4 o[4]; };
DEVI void nsa_init8(NsaSt8& st) { st.m = 0.f; st.l = 0.f; st.set = false; st.negm = (f32x4){7.f, 7.f, 7.f, 7.f};
#pragma unroll
    for (int dt = 0; dt < 4; ++dt) st.o[dt] = (f32x4){0.f, 0.f, 0.f, 0.f}; }

struct NsaBuf { bf16x8 ka[4]; bf16x8 va[4]; };
DEVI void nsa_init(NsaSt& st) { st.m = -1e20f; st.l = 0.f;
#pragma unroll
    for (int dt = 0; dt < 4; ++dt) st.o[dt] = (f32x4){0.f, 0.f, 0.f, 0.f}; }
template <bool PV>
DEVI void nsa_chunk(NsaSt& st, float (&sv)[8], int pos0, int lo, int hi, const bf16x8 (&va)[4]) {
    float cm = -1e30f;
#pragma unroll
    for (int j = 0; j < 8; ++j) { const bool ok = (pos0 + j >= lo) && (pos0 + j <= hi); sv[j] = ok ? sv[j] : -1e30f; cm = fmaxf(cm, sv[j]); }
    cm = xmax16(cm); cm = xmax32(cm);
    if (__any(cm > st.m)) {
        const float mn = fmaxf(st.m, cm), sc = __builtin_amdgcn_exp2f(st.m - mn);
        st.l *= sc;
        if (PV) {
#pragma unroll
            for (int dt = 0; dt < 4; ++dt) st.o[dt] *= sc;
        }
        st.m = mn;
    }
    float p[8]; float ps = 0.f;
#pragma unroll
    for (int j = 0; j < 8; ++j) { p[j] = __builtin_amdgcn_exp2f(sv[j] - st.m); ps += p[j]; }
    st.l += ps;
    if (PV) {
        const bf16x8 pb = pack8(p);
#pragma unroll
        for (int dt = 0; dt < 4; ++dt) st.o[dt] = __builtin_amdgcn_mfma_f32_16x16x32_bf16(va[dt], pb, st.o[dt], 0, 0, 0);
    }
}
template <int MASK>
DEVI void nsa_chunk8(NsaSt8& st, const long (&ka)[4], const long (&qf)[2], const long (&va)[4], int pos0, int hi, bool own) {
    f32x4 s0 = st.negm, s1 = st.negm;
    s0 = __builtin_amdgcn_mfma_f32_16x16x32_fp8_fp8(ka[0], qf[0], s0, 0, 0, 0); s1 = __builtin_amdgcn_mfma_f32_16x16x32_fp8_fp8(ka[2], qf[0], s1, 0, 0, 0);
    s0 = __builtin_amdgcn_mfma_f32_16x16x32_fp8_fp8(ka[1], qf[1], s0, 0, 0, 0); s1 = __builtin_amdgcn_mfma_f32_16x16x32_fp8_fp8(ka[3], qf[1], s1, 0, 0, 0);
    float sv[8] = {s0[0], s0[1], s0[2], s0[3], s1[0], s1[1], s1[2], s1[3]};
    if (MASK == 1) {
#pragma unroll
        for (int j = 0; j < 8; ++j) sv[j] = own ? sv[j] : -1e30f;
    } else if (MASK == 2) {
#pragma unroll
        for (int j = 0; j < 8; ++j) sv[j] = (pos0 + j <= hi) ? sv[j] : -1e30f;
    }
    float cm = fmaxf(fmaxf(fmaxf(sv[0], sv[1]), fmaxf(sv[2], sv[3])), fmaxf(fmaxf(sv[4], sv[5]), fmaxf(sv[6], sv[7])));
    cm = xmax16(cm); cm = xmax32(cm);
    const bool need = (cm > 7.f) || (!st.set && cm > -1e29f);
    if (__any(need)) {
        const float d = need ? cm - 7.f : 0.f;
        const float sc = need ? (st.set ? __builtin_amdgcn_exp2f(-d) : 0.f) : 1.f;
        st.m += d; st.set = st.set || need;
        const float nm = 7.f - st.m; st.negm = (f32x4){nm, nm, nm, nm};
        st.l *= sc;
#pragma unroll
        for (int dt = 0; dt < 4; ++dt) st.o[dt] *= sc;
#pragma unroll
        for (int j = 0; j < 8; ++j) sv[j] -= d;
    }
    float p[8];
#pragma unroll
    for (int j = 0; j < 8; ++j) p[j] = __builtin_amdgcn_exp2f(sv[j]);
    st.l += ((p[0] + p[1]) + (p[2] + p[3])) + ((p[4] + p[5]) + (p[6] + p[7]));
    const long pb = (long)pack8_fp8(p);
#pragma unroll
    for (int dt = 0; dt < 4; ++dt) st.o[dt] = __builtin_amdgcn_mfma_f32_16x16x32_fp8_fp8(va[dt], pb, st.o[dt], 0, 0, 0);
}
struct NsaBlk8 { long ka[8]; long va[8]; int e; };
template <int MASK>
DEVI void nsa_block8(NsaSt8& st, const NsaBlk8& bf, const long (&qf)[2], int pos0, int hi, bool own) {
    f32x4 s0 = st.negm, s1 = st.negm, s2 = st.negm, s3 = st.negm;
    s0 = __builtin_amdgcn_mfma_f32_16x16x32_fp8_fp8(bf.ka[0], qf[0], s0, 0, 0, 0); s1 = __builtin_amdgcn_mfma_f32_16x16x32_fp8_fp8(bf.ka[2], qf[0], s1, 0, 0, 0);
    s2 = __builtin_amdgcn_mfma_f32_16x16x32_fp8_fp8(bf.ka[4], qf[0], s2, 0, 0, 0); s3 = __builtin_amdgcn_mfma_f32_16x16x32_fp8_fp8(bf.ka[6], qf[0], s3, 0, 0, 0);
    s0 = __builtin_amdgcn_mfma_f32_16x16x32_fp8_fp8(bf.ka[1], qf[1], s0, 0, 0, 0); s1 = __builtin_amdgcn_mfma_f32_16x16x32_fp8_fp8(bf.ka[3], qf[1], s1, 0, 0, 0);
    s2 = __builtin_amdgcn_mfma_f32_16x16x32_fp8_fp8(bf.ka[5], qf[1], s2, 0, 0, 0); s3 = __builtin_amdgcn_mfma_f32_16x16x32_fp8_fp8(bf.ka[7], qf[1], s3, 0, 0, 0);
    float sv[16] = {s0[0], s0[1], s0[2], s0[3], s1[0], s1[1], s1[2], s1[3], s2[0], s2[1], s2[2], s2[3], s3[0], s3[1], s3[2], s3[3]};
    if (MASK == 1) {
#pragma unroll
        for (int j = 0; j < 16; ++j) sv[j] = own ? sv[j] : -1e30f;
    } else if (MASK == 2) {
#pragma unroll
        for (int j = 0; j < 16; ++j) sv[j] = (pos0 + (j & 7) + 32 * (j >> 3) <= hi) ? sv[j] : -1e30f;
    }
    float cm = fmaxf(fmaxf(fmaxf(fmaxf(sv[0], sv[1]), fmaxf(sv[2], sv[3])), fmaxf(fmaxf(sv[4], sv[5]), fmaxf(sv[6], sv[7]))),
                     fmaxf(fmaxf(fmaxf(sv[8], sv[9]), fmaxf(sv[10], sv[11])), fmaxf(fmaxf(sv[12], sv[13]), fmaxf(sv[14], sv[15]))));
    cm = xmax16(cm); cm = xmax32(cm);
    const bool need = (cm > 7.f) || (!st.set && cm > -1e29f);
    if (__any(need)) {
        const float d = need ? cm - 7.f : 0.f;
        const float sc = need ? (st.set ? __builtin_amdgcn_exp2f(-d) : 0.f) : 1.f;
        st.m += d; st.set = st.set || need;
        const float nm = 7.f - st.m; st.negm = (f32x4){nm, nm, nm, nm};
        st.l *= sc;
#pragma unroll
        for (int dt = 0; dt < 4; ++dt) st.o[dt] *= sc;
#pragma unroll
        for (int j = 0; j < 16; ++j) sv[j] -= d;
    }
    float p[8], q[8];
#pragma unroll
    for (int j = 0; j < 8; ++j) { p[j] = __builtin_amdgcn_exp2f(sv[j]); q[j] = __builtin_amdgcn_exp2f(sv[8 + j]); }
    st.l += (((p[0] + p[1]) + (p[2] + p[3])) + ((p[4] + p[5]) + (p[6] + p[7]))) + (((q[0] + q[1]) + (q[2] + q[3])) + ((q[4] + q[5]) + (q[6] + q[7])));
    const long pb0 = (long)pack8_fp8(p), pb1 = (long)pack8_fp8(q);
#pragma unroll
    for (int dt = 0; dt < 4; ++dt) st.o[dt] = __builtin_amdgcn_mfma_f32_16x16x32_fp8_fp8(bf.va[dt], pb0, st.o[dt], 0, 0, 0);
#pragma unroll
    for (int dt = 0; dt < 4; ++dt) st.o[dt] = __builtin_amdgcn_mfma_f32_16x16x32_fp8_fp8(bf.va[4 + dt], pb1, st.o[dt], 0, 0, 0);
}
template <class LD, class CP>
DEVI void nsa_streamb(int n, LD ld, CP cp) {
    NsaBlk8 A, B;
    if (n > 0) ld(A, 0);
#pragma unroll 1
    for (int i = 0; i < n; i += 2) {
        if (i + 1 < n) ld(B, i + 1);
        cp(A, i);
        if (i + 1 < n) { if (i + 2 < n) ld(A, i + 2); cp(B, i + 1); }
    }
}
DEVI void nsa_fold8(f32x4 (&comb)[4], NsaSt8& st, float gate) {
    float l = st.l; l = xsum16(l); l = xsum32(l);
    const float w = gate / fmaxf(l, 1e-30f);
#pragma unroll
    for (int dt = 0; dt < 4; ++dt) comb[dt] += st.o[dt] * w;
}
template <class LD, class CP>
DEVI void nsa_stream8(int n, LD ld, CP cp) {
    NsaBuf8 A, B, C, D;
    if (n > 0) ld(A, 0);
    if (n > 1) ld(B, 1);
    if (n > 2) ld(C, 2);
#pragma unroll 1
    for (int i = 0; i < n; i += 4) {
        if (i + 3 < n) ld(D, i + 3);
        cp(A, i);
        if (i + 1 < n) { if (i + 4 < n) ld(A, i + 4); cp(B, i + 1); }
        if (i + 2 < n) { if (i + 5 < n) ld(B, i + 5); cp(C, i + 2); }
        if (i + 3 < n) { if (i + 6 < n) ld(C, i + 6); cp(D, i + 3); }
    }
}
DEVI void nsa_fold(f32x4 (&comb)[4], NsaSt& st, float gate) {
    float l = st.l; l = xsum16(l); l = xsum32(l);
    const float w = gate / fmaxf(l, 1e-30f);
#pragma unroll
    for (int dt = 0; dt < 4; ++dt) comb[dt] += st.o[dt] * w;
}
template <class LD, class CP>
DEVI void nsa_stream(int n, LD ld, CP cp) {
    NsaBuf A, B, C;
    if (n > 0) ld(A, 0);
    if (n > 1) ld(B, 1);
#pragma unroll 1
    for (int i = 0; i < n; i += 3) {
        if (i + 2 < n) ld(C, i + 2);
        cp(A, i);
        if (i + 1 < n) { if (i + 3 < n) ld(A, i + 3); cp(B, i + 1); }
        if (i + 2 < n) { if (i + 4 < n) ld(B, i + 4); cp(C, i + 2); }
    }
}
template <class LD, class CP>
DEVI void nsa_stream2(int n, LD ld, CP cp) {
    NsaBuf A, B;
    if (n > 0) ld(A, 0);
#pragma unroll 1
    for (int i = 0; i < n; i += 2) {
        if (i + 1 < n) ld(B, i + 1);
        cp(A, i);
        if (i + 1 < n) { if (i + 2 < n) ld(A, i + 2); cp(B, i + 1); }
    }
}

#define XB_TMO      128
#define XB_XCNT(j)  (256  + 64 * (j))
#define XB_XSUB(j)  (1280 + 64 * (j))
#define XB_XGEN(j)  (2304 + 64 * (j))
#define XB_TOP      3328
#define XB_TOPGEN   3392
#define XCD_BAR_WORDS 3456
#define XB_SPIN_CAP (1u << 22)
#define LAS __attribute__((address_space(3)))
DEVI unsigned xb_ld(unsigned* p)              { return __hip_atomic_load(p, __ATOMIC_RELAXED, __HIP_MEMORY_SCOPE_AGENT); }
DEVI unsigned xb_add(unsigned* p, unsigned v) { return __hip_atomic_fetch_add(p, v, __ATOMIC_RELAXED, __HIP_MEMORY_SCOPE_AGENT); }
DEVI unsigned xb_xcc_id() { return (unsigned)__builtin_amdgcn_s_getreg((3 << 11) | 20) & 0xFu; }
#define XB_SPIN(cond, bar) do { unsigned _sp = 0; while (cond) { __builtin_amdgcn_s_sleep(1); \
    if ((++_sp & 255u) == 0u) { if (xb_ld(&(bar)[XB_TMO])) break; if (_sp > XB_SPIN_CAP) { atomicAdd(&(bar)[XB_TMO], 1u); break; } } } } while (0)
struct XcdBarrier { unsigned* bar; unsigned x; volatile LAS unsigned* st; };
DEVI XcdBarrier xcd_barrier_post(unsigned* bar, volatile LAS unsigned* st) {
    XcdBarrier b; b.bar = bar; b.x = xb_xcc_id(); b.st = st;
    if (threadIdx.x == 0) (void)xb_add(&bar[XB_XCNT(b.x)], 1u);
    return b;
}
DEVI void xcd_barrier_complete(unsigned* bar, unsigned x, unsigned& nloc, unsigned& nx) {
    const unsigned G = gridDim.x * gridDim.y * gridDim.z;
    unsigned sum, cnt, mine, sp = 0u;
    for (;;) {
        sum = 0u; cnt = 0u; mine = 0u;
#pragma unroll
        for (unsigned j = 0; j < 16; ++j) { const unsigned c = xb_ld(&bar[XB_XCNT(j)]); sum += c; cnt += (c > 0u) ? 1u : 0u; mine = (j == x) ? c : mine; }
        if (sum == G) break;
        __builtin_amdgcn_s_sleep(1);
        if ((++sp & 255u) == 0u) { if (xb_ld(&bar[XB_TMO])) break; if (sp > XB_SPIN_CAP) { atomicAdd(&bar[XB_TMO], 1u); break; } }
    }
    nloc = mine > 0u ? mine : 1u; nx = cnt > 0u ? cnt : 1u;
}
DEVI void xcd_barrier(const XcdBarrier& b) {
    asm volatile("s_waitcnt vmcnt(0)" ::: "memory");
    __syncthreads();
    if (threadIdx.x == 0) {
        unsigned* bar = b.bar;
        __builtin_amdgcn_s_waitcnt(0);
        unsigned nloc = b.st[0], nx = b.st[1];
        if (nloc == 0u) { xcd_barrier_complete(bar, b.x, nloc, nx); b.st[0] = nloc; b.st[1] = nx; }
        const unsigned old = xb_add(&bar[XB_XSUB(b.x)], 1u);
        const unsigned gen = old / nloc;
        if (old + 1u == (gen + 1u) * nloc) {
            __builtin_amdgcn_fence(__ATOMIC_RELEASE, "agent");
            asm volatile("s_waitcnt vmcnt(0)" ::: "memory");
            const unsigned og = xb_add(&bar[XB_TOP], 1u);
            const unsigned tg = og / nx;
            if (og + 1u == (tg + 1u) * nx) xb_add(&bar[XB_TOPGEN], 1u);
            else XB_SPIN(xb_ld(&bar[XB_TOPGEN]) == tg, bar);
            __builtin_amdgcn_fence(__ATOMIC_ACQUIRE, "agent");
            xb_add(&bar[XB_XGEN(b.x)], 1u);
            asm volatile("s_waitcnt vmcnt(0)" ::: "memory");
        } else {
            XB_SPIN(xb_ld(&bar[XB_XGEN(b.x)]) == gen, bar);
            __builtin_amdgcn_fence(__ATOMIC_ACQUIRE, "agent");
            asm volatile("s_waitcnt vmcnt(0)" ::: "memory");
        }
    }
    __syncthreads();
}

DEVI void* ldptr(volatile LAS unsigned long long* tab, int i) { const unsigned long long v = tab[i];
    const unsigned lo = __builtin_amdgcn_readfirstlane((unsigned)v), hi = __builtin_amdgcn_readfirstlane((unsigned)(v >> 32));
    return (void*)(__attribute__((address_space(1))) void*)(((unsigned long long)hi << 32) | lo); }


DEVI unsigned key_pack(float f, int idx) { const unsigned u = __float_as_uint(f); const unsigned o = (u & 0x80000000u) ? ~u : (u | 0x80000000u); return (o & 0xFFFFFF80u) | (unsigned)(127 - idx); }
DEVI float key_val(unsigned k) { const unsigned o = k & 0xFFFFFF80u; return __uint_as_float((o & 0x80000000u) ? (o & 0x7FFFFFFFu) : ~o); }
DEVI void ce_desc(unsigned& a, unsigned& b) { const unsigned hi = a > b ? a : b, lo = a > b ? b : a; a = hi; b = lo; }
template <int N> DEVI void bitonic_sort_desc(unsigned (&a)[N]) {
#pragma unroll
    for (int k = 2; k <= N; k <<= 1)
#pragma unroll
        for (int j = k >> 1; j > 0; j >>= 1)
#pragma unroll
            for (int i = 0; i < N; ++i) { const int l = i ^ j; if (l > i) { if ((i & k) == 0) ce_desc(a[i], a[l]); else ce_desc(a[l], a[i]); } }
}
template <int N> DEVI void bitonic_merge_desc(unsigned (&a)[N]) {
#pragma unroll
    for (int j = N >> 1; j > 0; j >>= 1)
#pragma unroll
        for (int i = 0; i < N; ++i) { const int l = i ^ j; if (l > i) ce_desc(a[i], a[l]); }
}

__global__ void __launch_bounds__(NTHREADS) fwd_mega(Params pa) {
    extern __shared__ __attribute__((aligned(16))) unsigned char smem[];
    const int bid = blockIdx.x, nb = gridDim.x, tid = threadIdx.x, lane = tid & 63, wave = tid >> 6;
    volatile LAS unsigned long long* ptab = (volatile LAS unsigned long long*)(smem + LDS_BYTES - 16 - 32 * 8);
    {
        volatile LAS unsigned* st0 = (volatile LAS unsigned*)(smem + LDS_BYTES - 16);
        if (tid < 4) st0[tid] = 0u;
        if (tid == 0) {
            ptab[0] = (unsigned long long)pa.x; ptab[1] = (unsigned long long)pa.mem; ptab[2] = (unsigned long long)pa.g_mix; ptab[3] = (unsigned long long)pa.w_in;
            ptab[4] = (unsigned long long)pa.pe_k; ptab[5] = (unsigned long long)pa.w1_k; ptab[6] = (unsigned long long)pa.b1_k; ptab[7] = (unsigned long long)pa.w2_k;
            ptab[8] = (unsigned long long)pa.pe_v; ptab[9] = (unsigned long long)pa.w1_v; ptab[10] = (unsigned long long)pa.b1_v; ptab[11] = (unsigned long long)pa.w2_v;
            ptab[12] = (unsigned long long)pa.ln_g; ptab[13] = (unsigned long long)pa.ln_b; ptab[14] = (unsigned long long)pa.gws; ptab[15] = (unsigned long long)pa.gbs;
            ptab[16] = (unsigned long long)pa.w_nsa_out; ptab[17] = (unsigned long long)pa.w_gmlp_out; ptab[18] = (unsigned long long)pa.w_mix_out; ptab[19] = (unsigned long long)pa.g_xattn;
            ptab[20] = (unsigned long long)pa.g_mem; ptab[21] = (unsigned long long)pa.w_xq; ptab[22] = (unsigned long long)pa.w_xkv; ptab[23] = (unsigned long long)pa.w_xo;
            ptab[24] = (unsigned long long)pa.g_peer; ptab[25] = (unsigned long long)pa.w_peer_q; ptab[26] = (unsigned long long)pa.sub_keys; ptab[27] = (unsigned long long)pa.peer_u;
            ptab[28] = (unsigned long long)pa.peer_v; ptab[29] = (unsigned long long)pa.g_final; ptab[30] = (unsigned long long)pa.out; ptab[31] = (unsigned long long)pa.ws;
        }
        __syncthreads();
    }
    const XcdBarrier xb = xcd_barrier_post((unsigned*)pa.ws, (volatile LAS unsigned*)(smem + LDS_BYTES - 16));
#define LDP(i) ((const float*)ldptr(ptab, i))
#define PHASE_BEGIN \
    const int tid = tid_opaque(), lane = tid & 63, wave = tid >> 6; (void)lane; (void)wave; \
    Params p; p.x = LDP(0); p.mem = LDP(1); p.g_mix = LDP(2); p.w_in = LDP(3); p.pe_k = LDP(4); p.w1_k = LDP(5); p.b1_k = LDP(6); p.w2_k = LDP(7); p.pe_v = LDP(8); p.w1_v = LDP(9); p.b1_v = LDP(10); p.w2_v = LDP(11); \
    p.ln_g = LDP(12); p.ln_b = LDP(13); p.gws = LDP(14); p.gbs = LDP(15); p.w_nsa_out = LDP(16); p.w_gmlp_out = LDP(17); p.w_mix_out = LDP(18); p.g_xattn = LDP(19); p.g_mem = LDP(20); p.w_xq = LDP(21); p.w_xkv = LDP(22); p.w_xo = LDP(23); \
    p.g_peer = LDP(24); p.w_peer_q = LDP(25); p.sub_keys = LDP(26); p.peer_u = LDP(27); p.peer_v = LDP(28); p.g_final = LDP(29); p.out = (float*)ldptr(ptab, 30); p.ws = (unsigned char*)ldptr(ptab, 31); \
    unsigned char* const ws = p.ws; \
    bf16_t* WIN = (bf16_t*)(ws + O_WIN); bf16_t* W1K = (bf16_t*)(ws + O_W1K); bf16_t* W1V = (bf16_t*)(ws + O_W1V); \
    bf16_t* WNSA = (bf16_t*)(ws + O_WNSA); bf16_t* WGM = (bf16_t*)(ws + O_WGM); bf16_t* WMIX = (bf16_t*)(ws + O_WMIX); \
    bf16_t* WXQ = (bf16_t*)(ws + O_WXQ); bf16_t* WXKV = (bf16_t*)(ws + O_WXKV); bf16_t* WXO = (bf16_t*)(ws + O_WXO); bf16_t* WPQ = (bf16_t*)(ws + O_WPQ); \
    float* B1F = (float*)(ws + 14336); \
    bf16_t* HN = (bf16_t*)(ws + O_HN); bf16_t* MN = (bf16_t*)(ws + O_MN); bf16_t* KVX = (bf16_t*)(ws + O_KVX); \
    float* GATES = (float*)(ws + O_GATES); float* HID = (float*)(ws + O_HID); \
    bf16_t* Q = (bf16_t*)(ws + O_Q); bf16_t* KV6 = (bf16_t*)(ws + O_KV6); bf16_t* U = (bf16_t*)(ws + O_U); bf16_t* VG = (bf16_t*)(ws + O_VG); \
    bf16_t* MG = (bf16_t*)(ws + O_MG); bf16_t* ONSA = (bf16_t*)(ws + O_ONSA); bf16_t* OGM = (bf16_t*)(ws + O_OGM); \
    bf16_t* Y = (bf16_t*)(ws + O_Y); bf16_t* QX = (bf16_t*)(ws + O_QX); bf16_t* OX = (bf16_t*)(ws + O_OX); bf16_t* QP = (bf16_t*)(ws + O_QP); \
    float* HS = (float*)(ws + O_HS); int* HI = (int*)(ws + O_HI); \
    bf16_t* VXT = (bf16_t*)(ws + O_VXT); bf16_t* SUBK = (bf16_t*)(ws + O_SUBK); \
    bf16_t* KCB = (bf16_t*)(ws + O_CMP); bf16_t* VCT = KCB + 4 * 512 * 64; \
    unsigned char* PU8 = ws + O_U; unsigned char* PV8 = ws + O_U + 16384ull * 1024; \
    float* PSC = (float*)(ws + O_PSC); float* SS = (float*)(ws + O_SS); (void)SS; \
    float* OUT = p.out; \
    (void)WIN; (void)W1K; (void)W1V; (void)WNSA; (void)WGM; (void)WMIX; (void)WXQ; (void)WXKV; (void)WXO; (void)WPQ; (void)B1F; (void)HN; (void)MN; (void)KVX; (void)GATES; (void)HID; (void)Q; (void)KV6; (void)U; (void)VG; \
    (void)MG; (void)ONSA; (void)OGM; (void)Y; (void)QX; (void)OX; (void)QP; (void)HS; (void)HI; (void)VXT; (void)SUBK; (void)KCB; (void)VCT; (void)PU8; (void)PV8; (void)PSC; (void)OUT;

    { PHASE_BEGIN
    {
        for (int j = bid * 8 + wave; j < 3424; j += nb * 8) {
            int t = j;
            if (t < 1120) { transpose_wave(p.w_in, 4376, WIN, 1024, t, WinMap(), lane); continue; } t -= 1120;
            if (t < 128) { transpose_wave(p.w1_k, 256, W1K, 2048, t, IdMap(), lane); continue; } t -= 128;
            if (t < 128) { transpose_wave(p.w1_v, 256, W1V, 2048, t, IdMap(), lane); continue; } t -= 128;
            if (t < 128) { transpose_wave(p.w_nsa_out, 1024, WNSA, 512, t, IdMap(), lane); continue; } t -= 128;
            if (t < 128) { transpose_wave(p.w_gmlp_out, 1024, WGM, 512, t, IdMap(), lane); continue; } t -= 128;
            if (t < 256) { transpose_wave(p.w_mix_out, 1024, WMIX, 1024, t, IdMap(), lane); continue; } t -= 256;
            if (t < 256) { transpose_wave(p.w_xq, 1024, WXQ, 1024, t, IdMap(), lane, p.g_xattn); continue; } t -= 256;
            if (t < 512) { transpose_wave(p.w_xkv, 2048, WXKV, 1024, t, IdMap(), lane); continue; } t -= 512;
            if (t < 256) { transpose_wave(p.w_xo, 1024, WXO, 1024, t, IdMap(), lane); continue; } t -= 256;
            transpose_wave(p.w_peer_q, 2048, WPQ, 1024, t, IdMap(), lane, p.g_peer);
        }
        for (int r = bid * 8 + wave; r < 16384 + 512; r += nb * 8) {
            if (r < 16384) rmsnorm_row_bf16(p.x + (size_t)r * 1024, p.g_mix, HN + (size_t)r * 1024, lane);
            else rmsnorm_row_bf16(p.mem + (size_t)(r - 16384) * 1024, p.g_mem, MN + (size_t)(r - 16384) * 1024, lane);
        }
        for (int i = bid * NTHREADS + tid; i < 3 * 16384; i += nb * NTHREADS) SS[i] = 0.f;
        for (int i = bid * NTHREADS + tid; i < 16 * 128 * 128; i += nb * NTHREADS) SUBK[(i & ~16383) + pk_koff((i >> 7) & 127, i & 127)] = f2bf(p.sub_keys[i]);
        for (int i = bid * NTHREADS + tid; i < 2 * 2048 * 256 / 4; i += nb * NTHREADS) ((float4*)HID)[i] = make_float4(0.f, 0.f, 0.f, 0.f);
        {
            const int wt = bid * 8 + wave;
            if (wt < 128) {
                const int kv = wt >> 6, ng = (wt >> 4) & 3, kc = wt & 15, n = ng * 64 + lane;
                const float* pe = (kv ? p.pe_v : p.pe_k) + kc * 128; const float* w1 = (kv ? p.w1_v : p.w1_k) + (size_t)kc * 128 * 256 + n;
                float a = 0.f;
#pragma unroll 16
                for (int k = 0; k < 128; ++k) a += pe[k] * w1[(size_t)k * 256];
                unsafeAtomicAdd(B1F + kv * 256 + n, a);
            }
        }
    }
    }
    xcd_barrier(xb);

    { PHASE_BEGIN
    {
        auto epi = [&](int r, int c, const f32x4& v0, const f32x4& v1) {
            if (c < 512) { const float qs_ = 0.125f * 1.4426950408889634f; store_bf16x8(Q + (size_t)r * 512 + c, v0 * qs_, v1 * qs_);
                const float q8[8] = {v0[0] * qs_, v0[1] * qs_, v0[2] * qs_, v0[3] * qs_, v1[0] * qs_, v1[1] * qs_, v1[2] * qs_, v1[3] * qs_};
                *(unsigned long long*)(ws + O_Q8 + (size_t)r * 512 + c) = pack8_fp8(q8); }
            else if (c < 1280) { const int w = (c - 512) >> 7, cc = (c - 512) & 127;
                const int b_ = r >> 13, t_ = r & 8191, g_ = cc >> 6, d_ = cc & 63;
                if (w == 5) {
                    bf16_t* vt = KV6 + (size_t)w * 16384 * 128 + (size_t)(b_ * 2 + g_) * 8192 * 64 + nsa_voff(t_, d_);
                    vt[0] = f2bf(v0[0]); vt[8] = f2bf(v0[1]); vt[16] = f2bf(v0[2]); vt[24] = f2bf(v0[3]); vt[32] = f2bf(v1[0]); vt[40] = f2bf(v1[1]); vt[48] = f2bf(v1[2]); vt[56] = f2bf(v1[3]); }
                else if (w == 4) store_bf16x8(KV6 + (size_t)w * 16384 * 128 + (size_t)(b_ * 2 + g_) * 8192 * 64 + nsa_koff(t_, d_), v0, v1);
                else if (w == 3) {
                    const float f8[8] = {v0[0], v0[1], v0[2], v0[3], v1[0], v1[1], v1[2], v1[3]}; const unsigned long long pk = pack8_fp8(f8);
                    unsigned char* vt = (unsigned char*)(KV6 + (size_t)w * 16384 * 128) + (size_t)(b_ * 2 + g_) * 8192 * 64 + nsa_voff8(t_, d_);
#pragma unroll
                    for (int e = 0; e < 8; ++e) vt[e * 16] = (unsigned char)(pk >> (8 * e)); }
                else if (w == 2) {
                    const float f8[8] = {v0[0], v0[1], v0[2], v0[3], v1[0], v1[1], v1[2], v1[3]};
                    *(unsigned long long*)((unsigned char*)(KV6 + (size_t)w * 16384 * 128) + (size_t)(b_ * 2 + g_) * 8192 * 64 + nsa_koff8(t_, d_)) = pack8_fp8(f8); }
                else store_bf16x8(KV6 + ((size_t)w * 16384 + r) * 128 + cc, v0, v1); }
            else if (c < 2304) { bf16_t* dst = c < 1792 ? U + (size_t)r * 512 + (c - 1280) : VG + (size_t)r * 512 + (c - 1792);
                f32x4 a, b;
#pragma unroll
                for (int e = 0; e < 4; ++e) { a[e] = gelu_f(v0[e]); b[e] = gelu_f(v1[e]); }
                store_bf16x8(dst, a, b); }
            else { f32x4 a, b;
#pragma unroll
                for (int e = 0; e < 4; ++e) { a[e] = sigmoid_f(v0[e]); b[e] = sigmoid_f(v1[e]); }
                store_bf16x8(MG + (size_t)r * 2048 + (c - 2304), a, b); }
        };
        big_gemm(smem, HN, WIN, 16384, 4352, 1024, epi);
        if (bid >= 64) {
            const int tl = bid - 64;
            bf16_t* As = (bf16_t*)smem; bf16_t* Bs = As + 128 * G_LD;
            const int wm = wave >> 2, wn = wave & 3;
            f32x4 acc[4][2];
#pragma unroll
            for (int i = 0; i < 4; ++i)
#pragma unroll
                for (int j = 0; j < 2; ++j) acc[i][j] = (f32x4){0.f, 0.f, 0.f, 0.f};
            if (tl < 128) {
                gemm_tile(acc, RowMajorA{HN, 1024}, tl * 128, WIN + (size_t)4352 * 1024, 1024, 1024, As, Bs);
#pragma unroll
                for (int i = 0; i < 4; ++i)
#pragma unroll
                    for (int j = 0; j < 2; ++j) { const int r = tl * 128 + wm * 64 + i * 16 + (lane & 15), c = wn * 32 + j * 16 + (lane >> 4) * 4;
                        if (c < 24) { float* gp = GATES + (size_t)r * 24 + c; gp[0] = sigmoid_f(acc[i][j][0]); gp[1] = sigmoid_f(acc[i][j][1]); gp[2] = sigmoid_f(acc[i][j][2]); gp[3] = sigmoid_f(acc[i][j][3]); } }
            } else if (tl < 192) {
                const int t2 = tl - 128, mt = t2 >> 4, nt = t2 & 15;
                gemm_tile(acc, RowMajorA{MN, 1024}, mt * 128, WXKV + (size_t)nt * 128 * 1024, 1024, 1024, As, Bs);
#pragma unroll
                for (int i = 0; i < 4; ++i)
#pragma unroll
                    for (int j = 0; j < 2; ++j) { const int r = mt * 128 + wm * 64 + i * 16 + (lane & 15), c = nt * 128 + wn * 32 + j * 16 + (lane >> 4) * 4;
                        const int b_ = r >> 8, m_ = r & 255; const f32x4 v = acc[i][j];
                        if (c < 1024) { const int h_ = c >> 8, d_ = c & 255; store_bf16x4(KVX + (size_t)(b_ * 4 + h_) * 65536 + xat_koff(m_, d_), v[0], v[1], v[2], v[3]); }
                        else { const int hd = c - 1024, h_ = hd >> 8, d_ = hd & 255;
                            bf16_t* vt = VXT + (size_t)(b_ * 4 + h_) * 65536 + xat_voff(m_, d_);
                            vt[0] = f2bf(v[0]); vt[8] = f2bf(v[1]); vt[16] = f2bf(v[2]); vt[24] = f2bf(v[3]); } }
            }
        }
    }
    }
    xcd_barrier(xb);

    { PHASE_BEGIN
    {
        for (int task = bid; task < 256; task += nb) {
            if (task < 128) {
                const int kv = task >> 6, t = task & 63, mt = t >> 2, nt = (t >> 1) & 1, kh = t & 1;
                bf16_t* As = (bf16_t*)smem; bf16_t* Bs = As + 128 * G_LD;
                const int wm = wave >> 2, wn = wave & 3;
                f32x4 acc[4][2];
#pragma unroll
                for (int i = 0; i < 4; ++i)
#pragma unroll
                    for (int j = 0; j < 2; ++j) acc[i][j] = (f32x4){0.f, 0.f, 0.f, 0.f};
                gemm_tile(acc, CmpA{KV6 + (size_t)kv * 16384 * 128, kh * 1024}, mt * 128, (kv ? W1V : W1K) + (size_t)nt * 128 * 2048 + kh * 1024, 2048, 1024, As, Bs);
#pragma unroll
                for (int i = 0; i < 4; ++i)
#pragma unroll
                    for (int j = 0; j < 2; ++j) {
                        const int r = mt * 128 + wm * 64 + i * 16 + (lane & 15), c = nt * 128 + wn * 32 + j * 16 + (lane >> 4) * 4;
                        if (r < 2044) { float* hp = HID + ((size_t)kv * 2048 + r) * 256 + c;
                            unsafeAtomicAdd(hp, acc[i][j][0]); unsafeAtomicAdd(hp + 1, acc[i][j][1]); unsafeAtomicAdd(hp + 2, acc[i][j][2]); unsafeAtomicAdd(hp + 3, acc[i][j][3]); }
                    }
                __syncthreads();
            } else {
                const int ch = task - 128;
                const size_t row0 = (size_t)ch * 128;
                constexpr int VLD = 136;
                bf16_t* VT = (bf16_t*)smem;
                float* st = (float*)(smem + 512 * VLD * 2);
                for (int r = wave * 16; r < wave * 16 + 16; ++r) {
                    float f[8]; load8(VG + (row0 + r) * 512 + lane * 8, f);
                    float s1 = 0.f;
#pragma unroll
                    for (int e = 0; e < 8; ++e) s1 += f[e];
                    s1 = wave_sum(s1); const float mu = s1 * (1.0f / 512.0f);
                    float s2 = 0.f;
#pragma unroll
                    for (int e = 0; e < 8; ++e) s2 += (f[e] - mu) * (f[e] - mu);
                    s2 = wave_sum(s2);
                    if (lane == 0) { st[r * 2] = mu; st[r * 2 + 1] = rsqrtf(s2 * (1.0f / 512.0f) + 1e-6f); }
                }
                __syncthreads();
                {
                    const int s_ = tid & 127; const float mu = st[s_ * 2], rs = st[s_ * 2 + 1];
#pragma unroll 1
                    for (int i = 0; i < 16; ++i) {
                        const int d0 = ((tid >> 7) + 4 * i) * 8;
                        float f[8]; load8(VG + (row0 + s_) * 512 + d0, f);
#pragma unroll
                        for (int e = 0; e < 8; ++e) VT[(d0 + e) * VLD + s_] = f2bf((f[e] - mu) * rs * p.ln_g[d0 + e] + p.ln_b[d0 + e]);
                    }
                }
                __syncthreads();
                {
                    const int tl = wave * 16 + (lane & 15), hq = lane >> 4, kmax = (wave * 16 + 15) >> 5;
                    for (int g = 0; g < 4; ++g) {
                        bf16x8 wf[4];
#pragma unroll
                        for (int ks = 0; ks < 4; ++ks) {
                            if (ks <= kmax) {
                                const float* wp = p.gws + (size_t)g * 16384 + tl * 128 + ks * 32 + 8 * hq;
                                float f[8]; load8(wp, f);
#pragma unroll
                                for (int e = 0; e < 8; ++e) f[e] = (ks * 32 + 8 * hq + e <= tl) ? f[e] : 0.f;
                                wf[ks] = pack8(f);
                            }
                        }
                        const float bsv = p.gbs[g * 128 + tl];
#pragma unroll 2
                        for (int dt = 0; dt < 8; ++dt) {
                            f32x4 a = {0.f, 0.f, 0.f, 0.f};
                            const bf16_t* vp = VT + (g * 128 + dt * 16 + (lane & 15)) * VLD + 8 * hq;
#pragma unroll
                            for (int ks = 0; ks < 4; ++ks) if (ks <= kmax) a = __builtin_amdgcn_mfma_f32_16x16x32_bf16(*(const bf16x8*)(vp + ks * 32), wf[ks], a, 0, 0, 0);
                            const size_t o = (row0 + tl) * 512 + g * 128 + dt * 16 + 4 * hq;
                            const uint2 uw = *(const uint2*)(U + o);
                            store_bf16x4(OGM + o, __uint_as_float(uw.x << 16) * (a[0] + bsv), __uint_as_float(uw.x & 0xffff0000u) * (a[1] + bsv),
                                         __uint_as_float(uw.y << 16) * (a[2] + bsv), __uint_as_float(uw.y & 0xffff0000u) * (a[3] + bsv));
                        }
                    }
                }
                __syncthreads();
            }
        }
    }
    }
    xcd_barrier(xb);

    { PHASE_BEGIN
    {
        __syncthreads();
        float* gl = (float*)smem + wave * 256;
        for (int task = bid * 8 + wave; task < 2 * 2044; task += nb * 8) {
            const int kv = task >= 2044 ? 1 : 0, r = task - kv * 2044;
            const float* hp = HID + ((size_t)kv * 2048 + r) * 256; const float* bb = B1F + kv * 256; const float* b1 = kv ? p.b1_v : p.b1_k;
#pragma unroll
            for (int i = 0; i < 4; ++i) gl[lane + 64 * i] = gelu_f(hp[lane + 64 * i] + bb[lane + 64 * i] + b1[lane + 64 * i]);
            lds_fence();
            const float* w2 = kv ? p.w2_v : p.w2_k;
            float a = 0.f;
#pragma unroll 8
            for (int j = 0; j < 256; ++j) a += gl[j] * w2[j * 64 + lane];
            const int b = r / 1022, rr = r - b * 1022, c = rr >> 1, g = rr & 1, n = lane;
            if (kv == 0) KCB[(size_t)(b * 2 + g) * 512 * 64 + nsa_koff(c, n)] = f2bf(a); else VCT[(size_t)(b * 2 + g) * 512 * 64 + nsa_voff(c, n)] = f2bf(a);
            lds_fence();
        }
        if (bid == 0 && tid < 256) { const int bg = tid >> 6, n = tid & 63; KCB[(size_t)bg * 512 * 64 + nsa_koff(511, n)] = 0; VCT[(size_t)bg * 512 * 64 + nsa_voff(511, n)] = 0; }
    }
    }
    xcd_barrier(xb);

    { PHASE_BEGIN
    {
        float* impL = (float*)smem + wave * 1024;
        int* sidxL = (int*)(impL + 512);
        const bf16_t* KS = KV6 + 2ull * 16384 * 128; const bf16_t* VST = KV6 + 3ull * 16384 * 128;
        const bf16_t* KW = KV6 + 4ull * 16384 * 128; const bf16_t* VWT = KV6 + 5ull * 16384 * 128;
        const int c = lane & 15, h = lane >> 4, tokc = c >> 2, headc = c & 3;
        const int rk = 8 * (c >> 2) + (c & 3), dh = 8 * h;
        for (int task = bid * 8 + wave; task < 8192; task += nb * 8) {
            const int bg = task >> 11, q4 = (bg & 1) ? 2047 - (task & 2047) : (task & 2047), b = bg >> 1, g = bg & 1, t0 = q4 * 4;
            const int tcol = t0 + tokc; const size_t bt0 = (size_t)b * 8192 + t0;
            bf16x8 qf[2];
            { const bf16_t* qp = Q + (bt0 + tokc) * 512 + g * 256 + headc * 64 + dh; qf[0] = *(const bf16x8*)qp; qf[1] = *(const bf16x8*)(qp + 32); }
            const float* gp = GATES + (bt0 + tokc) * 24 + (g * 4 + headc) * 3;
            const float gate0 = gp[0], gate1 = gp[1], gate2 = gp[2];
            f32x4 comb[4];
#pragma unroll
            for (int dt = 0; dt < 4; ++dt) comb[dt] = (f32x4){0.f, 0.f, 0.f, 0.f};
            {
                const int ncvc = tcol >= 31 ? ((tcol - 31) >> 4) + 1 : 0;
                const int ncvmax = (t0 + 3) >= 31 ? ((t0 + 3 - 31) >> 4) + 1 : 0;
                const int nch = (ncvmax + 31) >> 5;
                const bf16_t* Kc = KCB + (size_t)bg * 512 * 64; const bf16_t* Vc = VCT + (size_t)bg * 64 * 512;
                NsaSt st; nsa_init(st);
                {
                    auto ld = [&](NsaBuf& bf, int i) { nsa_load_kf(bf.ka, Kc, i, lane); };
                    auto cp = [&](NsaBuf& bf, int i) { float sv[8]; nsa_scores(bf.ka, qf, sv); nsa_chunk<false>(st, sv, i * 32 + dh, 0, ncvc - 1, bf.va); };
                    nsa_stream2(nch, ld, cp);
                }
                float l = st.l; l = xsum16(l); l = xsum32(l);
                const float inv = 1.0f / fmaxf(l, 1e-30f), mfin = st.m;
                *(float4*)(impL + lane * 8) = make_float4(0.f, 0.f, 0.f, 0.f); *(float4*)(impL + lane * 8 + 4) = make_float4(0.f, 0.f, 0.f, 0.f);
                lds_fence();
                f32x4 oc[4];
#pragma unroll
                for (int dt = 0; dt < 4; ++dt) oc[dt] = (f32x4){0.f, 0.f, 0.f, 0.f};
                float carry = 0.f;
                {
                    auto ld = [&](NsaBuf& bf, int i) { nsa_load_kf(bf.ka, Kc, i, lane); nsa_load_kf(bf.va, Vc, i, lane); };
                    auto cp = [&](NsaBuf& bf, int ch) {
                        float sv[8]; nsa_scores(bf.ka, qf, sv);
                        float p[8];
#pragma unroll
                        for (int j = 0; j < 8; ++j) p[j] = (ch * 32 + dh + j < ncvc) ? __builtin_amdgcn_exp2f(sv[j] - mfin) * inv : 0.f;
                        const float up = __shfl(p[7], (lane + 48) & 63);
                        const float prev7 = (h >= 1) ? up : carry; carry = up;
                        float i0 = p[0] + p[1] + p[2] + 0.5f * p[3] + 0.5f * prev7, i1 = p[4] + p[5] + p[6] + 0.5f * p[7] + 0.5f * p[3];
                        i0 += __shfl_xor(i0, 1); i0 += __shfl_xor(i0, 2); i1 += __shfl_xor(i1, 1); i1 += __shfl_xor(i1, 2);
                        if (headc == 0) { impL[tokc * 128 + 8 * ch + 2 * h] = i0; impL[tokc * 128 + 8 * ch + 2 * h + 1] = i1; }
                        const bf16x8 pb = pack8(p);
#pragma unroll
                        for (int dt = 0; dt < 4; ++dt) oc[dt] = __builtin_amdgcn_mfma_f32_16x16x32_bf16(bf.va[dt], pb, oc[dt], 0, 0, 0);
                    };
                    nsa_stream2(nch, ld, cp);
                }
#pragma unroll
                for (int dt = 0; dt < 4; ++dt) comb[dt] += oc[dt] * gate0;
            }
            lds_fence();
            int nblk;
            {
                const int tok = lane >> 4, sub = lane & 15, cur = t0 >> 6;
                float sc[8];
#pragma unroll
                for (int e = 0; e < 8; ++e) { const int j = sub + 16 * e; const float imp = impL[tok * 128 + j];
                    const bool al = j <= cur, fo = (j == 0) || (j == cur) || (j == cur - 1);
                    sc[e] = (fo && al) ? 1e4f : (al ? imp : -1e30f); }
                unsigned k8[8];
#pragma unroll
                for (int e = 0; e < 8; ++e) k8[e] = key_pack(sc[e], sub + 16 * e);
                bitonic_sort_desc<8>(k8);
                unsigned k16[16];
#pragma unroll
                for (int e = 0; e < 8; ++e) { k16[e] = k8[e]; k16[15 - e] = (unsigned)__shfl_xor((int)k8[e], 1); }
                bitonic_merge_desc<16>(k16);
#pragma unroll
                for (int o = 2; o < 16; o <<= 1) {
                    unsigned pk[16];
#pragma unroll
                    for (int e = 0; e < 16; ++e) pk[e] = (unsigned)__shfl_xor((int)k16[e], o);
#pragma unroll
                    for (int e = 0; e < 16; ++e) k16[e] = k16[e] > pk[15 - e] ? k16[e] : pk[15 - e];
                    bitonic_merge_desc<16>(k16);
                }
                unsigned mk = k16[0];
#pragma unroll
                for (int e = 1; e < 16; ++e) mk = (sub == e) ? k16[e] : mk;
                const float myv = key_val(mk); const int myi = 127 - (int)(mk & 127u);
                const bool forced = myv > 5e3f;
                const bool keep = (myv > -0.5e30f) && !(forced && tok > 0);
                const unsigned long long bal = __ballot(keep);
                const int pos = __popcll(bal & ((1ull << lane) - 1ull));
                lds_fence();
                if (keep) sidxL[pos] = ((forced ? 7 : tok) << 16) | myi;
                nblk = __popcll(bal);
            }
            lds_fence();
            {
                NsaSt8 st; nsa_init8(st);
                const unsigned char* Kp = (const unsigned char*)KS + (size_t)bg * 8192 * 64; const unsigned char* Vp = (const unsigned char*)VST + (size_t)bg * 8192 * 64;
                long qf8[2];
                { const unsigned char* qp = ws + O_Q8 + (bt0 + tokc) * 512 + g * 256 + headc * 64 + dh; qf8[0] = *(const long*)qp; qf8[1] = *(const long*)(qp + 32); }
                const int cur_ = t0 >> 6;
                auto ld = [&](NsaBlk8& bf, int i) { const int e = __builtin_amdgcn_readfirstlane(sidxL[i]); const int chn = (e & 0xffff) * 2; bf.e = e;
                    long t4[4];
                    nsa_load8(t4, Kp, chn, lane); bf.ka[0] = t4[0]; bf.ka[1] = t4[1]; bf.ka[2] = t4[2]; bf.ka[3] = t4[3];
                    nsa_load8(t4, Kp, chn + 1, lane); bf.ka[4] = t4[0]; bf.ka[5] = t4[1]; bf.ka[6] = t4[2]; bf.ka[7] = t4[3];
                    nsa_load8(t4, Vp, chn, lane); bf.va[0] = t4[0]; bf.va[1] = t4[1]; bf.va[2] = t4[2]; bf.va[3] = t4[3];
                    nsa_load8(t4, Vp, chn + 1, lane); bf.va[4] = t4[0]; bf.va[5] = t4[1]; bf.va[6] = t4[2]; bf.va[7] = t4[3]; };
                auto cp = [&](NsaBlk8& bf, int i) { const int e = bf.e; const int blk = e & 0xffff, ow = e >> 16;
                    if (blk == cur_) { const int hi = (ow == 7 || ow == tokc) ? tcol : -1; nsa_block8<2>(st, bf, qf8, blk * 64 + dh, hi, false); }
                    else if (ow == 7) nsa_block8<0>(st, bf, qf8, 0, 0, true);
                    else nsa_block8<1>(st, bf, qf8, 0, 0, ow == tokc); };
                nsa_streamb(nblk, ld, cp);
                nsa_fold8(comb, st, gate1);
            }
            {
                NsaSt st; nsa_init(st);
                const bf16_t* Kp = KW + (size_t)bg * 8192 * 64; const bf16_t* Vp = VWT + (size_t)bg * 8192 * 64;
                const int kbf = (t0 > 511 ? t0 - 511 : 0) & ~31, kbl = (t0 + 3) & ~31;
                const int lo = tcol > 511 ? tcol - 511 : 0;
                auto ld = [&](NsaBuf& bf, int i) { const int kb = kbf + i * 32; nsa_load_kf(bf.ka, Kp, kb >> 5, lane); nsa_load_kf(bf.va, Vp, kb >> 5, lane); };
                auto cp = [&](NsaBuf& bf, int i) { const int kb = kbf + i * 32; float sv[8]; nsa_scores(bf.ka, qf, sv); nsa_chunk<true>(st, sv, kb + dh, lo, tcol, bf.va); };
                nsa_stream2(((kbl - kbf) >> 5) + 1, ld, cp);
                nsa_fold(comb, st, gate2);
            }
            {
                bf16_t* op = ONSA + (bt0 + tokc) * 512 + g * 256 + headc * 64 + 4 * h;
#pragma unroll
                for (int dt = 0; dt < 4; ++dt) store_bf16x4(op + dt * 16, comb[dt][0], comb[dt][1], comb[dt][2], comb[dt][3]);
            }
            lds_fence();
        }
    }
    }
    xcd_barrier(xb);

    { PHASE_BEGIN
    {
        auto unpack8 = [](const u32x4& w, f32x4& a, f32x4& b) { a[0] = __uint_as_float(w.x << 16); a[1] = __uint_as_float(w.x & 0xffff0000u); a[2] = __uint_as_float(w.y << 16); a[3] = __uint_as_float(w.y & 0xffff0000u);
            b[0] = __uint_as_float(w.z << 16); b[1] = __uint_as_float(w.z & 0xffff0000u); b[2] = __uint_as_float(w.w << 16); b[3] = __uint_as_float(w.w & 0xffff0000u); };
        auto e1 = [&](int r, int c, const f32x4& v0, const f32x4& v1) { f32x4 m0, m1; unpack8(*(const u32x4*)(MG + (size_t)r * 2048 + c), m0, m1); store_bf16x8(Y + (size_t)r * 1024 + c, m0 * v0, m1 * v1); };
        big_gemm(smem, ONSA, WNSA, 16384, 1024, 512, e1);
        auto e2 = [&](int r, int c, const f32x4& v0, const f32x4& v1) { f32x4 m0, m1, y0, y1; unpack8(*(const u32x4*)(MG + (size_t)r * 2048 + 1024 + c), m0, m1); unpack8(*(const u32x4*)(Y + (size_t)r * 1024 + c), y0, y1);
            store_bf16x8(Y + (size_t)r * 1024 + c, y0 + m0 * v0, y1 + m1 * v1); };
        big_gemm(smem, OGM, WGM, 16384, 1024, 512, e2);
    }
    }
    xcd_barrier(xb);

    { PHASE_BEGIN
    {
        auto epi = [&](int r, int c, const f32x4& v0, const f32x4& v1) { const float* xp = p.x + (size_t)r * 1024 + c; float* op = OUT + (size_t)r * 1024 + c;
            const f32x4 h0 = *(const f32x4*)xp + v0, h1 = *(const f32x4*)(xp + 4) + v1;
            *(f32x4*)op = h0; *(f32x4*)(op + 4) = h1; store_bf16x8(HN + (size_t)r * 1024 + c, h0, h1);
            float ss = (h0[0] * h0[0] + h0[1] * h0[1]) + (h0[2] * h0[2] + h0[3] * h0[3]) + (h1[0] * h1[0] + h1[1] * h1[1]) + (h1[2] * h1[2] + h1[3] * h1[3]);
            ss = xsum16(ss); ss = xsum32(ss);
            if (lane < 16) unsafeAtomicAdd(SS + r, ss); };
        big_gemm(smem, Y, WMIX, 16384, 1024, 1024, epi);
    }
    }
    xcd_barrier(xb);

    { PHASE_BEGIN
    {
        auto epi = [&](int r, int c, const f32x4& v0, const f32x4& v1) { const float rs = rsqrtf(SS[r] * (1.0f / 1024.0f) + 1e-6f) * 0.0625f; store_bf16x8(QX + (size_t)r * 1024 + c, v0 * rs, v1 * rs); };
        big_gemm(smem, HN, WXQ, 16384, 1024, 1024, epi);
    }
    }
    xcd_barrier(xb);

    { PHASE_BEGIN
    {
        const int c = lane & 15, hg = lane >> 4;
        for (int task = bid; task < 512; task += nb) {
            const int h = task & 3, tg = task >> 2, b = tg >> 6; const size_t bt0 = (size_t)tg * 128 + wave * 16;
            const uint4* Kg = (const uint4*)(KVX + (size_t)(b * 4 + h) * 65536); const uint4* Vg = (const uint4*)(VXT + (size_t)(b * 4 + h) * 65536);
            __syncthreads();
#pragma unroll 4
            for (int i = tid; i < 8192; i += NTHREADS) ((uint4*)smem)[i] = Kg[i];
            bf16x8 qf[8];
#pragma unroll
            for (int ks = 0; ks < 8; ++ks) qf[ks] = *(const bf16x8*)(QX + (bt0 + c) * 1024 + h * 256 + ks * 32 + 8 * hg);
            __syncthreads();
            float sv[8][8];
#pragma unroll
            for (int ch = 0; ch < 8; ++ch) {
                f32x4 s0 = {0.f, 0.f, 0.f, 0.f}, s1 = {0.f, 0.f, 0.f, 0.f};
#pragma unroll
                for (int ks = 0; ks < 8; ++ks) {
                    const bf16x8 a0 = *(const bf16x8*)(smem + ((ch * 16 + ks) * 64 + lane) * 16), a1 = *(const bf16x8*)(smem + ((ch * 16 + 8 + ks) * 64 + lane) * 16);
                    s0 = __builtin_amdgcn_mfma_f32_16x16x32_bf16(a0, qf[ks], s0, 0, 0, 0); s1 = __builtin_amdgcn_mfma_f32_16x16x32_bf16(a1, qf[ks], s1, 0, 0, 0);
                }
                sv[ch][0] = s0[0]; sv[ch][1] = s0[1]; sv[ch][2] = s0[2]; sv[ch][3] = s0[3]; sv[ch][4] = s1[0]; sv[ch][5] = s1[1]; sv[ch][6] = s1[2]; sv[ch][7] = s1[3];
            }
            float m = sv[0][0];
#pragma unroll
            for (int ch = 0; ch < 8; ++ch)
#pragma unroll
                for (int j = 0; j < 8; ++j) m = fmaxf(m, sv[ch][j]);
            m = xmax16(m); m = xmax32(m);
            float l = 0.f; bf16x8 pb[8];
#pragma unroll
            for (int ch = 0; ch < 8; ++ch) { float pp[8];
#pragma unroll
                for (int j = 0; j < 8; ++j) { pp[j] = __expf(sv[ch][j] - m); l += pp[j]; }
                pb[ch] = pack8(pp); }
            l = xsum16(l); l = xsum32(l);
            const float inv = 1.0f / l;
            __syncthreads();
#pragma unroll 4
            for (int i = tid; i < 8192; i += NTHREADS) ((uint4*)smem)[i] = Vg[i];
            __syncthreads();
            bf16_t* op = OX + (bt0 + c) * 1024 + h * 256 + 4 * hg;
#pragma unroll 4
            for (int dt = 0; dt < 16; ++dt) {
                f32x4 o = {0.f, 0.f, 0.f, 0.f};
#pragma unroll
                for (int ch = 0; ch < 8; ++ch) o = __builtin_amdgcn_mfma_f32_16x16x32_bf16(*(const bf16x8*)(smem + ((ch * 16 + dt) * 64 + lane) * 16), pb[ch], o, 0, 0, 0);
                store_bf16x4(op + dt * 16, o[0] * inv, o[1] * inv, o[2] * inv, o[3] * inv);
            }
        }
        __syncthreads();
    }
    }
    xcd_barrier(xb);

    { PHASE_BEGIN
    {
        auto epi = [&](int r, int c, const f32x4& v0, const f32x4& v1) { float* op = OUT + (size_t)r * 1024 + c;
            const f32x4 h0 = *(const f32x4*)op + v0, h1 = *(const f32x4*)(op + 4) + v1;
            *(f32x4*)op = h0; *(f32x4*)(op + 4) = h1; store_bf16x8(HN + (size_t)r * 1024 + c, h0, h1);
            float ss = (h0[0] * h0[0] + h0[1] * h0[1]) + (h0[2] * h0[2] + h0[3] * h0[3]) + (h1[0] * h1[0] + h1[1] * h1[1]) + (h1[2] * h1[2] + h1[3] * h1[3]);
            ss = xsum16(ss); ss = xsum32(ss);
            if (lane < 16) unsafeAtomicAdd(SS + 16384 + r, ss); };
        big_gemm(smem, OX, WXO, 16384, 1024, 1024, epi);
    }
    {
        for (int row = bid * 8 + wave; row < 32768; row += nb * 8) {
            const bool isv = row >= 16384; const int rr = isv ? row - 16384 : row;
            const float* src = (isv ? p.peer_v : p.peer_u) + (size_t)rr * 1024 + lane * 16;
            float f[16];
#pragma unroll
            for (int i = 0; i < 4; ++i) { const float4 a = *(const float4*)(src + 4 * i); f[4 * i] = a.x; f[4 * i + 1] = a.y; f[4 * i + 2] = a.z; f[4 * i + 3] = a.w; }
            float am = 0.f;
#pragma unroll
            for (int i = 0; i < 16; ++i) am = fmaxf(am, fabsf(f[i]));
            am = wave_max(am);
            int ex = 0; (void)frexpf(am, &ex);
            if (am == 0.f) ex = 8;
            const float sc = ldexpf(1.0f, 8 - ex);
            uint4 w; unsigned* wp = (unsigned*)&w;
#pragma unroll
            for (int i = 0; i < 4; ++i) { int t = 0; t = __builtin_amdgcn_cvt_pk_fp8_f32(f[4 * i] * sc, f[4 * i + 1] * sc, t, false); t = __builtin_amdgcn_cvt_pk_fp8_f32(f[4 * i + 2] * sc, f[4 * i + 3] * sc, t, true); wp[i] = (unsigned)t; }
            if (isv) *(uint4*)(PV8 + ((size_t)(lane >> 3) * 16384 + rr) * 128 + (lane & 7) * 16) = w;
            else *(uint4*)(PU8 + (size_t)rr * 1024 + lane * 16) = w;
            if (lane == 0) PSC[row] = ldexpf(1.0f, ex - 8);
        }
    }
    }
    xcd_barrier(xb);

    { PHASE_BEGIN
    {
        auto epi = [&](int r, int c, const f32x4& v0, const f32x4& v1) { const float rs = rsqrtf(SS[16384 + r] * (1.0f / 1024.0f) + 1e-6f); store_bf16x8(QP + (size_t)r * 2048 + c, v0 * rs, v1 * rs); };
        big_gemm(smem, HN, WPQ, 16384, 2048, 1024, epi);
    }
    }
    xcd_barrier(xb);

    { PHASE_BEGIN
    {
        const int c = lane & 15, hg = lane >> 4;
        for (int task = bid * 8 + wave; task < 16384; task += nb * 8) {
            const int hp = task & 15, tgrp = task >> 4; const size_t bt0 = (size_t)tgrp * 16;
            bf16x8 qf[4];
#pragma unroll
            for (int ks = 0; ks < 4; ++ks) qf[ks] = *(const bf16x8*)(QP + (bt0 + c) * 2048 + hp * 128 + ks * 32 + 8 * hg);
            const bf16_t* Kp = SUBK + (size_t)hp * 16384 + lane * 8;
            float sc[32];
#pragma unroll
            for (int kt = 0; kt < 8; ++kt) {
                f32x4 a = {0.f, 0.f, 0.f, 0.f};
#pragma unroll
                for (int ks = 0; ks < 4; ++ks) a = __builtin_amdgcn_mfma_f32_16x16x32_bf16(*(const bf16x8*)(Kp + (kt * 4 + ks) * 512), qf[ks], a, 0, 0, 0);
                sc[kt * 4 + 0] = a[0]; sc[kt * 4 + 1] = a[1]; sc[kt * 4 + 2] = a[2]; sc[kt * 4 + 3] = a[3];
            }
            unsigned ka_[16], kb_[16];
#pragma unroll
            for (int e = 0; e < 16; ++e) { ka_[e] = key_pack(sc[e], (e >> 2) * 16 + 4 * hg + (e & 3)); kb_[e] = key_pack(sc[16 + e], ((16 + e) >> 2) * 16 + 4 * hg + (e & 3)); }
            bitonic_sort_desc<16>(ka_); bitonic_sort_desc<16>(kb_);
#pragma unroll
            for (int e = 0; e < 16; ++e) ka_[e] = ka_[e] > kb_[15 - e] ? ka_[e] : kb_[15 - e];
            bitonic_merge_desc<16>(ka_);
#pragma unroll
            for (int e = 0; e < 16; ++e) kb_[e] = xchg16(ka_[e], lane);
#pragma unroll
            for (int e = 0; e < 16; ++e) ka_[e] = ka_[e] > kb_[15 - e] ? ka_[e] : kb_[15 - e];
            bitonic_merge_desc<16>(ka_);
#pragma unroll
            for (int e = 0; e < 16; ++e) kb_[e] = xchg32(ka_[e], lane);
#pragma unroll
            for (int e = 0; e < 16; ++e) ka_[e] = ka_[e] > kb_[15 - e] ? ka_[e] : kb_[15 - e];
            bitonic_merge_desc<16>(ka_);
            if (hg == 0) {
                float* hsp = HS + (bt0 + c) * 256 + hp * 16; int* hip_ = HI + (bt0 + c) * 256 + hp * 16;
#pragma unroll
                for (int e = 0; e < 16; e += 4) {
                    *(float4*)(hsp + e) = make_float4(key_val(ka_[e]), key_val(ka_[e + 1]), key_val(ka_[e + 2]), key_val(ka_[e + 3]));
                    *(int4*)(hip_ + e) = make_int4(127 - (int)(ka_[e] & 127u), 127 - (int)(ka_[e + 1] & 127u), 127 - (int)(ka_[e + 2] & 127u), 127 - (int)(ka_[e + 3] & 127u));
                }
            }
        }
    }
    }
    xcd_barrier(xb);

    { PHASE_BEGIN
    {
        int* exl = (int*)smem + wave * 256; float* gtl = (float*)(exl + 128);
        for (int tok = bid * 8 + wave; tok < 16384; tok += nb * 8) {
#pragma unroll 1
            for (int hh = 0; hh < 2; ++hh) {
                const int head = hh * 4 + (lane >> 4), i = lane & 15, gb = lane & 48;
                const float* s0p = HS + (size_t)tok * 256 + (2 * head) * 16;
                const float s0i = s0p[i], s1m = s0p[16 + i];
                int pj = 0; float myv = 0.f; int myf = 0;
#pragma unroll 1
                for (int it = 0; it < 16; ++it) {
                    const float s1v = __shfl(s1m, gb + (pj & 15));
                    float bv = pj < 16 ? s0i + s1v : -INFINITY; int bf = i * 16 + pj;
#pragma unroll
                    for (int o = 1; o < 16; o <<= 1) { const float ov = __shfl_xor(bv, o); const int of = __shfl_xor(bf, o);
                        const bool take = (ov > bv) || (ov == bv && of < bf); bv = take ? ov : bv; bf = take ? of : bf; }
                    if (i == it) { myv = bv; myf = bf; }
                    if ((bf >> 4) == i) ++pj;
                }
                const float vmax = __shfl(myv, gb);
                const float e = expf(myv - vmax);
                float se = e;
#pragma unroll
                for (int o = 1; o < 16; o <<= 1) se += __shfl_xor(se, o);
                const int* i0p = HI + (size_t)tok * 256 + (2 * head) * 16;
                exl[head * 16 + i] = i0p[myf >> 4] * 128 + i0p[16 + (myf & 15)];
                gtl[head * 16 + i] = e / se;
            }
            lds_fence();
            float xv[16];
            { const float rs2 = rsqrtf(SS[16384 + tok] * (1.0f / 1024.0f) + 1e-6f);
              const float* hp2 = OUT + (size_t)tok * 1024 + lane * 16; const float* gpp = p.g_peer + lane * 16;
#pragma unroll
              for (int i = 0; i < 4; ++i) { const float4 hv = *(const float4*)(hp2 + 4 * i), gv = *(const float4*)(gpp + 4 * i);
                  xv[4 * i] = hv.x * rs2 * gv.x; xv[4 * i + 1] = hv.y * rs2 * gv.y; xv[4 * i + 2] = hv.z * rs2 * gv.z; xv[4 * i + 3] = hv.w * rs2 * gv.w; } }
#pragma unroll 1
            for (int e0 = 0; e0 < 128; e0 += 16) {
                uint4 ur[16];
#pragma unroll
                for (int q = 0; q < 16; ++q) ur[q] = *(const uint4*)(PU8 + (size_t)exl[e0 + q] * 1024 + lane * 16);
                float d[16];
#pragma unroll
                for (int q = 0; q < 16; ++q) {
                    const unsigned* wp = (const unsigned*)&ur[q]; float a = 0.f;
#pragma unroll
                    for (int i = 0; i < 4; ++i) { const auto lo = __builtin_amdgcn_cvt_pk_f32_fp8((int)wp[i], false); const auto hi = __builtin_amdgcn_cvt_pk_f32_fp8((int)wp[i], true);
                        a += lo[0] * xv[4 * i] + lo[1] * xv[4 * i + 1] + hi[0] * xv[4 * i + 2] + hi[1] * xv[4 * i + 3]; }
                    d[q] = a;
                }
                {
                    const bool u5 = lane & 32, u4 = lane & 16, u3 = lane & 8, u2 = lane & 4;
                    float e8[8], e4[4], e2[2], e1;
#pragma unroll
                    for (int q = 0; q < 8; ++q) { const float keep = u5 ? d[q + 8] : d[q], send = u5 ? d[q] : d[q + 8]; e8[q] = keep + __uint_as_float(xchg32(__float_as_uint(send), lane)); }
#pragma unroll
                    for (int q = 0; q < 4; ++q) { const float keep = u4 ? e8[q + 4] : e8[q], send = u4 ? e8[q] : e8[q + 4]; e4[q] = keep + __uint_as_float(xchg16(__float_as_uint(send), lane)); }
#pragma unroll
                    for (int q = 0; q < 2; ++q) { const float keep = u3 ? e4[q + 2] : e4[q], send = u3 ? e4[q] : e4[q + 2]; e2[q] = keep + __shfl_xor(send, 8); }
                    { const float keep = u2 ? e2[1] : e2[0], send = u2 ? e2[0] : e2[1]; e1 = keep + __shfl_xor(send, 4); }
                    e1 += __shfl_xor(e1, 2); e1 += __shfl_xor(e1, 1);
                    if ((lane & 3) == 0) { const int q = ((lane >> 5) & 1) * 8 + ((lane >> 4) & 1) * 4 + ((lane >> 3) & 1) * 2 + ((lane >> 2) & 1);
                        const int ex_ = exl[e0 + q];
                        gtl[e0 + q] = gtl[e0 + q] * gelu_f(e1 * PSC[ex_]) * PSC[16384 + ex_]; }
                }
            }
            lds_fence();
            { float* crow = HS + (size_t)tok * 256; crow[lane] = gtl[lane]; crow[64 + lane] = gtl[64 + lane];
              ((int*)crow)[128 + lane] = exl[lane]; ((int*)crow)[192 + lane] = exl[64 + lane]; }
            lds_fence();
        }
    }
    }
    xcd_barrier(xb);

    { PHASE_BEGIN
    {
        unsigned* qh = (unsigned*)ws;
        const unsigned xcc = xb.x;
        float* cl = (float*)(smem + wave * 4096);
        const int part = lane & 7, rg = lane >> 3;
        const bool u5 = lane & 32, u4 = lane & 16, u3 = lane & 8;
        const int j0 = 8 * ((lane >> 5) & 1) + 4 * ((lane >> 4) & 1) + 2 * ((lane >> 3) & 1);
        for (int k = 0; k < 8; ++k) {
            const int sl = (int)((xcc + (unsigned)k) & 7u);
            const unsigned char* Vs = PV8 + (size_t)sl * 16384 * 128;
            int cn = 0; if (lane == 0) cn = (int)__hip_atomic_fetch_add(qh + 16 * sl, 1u, __ATOMIC_RELAXED, __HIP_MEMORY_SCOPE_AGENT);
            cn = __builtin_amdgcn_readfirstlane(cn);
            for (;;) {
                const int c = cn;
                if (c >= 4096) break;
                const int tok0 = c * 4;
                {
                    const unsigned char* hsrc = (const unsigned char*)HS + (size_t)tok0 * 1024 + lane * 16;
                    const uint4 r0 = *(const uint4*)hsrc, r1 = *(const uint4*)(hsrc + 1024), r2 = *(const uint4*)(hsrc + 2048), r3 = *(const uint4*)(hsrc + 3072);
                    { int t_ = 0; if (lane == 0) t_ = (int)__hip_atomic_fetch_add(qh + 16 * sl, 1u, __ATOMIC_RELAXED, __HIP_MEMORY_SCOPE_AGENT); cn = __builtin_amdgcn_readfirstlane(t_); }
                    LAS u32x4* cd = (LAS u32x4*)(smem + wave * 4096 + lane * 16);
                    cd[0] = (u32x4){r0.x, r0.y, r0.z, r0.w}; cd[64] = (u32x4){r1.x, r1.y, r1.z, r1.w}; cd[128] = (u32x4){r2.x, r2.y, r2.z, r2.w}; cd[192] = (u32x4){r3.x, r3.y, r3.z, r3.w};
                }
                lds_fence();
#pragma unroll 2
                for (int tt = 0; tt < 4; ++tt) {
                    const int* el = (const int*)(cl + tt * 256 + 128); const float* cf = cl + tt * 256;
                    uint4 v[16];
#pragma unroll
                    for (int i = 0; i < 16; ++i) v[i] = *(const uint4*)(Vs + (unsigned)(el[8 * i + rg] * 128 + part * 16));
                    float* op_ = OUT + (size_t)(tok0 + tt) * 1024 + sl * 128 + part * 16 + j0;
                    const float2 hr = *(const float2*)op_;
                    float ac[16];
#pragma unroll
                    for (int i = 0; i < 16; ++i) ac[i] = 0.f;
#pragma unroll
                    for (int i = 0; i < 16; ++i) { const float cfi = cf[8 * i + rg];
                        const auto l0 = __builtin_amdgcn_cvt_pk_f32_fp8((int)v[i].x, false), h0_ = __builtin_amdgcn_cvt_pk_f32_fp8((int)v[i].x, true);
                        const auto l1 = __builtin_amdgcn_cvt_pk_f32_fp8((int)v[i].y, false), h1_ = __builtin_amdgcn_cvt_pk_f32_fp8((int)v[i].y, true);
                        const auto l2 = __builtin_amdgcn_cvt_pk_f32_fp8((int)v[i].z, false), h2_ = __builtin_amdgcn_cvt_pk_f32_fp8((int)v[i].z, true);
                        const auto l3 = __builtin_amdgcn_cvt_pk_f32_fp8((int)v[i].w, false), h3_ = __builtin_amdgcn_cvt_pk_f32_fp8((int)v[i].w, true);
                        ac[0] += cfi * l0[0]; ac[1] += cfi * l0[1]; ac[2] += cfi * h0_[0]; ac[3] += cfi * h0_[1];
                        ac[4] += cfi * l1[0]; ac[5] += cfi * l1[1]; ac[6] += cfi * h1_[0]; ac[7] += cfi * h1_[1];
                        ac[8] += cfi * l2[0]; ac[9] += cfi * l2[1]; ac[10] += cfi * h2_[0]; ac[11] += cfi * h2_[1];
                        ac[12] += cfi * l3[0]; ac[13] += cfi * l3[1]; ac[14] += cfi * h3_[0]; ac[15] += cfi * h3_[1]; }
                    float e8[8], e4[4], e2[2];
#pragma unroll
                    for (int q = 0; q < 8; ++q) { const float keep = u5 ? ac[q + 8] : ac[q], send = u5 ? ac[q] : ac[q + 8]; e8[q] = keep + __uint_as_float(xchg32(__float_as_uint(send), lane)); }
#pragma unroll
                    for (int q = 0; q < 4; ++q) { const float keep = u4 ? e8[q + 4] : e8[q], send = u4 ? e8[q] : e8[q + 4]; e4[q] = keep + __uint_as_float(xchg16(__float_as_uint(send), lane)); }
#pragma unroll
                    for (int q = 0; q < 2; ++q) { const float keep = u3 ? e4[q + 2] : e4[q], send = u3 ? e4[q] : e4[q + 2]; e2[q] = keep + __shfl_xor(send, 8); }
                    const float h0 = hr.x + e2[0], h1 = hr.y + e2[1];
                    *(float2*)op_ = make_float2(h0, h1);
                    const float ss = wave_sum(h0 * h0 + h1 * h1);
                    if (lane == 0) unsafeAtomicAdd(SS + 32768 + tok0 + tt, ss);
                }
                lds_fence();
            }
        }
    }
    }
    xcd_barrier(xb);

    { PHASE_BEGIN
    for (int r = bid * 8 + wave; r < 16384; r += nb * 8) {
        float* hp = OUT + (size_t)r * 1024 + lane * 4;
        const float rr = rsqrtf(SS[32768 + r] * (1.0f / 1024.0f) + 1e-6f);
        float4 hv[4];
#pragma unroll
        for (int i = 0; i < 4; ++i) hv[i] = *(const float4*)(hp + i * 256);
#pragma unroll
        for (int i = 0; i < 4; ++i) { const float4 gg = *(const float4*)(p.g_final + lane * 4 + i * 256);
            *(float4*)(hp + i * 256) = make_float4(hv[i].x * rr * gg.x, hv[i].y * rr * gg.y, hv[i].z * rr * gg.z, hv[i].w * rr * gg.w); }
    }
    }
}

extern "C" void kernel_launch(void* const* d_in, const int* in_sizes, int n_in, void* d_out, int out_size, void* d_ws, size_t ws_size, hipStream_t stream) {
    static int grid_blocks = 0;
    if (grid_blocks == 0) {
        int dev = 0, cus = 0, per_cu = 0;
        hipGetDevice(&dev);
        hipDeviceGetAttribute(&cus, hipDeviceAttributeMultiprocessorCount, dev);
        if (hipFuncSetAttribute((const void*)fwd_mega, hipFuncAttributeMaxDynamicSharedMemorySize, LDS_BYTES) != hipSuccess) { fprintf(stderr, "hipFuncSetAttribute failed\n"); }
        if (hipOccupancyMaxActiveBlocksPerMultiprocessor(&per_cu, (const void*)fwd_mega, NTHREADS, LDS_BYTES) != hipSuccess || per_cu < 1) { fprintf(stderr, "occupancy query failed (%d)\n", per_cu); per_cu = 1; }
        (void)hipGetLastError();
        if (per_cu > 1) per_cu = 1;
        grid_blocks = cus * per_cu;
        if (ws_size < O_END) { fprintf(stderr, "workspace too small: %zu < %zu\n", ws_size, (size_t)O_END); grid_blocks = -1; }
    }
    if (grid_blocks < 0) return;
    Params p{};
    const float** pp = (const float**)&p;
    for (int i = 0; i < 30; ++i) pp[i] = (const float*)d_in[i];
    p.out = (float*)d_out; p.ws = (unsigned char*)d_ws;
    if (hipMemsetAsync((char*)d_ws + O_BAR, 0, 16384, stream) != hipSuccess) { fprintf(stderr, "memset of barrier words failed\n"); return; }
    void* args[] = {&p};
    hipError_t e = hipLaunchKernel((const void*)fwd_mega, dim3(grid_blocks), dim3(NTHREADS), args, LDS_BYTES, stream);
    if (e != hipSuccess) fprintf(stderr, "launch failed: %s (grid %d)\n", hipGetErrorString(e), grid_blocks);
}
```

```cpp
#include <hip/hip_runtime.h>
#include <cstdio>
#include <cstdint>

typedef unsigned short bf16_t;
typedef short bf16x8 __attribute__((ext_vector_type(8)));
typedef float f32x4 __attribute__((ext_vector_type(4)));
#define DEVI __device__ __forceinline__

__device__ __forceinline__ int tid_opaque() { int t = threadIdx.x; asm volatile("" : "+v"(t)); return t; }
constexpr int NTHREADS = 512;
constexpr int LDS_BYTES = 140 * 1024;

constexpr size_t O_BAR  = 0;
constexpr size_t O_WIN  = 16384;
constexpr size_t O_W1K  = O_WIN  + 4480ull * 1024 * 2;
constexpr size_t O_W1V  = O_W1K  + 256ull * 2048 * 2;
constexpr size_t O_WNSA = O_W1V  + 256ull * 2048 * 2;
constexpr size_t O_WGM  = O_WNSA + 1024ull * 512 * 2;
constexpr size_t O_WMIX = O_WGM  + 1024ull * 512 * 2;
constexpr size_t O_WXQ  = O_WMIX + 1024ull * 1024 * 2;
constexpr size_t O_WXKV = O_WXQ  + 1024ull * 1024 * 2;
constexpr size_t O_WXO  = O_WXKV + 2048ull * 1024 * 2;
constexpr size_t O_WPQ  = O_WXO  + 1024ull * 1024 * 2;
constexpr size_t O_B1   = O_WPQ  + 2048ull * 1024 * 2;
constexpr size_t O_VXT  = O_B1   + 2048;
constexpr size_t O_SUBK = O_VXT  + 8ull * 256 * 256 * 2;
constexpr size_t O_PSC  = O_SUBK + 16ull * 128 * 128 * 2;
constexpr size_t O_SS   = O_PSC  + 2ull * 16384 * 4;
constexpr size_t O_HN   = O_SS   + 3ull * 16384 * 4;
constexpr size_t O_MN   = O_HN   + 16384ull * 1024 * 2;
constexpr size_t O_KVX  = O_MN   + 512ull * 1024 * 2;
constexpr size_t O_GATES= O_KVX  + 512ull * 2048 * 2;
constexpr size_t O_HID  = O_GATES+ 16384ull * 24 * 4;
constexpr size_t O_CMP  = O_HID  + 2ull * 2048 * 256 * 4;
constexpr size_t O_Q    = O_CMP  + 2ull * 4 * 512 * 64 * 4;
constexpr size_t O_KV6  = O_Q    + 16384ull * 512 * 2;
constexpr size_t O_U    = O_KV6  + 6ull * 16384 * 128 * 2;
constexpr size_t O_VG   = O_U    + 16384ull * 512 * 2;
constexpr size_t O_MG   = O_VG   + 16384ull * 512 * 2;
constexpr size_t O_ONSA = O_MG   + 16384ull * 2048 * 2;
constexpr size_t O_OGM  = O_ONSA + 16384ull * 512 * 2;
constexpr size_t O_Q8   = O_OGM  + 16384ull * 512 * 2;
constexpr size_t O_END  = O_Q8   + 16384ull * 512;
constexpr size_t O_Y    = O_Q;
constexpr size_t O_QX   = O_U;
constexpr size_t O_OX   = O_ONSA;
constexpr size_t O_QP   = O_MG;
constexpr size_t O_HS   = O_Q;
constexpr size_t O_HI   = O_Q + 16384ull * 256 * 4;
constexpr size_t O_EX   = O_U;
static_assert(O_END <= 256ull * 1024 * 1024, "workspace too large");

struct Params {
    const float *x, *mem, *g_mix, *w_in, *pe_k, *w1_k, *b1_k, *w2_k, *pe_v, *w1_v, *b1_v, *w2_v, *ln_g, *ln_b, *gws, *gbs,
        *w_nsa_out, *w_gmlp_out, *w_mix_out, *g_xattn, *g_mem, *w_xq, *w_xkv, *w_xo, *g_peer, *w_peer_q, *sub_keys, *peer_u, *peer_v, *g_final;
    float* out;
    unsigned char* ws;
};

DEVI bf16_t f2bf(float f) { unsigned u = __float_as_uint(f); u += 0x7fffu + ((u >> 16) & 1u); return (bf16_t)(u >> 16); }
DEVI float bf2f(bf16_t h) { return __uint_as_float(((unsigned)h) << 16); }
DEVI float tof(float v) { return v; }
DEVI float tof(bf16_t v) { return bf2f(v); }
DEVI float wave_sum(float v);
DEVI float wave_max(float v);

DEVI float xmax16(float x) { const auto r = __builtin_amdgcn_permlane16_swap(__float_as_uint(x), __float_as_uint(x), false, false); return fmaxf(__uint_as_float(r[0]), __uint_as_float(r[1])); }
DEVI float xmax32(float x) { const auto r = __builtin_amdgcn_permlane32_swap(__float_as_uint(x), __float_as_uint(x), false, false); return fmaxf(__uint_as_float(r[0]), __uint_as_float(r[1])); }
DEVI float xsum16(float x) { const auto r = __builtin_amdgcn_permlane16_swap(__float_as_uint(x), __float_as_uint(x), false, false); return __uint_as_float(r[0]) + __uint_as_float(r[1]); }
DEVI float xsum32(float x) { const auto r = __builtin_amdgcn_permlane32_swap(__float_as_uint(x), __float_as_uint(x), false, false); return __uint_as_float(r[0]) + __uint_as_float(r[1]); }
DEVI unsigned xchg16(unsigned x, int lane) { const auto r = __builtin_amdgcn_permlane16_swap(x, x, false, false); return (lane & 16) ? r[0] : r[1]; }
DEVI unsigned xchg32(unsigned x, int lane) { const auto r = __builtin_amdgcn_permlane32_swap(x, x, false, false); return (lane & 32) ? r[0] : r[1]; }
DEVI float wave_sum(float v) { v = xsum32(v); v = xsum16(v); for (int o = 8; o > 0; o >>= 1) v += __shfl_xor(v, o); return v; }
DEVI float wave_max(float v) { v = xmax32(v); v = xmax16(v); for (int o = 8; o > 0; o >>= 1) v = fmaxf(v, __shfl_xor(v, o)); return v; }
DEVI float gelu_f(float x) { return 0.5f * x * (1.0f + erff(x * 0.70710678118654752f)); }
DEVI float sigmoid_f(float x) { return 1.0f / (1.0f + expf(-x)); }
DEVI void wave_argmax(float& v, int& idx) {
    for (int o = 32; o > 0; o >>= 1) {
        const float ov = __shfl_xor(v, o); const int oi = __shfl_xor(idx, o);
        const bool take = (ov > v) || (ov == v && oi < idx);
        v = take ? ov : v; idx = take ? oi : idx;
    }
}
typedef unsigned u32x4 __attribute__((ext_vector_type(4)));
DEVI unsigned cvt_pk_bf16(float lo, float hi) { unsigned r; asm("v_cvt_pk_bf16_f32 %0, %1, %2" : "=v"(r) : "v"(lo), "v"(hi)); return r; }
DEVI bf16x8 pack8(const float (&p)[8]) { u32x4 u; u.x = cvt_pk_bf16(p[0], p[1]); u.y = cvt_pk_bf16(p[2], p[3]); u.z = cvt_pk_bf16(p[4], p[5]); u.w = cvt_pk_bf16(p[6], p[7]); return __builtin_bit_cast(bf16x8, u); }
DEVI void lds_fence() { asm volatile("s_waitcnt lgkmcnt(0)" ::: "memory"); }
DEVI void load8(const float* p, float (&f)[8]) { const float4 a = *(const float4*)p, b = *(const float4*)(p + 4); f[0]=a.x; f[1]=a.y; f[2]=a.z; f[3]=a.w; f[4]=b.x; f[5]=b.y; f[6]=b.z; f[7]=b.w; }
DEVI void load8(const bf16_t* p, float (&f)[8]) { const uint4 a = *(const uint4*)p;
    f[0] = __uint_as_float(a.x << 16); f[1] = __uint_as_float(a.x & 0xffff0000u); f[2] = __uint_as_float(a.y << 16); f[3] = __uint_as_float(a.y & 0xffff0000u);
    f[4] = __uint_as_float(a.z << 16); f[5] = __uint_as_float(a.z & 0xffff0000u); f[6] = __uint_as_float(a.w << 16); f[7] = __uint_as_float(a.w & 0xffff0000u); }

template <class CMap>
DEVI void transpose_tile(const float* src, int srcN, bf16_t* dst, int K, int tl, CMap cmap, float* tile, const float* kscale = nullptr) {
    const int nkt = K / 64, kt = tl % nkt, nt = tl / nkt, k0 = kt * 64, n0 = nt * 64;
    const int tidq = tid_opaque(), tx = tidq & 63, ty = tidq >> 6;
    const int sc = cmap(n0 + tx);
#pragma unroll
    for (int i = 0; i < 8; ++i) { const int k = k0 + ty + 8 * i; tile[(ty + 8 * i) * 65 + tx] = sc >= 0 ? src[(size_t)k * srcN + sc] * (kscale ? kscale[k] : 1.0f) : 0.f; }
    __syncthreads();
#pragma unroll
    for (int i = 0; i < 8; ++i) { const int n = n0 + ty + 8 * i; dst[(size_t)n * K + k0 + tx] = f2bf(tile[tx * 65 + ty + 8 * i]); }
    __syncthreads();
}

template <class CMap>
DEVI void transpose_wave(const float* src, int srcN, bf16_t* dst, int K, int tl, CMap cmap, int lane, const float* kscale = nullptr) {
    const int nkt = K / 64, kt = tl % nkt, nt = tl / nkt, k0 = kt * 64, n = nt * 64 + lane;
    const int sc = cmap(n);
    const float* sp = src + (size_t)k0 * srcN + (sc >= 0 ? sc : 0);
    float v[64];
#pragma unroll
    for (int i = 0; i < 64; ++i) v[i] = sp[(size_t)i * srcN];
    if (kscale) {
#pragma unroll
        for (int i = 0; i < 64; ++i) v[i] *= kscale[k0 + i];
    }
    if (sc < 0) {
#pragma unroll
        for (int i = 0; i < 64; ++i) v[i] = 0.f;
    }
    bf16_t* dp = dst + (size_t)n * K + k0;
#pragma unroll
    for (int i = 0; i < 64; i += 8) { u32x4 w; w.x = cvt_pk_bf16(v[i], v[i + 1]); w.y = cvt_pk_bf16(v[i + 2], v[i + 3]); w.z = cvt_pk_bf16(v[i + 4], v[i + 5]); w.w = cvt_pk_bf16(v[i + 6], v[i + 7]); *(u32x4*)(dp + i) = w; }
}
struct IdMap { DEVI int operator()(int n) const { return n; } };
struct WinMap { DEVI int operator()(int n) const { return n < 1280 ? n : (n < 4352 ? n + 24 : (n < 4376 ? n - 4352 + 1280 : -1)); } };

DEVI void rmsnorm_row_bf16(const float* xrow, const float* g, bf16_t* dst, int lane) {
    float4 v[4]; float ss = 0.f;
#pragma unroll
    for (int i = 0; i < 4; ++i) { v[i] = ((const float4*)xrow)[lane + 64 * i]; ss += v[i].x * v[i].x + v[i].y * v[i].y + v[i].z * v[i].z + v[i].w * v[i].w; }
    ss = wave_sum(ss);
    const float r = rsqrtf(ss * (1.0f / 1024.0f) + 1e-6f);
#pragma unroll
    for (int i = 0; i < 4; ++i) {
        const float4 gg = ((const float4*)g)[lane + 64 * i];
        uint2 w; w.x = (unsigned)f2bf(v[i].x * r * gg.x) | ((unsigned)f2bf(v[i].y * r * gg.y) << 16); w.y = (unsigned)f2bf(v[i].z * r * gg.z) | ((unsigned)f2bf(v[i].w * r * gg.w) << 16);
        ((uint2*)dst)[lane + 64 * i] = w;
    }
}

constexpr int G_LD = 72;
template <class AF>
DEVI void gemm_tile(f32x4 (&acc)[4][2], AF af, int m0, const bf16_t* Bt, int ldb, int K, bf16_t* As, bf16_t* Bs) {
    const int tid = tid_opaque(), lane = tid & 63, wave = tid >> 6, wm = wave >> 2, wn = wave & 3;
    const int r0 = tid >> 3, kc = (tid & 7) * 8;
    uint4 ra0, ra1, rb0, rb1;
    ra0 = *(const uint4*)af(m0 + r0, kc); ra1 = *(const uint4*)af(m0 + r0 + 64, kc);
    rb0 = *(const uint4*)(Bt + (size_t)r0 * ldb + kc); rb1 = *(const uint4*)(Bt + (size_t)(r0 + 64) * ldb + kc);
    for (int k0 = 0; k0 < K; k0 += 64) {
        __syncthreads();
        *(uint4*)(As + r0 * G_LD + kc) = ra0; *(uint4*)(As + (r0 + 64) * G_LD + kc) = ra1;
        *(uint4*)(Bs + r0 * G_LD + kc) = rb0; *(uint4*)(Bs + (r0 + 64) * G_LD + kc) = rb1;
        __syncthreads();
        if (k0 + 64 < K) {
            const int kn = k0 + 64 + kc;
            ra0 = *(const uint4*)af(m0 + r0, kn); ra1 = *(const uint4*)af(m0 + r0 + 64, kn);
            rb0 = *(const uint4*)(Bt + (size_t)r0 * ldb + kn); rb1 = *(const uint4*)(Bt + (size_t)(r0 + 64) * ldb + kn);
        }
#pragma unroll
        for (int ks = 0; ks < 2; ++ks) {
            bf16x8 af_[4], bf_[2];
#pragma unroll
            for (int i = 0; i < 4; ++i) af_[i] = *(const bf16x8*)(As + (wm * 64 + i * 16 + (lane & 15)) * G_LD + ks * 32 + (lane >> 4) * 8);
#pragma unroll
            for (int j = 0; j < 2; ++j) bf_[j] = *(const bf16x8*)(Bs + (wn * 32 + j * 16 + (lane & 15)) * G_LD + ks * 32 + (lane >> 4) * 8);
#pragma unroll
            for (int i = 0; i < 4; ++i)
#pragma unroll
                for (int j = 0; j < 2; ++j) acc[i][j] = __builtin_amdgcn_mfma_f32_16x16x32_bf16(bf_[j], af_[i], acc[i][j], 0, 0, 0);
        }
    }
}
struct RowMajorA { const bf16_t* A; int lda; DEVI const bf16_t* operator()(int row, int k) const { return A + (size_t)row * lda + k; } };
struct CmpA { const bf16_t* KC; int koff;
    DEVI const bf16_t* operator()(int row, int k_) const { const int k = k_ + koff; const int rr = row < 2044 ? row : 2043; const int b = rr / 1022, rem = rr - b * 1022, c = rem >> 1, g = rem & 1;
        return KC + ((size_t)(b * 8192 + 16 * c + (k >> 6)) * 128 + g * 64 + (k & 63)); } };

template <class AF, class Epi>
DEVI void gemm_run(AF af, const bf16_t* Bt, int K, int MT, int NT, Epi epi, unsigned char* smem, int bid, int nb) {
    bf16_t* As = (bf16_t*)smem; bf16_t* Bs = As + 128 * G_LD;
    const int tidq = tid_opaque(), lane = tidq & 63, wave = tidq >> 6, wm = wave >> 2, wn = wave & 3;
    for (int t = bid; t < MT * NT; t += nb) {
        const int mt = t / NT, nt = t % NT;
        f32x4 acc[4][2];
#pragma unroll
        for (int i = 0; i < 4; ++i)
#pragma unroll
            for (int j = 0; j < 2; ++j) acc[i][j] = (f32x4){0.f, 0.f, 0.f, 0.f};
        gemm_tile(acc, af, mt * 128, Bt + (size_t)nt * 128 * K, K, K, As, Bs);
#pragma unroll
        for (int i = 0; i < 4; ++i)
#pragma unroll
            for (int j = 0; j < 2; ++j) epi(mt * 128 + wm * 64 + i * 16 + (lane & 15), nt * 128 + wn * 32 + j * 16 + (lane >> 4) * 4, acc[i][j]);
    }
}
DEVI void store_bf16x4(bf16_t* p, float a, float b, float c, float d) { uint2 w; w.x = (unsigned)f2bf(a) | ((unsigned)f2bf(b) << 16); w.y = (unsigned)f2bf(c) | ((unsigned)f2bf(d) << 16); *(uint2*)p = w; }

namespace pg8 {
#define PG8_LAS __attribute__((address_space(3)))
typedef unsigned short bf16_t;
typedef short bf16x8 __attribute__((ext_vector_type(8)));
typedef float f32x4 __attribute__((ext_vector_type(4)));
typedef unsigned u32x4 __attribute__((ext_vector_type(4)));
constexpr int BM = 256, BK = 64, HALF = 128, HTB = HALF * BK * 2  , STAGE_BYTES = 8 * HTB, NXCD = 8, WGM = 8;

__host__ __device__ __forceinline__ int lds_byte(int r, int c) { const int st = (r >> 4) * 2 + (c >> 5), rr = r & 15, cc = c & 31, ob = rr * 64 + cc * 2; return st * 1024 + (ob ^ (((ob >> 9) & 1) << 5)); }
__host__ __device__ __forceinline__ void stage_rc(int b, int& R, int& C) { const int st = b / 1024, sb = b % 1024, swz = sb ^ (((sb >> 9) & 1) << 5); R = (st >> 1) * 16 + swz / 64; C = (st & 1) * 32 + (swz % 64) / 2; }
__host__ __device__ __forceinline__ int perm32(int rho) { const int n = rho >> 4, i = rho & 15; return 8 * (i >> 2) + 4 * n + (i & 3); }

struct Unit { int pm, pn; };
struct Gemm { const bf16_t* A; const bf16_t* Bt; int M, N, K; };

struct StaticOrder {
    int nM, nN, nwg, G, c;
    __host__ __device__ void init(int M, int N, int G_, int c_) { nM = M / BM; nN = N / BM; nwg = nM * nN; G = G_; c = c_; }
    __host__ __device__ bool next(int i, Unit& u) const {
        const long L = (long)i * G + c; if (L >= nwg) return false;
        int wgid = (int)L; { const int q = nwg / NXCD, r = nwg % NXCD, xcd = wgid % NXCD, off = wgid / NXCD; wgid = (xcd < r ? xcd * (q + 1) : r * (q + 1) + (xcd - r) * q) + off; }
        const int nig = WGM * nN, gid = wgid / nig, fm = gid * WGM, gsz = (nM - fm) < WGM ? (nM - fm) : WGM;
        u.pm = fm + ((wgid % nig) % gsz); u.pn = (wgid % nig) / gsz; return true;
    }
    __device__ __forceinline__ void a_ready(const Unit&) const {}
    __device__ __forceinline__ void done(const Unit&) const {}
};

template <class Epi, class Sched, bool ALIGN_EPI = false, bool SP2 = false>
__device__ __forceinline__ void gemm_phase(PG8_LAS unsigned char* lds, const Gemm g, const Sched& S, const Epi& E) {
    const int tid = tid_opaque(), wid = __builtin_amdgcn_readfirstlane(tid >> 6), lane = tid & 63, wr = wid >> 2, wc = wid & 3, fr = lane & 15, fq = lane >> 4;
    const int K = g.K, nt = K / BK;
    unsigned voffA[2], voffB[2];
#pragma unroll
    for (int i = 0; i < 2; ++i) { int R, C; stage_rc(tid * 16 + i * 8192, R, C); const int Rb = Epi::PERM ? ((R & ~31) + perm32(R & 31)) : R;
        voffA[i] = (unsigned)(R * K + C) * 2u; voffB[i] = (unsigned)(Rb * K + C) * 2u; }
    const size_t kstep = (size_t)(BK * 2);
    const size_t hstep = (size_t)HALF * K * 2;
    const size_t tstep = 2 * hstep;
    const unsigned ldsw = (unsigned)wid * 1024u;
    const int aoff = lds_byte(wr * 64 + fr, fq * 8), boff = lds_byte(wc * 32 + fr, fq * 8);
#define PG8_SA(b, h) (((b) * 2 + (h)) * HTB)
#define PG8_SB(b, h) ((4 + (b) * 2 + (h)) * HTB)
#define PG8_STAGE(bufoff, gbase, voff) do { _Pragma("unroll") for (int _i = 0; _i < 2; ++_i) \
        __builtin_amdgcn_global_load_lds((const unsigned*)((const char*)(gbase) + (voff)[_i]), (PG8_LAS unsigned*)(lds + (bufoff) + ldsw + _i * 8192), 16, 0, 0); } while (0)
#define PG8_LDA(dst, b, h) do { _Pragma("unroll") for (int m = 0; m < 4; ++m) _Pragma("unroll") for (int k = 0; k < 2; ++k) dst[m][k] = *(const PG8_LAS bf16x8*)(lds + PG8_SA(b, h) + aoff + m * 2048 + k * 1024); } while (0)
#define PG8_LDB(dst, b, h) do { _Pragma("unroll") for (int n = 0; n < 2; ++n) _Pragma("unroll") for (int k = 0; k < 2; ++k) dst[n][k] = *(const PG8_LAS bf16x8*)(lds + PG8_SB(b, h) + boff + n * 2048 + k * 1024); } while (0)
#define PG8_MMA(ai, bj, At, Bt) do { __builtin_amdgcn_s_setprio(1); _Pragma("unroll") for (int m = 0; m < 4; ++m) _Pragma("unroll") for (int n = 0; n < 2; ++n) _Pragma("unroll") for (int k = 0; k < 2; ++k) \
        acc[ai][bj][m][n] = __builtin_amdgcn_mfma_f32_16x16x32_bf16(Bt[n][k], At[m][k], acc[ai][bj][m][n], 0, 0, 0); __builtin_amdgcn_s_setprio(0); } while (0)
#define PG8_WAIT_V(n) asm volatile("s_waitcnt vmcnt(" #n ")" ::: "memory")
#define PG8_WAIT_L(n) asm volatile("s_waitcnt lgkmcnt(" #n ")" ::: "memory")
#define PG8_BAR __builtin_amdgcn_s_barrier()
#define PG8_SCHED __builtin_amdgcn_sched_barrier(0)
    Unit cur, nxt; int ui = 0;
    if (!S.next(0, cur)) return;
    f32x4 acc[2][2][4][2];
#pragma unroll
    for (int a = 0; a < 2; ++a)
#pragma unroll
        for (int b = 0; b < 2; ++b)
#pragma unroll
            for (int m = 0; m < 4; ++m)
#pragma unroll
                for (int n = 0; n < 2; ++n) acc[a][b][m][n] = (f32x4){0.f, 0.f, 0.f, 0.f};
    bf16x8 At[4][2], B0[2][2], B1[2][2];
    const char* cA = (const char*)g.A + (size_t)cur.pm * tstep; const char* cB = (const char*)g.Bt + (size_t)cur.pn * tstep;
    S.a_ready(cur);
    if constexpr (SP2) {
        PG8_STAGE(PG8_SB(0, 0), cB, voffB); PG8_STAGE(PG8_SB(0, 1), cB + hstep, voffB); PG8_STAGE(PG8_SA(0, 0), cA, voffA); PG8_STAGE(PG8_SA(0, 1), cA + hstep, voffA);
        if (wr == 1) PG8_BAR;
        PG8_WAIT_V(2); PG8_BAR;
        PG8_STAGE(PG8_SB(1, 0), cB + kstep, voffB); PG8_STAGE(PG8_SA(1, 0), cA + kstep, voffA); PG8_STAGE(PG8_SB(1, 1), cB + hstep + kstep, voffB);
        PG8_WAIT_V(6); PG8_BAR;
    } else {
        PG8_STAGE(PG8_SB(0, 0), cB, voffB); PG8_STAGE(PG8_SA(0, 0), cA, voffA); PG8_STAGE(PG8_SB(0, 1), cB + hstep, voffB); PG8_STAGE(PG8_SA(0, 1), cA + hstep, voffA);
        if (wr == 1) PG8_BAR;
        PG8_WAIT_V(4); PG8_BAR;
        PG8_STAGE(PG8_SB(1, 0), cB + kstep, voffB); PG8_STAGE(PG8_SA(1, 0), cA + kstep, voffA); PG8_STAGE(PG8_SB(1, 1), cB + hstep + kstep, voffB);
        PG8_WAIT_V(6); PG8_BAR;
    }
    for (;;) {
        const bool has_next = S.next(ui + 1, nxt);
        const char* nA = has_next ? (const char*)g.A + (size_t)nxt.pm * tstep : cA; const char* nB = has_next ? (const char*)g.Bt + (size_t)nxt.pn * tstep : cB;
        for (int t = 0; t < nt; t += 2) {
            const bool last = (t == nt - 2);
            const char* a1 = cA + (size_t)(t + 1) * kstep;
            const char* a2 = last ? nA : cA + (size_t)(t + 2) * kstep; const char* b2 = last ? nB : cB + (size_t)(t + 2) * kstep;
            const char* a3 = a2 + kstep; const char* b3 = b2 + kstep;
            if (last && has_next) S.a_ready(nxt);
            if constexpr (SP2) {
            PG8_LDB(B0, 0, 0); PG8_LDB(B1, 0, 1); PG8_SCHED; PG8_LDA(At, 0, 0); PG8_STAGE(PG8_SA(1, 1), a1 + hstep, voffA);
            PG8_WAIT_V(8); PG8_WAIT_L(0); PG8_BAR; PG8_MMA(0, 0, At, B0); PG8_MMA(0, 1, At, B1); PG8_BAR; PG8_SCHED;
            PG8_LDA(At, 0, 1); PG8_STAGE(PG8_SB(0, 0), b2, voffB); PG8_STAGE(PG8_SB(0, 1), b2 + hstep, voffB); PG8_STAGE(PG8_SA(0, 0), a2, voffA);
            PG8_WAIT_V(8); PG8_WAIT_L(0); PG8_BAR; PG8_MMA(1, 0, At, B0); PG8_MMA(1, 1, At, B1); PG8_BAR; PG8_SCHED;
            PG8_LDB(B0, 1, 0); PG8_LDB(B1, 1, 1); PG8_SCHED; PG8_LDA(At, 1, 0); PG8_STAGE(PG8_SA(0, 1), a2 + hstep, voffA);
            PG8_WAIT_V(8); PG8_WAIT_L(0); PG8_BAR; PG8_MMA(0, 0, At, B0); PG8_MMA(0, 1, At, B1); PG8_BAR; PG8_SCHED;
            PG8_LDA(At, 1, 1); PG8_STAGE(PG8_SB(1, 0), b3, voffB); PG8_STAGE(PG8_SB(1, 1), b3 + hstep, voffB); PG8_STAGE(PG8_SA(1, 0), a3, voffA);
            PG8_WAIT_V(8); PG8_WAIT_L(0); PG8_BAR; PG8_MMA(1, 0, At, B0); PG8_MMA(1, 1, At, B1); PG8_BAR; PG8_SCHED;
            } else {
            PG8_LDB(B0, 0, 0); PG8_SCHED; PG8_LDA(At, 0, 0); PG8_STAGE(PG8_SA(1, 1), a1 + hstep, voffA);
            PG8_WAIT_L(8); PG8_BAR; PG8_WAIT_L(0); PG8_MMA(0, 0, At, B0); PG8_BAR; PG8_SCHED;
            PG8_LDB(B1, 0, 1); PG8_STAGE(PG8_SB(0, 0), b2, voffB);
            PG8_BAR; PG8_WAIT_L(0); PG8_MMA(0, 1, At, B1); PG8_BAR;
            PG8_LDA(At, 0, 1); PG8_STAGE(PG8_SA(0, 0), a2, voffA);
            PG8_BAR; PG8_WAIT_L(0); PG8_MMA(1, 0, At, B0); PG8_BAR; PG8_SCHED;
            PG8_STAGE(PG8_SB(0, 1), b2 + hstep, voffB);
            PG8_WAIT_V(6); PG8_BAR; PG8_MMA(1, 1, At, B1); PG8_BAR;
            PG8_LDB(B0, 1, 0); PG8_SCHED; PG8_LDA(At, 1, 0); PG8_STAGE(PG8_SA(0, 1), a2 + hstep, voffA);
            PG8_WAIT_L(8); PG8_BAR; PG8_WAIT_L(0); PG8_MMA(0, 0, At, B0); PG8_BAR; PG8_SCHED;
            PG8_LDB(B1, 1, 1); PG8_STAGE(PG8_SB(1, 0), b3, voffB);
            PG8_BAR; PG8_WAIT_L(0); PG8_MMA(0, 1, At, B1); PG8_BAR;
            PG8_LDA(At, 1, 1); PG8_STAGE(PG8_SA(1, 0), a3, voffA);
            PG8_BAR; PG8_WAIT_L(0); PG8_MMA(1, 0, At, B0); PG8_BAR; PG8_SCHED;
            PG8_STAGE(PG8_SB(1, 1), b3 + hstep, voffB);
            PG8_WAIT_V(6); PG8_BAR; PG8_MMA(1, 1, At, B1); PG8_BAR;
            }
        }
        if constexpr (ALIGN_EPI) { if (wr == 0) PG8_BAR; }
        if constexpr (!Epi::AFTER_DRAIN) { E(acc, cur, wr, wc, fr, fq); S.done(cur); }
        if (!has_next) break;
#pragma unroll
        for (int a = 0; a < 2; ++a)
#pragma unroll
            for (int b = 0; b < 2; ++b)
#pragma unroll
                for (int m = 0; m < 4; ++m)
#pragma unroll
                    for (int n = 0; n < 2; ++n) acc[a][b][m][n] = (f32x4){0.f, 0.f, 0.f, 0.f};
        cur = nxt; cA = nA; cB = nB; ++ui;
        if constexpr (ALIGN_EPI) { if (wr == 1) PG8_BAR; }
    }
    PG8_WAIT_V(0);
    if constexpr (!ALIGN_EPI) { if (wr == 0) PG8_BAR; }
    PG8_BAR;
    if constexpr (Epi::AFTER_DRAIN) { E.fused(acc, cur, wr, wc, fr, fq, lds, wid, lane); S.done(cur); }
#undef PG8_SA
#undef PG8_SB
#undef PG8_STAGE
#undef PG8_LDA
#undef PG8_LDB
#undef PG8_MMA
#undef PG8_WAIT_V
#undef PG8_WAIT_L
#undef PG8_BAR
#undef PG8_SCHED
}
}

template <class F> struct EpiFn {
    static constexpr bool PERM = true, AFTER_DRAIN = false;
    F f;
    DEVI void operator()(const f32x4 (&acc)[2][2][4][2], const pg8::Unit& u, int wr, int wc, int fr, int fq) const {
#pragma unroll
        for (int ai = 0; ai < 2; ++ai)
#pragma unroll
            for (int m = 0; m < 4; ++m) {
                const int row = u.pm * 256 + ai * 128 + wr * 64 + m * 16 + fr;
#pragma unroll
                for (int bj = 0; bj < 2; ++bj) { f(row, u.pn * 256 + bj * 128 + wc * 32 + 8 * fq, acc[ai][bj][m][0], acc[ai][bj][m][1]); __builtin_amdgcn_sched_barrier(0); }
            }
    }
};
template <class F> DEVI EpiFn<F> make_epi(F f) { return EpiFn<F>{f}; }
template <class F>
DEVI void big_gemm(unsigned char* smem, const bf16_t* A, const bf16_t* Bt, int M, int N, int K, F f) {
    pg8::StaticOrder S; S.init(M, N, (int)gridDim.x, (int)blockIdx.x);
    const pg8::Gemm g{A, Bt, M, N, K};
    const auto E = make_epi(f);
    pg8::gemm_phase<EpiFn<F>, pg8::StaticOrder, true, true>((PG8_LAS unsigned char*)smem, g, S, E);
}
DEVI void store_bf16x8(bf16_t* p, const f32x4& a, const f32x4& b) { u32x4 w; w.x = cvt_pk_bf16(a[0], a[1]); w.y = cvt_pk_bf16(a[2], a[3]); w.z = cvt_pk_bf16(b[0], b[1]); w.w = cvt_pk_bf16(b[2], b[3]); *(u32x4*)p = w; }

template <int DH, int R, int NCH, bool PSUM, typename KT, class RowF>
DEVI void attend(const float* qs, float* pl, float* psum, const KT* Kb, const KT* Vb, size_t stride, RowF rowf, float (&o)[R][DH / 64], int lane) {
    float m[R], l[R];
#pragma unroll
    for (int r = 0; r < R; ++r) { m[r] = -1e30f; l[r] = 0.f; }
#pragma unroll 1
    for (int i = 0; i < NCH; ++i) {
        bool valid; const long row = rowf(i, lane, valid);
        if (__ballot(valid) == 0ull) continue;
        const KT* kp = Kb + (size_t)row * stride;
        float a[R];
#pragma unroll
        for (int r = 0; r < R; ++r) a[r] = 0.f;
#pragma unroll 2
        for (int d0 = 0; d0 < DH; d0 += 8) {
            float kf[8]; load8(kp + d0, kf);
#pragma unroll
            for (int r = 0; r < R; ++r) {
                const float4 q0 = *(const float4*)(qs + r * DH + d0), q1 = *(const float4*)(qs + r * DH + d0 + 4);
                a[r] += kf[0] * q0.x + kf[1] * q0.y + kf[2] * q0.z + kf[3] * q0.w + kf[4] * q1.x + kf[5] * q1.y + kf[6] * q1.z + kf[7] * q1.w;
            }
        }
#pragma unroll
        for (int r = 0; r < R; ++r) {
            const float sv = valid ? a[r] : -1e30f;
            const float mn = fmaxf(m[r], wave_max(sv));
            const float pe = valid ? expf(sv - mn) : 0.f;
            l[r] = l[r] * expf(m[r] - mn) + wave_sum(pe);
            m[r] = mn;
        }
    }
    float inv[R];
#pragma unroll
    for (int r = 0; r < R; ++r) inv[r] = 1.0f / fmaxf(l[r], 1e-30f);
#pragma unroll 1
    for (int i = 0; i < NCH; ++i) {
        bool valid; const long row = rowf(i, lane, valid);
        const bool any = __ballot(valid) != 0ull;
        float a[R];
#pragma unroll
        for (int r = 0; r < R; ++r) a[r] = 0.f;
        if (any) {
            const KT* kp = Kb + (size_t)row * stride;
#pragma unroll 2
            for (int d0 = 0; d0 < DH; d0 += 8) {
                float kf[8]; load8(kp + d0, kf);
#pragma unroll
                for (int r = 0; r < R; ++r) {
                    const float4 q0 = *(const float4*)(qs + r * DH + d0), q1 = *(const float4*)(qs + r * DH + d0 + 4);
                    a[r] += kf[0] * q0.x + kf[1] * q0.y + kf[2] * q0.z + kf[3] * q0.w + kf[4] * q1.x + kf[5] * q1.y + kf[6] * q1.z + kf[7] * q1.w;
                }
            }
        }
        float ps = 0.f;
#pragma unroll
        for (int r = 0; r < R; ++r) { const float pv = valid ? expf(a[r] - m[r]) * inv[r] : 0.f; pl[r * 64 + lane] = pv; ps += pv; }
        if (PSUM) psum[i * 64 + lane] = ps;
        lds_fence();
        if (any) {
#pragma unroll 2
            for (int key = 0; key < 64; ++key) {
                bool dummy; const long vrow = rowf(i, key, dummy);
                const KT* vp = Vb + (size_t)vrow * stride;
                float pr[R];
#pragma unroll
                for (int r = 0; r < R; ++r) pr[r] = pl[r * 64 + key];
#pragma unroll
                for (int j = 0; j < DH / 64; ++j) { const float v = tof(vp[lane + 64 * j]);
#pragma unroll
                    for (int r = 0; r < R; ++r) o[r][j] += pr[r] * v; }
            }
        }
        lds_fence();
    }
}


DEVI int nsa_koff(int t, int d) { return ((((t >> 5) * 4 + (((t >> 2) & 1) * 2 + (d >> 5))) * 64) + ((((t & 31) >> 3) << 2) | (t & 3)) + 16 * ((d >> 3) & 3)) * 8 + (d & 7); }
DEVI int nsa_voff(int t, int d) { return ((((t >> 5) * 4 + (d >> 4)) * 64) + (d & 15) + 16 * ((t & 31) >> 3)) * 8 + (t & 7); }
DEVI int xat_koff(int m, int d) { return ((((m >> 5) * 16 + ((m >> 2) & 1) * 8 + (d >> 5)) * 64) + ((((m & 31) >> 3) << 2) | (m & 3)) + 16 * ((d >> 3) & 3)) * 8 + (d & 7); }
DEVI int xat_voff(int m, int d) { return ((((m >> 5) * 16 + (d >> 4)) * 64) + (d & 15) + 16 * ((m & 31) >> 3)) * 8 + (m & 7); }
DEVI int pk_koff(int k, int d) { return ((((k >> 4) * 4 + (d >> 5)) * 64) + (k & 15) + 16 * ((d >> 3) & 3)) * 8 + (d & 7); }
DEVI int nsa_koff8(int t, int d) { return ((((t >> 5) * 2 + ((t >> 2) & 1)) * 64) + ((((t & 31) >> 3) << 2) | (t & 3)) + 16 * ((d >> 3) & 3)) * 16 + (d >> 5) * 8 + (d & 7); }
DEVI int nsa_voff8(int t, int d) { return ((((t >> 5) * 2 + (d >> 5)) * 64) + (d & 15) + 16 * ((t & 31) >> 3)) * 16 + ((d >> 4) & 1) * 8 + (t & 7); }
DEVI void nsa_load_kf(bf16x8 (&ka)[4], const bf16_t* Kp, int ch, int lane) {
#pragma unroll
    for (int f = 0; f < 4; ++f) ka[f] = *(const bf16x8*)(Kp + ((ch * 4 + f) * 64 + lane) * 8);
}
DEVI void nsa_load_k(bf16x8 (&ka)[4], const bf16_t* Kp, int stride, int kb, int rk, int dh) {
    const int o0 = (kb + rk) * stride + dh, o1 = o0 + 4 * stride;
    ka[0] = *(const bf16x8*)(Kp + o0); ka[1] = *(const bf16x8*)(Kp + o0 + 32); ka[2] = *(const bf16x8*)(Kp + o1); ka[3] = *(const bf16x8*)(Kp + o1 + 32);
}
DEVI void nsa_load_v(bf16x8 (&va)[4], const bf16_t* Vp, int vstride, int kb8, int lr) {
    const int o = lr * vstride + kb8;
#pragma unroll
    for (int dt = 0; dt < 4; ++dt) va[dt] = *(const bf16x8*)(Vp + o + dt * 16 * vstride);
}
DEVI void nsa_load_vb(bf16x8 (&va)[4], const bf16_t* Vp, int kb8, int lr) {
    const int o = ((kb8 >> 6) * 64 + lr) * 64 + (kb8 & 63);
#pragma unroll
    for (int dt = 0; dt < 4; ++dt) va[dt] = *(const bf16x8*)(Vp + o + dt * 16 * 64);
}
DEVI void nsa_scores(const bf16x8 (&ka)[4], const bf16x8 (&qf)[2], float (&sv)[8]) {
    f32x4 s0 = {0.f, 0.f, 0.f, 0.f}, s1 = {0.f, 0.f, 0.f, 0.f};
    s0 = __builtin_amdgcn_mfma_f32_16x16x32_bf16(ka[0], qf[0], s0, 0, 0, 0); s1 = __builtin_amdgcn_mfma_f32_16x16x32_bf16(ka[2], qf[0], s1, 0, 0, 0);
    s0 = __builtin_amdgcn_mfma_f32_16x16x32_bf16(ka[1], qf[1], s0, 0, 0, 0); s1 = __builtin_amdgcn_mfma_f32_16x16x32_bf16(ka[3], qf[1], s1, 0, 0, 0);
    sv[0] = s0[0]; sv[1] = s0[1]; sv[2] = s0[2]; sv[3] = s0[3]; sv[4] = s1[0]; sv[5] = s1[1]; sv[6] = s1[2]; sv[7] = s1[3];
}
DEVI unsigned long long pack8_fp8(const float (&p)[8]) {
    int lo = 0, hi = 0;
    lo = __builtin_amdgcn_cvt_pk_fp8_f32(p[0], p[1], lo, false); lo = __builtin_amdgcn_cvt_pk_fp8_f32(p[2], p[3], lo, true);
    hi = __builtin_amdgcn_cvt_pk_fp8_f32(p[4], p[5], hi, false); hi = __builtin_amdgcn_cvt_pk_fp8_f32(p[6], p[7], hi, true);
    return ((unsigned long long)(unsigned)hi << 32) | (unsigned)lo;
}
struct NsaSt { float m, l; f32x4 o[4]; };
struct NsaBuf8 { long ka[4]; long va[4]; int e; };
DEVI void nsa_load8(long (&f)[4], const unsigned char* P, int ch, int lane) {
#pragma unroll
    for (int i = 0; i < 2; ++i) { const uint4 w = *(const uint4*)(P + ((ch * 2 + i) * 64 + lane) * 16);
        f[2 * i] = (long)(((unsigned long long)w.y << 32) | w.x); f[2 * i + 1] = (long)(((unsigned long long)w.w << 32) | w.z); }
}
struct NsaSt8 { float m, l; bool set; f32x4 negm; f32x4 o[4]; };
DEVI void nsa_init8(NsaSt8& st) { st.m = 0.f; st.l = 0.f; st.set = false; st.negm = (f32x4){7.f, 7.f, 7.f, 7.f};
#pragma unroll
    for (int dt = 0; dt < 4; ++dt) st.o[dt] = (f32x4){0.f, 0.f, 0.f, 0.f}; }

struct NsaBuf { bf16x8 ka[4]; bf16x8 va[4]; };
DEVI void nsa_init(NsaSt& st) { st.m = -1e20f; st.l = 0.f;
#pragma unroll
    for (int dt = 0; dt < 4; ++dt) st.o[dt] = (f32x4){0.f, 0.f, 0.f, 0.f}; }
template <bool PV>
DEVI void nsa_chunk(NsaSt& st, float (&sv)[8], int pos0, int lo, int hi, const bf16x8 (&va)[4]) {
    float cm = -1e30f;
#pragma unroll
    for (int j = 0; j < 8; ++j) { const bool ok = (pos0 + j >= lo) && (pos0 + j <= hi); sv[j] = ok ? sv[j] : -1e30f; cm = fmaxf(cm, sv[j]); }
    cm = xmax16(cm); cm = xmax32(cm);
    if (__any(cm > st.m)) {
        const float mn = fmaxf(st.m, cm), sc = __builtin_amdgcn_exp2f(st.m - mn);
        st.l *= sc;
        if (PV) {
#pragma unroll
            for (int dt = 0; dt < 4; ++dt) st.o[dt] *= sc;
        }
        st.m = mn;
    }
    float p[8]; float ps = 0.f;
#pragma unroll
    for (int j = 0; j < 8; ++j) { p[j] = __builtin_amdgcn_exp2f(sv[j] - st.m); ps += p[j]; }
    st.l += ps;
    if (PV) {
        const bf16x8 pb = pack8(p);
#pragma unroll
        for (int dt = 0; dt < 4; ++dt) st.o[dt] = __builtin_amdgcn_mfma_f32_16x16x32_bf16(va[dt], pb, st.o[dt], 0, 0, 0);
    }
}
template <int MASK>
DEVI void nsa_chunk8(NsaSt8& st, const long (&ka)[4], const long (&qf)[2], const long (&va)[4], int pos0, int hi, bool own) {
    f32x4 s0 = st.negm, s1 = st.negm;
    s0 = __builtin_amdgcn_mfma_f32_16x16x32_fp8_fp8(ka[0], qf[0], s0, 0, 0, 0); s1 = __builtin_amdgcn_mfma_f32_16x16x32_fp8_fp8(ka[2], qf[0], s1, 0, 0, 0);
    s0 = __builtin_amdgcn_mfma_f32_16x16x32_fp8_fp8(ka[1], qf[1], s0, 0, 0, 0); s1 = __builtin_amdgcn_mfma_f32_16x16x32_fp8_fp8(ka[3], qf[1], s1, 0, 0, 0);
    float sv[8] = {s0[0], s0[1], s0[2], s0[3], s1[0], s1[1], s1[2], s1[3]};
    if (MASK == 1) {
#pragma unroll
        for (int j = 0; j < 8; ++j) sv[j] = own ? sv[j] : -1e30f;
    } else if (MASK == 2) {
#pragma unroll
        for (int j = 0; j < 8; ++j) sv[j] = (pos0 + j <= hi) ? sv[j] : -1e30f;
    }
    float cm = fmaxf(fmaxf(fmaxf(sv[0], sv[1]), fmaxf(sv[2], sv[3])), fmaxf(fmaxf(sv[4], sv[5]), fmaxf(sv[6], sv[7])));
    cm = xmax16(cm); cm = xmax32(cm);
    const bool need = (cm > 7.f) || (!st.set && cm > -1e29f);
    if (__any(need)) {
        const float d = need ? cm - 7.f : 0.f;
        const float sc = need ? (st.set ? __builtin_amdgcn_exp2f(-d) : 0.f) : 1.f;
        st.m += d; st.set = st.set || need;
        const float nm = 7.f - st.m; st.negm = (f32x4){nm, nm, nm, nm};
        st.l *= sc;
#pragma unroll
        for (int dt = 0; dt < 4; ++dt) st.o[dt] *= sc;
#pragma unroll
        for (int j = 0; j < 8; ++j) sv[j] -= d;
    }
    float p[8];
#pragma unroll
    for (int j = 0; j < 8; ++j) p[j] = __builtin_amdgcn_exp2f(sv[j]);
    st.l += ((p[0] + p[1]) + (p[2] + p[3])) + ((p[4] + p[5]) + (p[6] + p[7]));
    const long pb = (long)pack8_fp8(p);
#pragma unroll
    for (int dt = 0; dt < 4; ++dt) st.o[dt] = __builtin_amdgcn_mfma_f32_16x16x32_fp8_fp8(va[dt], pb, st.o[dt], 0, 0, 0);
}
struct NsaBlk8 { long ka[8]; long va[8]; int e; };
template <int MASK>
DEVI void nsa_block8(NsaSt8& st, const NsaBlk8& bf, const long (&qf)[2], int pos0, int hi, bool own) {
    f32x4 s0 = st.negm, s1 = st.negm, s2 = st.negm, s3 = st.negm;
    s0 = __builtin_amdgcn_mfma_f32_16x16x32_fp8_fp8(bf.ka[0], qf[0], s0, 0, 0, 0); s1 = __builtin_amdgcn_mfma_f32_16x16x32_fp8_fp8(bf.ka[2], qf[0], s1, 0, 0, 0);
    s2 = __builtin_amdgcn_mfma_f32_16x16x32_fp8_fp8(bf.ka[4], qf[0], s2, 0, 0, 0); s3 = __builtin_amdgcn_mfma_f32_16x16x32_fp8_fp8(bf.ka[6], qf[0], s3, 0, 0, 0);
    s0 = __builtin_amdgcn_mfma_f32_16x16x32_fp8_fp8(bf.ka[1], qf[1], s0, 0, 0, 0); s1 = __builtin_amdgcn_mfma_f32_16x16x32_fp8_fp8(bf.ka[3], qf[1], s1, 0, 0, 0);
    s2 = __builtin_amdgcn_mfma_f32_16x16x32_fp8_fp8(bf.ka[5], qf[1], s2, 0, 0, 0); s3 = __builtin_amdgcn_mfma_f32_16x16x32_fp8_fp8(bf.ka[7], qf[1], s3, 0, 0, 0);
    float sv[16] = {s0[0], s0[1], s0[2], s0[3], s1[0], s1[1], s1[2], s1[3], s2[0], s2[1], s2[2], s2[3], s3[0], s3[1], s3[2], s3[3]};
    if (MASK == 1) {
#pragma unroll
        for (int j = 0; j < 16; ++j) sv[j] = own ? sv[j] : -1e30f;
    } else if (MASK == 2) {
#pragma unroll
        for (int j = 0; j < 16; ++j) sv[j] = (pos0 + (j & 7) + 32 * (j >> 3) <= hi) ? sv[j] : -1e30f;
    }
    float cm = fmaxf(fmaxf(fmaxf(fmaxf(sv[0], sv[1]), fmaxf(sv[2], sv[3])), fmaxf(fmaxf(sv[4], sv[5]), fmaxf(sv[6], sv[7]))),
                     fmaxf(fmaxf(fmaxf(sv[8], sv[9]), fmaxf(sv[10], sv[11])), fmaxf(fmaxf(sv[12], sv[13]), fmaxf(sv[14], sv[15]))));
    cm = xmax16(cm); cm = xmax32(cm);
    const bool need = (cm > 7.f) || (!st.set && cm > -1e29f);
    if (__any(need)) {
        const float d = need ? cm - 7.f : 0.f;
        const float sc = need ? (st.set ? __builtin_amdgcn_exp2f(-d) : 0.f) : 1.f;
        st.m += d; st.set = st.set || need;
        const float nm = 7.f - st.m; st.negm = (f32x4){nm, nm, nm, nm};
        st.l *= sc;
#pragma unroll
        for (int dt = 0; dt < 4; ++dt) st.o[dt] *= sc;
#pragma unroll
        for (int j = 0; j < 16; ++j) sv[j] -= d;
    }
    float p[8], q[8];
#pragma unroll
    for (int j = 0; j < 8; ++j) { p[j] = __builtin_amdgcn_exp2f(sv[j]); q[j] = __builtin_amdgcn_exp2f(sv[8 + j]); }
    st.l += (((p[0] + p[1]) + (p[2] + p[3])) + ((p[4] + p[5]) + (p[6] + p[7]))) + (((q[0] + q[1]) + (q[2] + q[3])) + ((q[4] + q[5]) + (q[6] + q[7])));
    const long pb0 = (long)pack8_fp8(p), pb1 = (long)pack8_fp8(q);
#pragma unroll
    for (int dt = 0; dt < 4; ++dt) st.o[dt] = __builtin_amdgcn_mfma_f32_16x16x32_fp8_fp8(bf.va[dt], pb0, st.o[dt], 0, 0, 0);
#pragma unroll
    for (int dt = 0; dt < 4; ++dt) st.o[dt] = __builtin_amdgcn_mfma_f32_16x16x32_fp8_fp8(bf.va[4 + dt], pb1, st.o[dt], 0, 0, 0);
}
template <class LD, class CP>
DEVI void nsa_streamb(int n, LD ld, CP cp) {
    NsaBlk8 A, B;
    if (n > 0) ld(A, 0);
#pragma unroll 1
    for (int i = 0; i < n; i += 2) {
        if (i + 1 < n) ld(B, i + 1);
        cp(A, i);
        if (i + 1 < n) { if (i + 2 < n) ld(A, i + 2); cp(B, i + 1); }
    }
}
DEVI void nsa_fold8(f32x4 (&comb)[4], NsaSt8& st, float gate) {
    float l = st.l; l = xsum16(l); l = xsum32(l);
    const float w = gate / fmaxf(l, 1e-30f);
#pragma unroll
    for (int dt = 0; dt < 4; ++dt) comb[dt] += st.o[dt] * w;
}
template <class LD, class CP>
DEVI void nsa_stream8(int n, LD ld, CP cp) {
    NsaBuf8 A, B, C, D;
    if (n > 0) ld(A, 0);
    if (n > 1) ld(B, 1);
    if (n > 2) ld(C, 2);
#pragma unroll 1
    for (int i = 0; i < n; i += 4) {
        if (i + 3 < n) ld(D, i + 3);
        cp(A, i);
        if (i + 1 < n) { if (i + 4 < n) ld(A, i + 4); cp(B, i + 1); }
        if (i + 2 < n) { if (i + 5 < n) ld(B, i + 5); cp(C, i + 2); }
        if (i + 3 < n) { if (i + 6 < n) ld(C, i + 6); cp(D, i + 3); }
    }
}
DEVI void nsa_fold(f32x4 (&comb)[4], NsaSt& st, float gate) {
    float l = st.l; l = xsum16(l); l = xsum32(l);
    const float w = gate / fmaxf(l, 1e-30f);
#pragma unroll
    for (int dt = 0; dt < 4; ++dt) comb[dt] += st.o[dt] * w;
}
template <class LD, class CP>
DEVI void nsa_stream(int n, LD ld, CP cp) {
    NsaBuf A, B, C;
    if (n > 0) ld(A, 0);
    if (n > 1) ld(B, 1);
#pragma unroll 1
    for (int i = 0; i < n; i += 3) {
        if (i + 2 < n) ld(C, i + 2);
        cp(A, i);
        if (i + 1 < n) { if (i + 3 < n) ld(A, i + 3); cp(B, i + 1); }
        if (i + 2 < n) { if (i + 4 < n) ld(B, i + 4); cp(C, i + 2); }
    }
}
template <class LD, class CP>
DEVI void nsa_stream2(int n, LD ld, CP cp) {
    NsaBuf A, B;
    if (n > 0) ld(A, 0);
#pragma unroll 1
    for (int i = 0; i < n; i += 2) {
        if (i + 1 < n) ld(B, i + 1);
        cp(A, i);
        if (i + 1 < n) { if (i + 2 < n) ld(A, i + 2); cp(B, i + 1); }
    }
}

#define XB_TMO      128
#define XB_XCNT(j)  (256  + 64 * (j))
#define XB_XSUB(j)  (1280 + 64 * (j))
#define XB_XGEN(j)  (2304 + 64 * (j))
#define XB_TOP      3328
#define XB_TOPGEN   3392
#define XCD_BAR_WORDS 3456
#define XB_SPIN_CAP (1u << 22)
#define LAS __attribute__((address_space(3)))
DEVI unsigned xb_ld(unsigned* p)              { return __hip_atomic_load(p, __ATOMIC_RELAXED, __HIP_MEMORY_SCOPE_AGENT); }
DEVI unsigned xb_add(unsigned* p, unsigned v) { return __hip_atomic_fetch_add(p, v, __ATOMIC_RELAXED, __HIP_MEMORY_SCOPE_AGENT); }
DEVI unsigned xb_xcc_id() { return (unsigned)__builtin_amdgcn_s_getreg((3 << 11) | 20) & 0xFu; }
#define XB_SPIN(cond, bar) do { unsigned _sp = 0; while (cond) { __builtin_amdgcn_s_sleep(1); \
    if ((++_sp & 255u) == 0u) { if (xb_ld(&(bar)[XB_TMO])) break; if (_sp > XB_SPIN_CAP) { atomicAdd(&(bar)[XB_TMO], 1u); break; } } } } while (0)
struct XcdBarrier { unsigned* bar; unsigned x; volatile LAS unsigned* st; };
DEVI XcdBarrier xcd_barrier_post(unsigned* bar, volatile LAS unsigned* st) {
    XcdBarrier b; b.bar = bar; b.x = xb_xcc_id(); b.st = st;
    if (threadIdx.x == 0) (void)xb_add(&bar[XB_XCNT(b.x)], 1u);
    return b;
}
DEVI void xcd_barrier_complete(unsigned* bar, unsigned x, unsigned& nloc, unsigned& nx) {
    const unsigned G = gridDim.x * gridDim.y * gridDim.z;
    unsigned sum, cnt, mine, sp = 0u;
    for (;;) {
        sum = 0u; cnt = 0u; mine = 0u;
#pragma unroll
        for (unsigned j = 0; j < 16; ++j) { const unsigned c = xb_ld(&bar[XB_XCNT(j)]); sum += c; cnt += (c > 0u) ? 1u : 0u; mine = (j == x) ? c : mine; }
        if (sum == G) break;
        __builtin_amdgcn_s_sleep(1);
        if ((++sp & 255u) == 0u) { if (xb_ld(&bar[XB_TMO])) break; if (sp > XB_SPIN_CAP) { atomicAdd(&bar[XB_TMO], 1u); break; } }
    }
    nloc = mine > 0u ? mine : 1u; nx = cnt > 0u ? cnt : 1u;
}
DEVI void xcd_barrier(const XcdBarrier& b) {
    asm volatile("s_waitcnt vmcnt(0)" ::: "memory");
    __syncthreads();
    if (threadIdx.x == 0) {
        unsigned* bar = b.bar;
        __builtin_amdgcn_s_waitcnt(0);
        unsigned nloc = b.st[0], nx = b.st[1];
        if (nloc == 0u) { xcd_barrier_complete(bar, b.x, nloc, nx); b.st[0] = nloc; b.st[1] = nx; }
        const unsigned old = xb_add(&bar[XB_XSUB(b.x)], 1u);
        const unsigned gen = old / nloc;
        if (old + 1u == (gen + 1u) * nloc) {
            __builtin_amdgcn_fence(__ATOMIC_RELEASE, "agent");
            asm volatile("s_waitcnt vmcnt(0)" ::: "memory");
            const unsigned og = xb_add(&bar[XB_TOP], 1u);
            const unsigned tg = og / nx;
            if (og + 1u == (tg + 1u) * nx) xb_add(&bar[XB_TOPGEN], 1u);
            else XB_SPIN(xb_ld(&bar[XB_TOPGEN]) == tg, bar);
            __builtin_amdgcn_fence(__ATOMIC_ACQUIRE, "agent");
            xb_add(&bar[XB_XGEN(b.x)], 1u);
            asm volatile("s_waitcnt vmcnt(0)" ::: "memory");
        } else {
            XB_SPIN(xb_ld(&bar[XB_XGEN(b.x)]) == gen, bar);
            __builtin_amdgcn_fence(__ATOMIC_ACQUIRE, "agent");
            asm volatile("s_waitcnt vmcnt(0)" ::: "memory");
        }
    }
    __syncthreads();
}

DEVI void* ldptr(volatile LAS unsigned long long* tab, int i) { const unsigned long long v = tab[i];
    const unsigned lo = __builtin_amdgcn_readfirstlane((unsigned)v), hi = __builtin_amdgcn_readfirstlane((unsigned)(v >> 32));
    return (void*)(__attribute__((address_space(1))) void*)(((unsigned long long)hi << 32) | lo); }


DEVI unsigned key_pack(float f, int idx) { const unsigned u = __float_as_uint(f); const unsigned o = (u & 0x80000000u) ? ~u : (u | 0x80000000u); return (o & 0xFFFFFF80u) | (unsigned)(127 - idx); }
DEVI unsigned key_pack8(float f, int idx) { const unsigned u = __float_as_uint(f); const unsigned o = (u & 0x80000000u) ? ~u : (u | 0x80000000u); return (o & 0xFFFFFF00u) | (unsigned)(255 - idx); }
DEVI float key_val8(unsigned k) { const unsigned o = k & 0xFFFFFF00u; return __uint_as_float((o & 0x80000000u) ? (o & 0x7FFFFFFFu) : ~o); }
DEVI float key_val(unsigned k) { const unsigned o = k & 0xFFFFFF80u; return __uint_as_float((o & 0x80000000u) ? (o & 0x7FFFFFFFu) : ~o); }
DEVI void ce_desc(unsigned& a, unsigned& b) { const unsigned hi = a > b ? a : b, lo = a > b ? b : a; a = hi; b = lo; }
template <int N> DEVI void bitonic_sort_desc(unsigned (&a)[N]) {
#pragma unroll
    for (int k = 2; k <= N; k <<= 1)
#pragma unroll
        for (int j = k >> 1; j > 0; j >>= 1)
#pragma unroll
            for (int i = 0; i < N; ++i) { const int l = i ^ j; if (l > i) { if ((i & k) == 0) ce_desc(a[i], a[l]); else ce_desc(a[l], a[i]); } }
}
template <int N> DEVI void bitonic_merge_desc(unsigned (&a)[N]) {
#pragma unroll
    for (int j = N >> 1; j > 0; j >>= 1)
#pragma unroll
        for (int i = 0; i < N; ++i) { const int l = i ^ j; if (l > i) ce_desc(a[i], a[l]); }
}


DEVI void pk_half_top16(unsigned (&ka_)[16], const bf16_t* QPp, const LAS bf16_t* Kp, int lane) {
    const int hg = lane >> 4;
    bf16x8 qf[4];
#pragma unroll
    for (int ks = 0; ks < 4; ++ks) qf[ks] = *(const bf16x8*)(QPp + ks * 32);
    float sc[32];
#pragma unroll
    for (int kt = 0; kt < 8; ++kt) {
        f32x4 a = {0.f, 0.f, 0.f, 0.f};
#pragma unroll
        for (int ks = 0; ks < 4; ++ks) a = __builtin_amdgcn_mfma_f32_16x16x32_bf16(*(const LAS bf16x8*)(Kp + (kt * 4 + ks) * 512), qf[ks], a, 0, 0, 0);
        sc[kt * 4 + 0] = a[0]; sc[kt * 4 + 1] = a[1]; sc[kt * 4 + 2] = a[2]; sc[kt * 4 + 3] = a[3];
    }
    unsigned kb_[16];
#pragma unroll
    for (int e = 0; e < 16; ++e) { ka_[e] = key_pack(sc[e], (e >> 2) * 16 + 4 * hg + (e & 3)); kb_[e] = key_pack(sc[16 + e], ((16 + e) >> 2) * 16 + 4 * hg + (e & 3)); }
    bitonic_sort_desc<16>(ka_); bitonic_sort_desc<16>(kb_);
#pragma unroll
    for (int e = 0; e < 16; ++e) ka_[e] = ka_[e] > kb_[15 - e] ? ka_[e] : kb_[15 - e];
    bitonic_merge_desc<16>(ka_);
#pragma unroll
    for (int e = 0; e < 16; ++e) kb_[e] = xchg16(ka_[e], lane);
#pragma unroll
    for (int e = 0; e < 16; ++e) ka_[e] = ka_[e] > kb_[15 - e] ? ka_[e] : kb_[15 - e];
    bitonic_merge_desc<16>(ka_);
#pragma unroll
    for (int e = 0; e < 16; ++e) kb_[e] = xchg32(ka_[e], lane);
#pragma unroll
    for (int e = 0; e < 16; ++e) ka_[e] = ka_[e] > kb_[15 - e] ? ka_[e] : kb_[15 - e];
    bitonic_merge_desc<16>(ka_);
}

__global__ void __launch_bounds__(NTHREADS) fwd_mega(Params pa) {
    extern __shared__ __attribute__((aligned(16))) unsigned char smem[];
    const int bid = blockIdx.x, nb = gridDim.x, tid = threadIdx.x, lane = tid & 63, wave = tid >> 6;
    volatile LAS unsigned long long* ptab = (volatile LAS unsigned long long*)(smem + LDS_BYTES - 16 - 32 * 8);
    {
        volatile LAS unsigned* st0 = (volatile LAS unsigned*)(smem + LDS_BYTES - 16);
        if (tid < 4) st0[tid] = 0u;
        if (tid == 0) {
            ptab[0] = (unsigned long long)pa.x; ptab[1] = (unsigned long long)pa.mem; ptab[2] = (unsigned long long)pa.g_mix; ptab[3] = (unsigned long long)pa.w_in;
            ptab[4] = (unsigned long long)pa.pe_k; ptab[5] = (unsigned long long)pa.w1_k; ptab[6] = (unsigned long long)pa.b1_k; ptab[7] = (unsigned long long)pa.w2_k;
            ptab[8] = (unsigned long long)pa.pe_v; ptab[9] = (unsigned long long)pa.w1_v; ptab[10] = (unsigned long long)pa.b1_v; ptab[11] = (unsigned long long)pa.w2_v;
            ptab[12] = (unsigned long long)pa.ln_g; ptab[13] = (unsigned long long)pa.ln_b; ptab[14] = (unsigned long long)pa.gws; ptab[15] = (unsigned long long)pa.gbs;
            ptab[16] = (unsigned long long)pa.w_nsa_out; ptab[17] = (unsigned long long)pa.w_gmlp_out; ptab[18] = (unsigned long long)pa.w_mix_out; ptab[19] = (unsigned long long)pa.g_xattn;
            ptab[20] = (unsigned long long)pa.g_mem; ptab[21] = (unsigned long long)pa.w_xq; ptab[22] = (unsigned long long)pa.w_xkv; ptab[23] = (unsigned long long)pa.w_xo;
            ptab[24] = (unsigned long long)pa.g_peer; ptab[25] = (unsigned long long)pa.w_peer_q; ptab[26] = (unsigned long long)pa.sub_keys; ptab[27] = (unsigned long long)pa.peer_u;
            ptab[28] = (unsigned long long)pa.peer_v; ptab[29] = (unsigned long long)pa.g_final; ptab[30] = (unsigned long long)pa.out; ptab[31] = (unsigned long long)pa.ws;
        }
        __syncthreads();
    }
    const XcdBarrier xb = xcd_barrier_post((unsigned*)pa.ws, (volatile LAS unsigned*)(smem + LDS_BYTES - 16));
#define LDP(i) ((const float*)ldptr(ptab, i))
#define PHASE_BEGIN \
    const int tid = tid_opaque(), lane = tid & 63, wave = tid >> 6; (void)lane; (void)wave; \
    Params p; p.x = LDP(0); p.mem = LDP(1); p.g_mix = LDP(2); p.w_in = LDP(3); p.pe_k = LDP(4); p.w1_k = LDP(5); p.b1_k = LDP(6); p.w2_k = LDP(7); p.pe_v = LDP(8); p.w1_v = LDP(9); p.b1_v = LDP(10); p.w2_v = LDP(11); \
    p.ln_g = LDP(12); p.ln_b = LDP(13); p.gws = LDP(14); p.gbs = LDP(15); p.w_nsa_out = LDP(16); p.w_gmlp_out = LDP(17); p.w_mix_out = LDP(18); p.g_xattn = LDP(19); p.g_mem = LDP(20); p.w_xq = LDP(21); p.w_xkv = LDP(22); p.w_xo = LDP(23); \
    p.g_peer = LDP(24); p.w_peer_q = LDP(25); p.sub_keys = LDP(26); p.peer_u = LDP(27); p.peer_v = LDP(28); p.g_final = LDP(29); p.out = (float*)ldptr(ptab, 30); p.ws = (unsigned char*)ldptr(ptab, 31); \
    unsigned char* const ws = p.ws; \
    bf16_t* WIN = (bf16_t*)(ws + O_WIN); bf16_t* W1K = (bf16_t*)(ws + O_W1K); bf16_t* W1V = (bf16_t*)(ws + O_W1V); \
    bf16_t* WNSA = (bf16_t*)(ws + O_WNSA); bf16_t* WGM = (bf16_t*)(ws + O_WGM); bf16_t* WMIX = (bf16_t*)(ws + O_WMIX); \
    bf16_t* WXQ = (bf16_t*)(ws + O_WXQ); bf16_t* WXKV = (bf16_t*)(ws + O_WXKV); bf16_t* WXO = (bf16_t*)(ws + O_WXO); bf16_t* WPQ = (bf16_t*)(ws + O_WPQ); \
    float* B1F = (float*)(ws + 14336); \
    bf16_t* HN = (bf16_t*)(ws + O_HN); bf16_t* MN = (bf16_t*)(ws + O_MN); bf16_t* KVX = (bf16_t*)(ws + O_KVX); \
    float* GATES = (float*)(ws + O_GATES); float* HID = (float*)(ws + O_HID); \
    bf16_t* Q = (bf16_t*)(ws + O_Q); bf16_t* KV6 = (bf16_t*)(ws + O_KV6); bf16_t* U = (bf16_t*)(ws + O_U); bf16_t* VG = (bf16_t*)(ws + O_VG); \
    bf16_t* MG = (bf16_t*)(ws + O_MG); bf16_t* ONSA = (bf16_t*)(ws + O_ONSA); bf16_t* OGM = (bf16_t*)(ws + O_OGM); \
    bf16_t* Y = (bf16_t*)(ws + O_Y); bf16_t* QX = (bf16_t*)(ws + O_QX); bf16_t* OX = (bf16_t*)(ws + O_OX); bf16_t* QP = (bf16_t*)(ws + O_QP); \
    float* HS = (float*)(ws + O_HS); int* HI = (int*)(ws + O_HI); \
    bf16_t* VXT = (bf16_t*)(ws + O_VXT); bf16_t* SUBK = (bf16_t*)(ws + O_SUBK); \
    bf16_t* KCB = (bf16_t*)(ws + O_CMP); bf16_t* VCT = KCB + 4 * 512 * 64; \
    unsigned char* PU8 = ws + O_U; unsigned char* PV8 = ws + O_U + 16384ull * 1024; \
    float* PSC = (float*)(ws + O_PSC); float* SS = (float*)(ws + O_SS); (void)SS; \
    float* OUT = p.out; \
    (void)WIN; (void)W1K; (void)W1V; (void)WNSA; (void)WGM; (void)WMIX; (void)WXQ; (void)WXKV; (void)WXO; (void)WPQ; (void)B1F; (void)HN; (void)MN; (void)KVX; (void)GATES; (void)HID; (void)Q; (void)KV6; (void)U; (void)VG; \
    (void)MG; (void)ONSA; (void)OGM; (void)Y; (void)QX; (void)OX; (void)QP; (void)HS; (void)HI; (void)VXT; (void)SUBK; (void)KCB; (void)VCT; (void)PU8; (void)PV8; (void)PSC; (void)OUT;

    { PHASE_BEGIN
    {
        for (int j = bid * 8 + wave; j < 3424; j += nb * 8) {
            int t = j;
            if (t < 1120) { transpose_wave(p.w_in, 4376, WIN, 1024, t, WinMap(), lane); continue; } t -= 1120;
            if (t < 128) { transpose_wave(p.w1_k, 256, W1K, 2048, t, IdMap(), lane); continue; } t -= 128;
            if (t < 128) { transpose_wave(p.w1_v, 256, W1V, 2048, t, IdMap(), lane); continue; } t -= 128;
            if (t < 128) { transpose_wave(p.w_nsa_out, 1024, WNSA, 512, t, IdMap(), lane); continue; } t -= 128;
            if (t < 128) { transpose_wave(p.w_gmlp_out, 1024, WGM, 512, t, IdMap(), lane); continue; } t -= 128;
            if (t < 256) { transpose_wave(p.w_mix_out, 1024, WMIX, 1024, t, IdMap(), lane); continue; } t -= 256;
            if (t < 256) { transpose_wave(p.w_xq, 1024, WXQ, 1024, t, IdMap(), lane, p.g_xattn); continue; } t -= 256;
            if (t < 512) { transpose_wave(p.w_xkv, 2048, WXKV, 1024, t, IdMap(), lane); continue; } t -= 512;
            if (t < 256) { transpose_wave(p.w_xo, 1024, WXO, 1024, t, IdMap(), lane); continue; } t -= 256;
            transpose_wave(p.w_peer_q, 2048, WPQ, 1024, t, IdMap(), lane, p.g_peer);
        }
        for (int r = bid * 8 + wave; r < 16384 + 512; r += nb * 8) {
            if (r < 16384) rmsnorm_row_bf16(p.x + (size_t)r * 1024, p.g_mix, HN + (size_t)r * 1024, lane);
            else rmsnorm_row_bf16(p.mem + (size_t)(r - 16384) * 1024, p.g_mem, MN + (size_t)(r - 16384) * 1024, lane);
        }
        for (int i = bid * NTHREADS + tid; i < 3 * 16384; i += nb * NTHREADS) SS[i] = 0.f;
        for (int i = bid * NTHREADS + tid; i < 16 * 128 * 128; i += nb * NTHREADS) SUBK[(i & ~16383) + pk_koff((i >> 7) & 127, i & 127)] = f2bf(p.sub_keys[i]);
        for (int i = bid * NTHREADS + tid; i < 2 * 2048 * 256 / 4; i += nb * NTHREADS) ((float4*)HID)[i] = make_float4(0.f, 0.f, 0.f, 0.f);
        {
            const int wt = bid * 8 + wave;
            if (wt < 128) {
                const int kv = wt >> 6, ng = (wt >> 4) & 3, kc = wt & 15, n = ng * 64 + lane;
                const float* pe = (kv ? p.pe_v : p.pe_k) + kc * 128; const float* w1 = (kv ? p.w1_v : p.w1_k) + (size_t)kc * 128 * 256 + n;
                float a = 0.f;
#pragma unroll 16
                for (int k = 0; k < 128; ++k) a += pe[k] * w1[(size_t)k * 256];
                unsafeAtomicAdd(B1F + kv * 256 + n, a);
            }
        }
    }
    }
    xcd_barrier(xb);

    { PHASE_BEGIN
    {
        auto epi = [&](int r, int c, const f32x4& v0, const f32x4& v1) {
            if (c < 512) { const float qs_ = 0.125f * 1.4426950408889634f; store_bf16x8(Q + (size_t)r * 512 + c, v0 * qs_, v1 * qs_);
                const float q8[8] = {v0[0] * qs_, v0[1] * qs_, v0[2] * qs_, v0[3] * qs_, v1[0] * qs_, v1[1] * qs_, v1[2] * qs_, v1[3] * qs_};
                *(unsigned long long*)(ws + O_Q8 + (size_t)r * 512 + c) = pack8_fp8(q8); }
            else if (c < 1280) { const int w = (c - 512) >> 7, cc = (c - 512) & 127;
                const int b_ = r >> 13, t_ = r & 8191, g_ = cc >> 6, d_ = cc & 63;
                if (w == 5) {
                    bf16_t* vt = KV6 + (size_t)w * 16384 * 128 + (size_t)(b_ * 2 + g_) * 8192 * 64 + nsa_voff(t_, d_);
                    vt[0] = f2bf(v0[0]); vt[8] = f2bf(v0[1]); vt[16] = f2bf(v0[2]); vt[24] = f2bf(v0[3]); vt[32] = f2bf(v1[0]); vt[40] = f2bf(v1[1]); vt[48] = f2bf(v1[2]); vt[56] = f2bf(v1[3]); }
                else if (w == 4) store_bf16x8(KV6 + (size_t)w * 16384 * 128 + (size_t)(b_ * 2 + g_) * 8192 * 64 + nsa_koff(t_, d_), v0, v1);
                else if (w == 3) {
                    const float f8[8] = {v0[0], v0[1], v0[2], v0[3], v1[0], v1[1], v1[2], v1[3]}; const unsigned long long pk = pack8_fp8(f8);
                    unsigned char* vt = (unsigned char*)(KV6 + (size_t)w * 16384 * 128) + (size_t)(b_ * 2 + g_) * 8192 * 64 + nsa_voff8(t_, d_);
#pragma unroll
                    for (int e = 0; e < 8; ++e) vt[e * 16] = (unsigned char)(pk >> (8 * e)); }
                else if (w == 2) {
                    const float f8[8] = {v0[0], v0[1], v0[2], v0[3], v1[0], v1[1], v1[2], v1[3]};
                    *(unsigned long long*)((unsigned char*)(KV6 + (size_t)w * 16384 * 128) + (size_t)(b_ * 2 + g_) * 8192 * 64 + nsa_koff8(t_, d_)) = pack8_fp8(f8); }
                else store_bf16x8(KV6 + ((size_t)w * 16384 + r) * 128 + cc, v0, v1); }
            else if (c < 2304) { bf16_t* dst = c < 1792 ? U + (size_t)r * 512 + (c - 1280) : VG + (size_t)r * 512 + (c - 1792);
                f32x4 a, b;
#pragma unroll
                for (int e = 0; e < 4; ++e) { a[e] = gelu_f(v0[e]); b[e] = gelu_f(v1[e]); }
                store_bf16x8(dst, a, b); }
            else { f32x4 a, b;
#pragma unroll
                for (int e = 0; e < 4; ++e) { a[e] = sigmoid_f(v0[e]); b[e] = sigmoid_f(v1[e]); }
                store_bf16x8(MG + (size_t)r * 2048 + (c - 2304), a, b); }
        };
        big_gemm(smem, HN, WIN, 16384, 4352, 1024, epi);
        if (bid >= 64) {
            const int tl = bid - 64;
            bf16_t* As = (bf16_t*)smem; bf16_t* Bs = As + 128 * G_LD;
            const int wm = wave >> 2, wn = wave & 3;
            f32x4 acc[4][2];
#pragma unroll
            for (int i = 0; i < 4; ++i)
#pragma unroll
                for (int j = 0; j < 2; ++j) acc[i][j] = (f32x4){0.f, 0.f, 0.f, 0.f};
            if (tl < 128) {
                gemm_tile(acc, RowMajorA{HN, 1024}, tl * 128, WIN + (size_t)4352 * 1024, 1024, 1024, As, Bs);
#pragma unroll
                for (int i = 0; i < 4; ++i)
#pragma unroll
                    for (int j = 0; j < 2; ++j) { const int r = tl * 128 + wm * 64 + i * 16 + (lane & 15), c = wn * 32 + j * 16 + (lane >> 4) * 4;
                        if (c < 24) { float* gp = GATES + (size_t)r * 24 + c; gp[0] = sigmoid_f(acc[i][j][0]); gp[1] = sigmoid_f(acc[i][j][1]); gp[2] = sigmoid_f(acc[i][j][2]); gp[3] = sigmoid_f(acc[i][j][3]); } }
            } else if (tl < 192) {
                const int t2 = tl - 128, mt = t2 >> 4, nt = t2 & 15;
                gemm_tile(acc, RowMajorA{MN, 1024}, mt * 128, WXKV + (size_t)nt * 128 * 1024, 1024, 1024, As, Bs);
#pragma unroll
                for (int i = 0; i < 4; ++i)
#pragma unroll
                    for (int j = 0; j < 2; ++j) { const int r = mt * 128 + wm * 64 + i * 16 + (lane & 15), c = nt * 128 + wn * 32 + j * 16 + (lane >> 4) * 4;
                        const int b_ = r >> 8, m_ = r & 255; const f32x4 v = acc[i][j];
                        if (c < 1024) { const int h_ = c >> 8, d_ = c & 255; store_bf16x4(KVX + (size_t)(b_ * 4 + h_) * 65536 + xat_koff(m_, d_), v[0], v[1], v[2], v[3]); }
                        else { const int hd = c - 1024, h_ = hd >> 8, d_ = hd & 255;
                            bf16_t* vt = VXT + (size_t)(b_ * 4 + h_) * 65536 + xat_voff(m_, d_);
                            vt[0] = f2bf(v[0]); vt[8] = f2bf(v[1]); vt[16] = f2bf(v[2]); vt[24] = f2bf(v[3]); } }
            }
        }
    }
    }
    xcd_barrier(xb);

    { PHASE_BEGIN
    {
        for (int task = bid; task < 256; task += nb) {
            if (task < 128) {
                const int kv = task >> 6, t = task & 63, mt = t >> 2, nt = (t >> 1) & 1, kh = t & 1;
                bf16_t* As = (bf16_t*)smem; bf16_t* Bs = As + 128 * G_LD;
                const int wm = wave >> 2, wn = wave & 3;
                f32x4 acc[4][2];
#pragma unroll
                for (int i = 0; i < 4; ++i)
#pragma unroll
                    for (int j = 0; j < 2; ++j) acc[i][j] = (f32x4){0.f, 0.f, 0.f, 0.f};
                gemm_tile(acc, CmpA{KV6 + (size_t)kv * 16384 * 128, kh * 1024}, mt * 128, (kv ? W1V : W1K) + (size_t)nt * 128 * 2048 + kh * 1024, 2048, 1024, As, Bs);
#pragma unroll
                for (int i = 0; i < 4; ++i)
#pragma unroll
                    for (int j = 0; j < 2; ++j) {
                        const int r = mt * 128 + wm * 64 + i * 16 + (lane & 15), c = nt * 128 + wn * 32 + j * 16 + (lane >> 4) * 4;
                        if (r < 2044) { float* hp = HID + ((size_t)kv * 2048 + r) * 256 + c;
                            unsafeAtomicAdd(hp, acc[i][j][0]); unsafeAtomicAdd(hp + 1, acc[i][j][1]); unsafeAtomicAdd(hp + 2, acc[i][j][2]); unsafeAtomicAdd(hp + 3, acc[i][j][3]); }
                    }
                __syncthreads();
            } else {
                const int ch = task - 128;
                const size_t row0 = (size_t)ch * 128;
                constexpr int VLD = 136;
                bf16_t* VT = (bf16_t*)smem;
                float* st = (float*)(smem + 512 * VLD * 2);
                for (int r = wave * 16; r < wave * 16 + 16; ++r) {
                    float f[8]; load8(VG + (row0 + r) * 512 + lane * 8, f);
                    float s1 = 0.f;
#pragma unroll
                    for (int e = 0; e < 8; ++e) s1 += f[e];
                    s1 = wave_sum(s1); const float mu = s1 * (1.0f / 512.0f);
                    float s2 = 0.f;
#pragma unroll
                    for (int e = 0; e < 8; ++e) s2 += (f[e] - mu) * (f[e] - mu);
                    s2 = wave_sum(s2);
                    if (lane == 0) { st[r * 2] = mu; st[r * 2 + 1] = rsqrtf(s2 * (1.0f / 512.0f) + 1e-6f); }
                }
                __syncthreads();
                {
                    const int s_ = tid & 127; const float mu = st[s_ * 2], rs = st[s_ * 2 + 1];
#pragma unroll 1
                    for (int i = 0; i < 16; ++i) {
                        const int d0 = ((tid >> 7) + 4 * i) * 8;
                        float f[8]; load8(VG + (row0 + s_) * 512 + d0, f);
#pragma unroll
                        for (int e = 0; e < 8; ++e) VT[(d0 + e) * VLD + s_] = f2bf((f[e] - mu) * rs * p.ln_g[d0 + e] + p.ln_b[d0 + e]);
                    }
                }
                __syncthreads();
                {
                    const int tl = wave * 16 + (lane & 15), hq = lane >> 4, kmax = (wave * 16 + 15) >> 5;
                    for (int g = 0; g < 4; ++g) {
                        bf16x8 wf[4];
#pragma unroll
                        for (int ks = 0; ks < 4; ++ks) {
                            if (ks <= kmax) {
                                const float* wp = p.gws + (size_t)g * 16384 + tl * 128 + ks * 32 + 8 * hq;
                                float f[8]; load8(wp, f);
#pragma unroll
                                for (int e = 0; e < 8; ++e) f[e] = (ks * 32 + 8 * hq + e <= tl) ? f[e] : 0.f;
                                wf[ks] = pack8(f);
                            }
                        }
                        const float bsv = p.gbs[g * 128 + tl];
#pragma unroll 2
                        for (int dt = 0; dt < 8; ++dt) {
                            f32x4 a = {0.f, 0.f, 0.f, 0.f};
                            const bf16_t* vp = VT + (g * 128 + dt * 16 + (lane & 15)) * VLD + 8 * hq;
#pragma unroll
                            for (int ks = 0; ks < 4; ++ks) if (ks <= kmax) a = __builtin_amdgcn_mfma_f32_16x16x32_bf16(*(const bf16x8*)(vp + ks * 32), wf[ks], a, 0, 0, 0);
                            const size_t o = (row0 + tl) * 512 + g * 128 + dt * 16 + 4 * hq;
                            const uint2 uw = *(const uint2*)(U + o);
                            store_bf16x4(OGM + o, __uint_as_float(uw.x << 16) * (a[0] + bsv), __uint_as_float(uw.x & 0xffff0000u) * (a[1] + bsv),
                                         __uint_as_float(uw.y << 16) * (a[2] + bsv), __uint_as_float(uw.y & 0xffff0000u) * (a[3] + bsv));
                        }
                    }
                }
                __syncthreads();
            }
        }
    }
    }
    xcd_barrier(xb);

    { PHASE_BEGIN
    {
        __syncthreads();
        float* gl = (float*)smem + wave * 256;
        for (int task = bid * 8 + wave; task < 2 * 2044; task += nb * 8) {
            const int kv = task >= 2044 ? 1 : 0, r = task - kv * 2044;
            const float* hp = HID + ((size_t)kv * 2048 + r) * 256; const float* bb = B1F + kv * 256; const float* b1 = kv ? p.b1_v : p.b1_k;
#pragma unroll
            for (int i = 0; i < 4; ++i) gl[lane + 64 * i] = gelu_f(hp[lane + 64 * i] + bb[lane + 64 * i] + b1[lane + 64 * i]);
            lds_fence();
            const float* w2 = kv ? p.w2_v : p.w2_k;
            float a = 0.f;
#pragma unroll 8
            for (int j = 0; j < 256; ++j) a += gl[j] * w2[j * 64 + lane];
            const int b = r / 1022, rr = r - b * 1022, c = rr >> 1, g = rr & 1, n = lane;
            if (kv == 0) KCB[(size_t)(b * 2 + g) * 512 * 64 + nsa_koff(c, n)] = f2bf(a); else VCT[(size_t)(b * 2 + g) * 512 * 64 + nsa_voff(c, n)] = f2bf(a);
            lds_fence();
        }
        if (bid == 0 && tid < 256) { const int bg = tid >> 6, n = tid & 63; KCB[(size_t)bg * 512 * 64 + nsa_koff(511, n)] = 0; VCT[(size_t)bg * 512 * 64 + nsa_voff(511, n)] = 0; }
    }
    }
    xcd_barrier(xb);

    { PHASE_BEGIN
    {
        float* impL = (float*)smem + wave * 1024;
        int* sidxL = (int*)(impL + 512);
        const bf16_t* KS = KV6 + 2ull * 16384 * 128; const bf16_t* VST = KV6 + 3ull * 16384 * 128;
        const bf16_t* KW = KV6 + 4ull * 16384 * 128; const bf16_t* VWT = KV6 + 5ull * 16384 * 128;
        const int c = lane & 15, h = lane >> 4, tokc = c >> 2, headc = c & 3;
        const int rk = 8 * (c >> 2) + (c & 3), dh = 8 * h;
        for (int task = bid * 8 + wave; task < 8192; task += nb * 8) {
            const int bg = task >> 11, q4 = (bg & 1) ? 2047 - (task & 2047) : (task & 2047), b = bg >> 1, g = bg & 1, t0 = q4 * 4;
            const int tcol = t0 + tokc; const size_t bt0 = (size_t)b * 8192 + t0;
            bf16x8 qf[2];
            { const bf16_t* qp = Q + (bt0 + tokc) * 512 + g * 256 + headc * 64 + dh; qf[0] = *(const bf16x8*)qp; qf[1] = *(const bf16x8*)(qp + 32); }
            const float* gp = GATES + (bt0 + tokc) * 24 + (g * 4 + headc) * 3;
            const float gate0 = gp[0], gate1 = gp[1], gate2 = gp[2];
            f32x4 comb[4];
#pragma unroll
            for (int dt = 0; dt < 4; ++dt) comb[dt] = (f32x4){0.f, 0.f, 0.f, 0.f};
            {
                const int ncvc = tcol >= 31 ? ((tcol - 31) >> 4) + 1 : 0;
                const int ncvmax = (t0 + 3) >= 31 ? ((t0 + 3 - 31) >> 4) + 1 : 0;
                const int nch = (ncvmax + 31) >> 5;
                const bf16_t* Kc = KCB + (size_t)bg * 512 * 64; const bf16_t* Vc = VCT + (size_t)bg * 64 * 512;
                NsaSt st; nsa_init(st);
                {
                    auto ld = [&](NsaBuf& bf, int i) { nsa_load_kf(bf.ka, Kc, i, lane); };
                    auto cp = [&](NsaBuf& bf, int i) { float sv[8]; nsa_scores(bf.ka, qf, sv); nsa_chunk<false>(st, sv, i * 32 + dh, 0, ncvc - 1, bf.va); };
                    nsa_stream2(nch, ld, cp);
                }
                float l = st.l; l = xsum16(l); l = xsum32(l);
                const float inv = 1.0f / fmaxf(l, 1e-30f), mfin = st.m;
                *(float4*)(impL + lane * 8) = make_float4(0.f, 0.f, 0.f, 0.f); *(float4*)(impL + lane * 8 + 4) = make_float4(0.f, 0.f, 0.f, 0.f);
                lds_fence();
                f32x4 oc[4];
#pragma unroll
                for (int dt = 0; dt < 4; ++dt) oc[dt] = (f32x4){0.f, 0.f, 0.f, 0.f};
                float carry = 0.f;
                {
                    auto ld = [&](NsaBuf& bf, int i) { nsa_load_kf(bf.ka, Kc, i, lane); nsa_load_kf(bf.va, Vc, i, lane); };
                    auto cp = [&](NsaBuf& bf, int ch) {
                        float sv[8]; nsa_scores(bf.ka, qf, sv);
                        float p[8];
#pragma unroll
                        for (int j = 0; j < 8; ++j) p[j] = (ch * 32 + dh + j < ncvc) ? __builtin_amdgcn_exp2f(sv[j] - mfin) * inv : 0.f;
                        const float up = __shfl(p[7], (lane + 48) & 63);
                        const float prev7 = (h >= 1) ? up : carry; carry = up;
                        float i0 = p[0] + p[1] + p[2] + 0.5f * p[3] + 0.5f * prev7, i1 = p[4] + p[5] + p[6] + 0.5f * p[7] + 0.5f * p[3];
                        i0 += __shfl_xor(i0, 1); i0 += __shfl_xor(i0, 2); i1 += __shfl_xor(i1, 1); i1 += __shfl_xor(i1, 2);
                        if (headc == 0) { impL[tokc * 128 + 8 * ch + 2 * h] = i0; impL[tokc * 128 + 8 * ch + 2 * h + 1] = i1; }
                        const bf16x8 pb = pack8(p);
#pragma unroll
                        for (int dt = 0; dt < 4; ++dt) oc[dt] = __builtin_amdgcn_mfma_f32_16x16x32_bf16(bf.va[dt], pb, oc[dt], 0, 0, 0);
                    };
                    nsa_stream2(nch, ld, cp);
                }
#pragma unroll
                for (int dt = 0; dt < 4; ++dt) comb[dt] += oc[dt] * gate0;
            }
            lds_fence();
            int nblk;
            {
                const int tok = lane >> 4, sub = lane & 15, cur = t0 >> 6;
                float sc[8];
#pragma unroll
                for (int e = 0; e < 8; ++e) { const int j = sub + 16 * e; const float imp = impL[tok * 128 + j];
                    const bool al = j <= cur, fo = (j == 0) || (j == cur) || (j == cur - 1);
                    sc[e] = (fo && al) ? 1e4f : (al ? imp : -1e30f); }
                unsigned k8[8];
#pragma unroll
                for (int e = 0; e < 8; ++e) k8[e] = key_pack(sc[e], sub + 16 * e);
                bitonic_sort_desc<8>(k8);
                unsigned k16[16];
#pragma unroll
                for (int e = 0; e < 8; ++e) { k16[e] = k8[e]; k16[15 - e] = (unsigned)__shfl_xor((int)k8[e], 1); }
                bitonic_merge_desc<16>(k16);
#pragma unroll
                for (int o = 2; o < 16; o <<= 1) {
                    unsigned pk[16];
#pragma unroll
                    for (int e = 0; e < 16; ++e) pk[e] = (unsigned)__shfl_xor((int)k16[e], o);
#pragma unroll
                    for (int e = 0; e < 16; ++e) k16[e] = k16[e] > pk[15 - e] ? k16[e] : pk[15 - e];
                    bitonic_merge_desc<16>(k16);
                }
                unsigned mk = k16[0];
#pragma unroll
                for (int e = 1; e < 16; ++e) mk = (sub == e) ? k16[e] : mk;
                const float myv = key_val(mk); const int myi = 127 - (int)(mk & 127u);
                const bool forced = myv > 5e3f;
                const bool keep = (myv > -0.5e30f) && !(forced && tok > 0);
                const unsigned long long bal = __ballot(keep);
                const int pos = __popcll(bal & ((1ull << lane) - 1ull));
                lds_fence();
                if (keep) sidxL[pos] = ((forced ? 7 : tok) << 16) | myi;
                nblk = __popcll(bal);
            }
            lds_fence();
            {
                NsaSt8 st; nsa_init8(st);
                const unsigned char* Kp = (const unsigned char*)KS + (size_t)bg * 8192 * 64; const unsigned char* Vp = (const unsigned char*)VST + (size_t)bg * 8192 * 64;
                long qf8[2];
                { const unsigned char* qp = ws + O_Q8 + (bt0 + tokc) * 512 + g * 256 + headc * 64 + dh; qf8[0] = *(const long*)qp; qf8[1] = *(const long*)(qp + 32); }
                const int cur_ = t0 >> 6;
                auto ld = [&](NsaBlk8& bf, int i) { const int e = __builtin_amdgcn_readfirstlane(sidxL[i]); const int chn = (e & 0xffff) * 2; bf.e = e;
                    long t4[4];
                    nsa_load8(t4, Kp, chn, lane); bf.ka[0] = t4[0]; bf.ka[1] = t4[1]; bf.ka[2] = t4[2]; bf.ka[3] = t4[3];
                    nsa_load8(t4, Kp, chn + 1, lane); bf.ka[4] = t4[0]; bf.ka[5] = t4[1]; bf.ka[6] = t4[2]; bf.ka[7] = t4[3];
                    nsa_load8(t4, Vp, chn, lane); bf.va[0] = t4[0]; bf.va[1] = t4[1]; bf.va[2] = t4[2]; bf.va[3] = t4[3];
                    nsa_load8(t4, Vp, chn + 1, lane); bf.va[4] = t4[0]; bf.va[5] = t4[1]; bf.va[6] = t4[2]; bf.va[7] = t4[3]; };
                auto cp = [&](NsaBlk8& bf, int i) { const int e = bf.e; const int blk = e & 0xffff, ow = e >> 16;
                    if (blk == cur_) { const int hi = (ow == 7 || ow == tokc) ? tcol : -1; nsa_block8<2>(st, bf, qf8, blk * 64 + dh, hi, false); }
                    else if (ow == 7) nsa_block8<0>(st, bf, qf8, 0, 0, true);
                    else nsa_block8<1>(st, bf, qf8, 0, 0, ow == tokc); };
                nsa_streamb(nblk, ld, cp);
                nsa_fold8(comb, st, gate1);
            }
            {
                NsaSt st; nsa_init(st);
                const bf16_t* Kp = KW + (size_t)bg * 8192 * 64; const bf16_t* Vp = VWT + (size_t)bg * 8192 * 64;
                const int kbf = (t0 > 511 ? t0 - 511 : 0) & ~31, kbl = (t0 + 3) & ~31;
                const int lo = tcol > 511 ? tcol - 511 : 0;
                auto ld = [&](NsaBuf& bf, int i) { const int kb = kbf + i * 32; nsa_load_kf(bf.ka, Kp, kb >> 5, lane); nsa_load_kf(bf.va, Vp, kb >> 5, lane); };
                auto cp = [&](NsaBuf& bf, int i) { const int kb = kbf + i * 32; float sv[8]; nsa_scores(bf.ka, qf, sv); nsa_chunk<true>(st, sv, kb + dh, lo, tcol, bf.va); };
                nsa_stream2(((kbl - kbf) >> 5) + 1, ld, cp);
                nsa_fold(comb, st, gate2);
            }
            {
                bf16_t* op = ONSA + (bt0 + tokc) * 512 + g * 256 + headc * 64 + 4 * h;
#pragma unroll
                for (int dt = 0; dt < 4; ++dt) store_bf16x4(op + dt * 16, comb[dt][0], comb[dt][1], comb[dt][2], comb[dt][3]);
            }
            lds_fence();
        }
    }
    }
    xcd_barrier(xb);

    { PHASE_BEGIN
    {
        auto unpack8 = [](const u32x4& w, f32x4& a, f32x4& b) { a[0] = __uint_as_float(w.x << 16); a[1] = __uint_as_float(w.x & 0xffff0000u); a[2] = __uint_as_float(w.y << 16); a[3] = __uint_as_float(w.y & 0xffff0000u);
            b[0] = __uint_as_float(w.z << 16); b[1] = __uint_as_float(w.z & 0xffff0000u); b[2] = __uint_as_float(w.w << 16); b[3] = __uint_as_float(w.w & 0xffff0000u); };
        auto e1 = [&](int r, int c, const f32x4& v0, const f32x4& v1) { f32x4 m0, m1; unpack8(*(const u32x4*)(MG + (size_t)r * 2048 + c), m0, m1); store_bf16x8(Y + (size_t)r * 1024 + c, m0 * v0, m1 * v1); };
        big_gemm(smem, ONSA, WNSA, 16384, 1024, 512, e1);
        auto e2 = [&](int r, int c, const f32x4& v0, const f32x4& v1) { f32x4 m0, m1, y0, y1; unpack8(*(const u32x4*)(MG + (size_t)r * 2048 + 1024 + c), m0, m1); unpack8(*(const u32x4*)(Y + (size_t)r * 1024 + c), y0, y1);
            store_bf16x8(Y + (size_t)r * 1024 + c, y0 + m0 * v0, y1 + m1 * v1); };
        big_gemm(smem, OGM, WGM, 16384, 1024, 512, e2);
    }
    }
    xcd_barrier(xb);

    { PHASE_BEGIN
    {
        auto epi = [&](int r, int c, const f32x4& v0, const f32x4& v1) { const float* xp = p.x + (size_t)r * 1024 + c; float* op = OUT + (size_t)r * 1024 + c;
            const f32x4 h0 = *(const f32x4*)xp + v0, h1 = *(const f32x4*)(xp + 4) + v1;
            *(f32x4*)op = h0; *(f32x4*)(op + 4) = h1; store_bf16x8(HN + (size_t)r * 1024 + c, h0, h1);
            float ss = (h0[0] * h0[0] + h0[1] * h0[1]) + (h0[2] * h0[2] + h0[3] * h0[3]) + (h1[0] * h1[0] + h1[1] * h1[1]) + (h1[2] * h1[2] + h1[3] * h1[3]);
            ss = xsum16(ss); ss = xsum32(ss);
            if (lane < 16) unsafeAtomicAdd(SS + r, ss); };
        big_gemm(smem, Y, WMIX, 16384, 1024, 1024, epi);
    }
    }
    xcd_barrier(xb);

    { PHASE_BEGIN
    {
        auto epi = [&](int r, int c, const f32x4& v0, const f32x4& v1) { const float rs = rsqrtf(SS[r] * (1.0f / 1024.0f) + 1e-6f) * 0.0625f; store_bf16x8(QX + (size_t)r * 1024 + c, v0 * rs, v1 * rs); };
        big_gemm(smem, HN, WXQ, 16384, 1024, 1024, epi);
    }
    }
    xcd_barrier(xb);

    { PHASE_BEGIN
    {
        const int c = lane & 15, hg = lane >> 4;
        for (int task = bid; task < 512; task += nb) {
            const int h = task & 3, tg = task >> 2, b = tg >> 6; const size_t bt0 = (size_t)tg * 128 + wave * 16;
            const uint4* Kg = (const uint4*)(KVX + (size_t)(b * 4 + h) * 65536); const uint4* Vg = (const uint4*)(VXT + (size_t)(b * 4 + h) * 65536);
            __syncthreads();
#pragma unroll 4
            for (int i = tid; i < 8192; i += NTHREADS) ((uint4*)smem)[i] = Kg[i];
            bf16x8 qf[8];
#pragma unroll
            for (int ks = 0; ks < 8; ++ks) qf[ks] = *(const bf16x8*)(QX + (bt0 + c) * 1024 + h * 256 + ks * 32 + 8 * hg);
            __syncthreads();
            float sv[8][8];
#pragma unroll
            for (int ch = 0; ch < 8; ++ch) {
                f32x4 s0 = {0.f, 0.f, 0.f, 0.f}, s1 = {0.f, 0.f, 0.f, 0.f};
#pragma unroll
                for (int ks = 0; ks < 8; ++ks) {
                    const bf16x8 a0 = *(const bf16x8*)(smem + ((ch * 16 + ks) * 64 + lane) * 16), a1 = *(const bf16x8*)(smem + ((ch * 16 + 8 + ks) * 64 + lane) * 16);
                    s0 = __builtin_amdgcn_mfma_f32_16x16x32_bf16(a0, qf[ks], s0, 0, 0, 0); s1 = __builtin_amdgcn_mfma_f32_16x16x32_bf16(a1, qf[ks], s1, 0, 0, 0);
                }
                sv[ch][0] = s0[0]; sv[ch][1] = s0[1]; sv[ch][2] = s0[2]; sv[ch][3] = s0[3]; sv[ch][4] = s1[0]; sv[ch][5] = s1[1]; sv[ch][6] = s1[2]; sv[ch][7] = s1[3];
            }
            float m = sv[0][0];
#pragma unroll
            for (int ch = 0; ch < 8; ++ch)
#pragma unroll
                for (int j = 0; j < 8; ++j) m = fmaxf(m, sv[ch][j]);
            m = xmax16(m); m = xmax32(m);
            float l = 0.f; bf16x8 pb[8];
#pragma unroll
            for (int ch = 0; ch < 8; ++ch) { float pp[8];
#pragma unroll
                for (int j = 0; j < 8; ++j) { pp[j] = __expf(sv[ch][j] - m); l += pp[j]; }
                pb[ch] = pack8(pp); }
            l = xsum16(l); l = xsum32(l);
            const float inv = 1.0f / l;
            __syncthreads();
#pragma unroll 4
            for (int i = tid; i < 8192; i += NTHREADS) ((uint4*)smem)[i] = Vg[i];
            __syncthreads();
            bf16_t* op = OX + (bt0 + c) * 1024 + h * 256 + 4 * hg;
#pragma unroll 4
            for (int dt = 0; dt < 16; ++dt) {
                f32x4 o = {0.f, 0.f, 0.f, 0.f};
#pragma unroll
                for (int ch = 0; ch < 8; ++ch) o = __builtin_amdgcn_mfma_f32_16x16x32_bf16(*(const bf16x8*)(smem + ((ch * 16 + dt) * 64 + lane) * 16), pb[ch], o, 0, 0, 0);
                store_bf16x4(op + dt * 16, o[0] * inv, o[1] * inv, o[2] * inv, o[3] * inv);
            }
        }
        __syncthreads();
    }
    }
    xcd_barrier(xb);

    { PHASE_BEGIN
    {
        auto epi = [&](int r, int c, const f32x4& v0, const f32x4& v1) { float* op = OUT + (size_t)r * 1024 + c;
            const f32x4 h0 = *(const f32x4*)op + v0, h1 = *(const f32x4*)(op + 4) + v1;
            *(f32x4*)op = h0; *(f32x4*)(op + 4) = h1; store_bf16x8(HN + (size_t)r * 1024 + c, h0, h1);
            float ss = (h0[0] * h0[0] + h0[1] * h0[1]) + (h0[2] * h0[2] + h0[3] * h0[3]) + (h1[0] * h1[0] + h1[1] * h1[1]) + (h1[2] * h1[2] + h1[3] * h1[3]);
            ss = xsum16(ss); ss = xsum32(ss);
            if (lane < 16) unsafeAtomicAdd(SS + 16384 + r, ss); };
        big_gemm(smem, OX, WXO, 16384, 1024, 1024, epi);
    }
    {
        for (int row = bid * 8 + wave; row < 32768; row += nb * 8) {
            const bool isv = row >= 16384; const int rr = isv ? row - 16384 : row;
            const float* src = (isv ? p.peer_v : p.peer_u) + (size_t)rr * 1024 + lane * 16;
            float f[16];
#pragma unroll
            for (int i = 0; i < 4; ++i) { const float4 a = *(const float4*)(src + 4 * i); f[4 * i] = a.x; f[4 * i + 1] = a.y; f[4 * i + 2] = a.z; f[4 * i + 3] = a.w; }
            float am = 0.f;
#pragma unroll
            for (int i = 0; i < 16; ++i) am = fmaxf(am, fabsf(f[i]));
            am = wave_max(am);
            int ex = 0; (void)frexpf(am, &ex);
            if (am == 0.f) ex = 8;
            const float sc = ldexpf(1.0f, 8 - ex);
            uint4 w; unsigned* wp = (unsigned*)&w;
#pragma unroll
            for (int i = 0; i < 4; ++i) { int t = 0; t = __builtin_amdgcn_cvt_pk_fp8_f32(f[4 * i] * sc, f[4 * i + 1] * sc, t, false); t = __builtin_amdgcn_cvt_pk_fp8_f32(f[4 * i + 2] * sc, f[4 * i + 3] * sc, t, true); wp[i] = (unsigned)t; }
            if (isv) *(uint4*)(PV8 + ((size_t)(lane >> 3) * 16384 + rr) * 128 + (lane & 7) * 16) = w;
            else *(uint4*)(PU8 + (size_t)rr * 1024 + lane * 16) = w;
            if (lane == 0) PSC[row] = ldexpf(1.0f, ex - 8);
        }
    }
    }
    xcd_barrier(xb);

    { PHASE_BEGIN
    {
        auto epi = [&](int r, int c, const f32x4& v0, const f32x4& v1) { const float rs = rsqrtf(SS[16384 + r] * (1.0f / 1024.0f) + 1e-6f); store_bf16x8(QP + (size_t)r * 2048 + c, v0 * rs, v1 * rs); };
        big_gemm(smem, HN, WPQ, 16384, 2048, 1024, epi);
    }
    }
    xcd_barrier(xb);

    { PHASE_BEGIN
    {
        const int c = lane & 15, hg = lane >> 4;
        unsigned char* ixl = smem + 131072 + wave * 512;
        for (int rr_ = 0; rr_ < 4 * ((256 - bid + nb - 1) / nb); ++rr_) {
            const int r = rr_ & 3, tq = bid + (rr_ >> 2) * nb;
            __syncthreads();
            { const uint4* src = (const uint4*)(SUBK + (size_t)(4 * r) * 16384);
#pragma unroll 4
              for (int i = tid; i < 8192; i += NTHREADS) ((uint4*)smem)[i] = src[i]; }
            __syncthreads();
            const int h = 2 * r + (wave & 1), tgrp = tq * 4 + (wave >> 1); const size_t bt0 = (size_t)tgrp * 16;
            const LAS bf16_t* K0 = (const LAS bf16_t*)(smem) + (size_t)((wave & 1) * 2) * 16384 + lane * 8;
            unsigned A_[16], B_[16];
            pk_half_top16(A_, QP + (bt0 + c) * 2048 + (2 * h) * 128 + 8 * hg, K0, lane);
            pk_half_top16(B_, QP + (bt0 + c) * 2048 + (2 * h + 1) * 128 + 8 * hg, K0 + 16384, lane);
#pragma unroll
            for (int e = 0; e < 16; ++e) if ((e >> 2) == hg) { ixl[c * 32 + e] = (unsigned char)(127 - (int)(A_[e] & 127u)); ixl[c * 32 + 16 + e] = (unsigned char)(127 - (int)(B_[e] & 127u)); }
            float bv[16];
#pragma unroll
            for (int j = 0; j < 16; ++j) bv[j] = key_val(B_[j]);
            float ar[4];
#pragma unroll
            for (int r = 0; r < 4; ++r) { const unsigned k0 = A_[4 * r], k1 = A_[4 * r + 1], k2 = A_[4 * r + 2], k3 = A_[4 * r + 3];
                ar[r] = key_val(hg == 0 ? k0 : (hg == 1 ? k1 : (hg == 2 ? k2 : k3))); }
            const int L0 = hg == 0 ? 16 : (hg == 1 ? 8 : (hg == 2 ? 5 : 4)), L1 = hg == 0 ? 3 : 2;
            unsigned C0[16], C1[8];
#pragma unroll
            for (int j = 0; j < 16; ++j) C0[j] = j < L0 ? key_pack8(ar[0] + bv[j], hg * 16 + j) : 0u;
#pragma unroll
            for (int j = 0; j < 3; ++j) C1[j] = j < L1 ? key_pack8(ar[1] + bv[j], (4 + hg) * 16 + j) : 0u;
            C1[3] = key_pack8(ar[2] + bv[0], (8 + hg) * 16); C1[4] = key_pack8(ar[3] + bv[0], (12 + hg) * 16); C1[5] = 0u; C1[6] = 0u; C1[7] = 0u;
            bitonic_sort_desc<8>(C1);
#pragma unroll
            for (int e = 8; e < 16; ++e) C0[e] = C0[e] > C1[15 - e] ? C0[e] : C1[15 - e];
            bitonic_merge_desc<16>(C0);
            {
                unsigned pk[16];
#pragma unroll
                for (int e = 0; e < 16; ++e) pk[e] = xchg16(C0[e], lane);
#pragma unroll
                for (int e = 0; e < 16; ++e) C0[e] = C0[e] > pk[15 - e] ? C0[e] : pk[15 - e];
                bitonic_merge_desc<16>(C0);
#pragma unroll
                for (int e = 0; e < 16; ++e) pk[e] = xchg32(C0[e], lane);
#pragma unroll
                for (int e = 0; e < 16; ++e) C0[e] = C0[e] > pk[15 - e] ? C0[e] : pk[15 - e];
                bitonic_merge_desc<16>(C0);
            }
            const float vmax = key_val8(C0[0]);
            float ex_[16]; float se = 0.f;
#pragma unroll
            for (int e = 0; e < 16; ++e) { ex_[e] = __expf(key_val8(C0[e]) - vmax); se += ex_[e]; }
            const float inv = 1.0f / se;
            lds_fence();
            float g4[4]; int e4_[4];
#pragma unroll
            for (int q = 0; q < 4; ++q) {
                const unsigned kq = hg == 0 ? C0[q] : (hg == 1 ? C0[4 + q] : (hg == 2 ? C0[8 + q] : C0[12 + q]));
                const float eq = hg == 0 ? ex_[q] : (hg == 1 ? ex_[4 + q] : (hg == 2 ? ex_[8 + q] : ex_[12 + q]));
                const int f = 255 - (int)(kq & 255u);
                e4_[q] = (int)ixl[c * 32 + (f >> 4)] * 128 + (int)ixl[c * 32 + 16 + (f & 15)];
                g4[q] = eq * inv;
            }
            float* row = HS + (bt0 + c) * 256 + h * 16 + 4 * hg;
            *(float4*)row = make_float4(g4[0], g4[1], g4[2], g4[3]);
            *(int4*)((int*)row + 128) = make_int4(e4_[0], e4_[1], e4_[2], e4_[3]);
            lds_fence();
        }
    }
    }
    xcd_barrier(xb);

    { PHASE_BEGIN
    {
        int* exl = (int*)smem + wave * 256; float* gtl = (float*)(exl + 128);
        for (int tok = bid * 8 + wave; tok < 16384; tok += nb * 8) {
            { const float* row = HS + (size_t)tok * 256;
              gtl[lane] = row[lane]; gtl[64 + lane] = row[64 + lane]; exl[lane] = ((const int*)row)[128 + lane]; exl[64 + lane] = ((const int*)row)[192 + lane]; }
            lds_fence();
            float xv[16];
            { const float rs2 = rsqrtf(SS[16384 + tok] * (1.0f / 1024.0f) + 1e-6f);
              const float* hp2 = OUT + (size_t)tok * 1024 + lane * 16; const float* gpp = p.g_peer + lane * 16;
#pragma unroll
              for (int i = 0; i < 4; ++i) { const float4 hv = *(const float4*)(hp2 + 4 * i), gv = *(const float4*)(gpp + 4 * i);
                  xv[4 * i] = hv.x * rs2 * gv.x; xv[4 * i + 1] = hv.y * rs2 * gv.y; xv[4 * i + 2] = hv.z * rs2 * gv.z; xv[4 * i + 3] = hv.w * rs2 * gv.w; } }
#pragma unroll 1
            for (int e0 = 0; e0 < 128; e0 += 16) {
                uint4 ur[16];
#pragma unroll
                for (int q = 0; q < 16; ++q) ur[q] = *(const uint4*)(PU8 + (size_t)exl[e0 + q] * 1024 + lane * 16);
                float d[16];
#pragma unroll
                for (int q = 0; q < 16; ++q) {
                    typedef float f32x2_ __attribute__((ext_vector_type(2)));
                    const unsigned wp[4] = {ur[q].x, ur[q].y, ur[q].z, ur[q].w}; f32x2_ a2 = {0.f, 0.f};
#pragma unroll
                    for (int i = 0; i < 4; ++i) { const f32x2_ lo = __builtin_amdgcn_cvt_pk_f32_fp8((int)wp[i], false), hi = __builtin_amdgcn_cvt_pk_f32_fp8((int)wp[i], true);
                        a2 = lo * (f32x2_){xv[4 * i], xv[4 * i + 1]} + a2; a2 = hi * (f32x2_){xv[4 * i + 2], xv[4 * i + 3]} + a2; }
                    d[q] = a2[0] + a2[1];
                }
                {
                    const bool u5 = lane & 32, u4 = lane & 16, u3 = lane & 8, u2 = lane & 4;
                    float e8[8], e4[4], e2[2], e1;
#pragma unroll
                    for (int q = 0; q < 8; ++q) { const float keep = u5 ? d[q + 8] : d[q], send = u5 ? d[q] : d[q + 8]; e8[q] = keep + __uint_as_float(xchg32(__float_as_uint(send), lane)); }
#pragma unroll
                    for (int q = 0; q < 4; ++q) { const float keep = u4 ? e8[q + 4] : e8[q], send = u4 ? e8[q] : e8[q + 4]; e4[q] = keep + __uint_as_float(xchg16(__float_as_uint(send), lane)); }
#pragma unroll
                    for (int q = 0; q < 2; ++q) { const float keep = u3 ? e4[q + 2] : e4[q], send = u3 ? e4[q] : e4[q + 2]; e2[q] = keep + __shfl_xor(send, 8); }
                    { const float keep = u2 ? e2[1] : e2[0], send = u2 ? e2[0] : e2[1]; e1 = keep + __shfl_xor(send, 4); }
                    e1 += __shfl_xor(e1, 2); e1 += __shfl_xor(e1, 1);
                    if ((lane & 3) == 0) { const int q = ((lane >> 5) & 1) * 8 + ((lane >> 4) & 1) * 4 + ((lane >> 3) & 1) * 2 + ((lane >> 2) & 1);
                        const int ex_ = exl[e0 + q];
                        gtl[e0 + q] = gtl[e0 + q] * gelu_f(e1 * PSC[ex_]) * PSC[16384 + ex_]; }
                }
            }
            lds_fence();
            { float* crow = HS + (size_t)tok * 256; crow[lane] = gtl[lane]; crow[64 + lane] = gtl[64 + lane];
              ((int*)crow)[128 + lane] = exl[lane]; ((int*)crow)[192 + lane] = exl[64 + lane]; }
            lds_fence();
        }
    }
    }
    xcd_barrier(xb);

    { PHASE_BEGIN
    {
        unsigned* qh = (unsigned*)ws;
        const unsigned xcc = xb.x;
        float* cl = (float*)(smem + wave * 4096);
        const int part = lane & 7, rg = lane >> 3;
        const bool u5 = lane & 32, u4 = lane & 16, u3 = lane & 8;
        const int j0 = 8 * ((lane >> 5) & 1) + 4 * ((lane >> 4) & 1) + 2 * ((lane >> 3) & 1);
        for (int k = 0; k < 8; ++k) {
            const int sl = (int)((xcc + (unsigned)k) & 7u);
            const unsigned char* Vs = PV8 + (size_t)sl * 16384 * 128;
            int cn = 0; if (lane == 0) cn = (int)__hip_atomic_fetch_add(qh + 16 * sl, 1u, __ATOMIC_RELAXED, __HIP_MEMORY_SCOPE_AGENT);
            cn = __builtin_amdgcn_readfirstlane(cn);
            for (;;) {
                const int c = cn;
                if (c >= 4096) break;
                const int tok0 = c * 4;
                {
                    const unsigned char* hsrc = (const unsigned char*)HS + (size_t)tok0 * 1024 + lane * 16;
                    const uint4 r0 = *(const uint4*)hsrc, r1 = *(const uint4*)(hsrc + 1024), r2 = *(const uint4*)(hsrc + 2048), r3 = *(const uint4*)(hsrc + 3072);
                    { int t_ = 0; if (lane == 0) t_ = (int)__hip_atomic_fetch_add(qh + 16 * sl, 1u, __ATOMIC_RELAXED, __HIP_MEMORY_SCOPE_AGENT); cn = __builtin_amdgcn_readfirstlane(t_); }
                    LAS u32x4* cd = (LAS u32x4*)(smem + wave * 4096 + lane * 16);
                    cd[0] = (u32x4){r0.x, r0.y, r0.z, r0.w}; cd[64] = (u32x4){r1.x, r1.y, r1.z, r1.w}; cd[128] = (u32x4){r2.x, r2.y, r2.z, r2.w}; cd[192] = (u32x4){r3.x, r3.y, r3.z, r3.w};
                }
                lds_fence();
#pragma unroll 2
                for (int tt = 0; tt < 4; ++tt) {
                    const int* el = (const int*)(cl + tt * 256 + 128); const float* cf = cl + tt * 256;
                    uint4 v[16];
#pragma unroll
                    for (int i = 0; i < 16; ++i) v[i] = *(const uint4*)(Vs + (unsigned)(el[8 * i + rg] * 128 + part * 16));
                    float* op_ = OUT + (size_t)(tok0 + tt) * 1024 + sl * 128 + part * 16 + j0;
                    const float2 hr = *(const float2*)op_;
                    float ac[16];
#pragma unroll
                    for (int i = 0; i < 16; ++i) ac[i] = 0.f;
#pragma unroll
                    for (int i = 0; i < 16; ++i) { const float cfi = cf[8 * i + rg];
                        const auto l0 = __builtin_amdgcn_cvt_pk_f32_fp8((int)v[i].x, false), h0_ = __builtin_amdgcn_cvt_pk_f32_fp8((int)v[i].x, true);
                        const auto l1 = __builtin_amdgcn_cvt_pk_f32_fp8((int)v[i].y, false), h1_ = __builtin_amdgcn_cvt_pk_f32_fp8((int)v[i].y, true);
                        const auto l2 = __builtin_amdgcn_cvt_pk_f32_fp8((int)v[i].z, false), h2_ = __builtin_amdgcn_cvt_pk_f32_fp8((int)v[i].z, true);
                        const auto l3 = __builtin_amdgcn_cvt_pk_f32_fp8((int)v[i].w, false), h3_ = __builtin_amdgcn_cvt_pk_f32_fp8((int)v[i].w, true);
                        ac[0] += cfi * l0[0]; ac[1] += cfi * l0[1]; ac[2] += cfi * h0_[0]; ac[3] += cfi * h0_[1];
                        ac[4] += cfi * l1[0]; ac[5] += cfi * l1[1]; ac[6] += cfi * h1_[0]; ac[7] += cfi * h1_[1];
                        ac[8] += cfi * l2[0]; ac[9] += cfi * l2[1]; ac[10] += cfi * h2_[0]; ac[11] += cfi * h2_[1];
                        ac[12] += cfi * l3[0]; ac[13] += cfi * l3[1]; ac[14] += cfi * h3_[0]; ac[15] += cfi * h3_[1]; }
                    float e8[8], e4[4], e2[2];
#pragma unroll
                    for (int q = 0; q < 8; ++q) { const float keep = u5 ? ac[q + 8] : ac[q], send = u5 ? ac[q] : ac[q + 8]; e8[q] = keep + __uint_as_float(xchg32(__float_as_uint(send), lane)); }
#pragma unroll
                    for (int q = 0; q < 4; ++q) { const float keep = u4 ? e8[q + 4] : e8[q], send = u4 ? e8[q] : e8[q + 4]; e4[q] = keep + __uint_as_float(xchg16(__float_as_uint(send), lane)); }
#pragma unroll
                    for (int q = 0; q < 2; ++q) { const float keep = u3 ? e4[q + 2] : e4[q], send = u3 ? e4[q] : e4[q + 2]; e2[q] = keep + __shfl_xor(send, 8); }
                    const float h0 = hr.x + e2[0], h1 = hr.y + e2[1];
                    *(float2*)op_ = make_float2(h0, h1);
                    const float ss = wave_sum(h0 * h0 + h1 * h1);
                    if (lane == 0) unsafeAtomicAdd(SS + 32768 + tok0 + tt, ss);
                }
                lds_fence();
            }
        }
    }
    }
    xcd_barrier(xb);

    { PHASE_BEGIN
    for (int r = bid * 8 + wave; r < 16384; r += nb * 8) {
        float* hp = OUT + (size_t)r * 1024 + lane * 4;
        const float rr = rsqrtf(SS[32768 + r] * (1.0f / 1024.0f) + 1e-6f);
        float4 hv[4];
#pragma unroll
        for (int i = 0; i < 4; ++i) hv[i] = *(const float4*)(hp + i * 256);
#pragma unroll
        for (int i = 0; i < 4; ++i) { const float4 gg = *(const float4*)(p.g_final + lane * 4 + i * 256);
            *(float4*)(hp + i * 256) = make_float4(hv[i].x * rr * gg.x, hv[i].y * rr * gg.y, hv[i].z * rr * gg.z, hv[i].w * rr * gg.w); }
    }
    }
}

extern "C" void kernel_launch(void* const* d_in, const int* in_sizes, int n_in, void* d_out, int out_size, void* d_ws, size_t ws_size, hipStream_t stream) {
    static int grid_blocks = 0;
    if (grid_blocks == 0) {
        int dev = 0, cus = 0, per_cu = 0;
        hipGetDevice(&dev);
        hipDeviceGetAttribute(&cus, hipDeviceAttributeMultiprocessorCount, dev);
        if (hipFuncSetAttribute((const void*)fwd_mega, hipFuncAttributeMaxDynamicSharedMemorySize, LDS_BYTES) != hipSuccess) { fprintf(stderr, "hipFuncSetAttribute failed\n"); }
        if (hipOccupancyMaxActiveBlocksPerMultiprocessor(&per_cu, (const void*)fwd_mega, NTHREADS, LDS_BYTES) != hipSuccess || per_cu < 1) { fprintf(stderr, "occupancy query failed (%d)\n", per_cu); per_cu = 1; }
        (void)hipGetLastError();
        if (per_cu > 1) per_cu = 1;
        grid_blocks = cus * per_cu;
        if (ws_size < O_END) { fprintf(stderr, "workspace too small: %zu < %zu\n", ws_size, (size_t)O_END); grid_blocks = -1; }
    }
    if (grid_blocks < 0) return;
    Params p{};
    const float** pp = (const float**)&p;
    for (int i = 0; i < 30; ++i) pp[i] = (const float*)d_in[i];
    p.out = (float*)d_out; p.ws = (unsigned char*)d_ws;
    if (hipMemsetAsync((char*)d_ws + O_BAR, 0, 16384, stream) != hipSuccess) { fprintf(stderr, "memset of barrier words failed\n"); return; }
    void* args[] = {&p};
    hipError_t e = hipLaunchKernel((const void*)fwd_mega, dim3(grid_blocks), dim3(NTHREADS), args, LDS_BYTES, stream);
    if (e != hipSuccess) fprintf(stderr, "launch failed: %s (grid %d)\n", hipGetErrorString(e), grid_blocks);
}
```

```cpp
#include <hip/hip_runtime.h>
#include <cstdio>
#include <cstdint>

typedef unsigned short bf16_t;
typedef short bf16x8 __attribute__((ext_vector_type(8)));
typedef float f32x4 __attribute__((ext_vector_type(4)));
#define DEVI __device__ __forceinline__

__device__ __forceinline__ int tid_opaque() { int t = threadIdx.x; asm volatile("" : "+v"(t)); return t; }
constexpr int NTHREADS = 512;
constexpr int LDS_BYTES = 140 * 1024;

constexpr size_t O_BAR  = 0;
constexpr size_t O_WIN  = 16384;
constexpr size_t O_W1K  = O_WIN  + 4480ull * 1024 * 2;
constexpr size_t O_W1V  = O_W1K  + 256ull * 2048 * 2;
constexpr size_t O_WNSA = O_W1V  + 256ull * 2048 * 2;
constexpr size_t O_WGM  = O_WNSA + 1024ull * 512 * 2;
constexpr size_t O_WMIX = O_WGM  + 1024ull * 512 * 2;
constexpr size_t O_WXQ  = O_WMIX + 1024ull * 1024 * 2;
constexpr size_t O_WXKV = O_WXQ  + 1024ull * 1024 * 2;
constexpr size_t O_WXO  = O_WXKV + 2048ull * 1024 * 2;
constexpr size_t O_WPQ  = O_WXO  + 1024ull * 1024 * 2;
constexpr size_t O_B1   = O_WPQ  + 2048ull * 1024 * 2;
constexpr size_t O_VXT  = O_B1   + 2048;
constexpr size_t O_SUBK = O_VXT  + 8ull * 256 * 256 * 2;
constexpr size_t O_PSC  = O_SUBK + 16ull * 128 * 128 * 2;
constexpr size_t O_SS   = O_PSC  + 2ull * 16384 * 4;
constexpr size_t O_B1I  = O_SS   + 3ull * 16384 * 8;
constexpr size_t O_HN   = O_B1I  + 512ull * 8;
constexpr size_t O_MN   = O_HN   + 16384ull * 1024 * 2;
constexpr size_t O_KVX  = O_MN   + 512ull * 1024 * 2;
constexpr size_t O_GATES= O_KVX  + 512ull * 2048 * 2;
constexpr size_t O_HID  = O_GATES+ 16384ull * 24 * 4;
constexpr size_t O_CMP  = O_HID  + 2ull * 2048 * 256 * 4;
constexpr size_t O_Q    = O_CMP  + 2ull * 4 * 512 * 64 * 4;
constexpr size_t O_KV6  = O_Q    + 16384ull * 512 * 2;
constexpr size_t O_U    = O_KV6  + 6ull * 16384 * 128 * 2;
constexpr size_t O_VG   = O_U    + 16384ull * 512 * 2;
constexpr size_t O_MG   = O_VG   + 16384ull * 512 * 2;
constexpr size_t O_ONSA = O_MG   + 16384ull * 2048 * 2;
constexpr size_t O_OGM  = O_ONSA + 16384ull * 512 * 2;
constexpr size_t O_Q8   = O_OGM  + 16384ull * 512 * 2;
constexpr size_t O_END  = O_Q8   + 16384ull * 512;
constexpr size_t O_Y    = O_Q;
constexpr size_t O_QX   = O_U;
constexpr size_t O_OX   = O_ONSA;
constexpr size_t O_QP   = O_MG;
constexpr size_t O_HS   = O_Q;
constexpr size_t O_HI   = O_Q + 16384ull * 256 * 4;
constexpr size_t O_EX   = O_U;
static_assert(O_END <= 256ull * 1024 * 1024, "workspace too large");

struct Params {
    const float *x, *mem, *g_mix, *w_in, *pe_k, *w1_k, *b1_k, *w2_k, *pe_v, *w1_v, *b1_v, *w2_v, *ln_g, *ln_b, *gws, *gbs,
        *w_nsa_out, *w_gmlp_out, *w_mix_out, *g_xattn, *g_mem, *w_xq, *w_xkv, *w_xo, *g_peer, *w_peer_q, *sub_keys, *peer_u, *peer_v, *g_final;
    float* out;
    unsigned char* ws;
};

DEVI bf16_t f2bf(float f) { unsigned u = __float_as_uint(f); u += 0x7fffu + ((u >> 16) & 1u); return (bf16_t)(u >> 16); }
DEVI float bf2f(bf16_t h) { return __uint_as_float(((unsigned)h) << 16); }
DEVI float tof(float v) { return v; }
DEVI float tof(bf16_t v) { return bf2f(v); }
DEVI float wave_sum(float v);
DEVI float wave_max(float v);

DEVI float xmax16(float x) { const auto r = __builtin_amdgcn_permlane16_swap(__float_as_uint(x), __float_as_uint(x), false, false); return fmaxf(__uint_as_float(r[0]), __uint_as_float(r[1])); }
DEVI float xmax32(float x) { const auto r = __builtin_amdgcn_permlane32_swap(__float_as_uint(x), __float_as_uint(x), false, false); return fmaxf(__uint_as_float(r[0]), __uint_as_float(r[1])); }
DEVI float xsum16(float x) { const auto r = __builtin_amdgcn_permlane16_swap(__float_as_uint(x), __float_as_uint(x), false, false); return __uint_as_float(r[0]) + __uint_as_float(r[1]); }
DEVI float xsum32(float x) { const auto r = __builtin_amdgcn_permlane32_swap(__float_as_uint(x), __float_as_uint(x), false, false); return __uint_as_float(r[0]) + __uint_as_float(r[1]); }
DEVI unsigned xchg16(unsigned x, int lane) { const auto r = __builtin_amdgcn_permlane16_swap(x, x, false, false); return (lane & 16) ? r[0] : r[1]; }
DEVI unsigned xchg32(unsigned x, int lane) { const auto r = __builtin_amdgcn_permlane32_swap(x, x, false, false); return (lane & 32) ? r[0] : r[1]; }
DEVI float wave_sum(float v) { v = xsum32(v); v = xsum16(v); for (int o = 8; o > 0; o >>= 1) v += __shfl_xor(v, o); return v; }
DEVI float wave_max(float v) { v = xmax32(v); v = xmax16(v); for (int o = 8; o > 0; o >>= 1) v = fmaxf(v, __shfl_xor(v, o)); return v; }
DEVI float gelu_f(float x) { return 0.5f * x * (1.0f + erff(x * 0.70710678118654752f)); }

DEVI float gelu_fast(float v) {
    const float av = fabsf(v), t = __builtin_amdgcn_rcpf(av * 0.2316418882f + 1.0f);
    float q = t * 0.5307027145f + (-0.7265760135f); q = q * t + 0.7107068705f; q = q * t + (-0.142248368f); q = q * t + 0.127414796f; q = q * t;
    const float e = __builtin_amdgcn_exp2f((v * v) * (-0.72134752044f));
    const float m = v * (q * e);
    return v < 0.f ? m : v - m;
}
DEVI float sigmoid_fast(float x) { return __builtin_amdgcn_rcpf(1.0f + __builtin_amdgcn_exp2f(x * -1.4426950408889634f)); }
DEVI float sigmoid_f(float x) { return 1.0f / (1.0f + expf(-x)); }
DEVI void wave_argmax(float& v, int& idx) {
    for (int o = 32; o > 0; o >>= 1) {
        const float ov = __shfl_xor(v, o); const int oi = __shfl_xor(idx, o);
        const bool take = (ov > v) || (ov == v && oi < idx);
        v = take ? ov : v; idx = take ? oi : idx;
    }
}
typedef unsigned u32x4 __attribute__((ext_vector_type(4)));
typedef float f32x2c __attribute__((ext_vector_type(2)));
typedef __bf16 bf16x2c __attribute__((ext_vector_type(2)));
DEVI unsigned cvt_pk_bf16(float lo, float hi) { const f32x2c v = {lo, hi}; return __builtin_bit_cast(unsigned, __builtin_convertvector(v, bf16x2c)); }
DEVI bf16x8 pack8(const float (&p)[8]) { u32x4 u; u.x = cvt_pk_bf16(p[0], p[1]); u.y = cvt_pk_bf16(p[2], p[3]); u.z = cvt_pk_bf16(p[4], p[5]); u.w = cvt_pk_bf16(p[6], p[7]); return __builtin_bit_cast(bf16x8, u); }
DEVI void lds_fence() { asm volatile("s_waitcnt lgkmcnt(0)" ::: "memory"); }
DEVI void load8(const float* p, float (&f)[8]) { const float4 a = *(const float4*)p, b = *(const float4*)(p + 4); f[0]=a.x; f[1]=a.y; f[2]=a.z; f[3]=a.w; f[4]=b.x; f[5]=b.y; f[6]=b.z; f[7]=b.w; }
DEVI void load8(const bf16_t* p, float (&f)[8]) { const uint4 a = *(const uint4*)p;
    f[0] = __uint_as_float(a.x << 16); f[1] = __uint_as_float(a.x & 0xffff0000u); f[2] = __uint_as_float(a.y << 16); f[3] = __uint_as_float(a.y & 0xffff0000u);
    f[4] = __uint_as_float(a.z << 16); f[5] = __uint_as_float(a.z & 0xffff0000u); f[6] = __uint_as_float(a.w << 16); f[7] = __uint_as_float(a.w & 0xffff0000u); }

template <class CMap>
DEVI void transpose_tile(const float* src, int srcN, bf16_t* dst, int K, int tl, CMap cmap, float* tile, const float* kscale = nullptr) {
    const int nkt = K / 64, kt = tl % nkt, nt = tl / nkt, k0 = kt * 64, n0 = nt * 64;
    const int tidq = tid_opaque(), tx = tidq & 63, ty = tidq >> 6;
    const int sc = cmap(n0 + tx);
#pragma unroll
    for (int i = 0; i < 8; ++i) { const int k = k0 + ty + 8 * i; tile[(ty + 8 * i) * 65 + tx] = sc >= 0 ? src[(size_t)k * srcN + sc] * (kscale ? kscale[k] : 1.0f) : 0.f; }
    __syncthreads();
#pragma unroll
    for (int i = 0; i < 8; ++i) { const int n = n0 + ty + 8 * i; dst[(size_t)n * K + k0 + tx] = f2bf(tile[tx * 65 + ty + 8 * i]); }
    __syncthreads();
}

template <class CMap>
DEVI void transpose_wave(const float* src, int srcN, bf16_t* dst, int K, int tl, CMap cmap, int lane, const float* kscale = nullptr) {
    const int nkt = K / 64, kt = tl % nkt, nt = tl / nkt, k0 = kt * 64, n = nt * 64 + lane;
    const int sc = cmap(n);
    const float* sp = src + (size_t)k0 * srcN + (sc >= 0 ? sc : 0);
    float v[64];
#pragma unroll
    for (int i = 0; i < 64; ++i) v[i] = sp[(size_t)i * srcN];
    if (kscale) {
#pragma unroll
        for (int i = 0; i < 64; ++i) v[i] *= kscale[k0 + i];
    }
    if (sc < 0) {
#pragma unroll
        for (int i = 0; i < 64; ++i) v[i] = 0.f;
    }
    bf16_t* dp = dst + (size_t)n * K + k0;
#pragma unroll
    for (int i = 0; i < 64; i += 8) { u32x4 w; w.x = cvt_pk_bf16(v[i], v[i + 1]); w.y = cvt_pk_bf16(v[i + 2], v[i + 3]); w.z = cvt_pk_bf16(v[i + 4], v[i + 5]); w.w = cvt_pk_bf16(v[i + 6], v[i + 7]); *(u32x4*)(dp + i) = w; }
}
struct IdMap { DEVI int operator()(int n) const { return n; } };
struct WinMap { DEVI int operator()(int n) const { return n < 1280 ? n : (n < 4352 ? n + 24 : (n < 4376 ? n - 4352 + 1280 : -1)); } };

DEVI void rmsnorm_row_bf16(const float* xrow, const float* g, bf16_t* dst, int lane) {
    float4 v[4]; float ss = 0.f;
#pragma unroll
    for (int i = 0; i < 4; ++i) { v[i] = ((const float4*)xrow)[lane + 64 * i]; ss += v[i].x * v[i].x + v[i].y * v[i].y + v[i].z * v[i].z + v[i].w * v[i].w; }
    ss = wave_sum(ss);
    const float r = rsqrtf(ss * (1.0f / 1024.0f) + 1e-6f);
#pragma unroll
    for (int i = 0; i < 4; ++i) {
        const float4 gg = ((const float4*)g)[lane + 64 * i];
        uint2 w; w.x = (unsigned)f2bf(v[i].x * r * gg.x) | ((unsigned)f2bf(v[i].y * r * gg.y) << 16); w.y = (unsigned)f2bf(v[i].z * r * gg.z) | ((unsigned)f2bf(v[i].w * r * gg.w) << 16);
        ((uint2*)dst)[lane + 64 * i] = w;
    }
}

constexpr int G_LD = 72;
template <class AF>
DEVI void gemm_tile(f32x4 (&acc)[4][2], AF af, int m0, const bf16_t* Bt, int ldb, int K, bf16_t* As, bf16_t* Bs) {
    const int tid = tid_opaque(), lane = tid & 63, wave = tid >> 6, wm = wave >> 2, wn = wave & 3;
    const int r0 = tid >> 3, kc = (tid & 7) * 8;
    uint4 ra0, ra1, rb0, rb1;
    ra0 = *(const uint4*)af(m0 + r0, kc); ra1 = *(const uint4*)af(m0 + r0 + 64, kc);
    rb0 = *(const uint4*)(Bt + (size_t)r0 * ldb + kc); rb1 = *(const uint4*)(Bt + (size_t)(r0 + 64) * ldb + kc);
    for (int k0 = 0; k0 < K; k0 += 64) {
        __syncthreads();
        *(uint4*)(As + r0 * G_LD + kc) = ra0; *(uint4*)(As + (r0 + 64) * G_LD + kc) = ra1;
        *(uint4*)(Bs + r0 * G_LD + kc) = rb0; *(uint4*)(Bs + (r0 + 64) * G_LD + kc) = rb1;
        __syncthreads();
        if (k0 + 64 < K) {
            const int kn = k0 + 64 + kc;
            ra0 = *(const uint4*)af(m0 + r0, kn); ra1 = *(const uint4*)af(m0 + r0 + 64, kn);
            rb0 = *(const uint4*)(Bt + (size_t)r0 * ldb + kn); rb1 = *(const uint4*)(Bt + (size_t)(r0 + 64) * ldb + kn);
        }
#pragma unroll
        for (int ks = 0; ks < 2; ++ks) {
            bf16x8 af_[4], bf_[2];
#pragma unroll
            for (int i = 0; i < 4; ++i) af_[i] = *(const bf16x8*)(As + (wm * 64 + i * 16 + (lane & 15)) * G_LD + ks * 32 + (lane >> 4) * 8);
#pragma unroll
            for (int j = 0; j < 2; ++j) bf_[j] = *(const bf16x8*)(Bs + (wn * 32 + j * 16 + (lane & 15)) * G_LD + ks * 32 + (lane >> 4) * 8);
#pragma unroll
            for (int i = 0; i < 4; ++i)
#pragma unroll
                for (int j = 0; j < 2; ++j) acc[i][j] = __builtin_amdgcn_mfma_f32_16x16x32_bf16(bf_[j], af_[i], acc[i][j], 0, 0, 0);
        }
    }
}
struct RowMajorA { const bf16_t* A; int lda; DEVI const bf16_t* operator()(int row, int k) const { return A + (size_t)row * lda + k; } };
struct CmpA { const bf16_t* KC; int koff;
    DEVI const bf16_t* operator()(int row, int k_) const { const int k = k_ + koff; const int rr = row < 2044 ? row : 2043; const int b = rr / 1022, rem = rr - b * 1022, c = rem >> 1, g = rem & 1;
        return KC + ((size_t)(b * 8192 + 16 * c + (k >> 6)) * 128 + g * 64 + (k & 63)); } };

template <class AF, class Epi>
DEVI void gemm_run(AF af, const bf16_t* Bt, int K, int MT, int NT, Epi epi, unsigned char* smem, int bid, int nb) {
    bf16_t* As = (bf16_t*)smem; bf16_t* Bs = As + 128 * G_LD;
    const int tidq = tid_opaque(), lane = tidq & 63, wave = tidq >> 6, wm = wave >> 2, wn = wave & 3;
    for (int t = bid; t < MT * NT; t += nb) {
        const int mt = t / NT, nt = t % NT;
        f32x4 acc[4][2];
#pragma unroll
        for (int i = 0; i < 4; ++i)
#pragma unroll
            for (int j = 0; j < 2; ++j) acc[i][j] = (f32x4){0.f, 0.f, 0.f, 0.f};
        gemm_tile(acc, af, mt * 128, Bt + (size_t)nt * 128 * K, K, K, As, Bs);
#pragma unroll
        for (int i = 0; i < 4; ++i)
#pragma unroll
            for (int j = 0; j < 2; ++j) epi(mt * 128 + wm * 64 + i * 16 + (lane & 15), nt * 128 + wn * 32 + j * 16 + (lane >> 4) * 4, acc[i][j]);
    }
}
DEVI void store_bf16x4(bf16_t* p, float a, float b, float c, float d) { uint2 w; w.x = (unsigned)f2bf(a) | ((unsigned)f2bf(b) << 16); w.y = (unsigned)f2bf(c) | ((unsigned)f2bf(d) << 16); *(uint2*)p = w; }

namespace pg8 {
#define PG8_LAS __attribute__((address_space(3)))
typedef unsigned short bf16_t;
typedef short bf16x8 __attribute__((ext_vector_type(8)));
typedef float f32x4 __attribute__((ext_vector_type(4)));
typedef unsigned u32x4 __attribute__((ext_vector_type(4)));
constexpr int BM = 256, BK = 64, HALF = 128, HTB = HALF * BK * 2  , STAGE_BYTES = 8 * HTB, NXCD = 8, WGM = 8;

__host__ __device__ __forceinline__ int lds_byte(int r, int c) { const int st = (r >> 4) * 2 + (c >> 5), rr = r & 15, cc = c & 31, ob = rr * 64 + cc * 2; return st * 1024 + (ob ^ (((ob >> 9) & 1) << 5)); }
__host__ __device__ __forceinline__ void stage_rc(int b, int& R, int& C) { const int st = b / 1024, sb = b % 1024, swz = sb ^ (((sb >> 9) & 1) << 5); R = (st >> 1) * 16 + swz / 64; C = (st & 1) * 32 + (swz % 64) / 2; }
__host__ __device__ __forceinline__ int perm32(int rho) { const int n = rho >> 4, i = rho & 15; return 8 * (i >> 2) + 4 * n + (i & 3); }

struct Unit { int pm, pn; };
struct Gemm { const bf16_t* A; const bf16_t* Bt; int M, N, K; };

struct StaticOrder {
    int nM, nN, nwg, G, c;
    __host__ __device__ void init(int M, int N, int G_, int c_) { nM = M / BM; nN = N / BM; nwg = nM * nN; G = G_; c = c_; }
    __host__ __device__ bool next(int i, Unit& u) const {
        const long L = (long)i * G + c; if (L >= nwg) return false;
        int wgid = (int)L; { const int q = nwg / NXCD, r = nwg % NXCD, xcd = wgid % NXCD, off = wgid / NXCD; wgid = (xcd < r ? xcd * (q + 1) : r * (q + 1) + (xcd - r) * q) + off; }
        const int nig = WGM * nN, gid = wgid / nig, fm = gid * WGM, gsz = (nM - fm) < WGM ? (nM - fm) : WGM;
        u.pm = fm + ((wgid % nig) % gsz); u.pn = (wgid % nig) / gsz; return true;
    }
    __device__ __forceinline__ void a_ready(const Unit&) const {}
    __device__ __forceinline__ void done(const Unit&) const {}
};

template <class Epi, class Sched, bool ALIGN_EPI = false, bool SP2 = false>
__device__ __forceinline__ void gemm_phase(PG8_LAS unsigned char* lds, const Gemm g, const Sched& S, const Epi& E) {
    const int tid = tid_opaque(), wid = __builtin_amdgcn_readfirstlane(tid >> 6), lane = tid & 63, wr = wid >> 2, wc = wid & 3, fr = lane & 15, fq = lane >> 4;
    const int K = g.K, nt = K / BK;
    unsigned voffA[2], voffB[2];
#pragma unroll
    for (int i = 0; i < 2; ++i) { int R, C; stage_rc(tid * 16 + i * 8192, R, C); const int Rb = Epi::PERM ? ((R & ~31) + perm32(R & 31)) : R;
        voffA[i] = (unsigned)(R * K + C) * 2u; voffB[i] = (unsigned)(Rb * K + C) * 2u; }
    const size_t kstep = (size_t)(BK * 2);
    const size_t hstep = (size_t)HALF * K * 2;
    const size_t tstep = 2 * hstep;
    const unsigned ldsw = (unsigned)wid * 1024u;
    const int aoff = lds_byte(wr * 64 + fr, fq * 8), boff = lds_byte(wc * 32 + fr, fq * 8);
#define PG8_SA(b, h) (((b) * 2 + (h)) * HTB)
#define PG8_SB(b, h) ((4 + (b) * 2 + (h)) * HTB)
#define PG8_STAGE(bufoff, gbase, voff) do { _Pragma("unroll") for (int _i = 0; _i < 2; ++_i) \
        __builtin_amdgcn_global_load_lds((const unsigned*)((const char*)(gbase) + (voff)[_i]), (PG8_LAS unsigned*)(lds + (bufoff) + ldsw + _i * 8192), 16, 0, 0); } while (0)
#define PG8_LDA(dst, b, h) do { _Pragma("unroll") for (int m = 0; m < 4; ++m) _Pragma("unroll") for (int k = 0; k < 2; ++k) dst[m][k] = *(const PG8_LAS bf16x8*)(lds + PG8_SA(b, h) + aoff + m * 2048 + k * 1024); } while (0)
#define PG8_LDB(dst, b, h) do { _Pragma("unroll") for (int n = 0; n < 2; ++n) _Pragma("unroll") for (int k = 0; k < 2; ++k) dst[n][k] = *(const PG8_LAS bf16x8*)(lds + PG8_SB(b, h) + boff + n * 2048 + k * 1024); } while (0)
#define PG8_MMA(ai, bj, At, Bt) do { __builtin_amdgcn_s_setprio(1); _Pragma("unroll") for (int m = 0; m < 4; ++m) _Pragma("unroll") for (int n = 0; n < 2; ++n) _Pragma("unroll") for (int k = 0; k < 2; ++k) \
        acc[ai][bj][m][n] = __builtin_amdgcn_mfma_f32_16x16x32_bf16(Bt[n][k], At[m][k], acc[ai][bj][m][n], 0, 0, 0); __builtin_amdgcn_s_setprio(0); } while (0)
#define PG8_WAIT_V(n) asm volatile("s_waitcnt vmcnt(" #n ")" ::: "memory")
#define PG8_WAIT_L(n) asm volatile("s_waitcnt lgkmcnt(" #n ")" ::: "memory")
#define PG8_BAR __builtin_amdgcn_s_barrier()
#define PG8_SCHED __builtin_amdgcn_sched_barrier(0)
    Unit cur, nxt; int ui = 0;
    if (!S.next(0, cur)) return;
    f32x4 acc[2][2][4][2];
#pragma unroll
    for (int a = 0; a < 2; ++a)
#pragma unroll
        for (int b = 0; b < 2; ++b)
#pragma unroll
            for (int m = 0; m < 4; ++m)
#pragma unroll
                for (int n = 0; n < 2; ++n) acc[a][b][m][n] = (f32x4){0.f, 0.f, 0.f, 0.f};
    bf16x8 At[4][2], B0[2][2], B1[2][2];
    const char* cA = (const char*)g.A + (size_t)cur.pm * tstep; const char* cB = (const char*)g.Bt + (size_t)cur.pn * tstep;
    S.a_ready(cur);
    if constexpr (SP2) {
        PG8_STAGE(PG8_SB(0, 0), cB, voffB); PG8_STAGE(PG8_SB(0, 1), cB + hstep, voffB); PG8_STAGE(PG8_SA(0, 0), cA, voffA); PG8_STAGE(PG8_SA(0, 1), cA + hstep, voffA);
        if (wr == 1) PG8_BAR;
        PG8_WAIT_V(2); PG8_BAR;
        PG8_STAGE(PG8_SB(1, 0), cB + kstep, voffB); PG8_STAGE(PG8_SA(1, 0), cA + kstep, voffA); PG8_STAGE(PG8_SB(1, 1), cB + hstep + kstep, voffB);
        PG8_WAIT_V(6); PG8_BAR;
    } else {
        PG8_STAGE(PG8_SB(0, 0), cB, voffB); PG8_STAGE(PG8_SA(0, 0), cA, voffA); PG8_STAGE(PG8_SB(0, 1), cB + hstep, voffB); PG8_STAGE(PG8_SA(0, 1), cA + hstep, voffA);
        if (wr == 1) PG8_BAR;
        PG8_WAIT_V(4); PG8_BAR;
        PG8_STAGE(PG8_SB(1, 0), cB + kstep, voffB); PG8_STAGE(PG8_SA(1, 0), cA + kstep, voffA); PG8_STAGE(PG8_SB(1, 1), cB + hstep + kstep, voffB);
        PG8_WAIT_V(6); PG8_BAR;
    }
    for (;;) {
        const bool has_next = S.next(ui + 1, nxt);
        const char* nA = has_next ? (const char*)g.A + (size_t)nxt.pm * tstep : cA; const char* nB = has_next ? (const char*)g.Bt + (size_t)nxt.pn * tstep : cB;
        for (int t = 0; t < nt; t += 2) {
            const bool last = (t == nt - 2);
            const char* a1 = cA + (size_t)(t + 1) * kstep;
            const char* a2 = last ? nA : cA + (size_t)(t + 2) * kstep; const char* b2 = last ? nB : cB + (size_t)(t + 2) * kstep;
            const char* a3 = a2 + kstep; const char* b3 = b2 + kstep;
            if (last && has_next) S.a_ready(nxt);
            if constexpr (SP2) {
            PG8_LDB(B0, 0, 0); PG8_LDB(B1, 0, 1); PG8_SCHED; PG8_LDA(At, 0, 0); PG8_STAGE(PG8_SA(1, 1), a1 + hstep, voffA);
            PG8_WAIT_V(8); PG8_WAIT_L(0); PG8_BAR; PG8_MMA(0, 0, At, B0); PG8_MMA(0, 1, At, B1); PG8_BAR; PG8_SCHED;
            PG8_LDA(At, 0, 1); PG8_STAGE(PG8_SB(0, 0), b2, voffB); PG8_STAGE(PG8_SB(0, 1), b2 + hstep, voffB); PG8_STAGE(PG8_SA(0, 0), a2, voffA);
            PG8_WAIT_V(8); PG8_WAIT_L(0); PG8_BAR; PG8_MMA(1, 0, At, B0); PG8_MMA(1, 1, At, B1); PG8_BAR; PG8_SCHED;
            PG8_LDB(B0, 1, 0); PG8_LDB(B1, 1, 1); PG8_SCHED; PG8_LDA(At, 1, 0); PG8_STAGE(PG8_SA(0, 1), a2 + hstep, voffA);
            PG8_WAIT_V(8); PG8_WAIT_L(0); PG8_BAR; PG8_MMA(0, 0, At, B0); PG8_MMA(0, 1, At, B1); PG8_BAR; PG8_SCHED;
            PG8_LDA(At, 1, 1); PG8_STAGE(PG8_SB(1, 0), b3, voffB); PG8_STAGE(PG8_SB(1, 1), b3 + hstep, voffB); PG8_STAGE(PG8_SA(1, 0), a3, voffA);
            PG8_WAIT_V(8); PG8_WAIT_L(0); PG8_BAR; PG8_MMA(1, 0, At, B0); PG8_MMA(1, 1, At, B1); PG8_BAR; PG8_SCHED;
            } else {
            PG8_LDB(B0, 0, 0); PG8_SCHED; PG8_LDA(At, 0, 0); PG8_STAGE(PG8_SA(1, 1), a1 + hstep, voffA);
            PG8_WAIT_L(8); PG8_BAR; PG8_WAIT_L(0); PG8_MMA(0, 0, At, B0); PG8_BAR; PG8_SCHED;
            PG8_LDB(B1, 0, 1); PG8_STAGE(PG8_SB(0, 0), b2, voffB);
            PG8_BAR; PG8_WAIT_L(0); PG8_MMA(0, 1, At, B1); PG8_BAR;
            PG8_LDA(At, 0, 1); PG8_STAGE(PG8_SA(0, 0), a2, voffA);
            PG8_BAR; PG8_WAIT_L(0); PG8_MMA(1, 0, At, B0); PG8_BAR; PG8_SCHED;
            PG8_STAGE(PG8_SB(0, 1), b2 + hstep, voffB);
            PG8_WAIT_V(6); PG8_BAR; PG8_MMA(1, 1, At, B1); PG8_BAR;
            PG8_LDB(B0, 1, 0); PG8_SCHED; PG8_LDA(At, 1, 0); PG8_STAGE(PG8_SA(0, 1), a2 + hstep, voffA);
            PG8_WAIT_L(8); PG8_BAR; PG8_WAIT_L(0); PG8_MMA(0, 0, At, B0); PG8_BAR; PG8_SCHED;
            PG8_LDB(B1, 1, 1); PG8_STAGE(PG8_SB(1, 0), b3, voffB);
            PG8_BAR; PG8_WAIT_L(0); PG8_MMA(0, 1, At, B1); PG8_BAR;
            PG8_LDA(At, 1, 1); PG8_STAGE(PG8_SA(1, 0), a3, voffA);
            PG8_BAR; PG8_WAIT_L(0); PG8_MMA(1, 0, At, B0); PG8_BAR; PG8_SCHED;
            PG8_STAGE(PG8_SB(1, 1), b3 + hstep, voffB);
            PG8_WAIT_V(6); PG8_BAR; PG8_MMA(1, 1, At, B1); PG8_BAR;
            }
        }
        if constexpr (ALIGN_EPI) { if (wr == 0) PG8_BAR; }
        if constexpr (!Epi::AFTER_DRAIN) { E(acc, cur, wr, wc, fr, fq); S.done(cur); }
        if (!has_next) break;
#pragma unroll
        for (int a = 0; a < 2; ++a)
#pragma unroll
            for (int b = 0; b < 2; ++b)
#pragma unroll
                for (int m = 0; m < 4; ++m)
#pragma unroll
                    for (int n = 0; n < 2; ++n) acc[a][b][m][n] = (f32x4){0.f, 0.f, 0.f, 0.f};
        cur = nxt; cA = nA; cB = nB; ++ui;
        if constexpr (ALIGN_EPI) { if (wr == 1) PG8_BAR; }
    }
    PG8_WAIT_V(0);
    if constexpr (!ALIGN_EPI) { if (wr == 0) PG8_BAR; }
    PG8_BAR;
    if constexpr (Epi::AFTER_DRAIN) { E.fused(acc, cur, wr, wc, fr, fq, lds, wid, lane); S.done(cur); }
#undef PG8_SA
#undef PG8_SB
#undef PG8_STAGE
#undef PG8_LDA
#undef PG8_LDB
#undef PG8_MMA
#undef PG8_WAIT_V
#undef PG8_WAIT_L
#undef PG8_BAR
#undef PG8_SCHED
}
}

template <class F> struct EpiFn {
    static constexpr bool PERM = true, AFTER_DRAIN = false;
    F f;
    DEVI void operator()(const f32x4 (&acc)[2][2][4][2], const pg8::Unit& u, int wr, int wc, int fr, int fq) const {
#pragma unroll
        for (int ai = 0; ai < 2; ++ai)
#pragma unroll
            for (int m = 0; m < 4; ++m) {
                const int row = u.pm * 256 + ai * 128 + wr * 64 + m * 16 + fr;
#pragma unroll
                for (int bj = 0; bj < 2; ++bj) { f(row, u.pn * 256 + bj * 128 + wc * 32 + 8 * fq, acc[ai][bj][m][0], acc[ai][bj][m][1]); __builtin_amdgcn_sched_barrier(0); }
            }
    }
};
template <class F> DEVI EpiFn<F> make_epi(F f) { return EpiFn<F>{f}; }
template <class F>
DEVI void big_gemm(unsigned char* smem, const bf16_t* A, const bf16_t* Bt, int M, int N, int K, F f) {
    pg8::StaticOrder S; S.init(M, N, (int)gridDim.x, (int)blockIdx.x);
    const pg8::Gemm g{A, Bt, M, N, K};
    const auto E = make_epi(f);
    pg8::gemm_phase<EpiFn<F>, pg8::StaticOrder, true, true>((PG8_LAS unsigned char*)smem, g, S, E);
}
DEVI void store_bf16x8(bf16_t* p, const f32x4& a, const f32x4& b) { u32x4 w; w.x = cvt_pk_bf16(a[0], a[1]); w.y = cvt_pk_bf16(a[2], a[3]); w.z = cvt_pk_bf16(b[0], b[1]); w.w = cvt_pk_bf16(b[2], b[3]); *(u32x4*)p = w; }

template <int DH, int R, int NCH, bool PSUM, typename KT, class RowF>
DEVI void attend(const float* qs, float* pl, float* psum, const KT* Kb, const KT* Vb, size_t stride, RowF rowf, float (&o)[R][DH / 64], int lane) {
    float m[R], l[R];
#pragma unroll
    for (int r = 0; r < R; ++r) { m[r] = -1e30f; l[r] = 0.f; }
#pragma unroll 1
    for (int i = 0; i < NCH; ++i) {
        bool valid; const long row = rowf(i, lane, valid);
        if (__ballot(valid) == 0ull) continue;
        const KT* kp = Kb + (size_t)row * stride;
        float a[R];
#pragma unroll
        for (int r = 0; r < R; ++r) a[r] = 0.f;
#pragma unroll 2
        for (int d0 = 0; d0 < DH; d0 += 8) {
            float kf[8]; load8(kp + d0, kf);
#pragma unroll
            for (int r = 0; r < R; ++r) {
                const float4 q0 = *(const float4*)(qs + r * DH + d0), q1 = *(const float4*)(qs + r * DH + d0 + 4);
                a[r] += kf[0] * q0.x + kf[1] * q0.y + kf[2] * q0.z + kf[3] * q0.w + kf[4] * q1.x + kf[5] * q1.y + kf[6] * q1.z + kf[7] * q1.w;
            }
        }
#pragma unroll
        for (int r = 0; r < R; ++r) {
            const float sv = valid ? a[r] : -1e30f;
            const float mn = fmaxf(m[r], wave_max(sv));
            const float pe = valid ? expf(sv - mn) : 0.f;
            l[r] = l[r] * expf(m[r] - mn) + wave_sum(pe);
            m[r] = mn;
        }
    }
    float inv[R];
#pragma unroll
    for (int r = 0; r < R; ++r) inv[r] = 1.0f / fmaxf(l[r], 1e-30f);
#pragma unroll 1
    for (int i = 0; i < NCH; ++i) {
        bool valid; const long row = rowf(i, lane, valid);
        const bool any = __ballot(valid) != 0ull;
        float a[R];
#pragma unroll
        for (int r = 0; r < R; ++r) a[r] = 0.f;
        if (any) {
            const KT* kp = Kb + (size_t)row * stride;
#pragma unroll 2
            for (int d0 = 0; d0 < DH; d0 += 8) {
                float kf[8]; load8(kp + d0, kf);
#pragma unroll
                for (int r = 0; r < R; ++r) {
                    const float4 q0 = *(const float4*)(qs + r * DH + d0), q1 = *(const float4*)(qs + r * DH + d0 + 4);
                    a[r] += kf[0] * q0.x + kf[1] * q0.y + kf[2] * q0.z + kf[3] * q0.w + kf[4] * q1.x + kf[5] * q1.y + kf[6] * q1.z + kf[7] * q1.w;
                }
            }
        }
        float ps = 0.f;
#pragma unroll
        for (int r = 0; r < R; ++r) { const float pv = valid ? expf(a[r] - m[r]) * inv[r] : 0.f; pl[r * 64 + lane] = pv; ps += pv; }
        if (PSUM) psum[i * 64 + lane] = ps;
        lds_fence();
        if (any) {
#pragma unroll 2
            for (int key = 0; key < 64; ++key) {
                bool dummy; const long vrow = rowf(i, key, dummy);
                const KT* vp = Vb + (size_t)vrow * stride;
                float pr[R];
#pragma unroll
                for (int r = 0; r < R; ++r) pr[r] = pl[r * 64 + key];
#pragma unroll
                for (int j = 0; j < DH / 64; ++j) { const float v = tof(vp[lane + 64 * j]);
#pragma unroll
                    for (int r = 0; r < R; ++r) o[r][j] += pr[r] * v; }
            }
        }
        lds_fence();
    }
}


DEVI int nsa_koff(int t, int d) { return ((((t >> 5) * 4 + (((t >> 2) & 1) * 2 + (d >> 5))) * 64) + ((((t & 31) >> 3) << 2) | (t & 3)) + 16 * ((d >> 3) & 3)) * 8 + (d & 7); }
DEVI int nsa_voff(int t, int d) { return ((((t >> 5) * 4 + (d >> 4)) * 64) + (d & 15) + 16 * ((t & 31) >> 3)) * 8 + (t & 7); }
DEVI int xat_koff(int m, int d) { return ((((m >> 5) * 16 + ((m >> 2) & 1) * 8 + (d >> 5)) * 64) + ((((m & 31) >> 3) << 2) | (m & 3)) + 16 * ((d >> 3) & 3)) * 8 + (d & 7); }
DEVI int xat_voff(int m, int d) { return ((((m >> 5) * 16 + (d >> 4)) * 64) + (d & 15) + 16 * ((m & 31) >> 3)) * 8 + (m & 7); }
DEVI int pk_koff(int k, int d) { return ((((k >> 4) * 4 + (d >> 5)) * 64) + (k & 15) + 16 * ((d >> 3) & 3)) * 8 + (d & 7); }
DEVI int nsa_koff8(int t, int d) { return ((((t >> 5) * 2 + ((t >> 2) & 1)) * 64) + ((((t & 31) >> 3) << 2) | (t & 3)) + 16 * ((d >> 3) & 3)) * 16 + (d >> 5) * 8 + (d & 7); }
DEVI int nsa_voff8(int t, int d) { return ((((t >> 5) * 2 + (d >> 5)) * 64) + (d & 15) + 16 * ((t & 31) >> 3)) * 16 + ((d >> 4) & 1) * 8 + (t & 7); }
DEVI void nsa_load_kf(bf16x8 (&ka)[4], const bf16_t* Kp, int ch, int lane) {
#pragma unroll
    for (int f = 0; f < 4; ++f) ka[f] = *(const bf16x8*)(Kp + ((ch * 4 + f) * 64 + lane) * 8);
}
DEVI void nsa_load_k(bf16x8 (&ka)[4], const bf16_t* Kp, int stride, int kb, int rk, int dh) {
    const int o0 = (kb + rk) * stride + dh, o1 = o0 + 4 * stride;
    ka[0] = *(const bf16x8*)(Kp + o0); ka[1] = *(const bf16x8*)(Kp + o0 + 32); ka[2] = *(const bf16x8*)(Kp + o1); ka[3] = *(const bf16x8*)(Kp + o1 + 32);
}
DEVI void nsa_load_v(bf16x8 (&va)[4], const bf16_t* Vp, int vstride, int kb8, int lr) {
    const int o = lr * vstride + kb8;
#pragma unroll
    for (int dt = 0; dt < 4; ++dt) va[dt] = *(const bf16x8*)(Vp + o + dt * 16 * vstride);
}
DEVI void nsa_load_vb(bf16x8 (&va)[4], const bf16_t* Vp, int kb8, int lr) {
    const int o = ((kb8 >> 6) * 64 + lr) * 64 + (kb8 & 63);
#pragma unroll
    for (int dt = 0; dt < 4; ++dt) va[dt] = *(const bf16x8*)(Vp + o + dt * 16 * 64);
}
DEVI void nsa_scores(const bf16x8 (&ka)[4], const bf16x8 (&qf)[2], float (&sv)[8]) {
    f32x4 s0 = {0.f, 0.f, 0.f, 0.f}, s1 = {0.f, 0.f, 0.f, 0.f};
    s0 = __builtin_amdgcn_mfma_f32_16x16x32_bf16(ka[0], qf[0], s0, 0, 0, 0); s1 = __builtin_amdgcn_mfma_f32_16x16x32_bf16(ka[2], qf[0], s1, 0, 0, 0);
    s0 = __builtin_amdgcn_mfma_f32_16x16x32_bf16(ka[1], qf[1], s0, 0, 0, 0); s1 = __builtin_amdgcn_mfma_f32_16x16x32_bf16(ka[3], qf[1], s1, 0, 0, 0);
    sv[0] = s0[0]; sv[1] = s0[1]; sv[2] = s0[2]; sv[3] = s0[3]; sv[4] = s1[0]; sv[5] = s1[1]; sv[6] = s1[2]; sv[7] = s1[3];
}
DEVI unsigned long long pack8_fp8(const float (&p)[8]) {
    int lo = 0, hi = 0;
    lo = __builtin_amdgcn_cvt_pk_fp8_f32(p[0], p[1], lo, false); lo = __builtin_amdgcn_cvt_pk_fp8_f32(p[2], p[3], lo, true);
    hi = __builtin_amdgcn_cvt_pk_fp8_f32(p[4], p[5], hi, false); hi = __builtin_amdgcn_cvt_pk_fp8_f32(p[6], p[7], hi, true);
    return ((unsigned long long)(unsigned)hi << 32) | (unsigned)lo;
}
struct NsaSt { float m, l; f32x4 o[4]; };
struct NsaBuf8 { long ka[4]; long va[4]; int e; };
DEVI void nsa_load8(long (&f)[4], const unsigned char* P, int ch, int lane) {
#pragma unroll
    for (int i = 0; i < 2; ++i) { const uint4 w = *(const uint4*)(P + ((ch * 2 + i) * 64 + lane) * 16);
        f[2 * i] = (long)(((unsigned long long)w.y << 32) | w.x); f[2 * i + 1] = (long)(((unsigned long long)w.w << 32) | w.z); }
}
struct NsaSt8 { float m, l; bool set; f32x4 negm; f32x4 o[4]; };
DEVI void nsa_init8(NsaSt8& st) { st.m = 0.f; st.l = 0.f; st.set = false; st.negm = (f32x4){7.f, 7.f, 7.f, 7.f};
#pragma unroll
    for (int dt = 0; dt < 4; ++dt) st.o[dt] = (f32x4){0.f, 0.f, 0.f, 0.f}; }

struct NsaBuf { bf16x8 ka[4]; bf16x8 va[4]; };
DEVI void nsa_init(NsaSt& st) { st.m = -1e20f; st.l = 0.f;
#pragma unroll
    for (int dt = 0; dt < 4; ++dt) st.o[dt] = (f32x4){0.f, 0.f, 0.f, 0.f}; }
template <bool PV>
DEVI void nsa_chunk(NsaSt& st, float (&sv)[8], int pos0, int lo, int hi, const bf16x8 (&va)[4]) {
    float cm = -1e30f;
#pragma unroll
    for (int j = 0; j < 8; ++j) { const bool ok = (pos0 + j >= lo) && (pos0 + j <= hi); sv[j] = ok ? sv[j] : -1e30f; cm = fmaxf(cm, sv[j]); }
    cm = xmax16(cm); cm = xmax32(cm);
    if (__any(cm > st.m)) {
        const float mn = fmaxf(st.m, cm), sc = __builtin_amdgcn_exp2f(st.m - mn);
        st.l *= sc;
        if (PV) {
#pragma unroll
            for (int dt = 0; dt < 4; ++dt) st.o[dt] *= sc;
        }
        st.m = mn;
    }
    float p[8]; float ps = 0.f;
#pragma unroll
    for (int j = 0; j < 8; ++j) { p[j] = __builtin_amdgcn_exp2f(sv[j] - st.m); ps += p[j]; }
    st.l += ps;
    if (PV) {
        const bf16x8 pb = pack8(p);
#pragma unroll
        for (int dt = 0; dt < 4; ++dt) st.o[dt] = __builtin_amdgcn_mfma_f32_16x16x32_bf16(va[dt], pb, st.o[dt], 0, 0, 0);
    }
}
template <int MASK>
DEVI void nsa_chunk8(NsaSt8& st, const long (&ka)[4], const long (&qf)[2], const long (&va)[4], int pos0, int hi, bool own) {
    f32x4 s0 = st.negm, s1 = st.negm;
    s0 = __builtin_amdgcn_mfma_f32_16x16x32_fp8_fp8(ka[0], qf[0], s0, 0, 0, 0); s1 = __builtin_amdgcn_mfma_f32_16x16x32_fp8_fp8(ka[2], qf[0], s1, 0, 0, 0);
    s0 = __builtin_amdgcn_mfma_f32_16x16x32_fp8_fp8(ka[1], qf[1], s0, 0, 0, 0); s1 = __builtin_amdgcn_mfma_f32_16x16x32_fp8_fp8(ka[3], qf[1], s1, 0, 0, 0);
    float sv[8] = {s0[0], s0[1], s0[2], s0[3], s1[0], s1[1], s1[2], s1[3]};
    if (MASK == 1) {
#pragma unroll
        for (int j = 0; j < 8; ++j) sv[j] = own ? sv[j] : -1e30f;
    } else if (MASK == 2) {
#pragma unroll
        for (int j = 0; j < 8; ++j) sv[j] = (pos0 + j <= hi) ? sv[j] : -1e30f;
    }
    float cm = fmaxf(fmaxf(fmaxf(sv[0], sv[1]), fmaxf(sv[2], sv[3])), fmaxf(fmaxf(sv[4], sv[5]), fmaxf(sv[6], sv[7])));
    cm = xmax16(cm); cm = xmax32(cm);
    const bool need = (cm > 7.f) || (!st.set && cm > -1e29f);
    if (__any(need)) {
        const float d = need ? cm - 7.f : 0.f;
        const float sc = need ? (st.set ? __builtin_amdgcn_exp2f(-d) : 0.f) : 1.f;
        st.m += d; st.set = st.set || need;
        const float nm = 7.f - st.m; st.negm = (f32x4){nm, nm, nm, nm};
        st.l *= sc;
#pragma unroll
        for (int dt = 0; dt < 4; ++dt) st.o[dt] *= sc;
#pragma unroll
        for (int j = 0; j < 8; ++j) sv[j] -= d;
    }
    float p[8];
#pragma unroll
    for (int j = 0; j < 8; ++j) p[j] = __builtin_amdgcn_exp2f(sv[j]);
    st.l += ((p[0] + p[1]) + (p[2] + p[3])) + ((p[4] + p[5]) + (p[6] + p[7]));
    const long pb = (long)pack8_fp8(p);
#pragma unroll
    for (int dt = 0; dt < 4; ++dt) st.o[dt] = __builtin_amdgcn_mfma_f32_16x16x32_fp8_fp8(va[dt], pb, st.o[dt], 0, 0, 0);
}
struct NsaBlk8 { long ka[8]; long va[8]; int e; };
template <int MASK>
DEVI void nsa_block8(NsaSt8& st, const NsaBlk8& bf, const long (&qf)[2], int pos0, int hi, bool own) {
    f32x4 s0 = st.negm, s1 = st.negm, s2 = st.negm, s3 = st.negm;
    s0 = __builtin_amdgcn_mfma_f32_16x16x32_fp8_fp8(bf.ka[0], qf[0], s0, 0, 0, 0); s1 = __builtin_amdgcn_mfma_f32_16x16x32_fp8_fp8(bf.ka[2], qf[0], s1, 0, 0, 0);
    s2 = __builtin_amdgcn_mfma_f32_16x16x32_fp8_fp8(bf.ka[4], qf[0], s2, 0, 0, 0); s3 = __builtin_amdgcn_mfma_f32_16x16x32_fp8_fp8(bf.ka[6], qf[0], s3, 0, 0, 0);
    s0 = __builtin_amdgcn_mfma_f32_16x16x32_fp8_fp8(bf.ka[1], qf[1], s0, 0, 0, 0); s1 = __builtin_amdgcn_mfma_f32_16x16x32_fp8_fp8(bf.ka[3], qf[1], s1, 0, 0, 0);
    s2 = __builtin_amdgcn_mfma_f32_16x16x32_fp8_fp8(bf.ka[5], qf[1], s2, 0, 0, 0); s3 = __builtin_amdgcn_mfma_f32_16x16x32_fp8_fp8(bf.ka[7], qf[1], s3, 0, 0, 0);
    float sv[16] = {s0[0], s0[1], s0[2], s0[3], s1[0], s1[1], s1[2], s1[3], s2[0], s2[1], s2[2], s2[3], s3[0], s3[1], s3[2], s3[3]};
    if (MASK == 1) {
#pragma unroll
        for (int j = 0; j < 16; ++j) sv[j] = own ? sv[j] : -1e30f;
    } else if (MASK == 2) {
#pragma unroll
        for (int j = 0; j < 16; ++j) sv[j] = (pos0 + (j & 7) + 32 * (j >> 3) <= hi) ? sv[j] : -1e30f;
    }
    float cm = fmaxf(fmaxf(fmaxf(fmaxf(sv[0], sv[1]), fmaxf(sv[2], sv[3])), fmaxf(fmaxf(sv[4], sv[5]), fmaxf(sv[6], sv[7]))),
                     fmaxf(fmaxf(fmaxf(sv[8], sv[9]), fmaxf(sv[10], sv[11])), fmaxf(fmaxf(sv[12], sv[13]), fmaxf(sv[14], sv[15]))));
    cm = xmax16(cm); cm = xmax32(cm);
    const bool need = (cm > 7.f) || (!st.set && cm > -1e29f);
    if (__any(need)) {
        const float d = need ? cm - 7.f : 0.f;
        const float sc = need ? (st.set ? __builtin_amdgcn_exp2f(-d) : 0.f) : 1.f;
        st.m += d; st.set = st.set || need;
        const float nm = 7.f - st.m; st.negm = (f32x4){nm, nm, nm, nm};
        st.l *= sc;
#pragma unroll
        for (int dt = 0; dt < 4; ++dt) st.o[dt] *= sc;
#pragma unroll
        for (int j = 0; j < 16; ++j) sv[j] -= d;
    }
    float p[8], q[8];
#pragma unroll
    for (int j = 0; j < 8; ++j) { p[j] = __builtin_amdgcn_exp2f(sv[j]); q[j] = __builtin_amdgcn_exp2f(sv[8 + j]); }
    st.l += (((p[0] + p[1]) + (p[2] + p[3])) + ((p[4] + p[5]) + (p[6] + p[7]))) + (((q[0] + q[1]) + (q[2] + q[3])) + ((q[4] + q[5]) + (q[6] + q[7])));
    const long pb0 = (long)pack8_fp8(p), pb1 = (long)pack8_fp8(q);
#pragma unroll
    for (int dt = 0; dt < 4; ++dt) st.o[dt] = __builtin_amdgcn_mfma_f32_16x16x32_fp8_fp8(bf.va[dt], pb0, st.o[dt], 0, 0, 0);
#pragma unroll
    for (int dt = 0; dt < 4; ++dt) st.o[dt] = __builtin_amdgcn_mfma_f32_16x16x32_fp8_fp8(bf.va[4 + dt], pb1, st.o[dt], 0, 0, 0);
}
template <class LD, class CP>
DEVI void nsa_streamb(int n, LD ld, CP cp) {
    NsaBlk8 A, B;
    if (n > 0) ld(A, 0);
#pragma unroll 1
    for (int i = 0; i < n; i += 2) {
        if (i + 1 < n) ld(B, i + 1);
        cp(A, i);
        if (i + 1 < n) { if (i + 2 < n) ld(A, i + 2); cp(B, i + 1); }
    }
}
DEVI void nsa_fold8(f32x4 (&comb)[4], NsaSt8& st, float gate) {
    float l = st.l; l = xsum16(l); l = xsum32(l);
    const float w = gate / fmaxf(l, 1e-30f);
#pragma unroll
    for (int dt = 0; dt < 4; ++dt) comb[dt] += st.o[dt] * w;
}
template <class LD, class CP>
DEVI void nsa_stream8(int n, LD ld, CP cp) {
    NsaBuf8 A, B, C, D;
    if (n > 0) ld(A, 0);
    if (n > 1) ld(B, 1);
    if (n > 2) ld(C, 2);
#pragma unroll 1
    for (int i = 0; i < n; i += 4) {
        if (i + 3 < n) ld(D, i + 3);
        cp(A, i);
        if (i + 1 < n) { if (i + 4 < n) ld(A, i + 4); cp(B, i + 1); }
        if (i + 2 < n) { if (i + 5 < n) ld(B, i + 5); cp(C, i + 2); }
        if (i + 3 < n) { if (i + 6 < n) ld(C, i + 6); cp(D, i + 3); }
    }
}
DEVI void nsa_fold(f32x4 (&comb)[4], NsaSt& st, float gate) {
    float l = st.l; l = xsum16(l); l = xsum32(l);
    const float w = gate / fmaxf(l, 1e-30f);
#pragma unroll
    for (int dt = 0; dt < 4; ++dt) comb[dt] += st.o[dt] * w;
}
template <class LD, class CP>
DEVI void nsa_stream(int n, LD ld, CP cp) {
    NsaBuf A, B, C;
    if (n > 0) ld(A, 0);
    if (n > 1) ld(B, 1);
#pragma unroll 1
    for (int i = 0; i < n; i += 3) {
        if (i + 2 < n) ld(C, i + 2);
        cp(A, i);
        if (i + 1 < n) { if (i + 3 < n) ld(A, i + 3); cp(B, i + 1); }
        if (i + 2 < n) { if (i + 4 < n) ld(B, i + 4); cp(C, i + 2); }
    }
}
template <class LD, class CP>
DEVI void nsa_stream2(int n, LD ld, CP cp) {
    NsaBuf A, B;
    if (n > 0) ld(A, 0);
#pragma unroll 1
    for (int i = 0; i < n; i += 2) {
        if (i + 1 < n) ld(B, i + 1);
        cp(A, i);
        if (i + 1 < n) { if (i + 2 < n) ld(A, i + 2); cp(B, i + 1); }
    }
}

#define XB_TMO      128
#define XB_XCNT(j)  (256  + 64 * (j))
#define XB_XSUB(j)  (1280 + 64 * (j))
#define XB_XGEN(j)  (2304 + 64 * (j))
#define XB_TOP      3328
#define XB_TOPGEN   3392
#define XCD_BAR_WORDS 3456
#define XB_SPIN_CAP (1u << 22)
#define LAS __attribute__((address_space(3)))
DEVI unsigned xb_ld(unsigned* p)              { return __hip_atomic_load(p, __ATOMIC_RELAXED, __HIP_MEMORY_SCOPE_AGENT); }
DEVI unsigned xb_add(unsigned* p, unsigned v) { return __hip_atomic_fetch_add(p, v, __ATOMIC_RELAXED, __HIP_MEMORY_SCOPE_AGENT); }
DEVI unsigned xb_xcc_id() { return (unsigned)__builtin_amdgcn_s_getreg((3 << 11) | 20) & 0xFu; }
#define XB_SPIN(cond, bar) do { unsigned _sp = 0; while (cond) { __builtin_amdgcn_s_sleep(1); \
    if ((++_sp & 255u) == 0u) { if (xb_ld(&(bar)[XB_TMO])) break; if (_sp > XB_SPIN_CAP) { atomicAdd(&(bar)[XB_TMO], 1u); break; } } } } while (0)
struct XcdBarrier { unsigned* bar; unsigned x; volatile LAS unsigned* st; };
DEVI XcdBarrier xcd_barrier_post(unsigned* bar, volatile LAS unsigned* st) {
    XcdBarrier b; b.bar = bar; b.x = xb_xcc_id(); b.st = st;
    if (threadIdx.x == 0) (void)xb_add(&bar[XB_XCNT(b.x)], 1u);
    return b;
}
DEVI void xcd_barrier_complete(unsigned* bar, unsigned x, unsigned& nloc, unsigned& nx) {
    const unsigned G = gridDim.x * gridDim.y * gridDim.z;
    unsigned sum, cnt, mine, sp = 0u;
    for (;;) {
        sum = 0u; cnt = 0u; mine = 0u;
#pragma unroll
        for (unsigned j = 0; j < 16; ++j) { const unsigned c = xb_ld(&bar[XB_XCNT(j)]); sum += c; cnt += (c > 0u) ? 1u : 0u; mine = (j == x) ? c : mine; }
        if (sum == G) break;
        __builtin_amdgcn_s_sleep(1);
        if ((++sp & 255u) == 0u) { if (xb_ld(&bar[XB_TMO])) break; if (sp > XB_SPIN_CAP) { atomicAdd(&bar[XB_TMO], 1u); break; } }
    }
    nloc = mine > 0u ? mine : 1u; nx = cnt > 0u ? cnt : 1u;
}
DEVI void xcd_barrier(const XcdBarrier& b) {
    asm volatile("s_waitcnt vmcnt(0)" ::: "memory");
    __syncthreads();
    if (threadIdx.x == 0) {
        unsigned* bar = b.bar;
        __builtin_amdgcn_s_waitcnt(0);
        unsigned nloc = b.st[0], nx = b.st[1];
        if (nloc == 0u) { xcd_barrier_complete(bar, b.x, nloc, nx); b.st[0] = nloc; b.st[1] = nx; }
        const unsigned old = xb_add(&bar[XB_XSUB(b.x)], 1u);
        const unsigned gen = old / nloc;
        if (old + 1u == (gen + 1u) * nloc) {
            __builtin_amdgcn_fence(__ATOMIC_RELEASE, "agent");
            asm volatile("s_waitcnt vmcnt(0)" ::: "memory");
            const unsigned og = xb_add(&bar[XB_TOP], 1u);
            const unsigned tg = og / nx;
            if (og + 1u == (tg + 1u) * nx) xb_add(&bar[XB_TOPGEN], 1u);
            else XB_SPIN(xb_ld(&bar[XB_TOPGEN]) == tg, bar);
            __builtin_amdgcn_fence(__ATOMIC_ACQUIRE, "agent");
            xb_add(&bar[XB_XGEN(b.x)], 1u);
            asm volatile("s_waitcnt vmcnt(0)" ::: "memory");
        } else {
            XB_SPIN(xb_ld(&bar[XB_XGEN(b.x)]) == gen, bar);
            __builtin_amdgcn_fence(__ATOMIC_ACQUIRE, "agent");
            asm volatile("s_waitcnt vmcnt(0)" ::: "memory");
        }
    }
    __syncthreads();
}

DEVI void* ldptr(volatile LAS unsigned long long* tab, int i) { const unsigned long long v = tab[i];
    const unsigned lo = __builtin_amdgcn_readfirstlane((unsigned)v), hi = __builtin_amdgcn_readfirstlane((unsigned)(v >> 32));
    return (void*)(__attribute__((address_space(1))) void*)(((unsigned long long)hi << 32) | lo); }


DEVI unsigned key_pack(float f, int idx) { const unsigned u = __float_as_uint(f); const unsigned o = (u & 0x80000000u) ? ~u : (u | 0x80000000u); return (o & 0xFFFFFF80u) | (unsigned)(127 - idx); }
DEVI unsigned key_pack8(float f, int idx) { const unsigned u = __float_as_uint(f); const unsigned o = (u & 0x80000000u) ? ~u : (u | 0x80000000u); return (o & 0xFFFFFF00u) | (unsigned)(255 - idx); }
DEVI float key_val8(unsigned k) { const unsigned o = k & 0xFFFFFF00u; return __uint_as_float((o & 0x80000000u) ? (o & 0x7FFFFFFFu) : ~o); }
DEVI float key_val(unsigned k) { const unsigned o = k & 0xFFFFFF80u; return __uint_as_float((o & 0x80000000u) ? (o & 0x7FFFFFFFu) : ~o); }
DEVI void ce_desc(unsigned& a, unsigned& b) { const unsigned hi = a > b ? a : b, lo = a > b ? b : a; a = hi; b = lo; }
template <int N> DEVI void bitonic_sort_desc(unsigned (&a)[N]) {
#pragma unroll
    for (int k = 2; k <= N; k <<= 1)
#pragma unroll
        for (int j = k >> 1; j > 0; j >>= 1)
#pragma unroll
            for (int i = 0; i < N; ++i) { const int l = i ^ j; if (l > i) { if ((i & k) == 0) ce_desc(a[i], a[l]); else ce_desc(a[l], a[i]); } }
}
template <int N> DEVI void bitonic_merge_desc(unsigned (&a)[N]) {
#pragma unroll
    for (int j = N >> 1; j > 0; j >>= 1)
#pragma unroll
        for (int i = 0; i < N; ++i) { const int l = i ^ j; if (l > i) ce_desc(a[i], a[l]); }
}


DEVI void pk_half_top16(unsigned (&ka_)[16], const bf16_t* QPp, const LAS bf16_t* Kp, int lane) {
    const int hg = lane >> 4;
    bf16x8 qf[4];
#pragma unroll
    for (int ks = 0; ks < 4; ++ks) qf[ks] = *(const bf16x8*)(QPp + ks * 32);
    float sc[32];
#pragma unroll
    for (int kt = 0; kt < 8; ++kt) {
        f32x4 a = {0.f, 0.f, 0.f, 0.f};
#pragma unroll
        for (int ks = 0; ks < 4; ++ks) a = __builtin_amdgcn_mfma_f32_16x16x32_bf16(*(const LAS bf16x8*)(Kp + (kt * 4 + ks) * 512), qf[ks], a, 0, 0, 0);
        sc[kt * 4 + 0] = a[0]; sc[kt * 4 + 1] = a[1]; sc[kt * 4 + 2] = a[2]; sc[kt * 4 + 3] = a[3];
    }
    unsigned kb_[16];
#pragma unroll
    for (int e = 0; e < 16; ++e) { ka_[e] = key_pack(sc[e], (e >> 2) * 16 + 4 * hg + (e & 3)); kb_[e] = key_pack(sc[16 + e], ((16 + e) >> 2) * 16 + 4 * hg + (e & 3)); }
    bitonic_sort_desc<16>(ka_); bitonic_sort_desc<16>(kb_);
#pragma unroll
    for (int e = 0; e < 16; ++e) ka_[e] = ka_[e] > kb_[15 - e] ? ka_[e] : kb_[15 - e];
    bitonic_merge_desc<16>(ka_);
#pragma unroll
    for (int e = 0; e < 16; ++e) kb_[e] = xchg16(ka_[e], lane);
#pragma unroll
    for (int e = 0; e < 16; ++e) ka_[e] = ka_[e] > kb_[15 - e] ? ka_[e] : kb_[15 - e];
    bitonic_merge_desc<16>(ka_);
#pragma unroll
    for (int e = 0; e < 16; ++e) kb_[e] = xchg32(ka_[e], lane);
#pragma unroll
    for (int e = 0; e < 16; ++e) ka_[e] = ka_[e] > kb_[15 - e] ? ka_[e] : kb_[15 - e];
    bitonic_merge_desc<16>(ka_);
}


DEVI void ss_add(unsigned long long* p, float v) { __hip_atomic_fetch_add(p, (unsigned long long)(v * 16777216.0f + 0.5f), __ATOMIC_RELAXED, __HIP_MEMORY_SCOPE_AGENT); }
DEVI float ss_get(const unsigned long long* p) { return (float)((double)(*p) * (1.0 / 16777216.0)); }

__global__ void __launch_bounds__(NTHREADS) fwd_mega(Params pa) {
    extern __shared__ __attribute__((aligned(16))) unsigned char smem[];
    const int bid = blockIdx.x, nb = gridDim.x, tid = threadIdx.x, lane = tid & 63, wave = tid >> 6;
    volatile LAS unsigned long long* ptab = (volatile LAS unsigned long long*)(smem + LDS_BYTES - 16 - 32 * 8);
    {
        volatile LAS unsigned* st0 = (volatile LAS unsigned*)(smem + LDS_BYTES - 16);
        if (tid < 4) st0[tid] = 0u;
        if (tid == 0) {
            ptab[0] = (unsigned long long)pa.x; ptab[1] = (unsigned long long)pa.mem; ptab[2] = (unsigned long long)pa.g_mix; ptab[3] = (unsigned long long)pa.w_in;
            ptab[4] = (unsigned long long)pa.pe_k; ptab[5] = (unsigned long long)pa.w1_k; ptab[6] = (unsigned long long)pa.b1_k; ptab[7] = (unsigned long long)pa.w2_k;
            ptab[8] = (unsigned long long)pa.pe_v; ptab[9] = (unsigned long long)pa.w1_v; ptab[10] = (unsigned long long)pa.b1_v; ptab[11] = (unsigned long long)pa.w2_v;
            ptab[12] = (unsigned long long)pa.ln_g; ptab[13] = (unsigned long long)pa.ln_b; ptab[14] = (unsigned long long)pa.gws; ptab[15] = (unsigned long long)pa.gbs;
            ptab[16] = (unsigned long long)pa.w_nsa_out; ptab[17] = (unsigned long long)pa.w_gmlp_out; ptab[18] = (unsigned long long)pa.w_mix_out; ptab[19] = (unsigned long long)pa.g_xattn;
            ptab[20] = (unsigned long long)pa.g_mem; ptab[21] = (unsigned long long)pa.w_xq; ptab[22] = (unsigned long long)pa.w_xkv; ptab[23] = (unsigned long long)pa.w_xo;
            ptab[24] = (unsigned long long)pa.g_peer; ptab[25] = (unsigned long long)pa.w_peer_q; ptab[26] = (unsigned long long)pa.sub_keys; ptab[27] = (unsigned long long)pa.peer_u;
            ptab[28] = (unsigned long long)pa.peer_v; ptab[29] = (unsigned long long)pa.g_final; ptab[30] = (unsigned long long)pa.out; ptab[31] = (unsigned long long)pa.ws;
        }
        __syncthreads();
    }
    const XcdBarrier xb = xcd_barrier_post((unsigned*)pa.ws, (volatile LAS unsigned*)(smem + LDS_BYTES - 16));
#define LDP(i) ((const float*)ldptr(ptab, i))
#define PHASE_BEGIN \
    const int tid = tid_opaque(), lane = tid & 63, wave = tid >> 6; (void)lane; (void)wave; \
    Params p; p.x = LDP(0); p.mem = LDP(1); p.g_mix = LDP(2); p.w_in = LDP(3); p.pe_k = LDP(4); p.w1_k = LDP(5); p.b1_k = LDP(6); p.w2_k = LDP(7); p.pe_v = LDP(8); p.w1_v = LDP(9); p.b1_v = LDP(10); p.w2_v = LDP(11); \
    p.ln_g = LDP(12); p.ln_b = LDP(13); p.gws = LDP(14); p.gbs = LDP(15); p.w_nsa_out = LDP(16); p.w_gmlp_out = LDP(17); p.w_mix_out = LDP(18); p.g_xattn = LDP(19); p.g_mem = LDP(20); p.w_xq = LDP(21); p.w_xkv = LDP(22); p.w_xo = LDP(23); \
    p.g_peer = LDP(24); p.w_peer_q = LDP(25); p.sub_keys = LDP(26); p.peer_u = LDP(27); p.peer_v = LDP(28); p.g_final = LDP(29); p.out = (float*)ldptr(ptab, 30); p.ws = (unsigned char*)ldptr(ptab, 31); \
    unsigned char* const ws = p.ws; \
    bf16_t* WIN = (bf16_t*)(ws + O_WIN); bf16_t* W1K = (bf16_t*)(ws + O_W1K); bf16_t* W1V = (bf16_t*)(ws + O_W1V); \
    bf16_t* WNSA = (bf16_t*)(ws + O_WNSA); bf16_t* WGM = (bf16_t*)(ws + O_WGM); bf16_t* WMIX = (bf16_t*)(ws + O_WMIX); \
    bf16_t* WXQ = (bf16_t*)(ws + O_WXQ); bf16_t* WXKV = (bf16_t*)(ws + O_WXKV); bf16_t* WXO = (bf16_t*)(ws + O_WXO); bf16_t* WPQ = (bf16_t*)(ws + O_WPQ); \
    long long* B1F = (long long*)(ws + O_B1I); \
    bf16_t* HN = (bf16_t*)(ws + O_HN); bf16_t* MN = (bf16_t*)(ws + O_MN); bf16_t* KVX = (bf16_t*)(ws + O_KVX); \
    float* GATES = (float*)(ws + O_GATES); float* HID = (float*)(ws + O_HID); \
    bf16_t* Q = (bf16_t*)(ws + O_Q); bf16_t* KV6 = (bf16_t*)(ws + O_KV6); bf16_t* U = (bf16_t*)(ws + O_U); bf16_t* VG = (bf16_t*)(ws + O_VG); \
    bf16_t* MG = (bf16_t*)(ws + O_MG); bf16_t* ONSA = (bf16_t*)(ws + O_ONSA); bf16_t* OGM = (bf16_t*)(ws + O_OGM); \
    bf16_t* Y = (bf16_t*)(ws + O_Y); bf16_t* QX = (bf16_t*)(ws + O_QX); bf16_t* OX = (bf16_t*)(ws + O_OX); bf16_t* QP = (bf16_t*)(ws + O_QP); \
    float* HS = (float*)(ws + O_HS); int* HI = (int*)(ws + O_HI); \
    bf16_t* VXT = (bf16_t*)(ws + O_VXT); bf16_t* SUBK = (bf16_t*)(ws + O_SUBK); \
    bf16_t* KCB = (bf16_t*)(ws + O_CMP); bf16_t* VCT = KCB + 4 * 512 * 64; \
    unsigned char* PU8 = ws + O_U; unsigned char* PV8 = ws + O_U + 16384ull * 1024; \
    float* PSC = (float*)(ws + O_PSC); unsigned long long* SS = (unsigned long long*)(ws + O_SS); (void)SS; \
    float* OUT = p.out; \
    (void)WIN; (void)W1K; (void)W1V; (void)WNSA; (void)WGM; (void)WMIX; (void)WXQ; (void)WXKV; (void)WXO; (void)WPQ; (void)B1F; (void)HN; (void)MN; (void)KVX; (void)GATES; (void)HID; (void)Q; (void)KV6; (void)U; (void)VG; \
    (void)MG; (void)ONSA; (void)OGM; (void)Y; (void)QX; (void)OX; (void)QP; (void)HS; (void)HI; (void)VXT; (void)SUBK; (void)KCB; (void)VCT; (void)PU8; (void)PV8; (void)PSC; (void)OUT;

    { PHASE_BEGIN
    {
        for (int j = bid * 8 + wave; j < 3424; j += nb * 8) {
            int t = j;
            if (t < 1120) { transpose_wave(p.w_in, 4376, WIN, 1024, t, WinMap(), lane); continue; } t -= 1120;
            if (t < 128) { transpose_wave(p.w1_k, 256, W1K, 2048, t, IdMap(), lane); continue; } t -= 128;
            if (t < 128) { transpose_wave(p.w1_v, 256, W1V, 2048, t, IdMap(), lane); continue; } t -= 128;
            if (t < 128) { transpose_wave(p.w_nsa_out, 1024, WNSA, 512, t, IdMap(), lane); continue; } t -= 128;
            if (t < 128) { transpose_wave(p.w_gmlp_out, 1024, WGM, 512, t, IdMap(), lane); continue; } t -= 128;
            if (t < 256) { transpose_wave(p.w_mix_out, 1024, WMIX, 1024, t, IdMap(), lane); continue; } t -= 256;
            if (t < 256) { transpose_wave(p.w_xq, 1024, WXQ, 1024, t, IdMap(), lane, p.g_xattn); continue; } t -= 256;
            if (t < 512) { transpose_wave(p.w_xkv, 2048, WXKV, 1024, t, IdMap(), lane); continue; } t -= 512;
            if (t < 256) { transpose_wave(p.w_xo, 1024, WXO, 1024, t, IdMap(), lane); continue; } t -= 256;
            transpose_wave(p.w_peer_q, 2048, WPQ, 1024, t, IdMap(), lane, p.g_peer);
        }
        for (int r = bid * 8 + wave; r < 16384 + 512; r += nb * 8) {
            if (r < 16384) rmsnorm_row_bf16(p.x + (size_t)r * 1024, p.g_mix, HN + (size_t)r * 1024, lane);
            else rmsnorm_row_bf16(p.mem + (size_t)(r - 16384) * 1024, p.g_mem, MN + (size_t)(r - 16384) * 1024, lane);
        }
        for (int i = bid * NTHREADS + tid; i < 3 * 16384; i += nb * NTHREADS) SS[i] = 0ull;
        for (int i = bid * NTHREADS + tid; i < 16 * 128 * 128; i += nb * NTHREADS) SUBK[(i & ~16383) + pk_koff((i >> 7) & 127, i & 127)] = f2bf(p.sub_keys[i]);
        for (int i = bid * NTHREADS + tid; i < 2 * 2048 * 256 / 4; i += nb * NTHREADS) ((float4*)HID)[i] = make_float4(0.f, 0.f, 0.f, 0.f);
        {
            const int wt = bid * 8 + wave;
            if (wt < 128) {
                const int kv = wt >> 6, ng = (wt >> 4) & 3, kc = wt & 15, n = ng * 64 + lane;
                const float* pe = (kv ? p.pe_v : p.pe_k) + kc * 128; const float* w1 = (kv ? p.w1_v : p.w1_k) + (size_t)kc * 128 * 256 + n;
                float a = 0.f;
#pragma unroll 16
                for (int k = 0; k < 128; ++k) a += pe[k] * w1[(size_t)k * 256];
                __hip_atomic_fetch_add((unsigned long long*)(B1F + kv * 256 + n), (unsigned long long)(long long)(a * 68719476736.0f), __ATOMIC_RELAXED, __HIP_MEMORY_SCOPE_AGENT);
            }
        }
    }
    }
    xcd_barrier(xb);

    { PHASE_BEGIN
    {
        auto epi = [&](int r, int c, const f32x4& v0, const f32x4& v1) {
            if (c < 512) { const float qs_ = 0.125f * 1.4426950408889634f; store_bf16x8(Q + (size_t)r * 512 + c, v0 * qs_, v1 * qs_);
                const float q8[8] = {v0[0] * qs_, v0[1] * qs_, v0[2] * qs_, v0[3] * qs_, v1[0] * qs_, v1[1] * qs_, v1[2] * qs_, v1[3] * qs_};
                *(unsigned long long*)(ws + O_Q8 + (size_t)r * 512 + c) = pack8_fp8(q8); }
            else if (c < 1280) { const int w = (c - 512) >> 7, cc = (c - 512) & 127;
                const int b_ = r >> 13, t_ = r & 8191, g_ = cc >> 6, d_ = cc & 63;
                if (w == 5) {
                    bf16_t* vt = KV6 + (size_t)w * 16384 * 128 + (size_t)(b_ * 2 + g_) * 8192 * 64 + nsa_voff(t_, d_);
                    vt[0] = f2bf(v0[0]); vt[8] = f2bf(v0[1]); vt[16] = f2bf(v0[2]); vt[24] = f2bf(v0[3]); vt[32] = f2bf(v1[0]); vt[40] = f2bf(v1[1]); vt[48] = f2bf(v1[2]); vt[56] = f2bf(v1[3]); }
                else if (w == 4) store_bf16x8(KV6 + (size_t)w * 16384 * 128 + (size_t)(b_ * 2 + g_) * 8192 * 64 + nsa_koff(t_, d_), v0, v1);
                else if (w == 3) {
                    const float f8[8] = {v0[0], v0[1], v0[2], v0[3], v1[0], v1[1], v1[2], v1[3]}; const unsigned long long pk = pack8_fp8(f8);
                    unsigned char* vt = (unsigned char*)(KV6 + (size_t)w * 16384 * 128) + (size_t)(b_ * 2 + g_) * 8192 * 64 + nsa_voff8(t_, d_);
#pragma unroll
                    for (int e = 0; e < 8; ++e) vt[e * 16] = (unsigned char)(pk >> (8 * e)); }
                else if (w == 2) {
                    const float f8[8] = {v0[0], v0[1], v0[2], v0[3], v1[0], v1[1], v1[2], v1[3]};
                    *(unsigned long long*)((unsigned char*)(KV6 + (size_t)w * 16384 * 128) + (size_t)(b_ * 2 + g_) * 8192 * 64 + nsa_koff8(t_, d_)) = pack8_fp8(f8); }
                else store_bf16x8(KV6 + ((size_t)w * 16384 + r) * 128 + cc, v0, v1); }
            else if (c < 2304) { bf16_t* dst = c < 1792 ? U + (size_t)r * 512 + (c - 1280) : VG + (size_t)r * 512 + (c - 1792);
                f32x4 a, b;
#pragma unroll
                for (int e = 0; e < 4; ++e) { a[e] = gelu_fast(v0[e]); b[e] = gelu_fast(v1[e]); }
                store_bf16x8(dst, a, b); }
            else { f32x4 a, b;
#pragma unroll
                for (int e = 0; e < 4; ++e) { a[e] = sigmoid_fast(v0[e]); b[e] = sigmoid_fast(v1[e]); }
                store_bf16x8(MG + (size_t)r * 2048 + (c - 2304), a, b); }
        };
        big_gemm(smem, HN, WIN, 16384, 4352, 1024, epi);
        if (bid >= 64) {
            const int tl = bid - 64;
            bf16_t* As = (bf16_t*)smem; bf16_t* Bs = As + 128 * G_LD;
            const int wm = wave >> 2, wn = wave & 3;
            f32x4 acc[4][2];
#pragma unroll
            for (int i = 0; i < 4; ++i)
#pragma unroll
                for (int j = 0; j < 2; ++j) acc[i][j] = (f32x4){0.f, 0.f, 0.f, 0.f};
            if (tl < 128) {
                gemm_tile(acc, RowMajorA{HN, 1024}, tl * 128, WIN + (size_t)4352 * 1024, 1024, 1024, As, Bs);
#pragma unroll
                for (int i = 0; i < 4; ++i)
#pragma unroll
                    for (int j = 0; j < 2; ++j) { const int r = tl * 128 + wm * 64 + i * 16 + (lane & 15), c = wn * 32 + j * 16 + (lane >> 4) * 4;
                        if (c < 24) { float* gp = GATES + (size_t)r * 24 + c; gp[0] = sigmoid_f(acc[i][j][0]); gp[1] = sigmoid_f(acc[i][j][1]); gp[2] = sigmoid_f(acc[i][j][2]); gp[3] = sigmoid_f(acc[i][j][3]); } }
            } else if (tl < 192) {
                const int t2 = tl - 128, mt = t2 >> 4, nt = t2 & 15;
                gemm_tile(acc, RowMajorA{MN, 1024}, mt * 128, WXKV + (size_t)nt * 128 * 1024, 1024, 1024, As, Bs);
#pragma unroll
                for (int i = 0; i < 4; ++i)
#pragma unroll
                    for (int j = 0; j < 2; ++j) { const int r = mt * 128 + wm * 64 + i * 16 + (lane & 15), c = nt * 128 + wn * 32 + j * 16 + (lane >> 4) * 4;
                        const int b_ = r >> 8, m_ = r & 255; const f32x4 v = acc[i][j];
                        if (c < 1024) { const int h_ = c >> 8, d_ = c & 255; store_bf16x4(KVX + (size_t)(b_ * 4 + h_) * 65536 + xat_koff(m_, d_), v[0], v[1], v[2], v[3]); }
                        else { const int hd = c - 1024, h_ = hd >> 8, d_ = hd & 255;
                            bf16_t* vt = VXT + (size_t)(b_ * 4 + h_) * 65536 + xat_voff(m_, d_);
                            vt[0] = f2bf(v[0]); vt[8] = f2bf(v[1]); vt[16] = f2bf(v[2]); vt[24] = f2bf(v[3]); } }
            }
        }
    }
    }
    xcd_barrier(xb);

    { PHASE_BEGIN
    {
        for (int task = bid; task < 256; task += nb) {
            if (task < 128) {
                const int kv = task >> 6, t = task & 63, mt = t >> 2, nt = (t >> 1) & 1, kh = t & 1;
                bf16_t* As = (bf16_t*)smem; bf16_t* Bs = As + 128 * G_LD;
                const int wm = wave >> 2, wn = wave & 3;
                f32x4 acc[4][2];
#pragma unroll
                for (int i = 0; i < 4; ++i)
#pragma unroll
                    for (int j = 0; j < 2; ++j) acc[i][j] = (f32x4){0.f, 0.f, 0.f, 0.f};
                gemm_tile(acc, CmpA{KV6 + (size_t)kv * 16384 * 128, kh * 1024}, mt * 128, (kv ? W1V : W1K) + (size_t)nt * 128 * 2048 + kh * 1024, 2048, 1024, As, Bs);
#pragma unroll
                for (int i = 0; i < 4; ++i)
#pragma unroll
                    for (int j = 0; j < 2; ++j) {
                        const int r = mt * 128 + wm * 64 + i * 16 + (lane & 15), c = nt * 128 + wn * 32 + j * 16 + (lane >> 4) * 4;
                        if (r < 2044) { float* hp = HID + ((size_t)kv * 2048 + r) * 256 + c;
                            unsafeAtomicAdd(hp, acc[i][j][0]); unsafeAtomicAdd(hp + 1, acc[i][j][1]); unsafeAtomicAdd(hp + 2, acc[i][j][2]); unsafeAtomicAdd(hp + 3, acc[i][j][3]); }
                    }
                __syncthreads();
            } else {
                const int ch = task - 128;
                const size_t row0 = (size_t)ch * 128;
                constexpr int VLD = 136;
                bf16_t* VT = (bf16_t*)smem;
                float* st = (float*)(smem + 512 * VLD * 2);
                for (int r = wave * 16; r < wave * 16 + 16; ++r) {
                    float f[8]; load8(VG + (row0 + r) * 512 + lane * 8, f);
                    float s1 = 0.f;
#pragma unroll
                    for (int e = 0; e < 8; ++e) s1 += f[e];
                    s1 = wave_sum(s1); const float mu = s1 * (1.0f / 512.0f);
                    float s2 = 0.f;
#pragma unroll
                    for (int e = 0; e < 8; ++e) s2 += (f[e] - mu) * (f[e] - mu);
                    s2 = wave_sum(s2);
                    if (lane == 0) { st[r * 2] = mu; st[r * 2 + 1] = rsqrtf(s2 * (1.0f / 512.0f) + 1e-6f); }
                }
                __syncthreads();
                {
                    const int s_ = tid & 127; const float mu = st[s_ * 2], rs = st[s_ * 2 + 1];
#pragma unroll 1
                    for (int i = 0; i < 16; ++i) {
                        const int d0 = ((tid >> 7) + 4 * i) * 8;
                        float f[8]; load8(VG + (row0 + s_) * 512 + d0, f);
#pragma unroll
                        for (int e = 0; e < 8; ++e) VT[(d0 + e) * VLD + s_] = f2bf((f[e] - mu) * rs * p.ln_g[d0 + e] + p.ln_b[d0 + e]);
                    }
                }
                __syncthreads();
                {
                    const int tl = wave * 16 + (lane & 15), hq = lane >> 4, kmax = (wave * 16 + 15) >> 5;
                    for (int g = 0; g < 4; ++g) {
                        bf16x8 wf[4];
#pragma unroll
                        for (int ks = 0; ks < 4; ++ks) {
                            if (ks <= kmax) {
                                const float* wp = p.gws + (size_t)g * 16384 + tl * 128 + ks * 32 + 8 * hq;
                                float f[8]; load8(wp, f);
#pragma unroll
                                for (int e = 0; e < 8; ++e) f[e] = (ks * 32 + 8 * hq + e <= tl) ? f[e] : 0.f;
                                wf[ks] = pack8(f);
                            }
                        }
                        const float bsv = p.gbs[g * 128 + tl];
#pragma unroll 2
                        for (int dt = 0; dt < 8; ++dt) {
                            f32x4 a = {0.f, 0.f, 0.f, 0.f};
                            const bf16_t* vp = VT + (g * 128 + dt * 16 + (lane & 15)) * VLD + 8 * hq;
#pragma unroll
                            for (int ks = 0; ks < 4; ++ks) if (ks <= kmax) a = __builtin_amdgcn_mfma_f32_16x16x32_bf16(*(const bf16x8*)(vp + ks * 32), wf[ks], a, 0, 0, 0);
                            const size_t o = (row0 + tl) * 512 + g * 128 + dt * 16 + 4 * hq;
                            const uint2 uw = *(const uint2*)(U + o);
                            store_bf16x4(OGM + o, __uint_as_float(uw.x << 16) * (a[0] + bsv), __uint_as_float(uw.x & 0xffff0000u) * (a[1] + bsv),
                                         __uint_as_float(uw.y << 16) * (a[2] + bsv), __uint_as_float(uw.y & 0xffff0000u) * (a[3] + bsv));
                        }
                    }
                }
                __syncthreads();
            }
        }
    }
    }
    xcd_barrier(xb);

    { PHASE_BEGIN
    {
        __syncthreads();
        float* gl = (float*)smem + wave * 256;
        for (int task = bid * 8 + wave; task < 2 * 2044; task += nb * 8) {
            const int kv = task >= 2044 ? 1 : 0, r = task - kv * 2044;
            const float* hp = HID + ((size_t)kv * 2048 + r) * 256; const long long* bb = B1F + kv * 256; const float* b1 = kv ? p.b1_v : p.b1_k;
#pragma unroll
            for (int i = 0; i < 4; ++i) gl[lane + 64 * i] = gelu_f(hp[lane + 64 * i] + (float)((double)bb[lane + 64 * i] * (1.0 / 68719476736.0)) + b1[lane + 64 * i]);
            lds_fence();
            const float* w2 = kv ? p.w2_v : p.w2_k;
            float a = 0.f;
#pragma unroll 8
            for (int j = 0; j < 256; ++j) a += gl[j] * w2[j * 64 + lane];
            const int b = r / 1022, rr = r - b * 1022, c = rr >> 1, g = rr & 1, n = lane;
            if (kv == 0) KCB[(size_t)(b * 2 + g) * 512 * 64 + nsa_koff(c, n)] = f2bf(a); else VCT[(size_t)(b * 2 + g) * 512 * 64 + nsa_voff(c, n)] = f2bf(a);
            lds_fence();
        }
        if (bid == 0 && tid < 256) { const int bg = tid >> 6, n = tid & 63; KCB[(size_t)bg * 512 * 64 + nsa_koff(511, n)] = 0; VCT[(size_t)bg * 512 * 64 + nsa_voff(511, n)] = 0; }
    }
    }
    xcd_barrier(xb);

    { PHASE_BEGIN
    {
        float* impL = (float*)smem + wave * 1024;
        int* sidxL = (int*)(impL + 512);
        const bf16_t* KS = KV6 + 2ull * 16384 * 128; const bf16_t* VST = KV6 + 3ull * 16384 * 128;
        const bf16_t* KW = KV6 + 4ull * 16384 * 128; const bf16_t* VWT = KV6 + 5ull * 16384 * 128;
        const int c = lane & 15, h = lane >> 4, tokc = c >> 2, headc = c & 3;
        const int rk = 8 * (c >> 2) + (c & 3), dh = 8 * h;
        for (int task = bid * 8 + wave; task < 8192; task += nb * 8) {
            const int bg = task >> 11, q4 = (bg & 1) ? 2047 - (task & 2047) : (task & 2047), b = bg >> 1, g = bg & 1, t0 = q4 * 4;
            const int tcol = t0 + tokc; const size_t bt0 = (size_t)b * 8192 + t0;
            bf16x8 qf[2];
            { const bf16_t* qp = Q + (bt0 + tokc) * 512 + g * 256 + headc * 64 + dh; qf[0] = *(const bf16x8*)qp; qf[1] = *(const bf16x8*)(qp + 32); }
            const float* gp = GATES + (bt0 + tokc) * 24 + (g * 4 + headc) * 3;
            const float gate0 = gp[0], gate1 = gp[1], gate2 = gp[2];
            f32x4 comb[4];
#pragma unroll
            for (int dt = 0; dt < 4; ++dt) comb[dt] = (f32x4){0.f, 0.f, 0.f, 0.f};
            {
                const int ncvc = tcol >= 31 ? ((tcol - 31) >> 4) + 1 : 0;
                const int ncvmax = (t0 + 3) >= 31 ? ((t0 + 3 - 31) >> 4) + 1 : 0;
                const int nch = (ncvmax + 31) >> 5;
                const bf16_t* Kc = KCB + (size_t)bg * 512 * 64; const bf16_t* Vc = VCT + (size_t)bg * 64 * 512;
                NsaSt st; nsa_init(st);
                {
                    auto ld = [&](NsaBuf& bf, int i) { nsa_load_kf(bf.ka, Kc, i, lane); };
                    auto cp = [&](NsaBuf& bf, int i) { float sv[8]; nsa_scores(bf.ka, qf, sv); nsa_chunk<false>(st, sv, i * 32 + dh, 0, ncvc - 1, bf.va); };
                    nsa_stream2(nch, ld, cp);
                }
                float l = st.l; l = xsum16(l); l = xsum32(l);
                const float inv = 1.0f / fmaxf(l, 1e-30f), mfin = st.m;
                *(float4*)(impL + lane * 8) = make_float4(0.f, 0.f, 0.f, 0.f); *(float4*)(impL + lane * 8 + 4) = make_float4(0.f, 0.f, 0.f, 0.f);
                lds_fence();
                f32x4 oc[4];
#pragma unroll
                for (int dt = 0; dt < 4; ++dt) oc[dt] = (f32x4){0.f, 0.f, 0.f, 0.f};
                float carry = 0.f;
                {
                    auto ld = [&](NsaBuf& bf, int i) { nsa_load_kf(bf.ka, Kc, i, lane); nsa_load_kf(bf.va, Vc, i, lane); };
                    auto cp = [&](NsaBuf& bf, int ch) {
                        float sv[8]; nsa_scores(bf.ka, qf, sv);
                        float p[8];
#pragma unroll
                        for (int j = 0; j < 8; ++j) p[j] = (ch * 32 + dh + j < ncvc) ? __builtin_amdgcn_exp2f(sv[j] - mfin) * inv : 0.f;
                        const float up = __shfl(p[7], (lane + 48) & 63);
                        const float prev7 = (h >= 1) ? up : carry; carry = up;
                        float i0 = p[0] + p[1] + p[2] + 0.5f * p[3] + 0.5f * prev7, i1 = p[4] + p[5] + p[6] + 0.5f * p[7] + 0.5f * p[3];
                        i0 += __shfl_xor(i0, 1); i0 += __shfl_xor(i0, 2); i1 += __shfl_xor(i1, 1); i1 += __shfl_xor(i1, 2);
                        if (headc == 0) { impL[tokc * 128 + 8 * ch + 2 * h] = i0; impL[tokc * 128 + 8 * ch + 2 * h + 1] = i1; }
                        const bf16x8 pb = pack8(p);
#pragma unroll
                        for (int dt = 0; dt < 4; ++dt) oc[dt] = __builtin_amdgcn_mfma_f32_16x16x32_bf16(bf.va[dt], pb, oc[dt], 0, 0, 0);
                    };
                    nsa_stream2(nch, ld, cp);
                }
#pragma unroll
                for (int dt = 0; dt < 4; ++dt) comb[dt] += oc[dt] * gate0;
            }
            lds_fence();
            int nblk;
            {
                const int tok = lane >> 4, sub = lane & 15, cur = t0 >> 6;
                float sc[8];
#pragma unroll
                for (int e = 0; e < 8; ++e) { const int j = sub + 16 * e; const float imp = impL[tok * 128 + j];
                    const bool al = j <= cur, fo = (j == 0) || (j == cur) || (j == cur - 1);
                    sc[e] = (fo && al) ? 1e4f : (al ? imp : -1e30f); }
                unsigned k8[8];
#pragma unroll
                for (int e = 0; e < 8; ++e) k8[e] = key_pack(sc[e], sub + 16 * e);
                bitonic_sort_desc<8>(k8);
                unsigned k16[16];
#pragma unroll
                for (int e = 0; e < 8; ++e) { k16[e] = k8[e]; k16[15 - e] = (unsigned)__shfl_xor((int)k8[e], 1); }
                bitonic_merge_desc<16>(k16);
#pragma unroll
                for (int o = 2; o < 16; o <<= 1) {
                    unsigned pk[16];
#pragma unroll
                    for (int e = 0; e < 16; ++e) pk[e] = (unsigned)__shfl_xor((int)k16[e], o);
#pragma unroll
                    for (int e = 0; e < 16; ++e) k16[e] = k16[e] > pk[15 - e] ? k16[e] : pk[15 - e];
                    bitonic_merge_desc<16>(k16);
                }
                unsigned mk = k16[0];
#pragma unroll
                for (int e = 1; e < 16; ++e) mk = (sub == e) ? k16[e] : mk;
                const float myv = key_val(mk); const int myi = 127 - (int)(mk & 127u);
                const bool forced = myv > 5e3f;
                const bool keep = (myv > -0.5e30f) && !(forced && tok > 0);
                const unsigned long long bal = __ballot(keep);
                const int pos = __popcll(bal & ((1ull << lane) - 1ull));
                lds_fence();
                if (keep) sidxL[pos] = ((forced ? 7 : tok) << 16) | myi;
                nblk = __popcll(bal);
            }
            lds_fence();
            {
                NsaSt8 st; nsa_init8(st);
                const unsigned char* Kp = (const unsigned char*)KS + (size_t)bg * 8192 * 64; const unsigned char* Vp = (const unsigned char*)VST + (size_t)bg * 8192 * 64;
                long qf8[2];
                { const unsigned char* qp = ws + O_Q8 + (bt0 + tokc) * 512 + g * 256 + headc * 64 + dh; qf8[0] = *(const long*)qp; qf8[1] = *(const long*)(qp + 32); }
                const int cur_ = t0 >> 6;
                auto ld = [&](NsaBlk8& bf, int i) { const int e = __builtin_amdgcn_readfirstlane(sidxL[i]); const int chn = (e & 0xffff) * 2; bf.e = e;
                    long t4[4];
                    nsa_load8(t4, Kp, chn, lane); bf.ka[0] = t4[0]; bf.ka[1] = t4[1]; bf.ka[2] = t4[2]; bf.ka[3] = t4[3];
                    nsa_load8(t4, Kp, chn + 1, lane); bf.ka[4] = t4[0]; bf.ka[5] = t4[1]; bf.ka[6] = t4[2]; bf.ka[7] = t4[3];
                    nsa_load8(t4, Vp, chn, lane); bf.va[0] = t4[0]; bf.va[1] = t4[1]; bf.va[2] = t4[2]; bf.va[3] = t4[3];
                    nsa_load8(t4, Vp, chn + 1, lane); bf.va[4] = t4[0]; bf.va[5] = t4[1]; bf.va[6] = t4[2]; bf.va[7] = t4[3]; };
                auto cp = [&](NsaBlk8& bf, int i) { const int e = bf.e; const int blk = e & 0xffff, ow = e >> 16;
                    if (blk == cur_) { const int hi = (ow == 7 || ow == tokc) ? tcol : -1; nsa_block8<2>(st, bf, qf8, blk * 64 + dh, hi, false); }
                    else if (ow == 7) nsa_block8<0>(st, bf, qf8, 0, 0, true);
                    else nsa_block8<1>(st, bf, qf8, 0, 0, ow == tokc); };
                nsa_streamb(nblk, ld, cp);
                nsa_fold8(comb, st, gate1);
            }
            {
                NsaSt st; nsa_init(st);
                const bf16_t* Kp = KW + (size_t)bg * 8192 * 64; const bf16_t* Vp = VWT + (size_t)bg * 8192 * 64;
                const int kbf = (t0 > 511 ? t0 - 511 : 0) & ~31, kbl = (t0 + 3) & ~31;
                const int lo = tcol > 511 ? tcol - 511 : 0;
                auto ld = [&](NsaBuf& bf, int i) { const int kb = kbf + i * 32; nsa_load_kf(bf.ka, Kp, kb >> 5, lane); nsa_load_kf(bf.va, Vp, kb >> 5, lane); };
                auto cp = [&](NsaBuf& bf, int i) { const int kb = kbf + i * 32; float sv[8]; nsa_scores(bf.ka, qf, sv); nsa_chunk<true>(st, sv, kb + dh, lo, tcol, bf.va); };
                nsa_stream2(((kbl - kbf) >> 5) + 1, ld, cp);
                nsa_fold(comb, st, gate2);
            }
            {
                bf16_t* op = ONSA + (bt0 + tokc) * 512 + g * 256 + headc * 64 + 4 * h;
#pragma unroll
                for (int dt = 0; dt < 4; ++dt) store_bf16x4(op + dt * 16, comb[dt][0], comb[dt][1], comb[dt][2], comb[dt][3]);
            }
            lds_fence();
        }
    }
    }
    xcd_barrier(xb);

    { PHASE_BEGIN
    {
        auto unpack8 = [](const u32x4& w, f32x4& a, f32x4& b) { a[0] = __uint_as_float(w.x << 16); a[1] = __uint_as_float(w.x & 0xffff0000u); a[2] = __uint_as_float(w.y << 16); a[3] = __uint_as_float(w.y & 0xffff0000u);
            b[0] = __uint_as_float(w.z << 16); b[1] = __uint_as_float(w.z & 0xffff0000u); b[2] = __uint_as_float(w.w << 16); b[3] = __uint_as_float(w.w & 0xffff0000u); };
        auto e1 = [&](int r, int c, const f32x4& v0, const f32x4& v1) { f32x4 m0, m1; unpack8(*(const u32x4*)(MG + (size_t)r * 2048 + c), m0, m1); store_bf16x8(Y + (size_t)r * 1024 + c, m0 * v0, m1 * v1); };
        big_gemm(smem, ONSA, WNSA, 16384, 1024, 512, e1);
        auto e2 = [&](int r, int c, const f32x4& v0, const f32x4& v1) { f32x4 m0, m1, y0, y1; unpack8(*(const u32x4*)(MG + (size_t)r * 2048 + 1024 + c), m0, m1); unpack8(*(const u32x4*)(Y + (size_t)r * 1024 + c), y0, y1);
            store_bf16x8(Y + (size_t)r * 1024 + c, y0 + m0 * v0, y1 + m1 * v1); };
        big_gemm(smem, OGM, WGM, 16384, 1024, 512, e2);
    }
    }
    xcd_barrier(xb);

    { PHASE_BEGIN
    {
        auto epi = [&](int r, int c, const f32x4& v0, const f32x4& v1) { const float* xp = p.x + (size_t)r * 1024 + c; float* op = OUT + (size_t)r * 1024 + c;
            const f32x4 h0 = *(const f32x4*)xp + v0, h1 = *(const f32x4*)(xp + 4) + v1;
            *(f32x4*)op = h0; *(f32x4*)(op + 4) = h1; store_bf16x8(HN + (size_t)r * 1024 + c, h0, h1);
            float ss = (h0[0] * h0[0] + h0[1] * h0[1]) + (h0[2] * h0[2] + h0[3] * h0[3]) + (h1[0] * h1[0] + h1[1] * h1[1]) + (h1[2] * h1[2] + h1[3] * h1[3]);
            ss = xsum16(ss); ss = xsum32(ss);
            if (lane < 16) ss_add(SS + r, ss); };
        big_gemm(smem, Y, WMIX, 16384, 1024, 1024, epi);
    }
    }
    xcd_barrier(xb);

    { PHASE_BEGIN
    {
        auto epi = [&](int r, int c, const f32x4& v0, const f32x4& v1) { const float rs = rsqrtf(ss_get(SS + r) * (1.0f / 1024.0f) + 1e-6f) * 0.0625f; store_bf16x8(QX + (size_t)r * 1024 + c, v0 * rs, v1 * rs); };
        big_gemm(smem, HN, WXQ, 16384, 1024, 1024, epi);
    }
    }
    xcd_barrier(xb);

    { PHASE_BEGIN
    {
        const int c = lane & 15, hg = lane >> 4;
        for (int task = bid; task < 512; task += nb) {
            const int h = task & 3, tg = task >> 2, b = tg >> 6; const size_t bt0 = (size_t)tg * 128 + wave * 16;
            const uint4* Kg = (const uint4*)(KVX + (size_t)(b * 4 + h) * 65536); const uint4* Vg = (const uint4*)(VXT + (size_t)(b * 4 + h) * 65536);
            __syncthreads();
#pragma unroll 4
            for (int i = tid; i < 8192; i += NTHREADS) ((uint4*)smem)[i] = Kg[i];
            bf16x8 qf[8];
#pragma unroll
            for (int ks = 0; ks < 8; ++ks) qf[ks] = *(const bf16x8*)(QX + (bt0 + c) * 1024 + h * 256 + ks * 32 + 8 * hg);
            __syncthreads();
            float sv[8][8];
#pragma unroll
            for (int ch = 0; ch < 8; ++ch) {
                f32x4 s0 = {0.f, 0.f, 0.f, 0.f}, s1 = {0.f, 0.f, 0.f, 0.f};
#pragma unroll
                for (int ks = 0; ks < 8; ++ks) {
                    const bf16x8 a0 = *(const bf16x8*)(smem + ((ch * 16 + ks) * 64 + lane) * 16), a1 = *(const bf16x8*)(smem + ((ch * 16 + 8 + ks) * 64 + lane) * 16);
                    s0 = __builtin_amdgcn_mfma_f32_16x16x32_bf16(a0, qf[ks], s0, 0, 0, 0); s1 = __builtin_amdgcn_mfma_f32_16x16x32_bf16(a1, qf[ks], s1, 0, 0, 0);
                }
                sv[ch][0] = s0[0]; sv[ch][1] = s0[1]; sv[ch][2] = s0[2]; sv[ch][3] = s0[3]; sv[ch][4] = s1[0]; sv[ch][5] = s1[1]; sv[ch][6] = s1[2]; sv[ch][7] = s1[3];
            }
            float m = sv[0][0];
#pragma unroll
            for (int ch = 0; ch < 8; ++ch)
#pragma unroll
                for (int j = 0; j < 8; ++j) m = fmaxf(m, sv[ch][j]);
            m = xmax16(m); m = xmax32(m);
            float l = 0.f; bf16x8 pb[8];
#pragma unroll
            for (int ch = 0; ch < 8; ++ch) { float pp[8];
#pragma unroll
                for (int j = 0; j < 8; ++j) { pp[j] = __expf(sv[ch][j] - m); l += pp[j]; }
                pb[ch] = pack8(pp); }
            l = xsum16(l); l = xsum32(l);
            const float inv = 1.0f / l;
            __syncthreads();
#pragma unroll 4
            for (int i = tid; i < 8192; i += NTHREADS) ((uint4*)smem)[i] = Vg[i];
            __syncthreads();
            bf16_t* op = OX + (bt0 + c) * 1024 + h * 256 + 4 * hg;
#pragma unroll 4
            for (int dt = 0; dt < 16; ++dt) {
                f32x4 o = {0.f, 0.f, 0.f, 0.f};
#pragma unroll
                for (int ch = 0; ch < 8; ++ch) o = __builtin_amdgcn_mfma_f32_16x16x32_bf16(*(const bf16x8*)(smem + ((ch * 16 + dt) * 64 + lane) * 16), pb[ch], o, 0, 0, 0);
                store_bf16x4(op + dt * 16, o[0] * inv, o[1] * inv, o[2] * inv, o[3] * inv);
            }
        }
        __syncthreads();
    }
    }
    xcd_barrier(xb);

    { PHASE_BEGIN
    {
        auto epi = [&](int r, int c, const f32x4& v0, const f32x4& v1) { float* op = OUT + (size_t)r * 1024 + c;
            const f32x4 h0 = *(const f32x4*)op + v0, h1 = *(const f32x4*)(op + 4) + v1;
            *(f32x4*)op = h0; *(f32x4*)(op + 4) = h1; store_bf16x8(HN + (size_t)r * 1024 + c, h0, h1);
            float ss = (h0[0] * h0[0] + h0[1] * h0[1]) + (h0[2] * h0[2] + h0[3] * h0[3]) + (h1[0] * h1[0] + h1[1] * h1[1]) + (h1[2] * h1[2] + h1[3] * h1[3]);
            ss = xsum16(ss); ss = xsum32(ss);
            if (lane < 16) ss_add(SS + 16384 + r, ss); };
        big_gemm(smem, OX, WXO, 16384, 1024, 1024, epi);
    }
    {
        for (int row = bid * 8 + wave; row < 32768; row += nb * 8) {
            const bool isv = row >= 16384; const int rr = isv ? row - 16384 : row;
            const float* src = (isv ? p.peer_v : p.peer_u) + (size_t)rr * 1024 + lane * 16;
            float f[16];
#pragma unroll
            for (int i = 0; i < 4; ++i) { const float4 a = *(const float4*)(src + 4 * i); f[4 * i] = a.x; f[4 * i + 1] = a.y; f[4 * i + 2] = a.z; f[4 * i + 3] = a.w; }
            float am = 0.f;
#pragma unroll
            for (int i = 0; i < 16; ++i) am = fmaxf(am, fabsf(f[i]));
            am = wave_max(am);
            int ex = 0; (void)frexpf(am, &ex);
            if (am == 0.f) ex = 8;
            const float sc = ldexpf(1.0f, 8 - ex);
            uint4 w; unsigned* wp = (unsigned*)&w;
#pragma unroll
            for (int i = 0; i < 4; ++i) { int t = 0; t = __builtin_amdgcn_cvt_pk_fp8_f32(f[4 * i] * sc, f[4 * i + 1] * sc, t, false); t = __builtin_amdgcn_cvt_pk_fp8_f32(f[4 * i + 2] * sc, f[4 * i + 3] * sc, t, true); wp[i] = (unsigned)t; }
            if (isv) *(uint4*)(PV8 + ((size_t)(lane >> 3) * 16384 + rr) * 128 + (lane & 7) * 16) = w;
            else *(uint4*)(PU8 + (size_t)rr * 1024 + lane * 16) = w;
            if (lane == 0) PSC[row] = ldexpf(1.0f, ex - 8);
        }
    }
    }
    xcd_barrier(xb);

    { PHASE_BEGIN
    {
        auto epi = [&](int r, int c, const f32x4& v0, const f32x4& v1) { const float rs = rsqrtf(ss_get(SS + 16384 + r) * (1.0f / 1024.0f) + 1e-6f); store_bf16x8(QP + (size_t)r * 2048 + c, v0 * rs, v1 * rs); };
        big_gemm(smem, HN, WPQ, 16384, 2048, 1024, epi);
    }
    }
    xcd_barrier(xb);

    { PHASE_BEGIN
    {
        const int c = lane & 15, hg = lane >> 4;
        unsigned char* ixl = smem + 131072 + wave * 512;
        for (int rr_ = 0; rr_ < 4 * ((256 - bid + nb - 1) / nb); ++rr_) {
            const int r = rr_ & 3, tq = bid + (rr_ >> 2) * nb;
            __syncthreads();
            { const uint4* src = (const uint4*)(SUBK + (size_t)(4 * r) * 16384);
#pragma unroll 4
              for (int i = tid; i < 8192; i += NTHREADS) ((uint4*)smem)[i] = src[i]; }
            __syncthreads();
            const int h = 2 * r + (wave & 1), tgrp = tq * 4 + (wave >> 1); const size_t bt0 = (size_t)tgrp * 16;
            const LAS bf16_t* K0 = (const LAS bf16_t*)(smem) + (size_t)((wave & 1) * 2) * 16384 + lane * 8;
            unsigned A_[16], B_[16];
            pk_half_top16(A_, QP + (bt0 + c) * 2048 + (2 * h) * 128 + 8 * hg, K0, lane);
            pk_half_top16(B_, QP + (bt0 + c) * 2048 + (2 * h + 1) * 128 + 8 * hg, K0 + 16384, lane);
#pragma unroll
            for (int e = 0; e < 16; ++e) if ((e >> 2) == hg) { ixl[c * 32 + e] = (unsigned char)(127 - (int)(A_[e] & 127u)); ixl[c * 32 + 16 + e] = (unsigned char)(127 - (int)(B_[e] & 127u)); }
            float bv[16];
#pragma unroll
            for (int j = 0; j < 16; ++j) bv[j] = key_val(B_[j]);
            float ar[4];
#pragma unroll
            for (int r = 0; r < 4; ++r) { const unsigned k0 = A_[4 * r], k1 = A_[4 * r + 1], k2 = A_[4 * r + 2], k3 = A_[4 * r + 3];
                ar[r] = key_val(hg == 0 ? k0 : (hg == 1 ? k1 : (hg == 2 ? k2 : k3))); }
            const int L0 = hg == 0 ? 16 : (hg == 1 ? 8 : (hg == 2 ? 5 : 4)), L1 = hg == 0 ? 3 : 2;
            unsigned C0[16], C1[8];
#pragma unroll
            for (int j = 0; j < 16; ++j) C0[j] = j < L0 ? key_pack8(ar[0] + bv[j], hg * 16 + j) : 0u;
#pragma unroll
            for (int j = 0; j < 3; ++j) C1[j] = j < L1 ? key_pack8(ar[1] + bv[j], (4 + hg) * 16 + j) : 0u;
            C1[3] = key_pack8(ar[2] + bv[0], (8 + hg) * 16); C1[4] = key_pack8(ar[3] + bv[0], (12 + hg) * 16); C1[5] = 0u; C1[6] = 0u; C1[7] = 0u;
            bitonic_sort_desc<8>(C1);
#pragma unroll
            for (int e = 8; e < 16; ++e) C0[e] = C0[e] > C1[15 - e] ? C0[e] : C1[15 - e];
            bitonic_merge_desc<16>(C0);
            {
                unsigned pk[16];
#pragma unroll
                for (int e = 0; e < 16; ++e) pk[e] = xchg16(C0[e], lane);
#pragma unroll
                for (int e = 0; e < 16; ++e) C0[e] = C0[e] > pk[15 - e] ? C0[e] : pk[15 - e];
                bitonic_merge_desc<16>(C0);
#pragma unroll
                for (int e = 0; e < 16; ++e) pk[e] = xchg32(C0[e], lane);
#pragma unroll
                for (int e = 0; e < 16; ++e) C0[e] = C0[e] > pk[15 - e] ? C0[e] : pk[15 - e];
                bitonic_merge_desc<16>(C0);
            }
            const float vmax = key_val8(C0[0]);
            float ex_[16]; float se = 0.f;
#pragma unroll
            for (int e = 0; e < 16; ++e) { ex_[e] = __expf(key_val8(C0[e]) - vmax); se += ex_[e]; }
            const float inv = 1.0f / se;
            lds_fence();
            float g4[4]; int e4_[4];
#pragma unroll
            for (int q = 0; q < 4; ++q) {
                const unsigned kq = hg == 0 ? C0[q] : (hg == 1 ? C0[4 + q] : (hg == 2 ? C0[8 + q] : C0[12 + q]));
                const float eq = hg == 0 ? ex_[q] : (hg == 1 ? ex_[4 + q] : (hg == 2 ? ex_[8 + q] : ex_[12 + q]));
                const int f = 255 - (int)(kq & 255u);
                e4_[q] = (int)ixl[c * 32 + (f >> 4)] * 128 + (int)ixl[c * 32 + 16 + (f & 15)];
                g4[q] = eq * inv;
            }
            float* row = HS + (bt0 + c) * 256 + h * 16 + 4 * hg;
            *(float4*)row = make_float4(g4[0], g4[1], g4[2], g4[3]);
            *(int4*)((int*)row + 128) = make_int4(e4_[0], e4_[1], e4_[2], e4_[3]);
            lds_fence();
        }
    }
    }
    xcd_barrier(xb);

    { PHASE_BEGIN
    {
        int* exl = (int*)smem + wave * 256; float* gtl = (float*)(exl + 128);
        for (int tok = bid * 8 + wave; tok < 16384; tok += nb * 8) {
            { const float* row = HS + (size_t)tok * 256;
              gtl[lane] = row[lane]; gtl[64 + lane] = row[64 + lane]; exl[lane] = ((const int*)row)[128 + lane]; exl[64 + lane] = ((const int*)row)[192 + lane]; }
            lds_fence();
            float xv[16];
            { const float rs2 = rsqrtf(ss_get(SS + 16384 + tok) * (1.0f / 1024.0f) + 1e-6f);
              const float* hp2 = OUT + (size_t)tok * 1024 + lane * 16; const float* gpp = p.g_peer + lane * 16;
#pragma unroll
              for (int i = 0; i < 4; ++i) { const float4 hv = *(const float4*)(hp2 + 4 * i), gv = *(const float4*)(gpp + 4 * i);
                  xv[4 * i] = hv.x * rs2 * gv.x; xv[4 * i + 1] = hv.y * rs2 * gv.y; xv[4 * i + 2] = hv.z * rs2 * gv.z; xv[4 * i + 3] = hv.w * rs2 * gv.w; } }
#pragma unroll 1
            for (int e0 = 0; e0 < 128; e0 += 16) {
                uint4 ur[16];
#pragma unroll
                for (int q = 0; q < 16; ++q) ur[q] = *(const uint4*)(PU8 + (size_t)exl[e0 + q] * 1024 + lane * 16);
                float d[16];
#pragma unroll
                for (int q = 0; q < 16; ++q) {
                    typedef float f32x2_ __attribute__((ext_vector_type(2)));
                    const unsigned wp[4] = {ur[q].x, ur[q].y, ur[q].z, ur[q].w}; f32x2_ a2 = {0.f, 0.f};
#pragma unroll
                    for (int i = 0; i < 4; ++i) { const f32x2_ lo = __builtin_amdgcn_cvt_pk_f32_fp8((int)wp[i], false), hi = __builtin_amdgcn_cvt_pk_f32_fp8((int)wp[i], true);
                        a2 = lo * (f32x2_){xv[4 * i], xv[4 * i + 1]} + a2; a2 = hi * (f32x2_){xv[4 * i + 2], xv[4 * i + 3]} + a2; }
                    d[q] = a2[0] + a2[1];
                }
                {
                    const bool u5 = lane & 32, u4 = lane & 16, u3 = lane & 8, u2 = lane & 4;
                    float e8[8], e4[4], e2[2], e1;
#pragma unroll
                    for (int q = 0; q < 8; ++q) { const float keep = u5 ? d[q + 8] : d[q], send = u5 ? d[q] : d[q + 8]; e8[q] = keep + __uint_as_float(xchg32(__float_as_uint(send), lane)); }
#pragma unroll
                    for (int q = 0; q < 4; ++q) { const float keep = u4 ? e8[q + 4] : e8[q], send = u4 ? e8[q] : e8[q + 4]; e4[q] = keep + __uint_as_float(xchg16(__float_as_uint(send), lane)); }
#pragma unroll
                    for (int q = 0; q < 2; ++q) { const float keep = u3 ? e4[q + 2] : e4[q], send = u3 ? e4[q] : e4[q + 2]; e2[q] = keep + __shfl_xor(send, 8); }
                    { const float keep = u2 ? e2[1] : e2[0], send = u2 ? e2[0] : e2[1]; e1 = keep + __shfl_xor(send, 4); }
                    e1 += __shfl_xor(e1, 2); e1 += __shfl_xor(e1, 1);
                    if ((lane & 3) == 0) { const int q = ((lane >> 5) & 1) * 8 + ((lane >> 4) & 1) * 4 + ((lane >> 3) & 1) * 2 + ((lane >> 2) & 1);
                        const int ex_ = exl[e0 + q];
                        gtl[e0 + q] = gtl[e0 + q] * gelu_f(e1 * PSC[ex_]) * PSC[16384 + ex_]; }
                }
            }
            lds_fence();
            { float* crow = HS + (size_t)tok * 256; crow[lane] = gtl[lane]; crow[64 + lane] = gtl[64 + lane];
              ((int*)crow)[128 + lane] = exl[lane]; ((int*)crow)[192 + lane] = exl[64 + lane]; }
            lds_fence();
        }
    }
    }
    xcd_barrier(xb);

    { PHASE_BEGIN
    {
        unsigned* qh = (unsigned*)ws;
        const unsigned xcc = xb.x;
        float* cl = (float*)(smem + wave * 4096);
        const int part = lane & 7, rg = lane >> 3;
        const bool u5 = lane & 32, u4 = lane & 16, u3 = lane & 8;
        const int j0 = 8 * ((lane >> 5) & 1) + 4 * ((lane >> 4) & 1) + 2 * ((lane >> 3) & 1);
        for (int k = 0; k < 8; ++k) {
            const int sl = (int)((xcc + (unsigned)k) & 7u);
            const unsigned char* Vs = PV8 + (size_t)sl * 16384 * 128;
            int cn = 0; if (lane == 0) cn = (int)__hip_atomic_fetch_add(qh + 16 * sl, 1u, __ATOMIC_RELAXED, __HIP_MEMORY_SCOPE_AGENT);
            cn = __builtin_amdgcn_readfirstlane(cn);
            for (;;) {
                const int c = cn;
                if (c >= 4096) break;
                const int tok0 = c * 4;
                {
                    const unsigned char* hsrc = (const unsigned char*)HS + (size_t)tok0 * 1024 + lane * 16;
                    const uint4 r0 = *(const uint4*)hsrc, r1 = *(const uint4*)(hsrc + 1024), r2 = *(const uint4*)(hsrc + 2048), r3 = *(const uint4*)(hsrc + 3072);
                    { int t_ = 0; if (lane == 0) t_ = (int)__hip_atomic_fetch_add(qh + 16 * sl, 1u, __ATOMIC_RELAXED, __HIP_MEMORY_SCOPE_AGENT); cn = __builtin_amdgcn_readfirstlane(t_); }
                    LAS u32x4* cd = (LAS u32x4*)(smem + wave * 4096 + lane * 16);
                    cd[0] = (u32x4){r0.x, r0.y, r0.z, r0.w}; cd[64] = (u32x4){r1.x, r1.y, r1.z, r1.w}; cd[128] = (u32x4){r2.x, r2.y, r2.z, r2.w}; cd[192] = (u32x4){r3.x, r3.y, r3.z, r3.w};
                }
                lds_fence();
#pragma unroll 2
                for (int tt = 0; tt < 4; ++tt) {
                    const int* el = (const int*)(cl + tt * 256 + 128); const float* cf = cl + tt * 256;
                    uint4 v[16];
#pragma unroll
                    for (int i = 0; i < 16; ++i) v[i] = *(const uint4*)(Vs + (unsigned)(el[8 * i + rg] * 128 + part * 16));
                    float* op_ = OUT + (size_t)(tok0 + tt) * 1024 + sl * 128 + part * 16 + j0;
                    const float2 hr = *(const float2*)op_;
                    float ac[16];
#pragma unroll
                    for (int i = 0; i < 16; ++i) ac[i] = 0.f;
#pragma unroll
                    for (int i = 0; i < 16; ++i) { const float cfi = cf[8 * i + rg];
                        const auto l0 = __builtin_amdgcn_cvt_pk_f32_fp8((int)v[i].x, false), h0_ = __builtin_amdgcn_cvt_pk_f32_fp8((int)v[i].x, true);
                        const auto l1 = __builtin_amdgcn_cvt_pk_f32_fp8((int)v[i].y, false), h1_ = __builtin_amdgcn_cvt_pk_f32_fp8((int)v[i].y, true);
                        const auto l2 = __builtin_amdgcn_cvt_pk_f32_fp8((int)v[i].z, false), h2_ = __builtin_amdgcn_cvt_pk_f32_fp8((int)v[i].z, true);
                        const auto l3 = __builtin_amdgcn_cvt_pk_f32_fp8((int)v[i].w, false), h3_ = __builtin_amdgcn_cvt_pk_f32_fp8((int)v[i].w, true);
                        ac[0] += cfi * l0[0]; ac[1] += cfi * l0[1]; ac[2] += cfi * h0_[0]; ac[3] += cfi * h0_[1];
                        ac[4] += cfi * l1[0]; ac[5] += cfi * l1[1]; ac[6] += cfi * h1_[0]; ac[7] += cfi * h1_[1];
                        ac[8] += cfi * l2[0]; ac[9] += cfi * l2[1]; ac[10] += cfi * h2_[0]; ac[11] += cfi * h2_[1];
                        ac[12] += cfi * l3[0]; ac[13] += cfi * l3[1]; ac[14] += cfi * h3_[0]; ac[15] += cfi * h3_[1]; }
                    float e8[8], e4[4], e2[2];
#pragma unroll
                    for (int q = 0; q < 8; ++q) { const float keep = u5 ? ac[q + 8] : ac[q], send = u5 ? ac[q] : ac[q + 8]; e8[q] = keep + __uint_as_float(xchg32(__float_as_uint(send), lane)); }
#pragma unroll
                    for (int q = 0; q < 4; ++q) { const float keep = u4 ? e8[q + 4] : e8[q], send = u4 ? e8[q] : e8[q + 4]; e4[q] = keep + __uint_as_float(xchg16(__float_as_uint(send), lane)); }
#pragma unroll
                    for (int q = 0; q < 2; ++q) { const float keep = u3 ? e4[q + 2] : e4[q], send = u3 ? e4[q] : e4[q + 2]; e2[q] = keep + __shfl_xor(send, 8); }
                    const float h0 = hr.x + e2[0], h1 = hr.y + e2[1];
                    *(float2*)op_ = make_float2(h0, h1);
                    const float ss = wave_sum(h0 * h0 + h1 * h1);
                    if (lane == 0) ss_add(SS + 32768 + tok0 + tt, ss);
                }
                lds_fence();
            }
        }
    }
    }
    xcd_barrier(xb);

    { PHASE_BEGIN
    for (int r = bid * 8 + wave; r < 16384; r += nb * 8) {
        float* hp = OUT + (size_t)r * 1024 + lane * 4;
        const float rr = rsqrtf(ss_get(SS + 32768 + r) * (1.0f / 1024.0f) + 1e-6f);
        float4 hv[4];
#pragma unroll
        for (int i = 0; i < 4; ++i) hv[i] = *(const float4*)(hp + i * 256);
#pragma unroll
        for (int i = 0; i < 4; ++i) { const float4 gg = *(const float4*)(p.g_final + lane * 4 + i * 256);
            *(float4*)(hp + i * 256) = make_float4(hv[i].x * rr * gg.x, hv[i].y * rr * gg.y, hv[i].z * rr * gg.z, hv[i].w * rr * gg.w); }
    }
    }
}

extern "C" void kernel_launch(void* const* d_in, const int* in_sizes, int n_in, void* d_out, int out_size, void* d_ws, size_t ws_size, hipStream_t stream) {
    static int grid_blocks = 0;
    if (grid_blocks == 0) {
        int dev = 0, cus = 0, per_cu = 0;
        hipGetDevice(&dev);
        hipDeviceGetAttribute(&cus, hipDeviceAttributeMultiprocessorCount, dev);
        if (hipFuncSetAttribute((const void*)fwd_mega, hipFuncAttributeMaxDynamicSharedMemorySize, LDS_BYTES) != hipSuccess) { fprintf(stderr, "hipFuncSetAttribute failed\n"); }
        if (hipOccupancyMaxActiveBlocksPerMultiprocessor(&per_cu, (const void*)fwd_mega, NTHREADS, LDS_BYTES) != hipSuccess || per_cu < 1) { fprintf(stderr, "occupancy query failed (%d)\n", per_cu); per_cu = 1; }
        (void)hipGetLastError();
        if (per_cu > 1) per_cu = 1;
        grid_blocks = cus * per_cu;
        if (ws_size < O_END) { fprintf(stderr, "workspace too small: %zu < %zu\n", ws_size, (size_t)O_END); grid_blocks = -1; }
    }
    if (grid_blocks < 0) return;
    Params p{};
    const float** pp = (const float**)&p;
    for (int i = 0; i < 30; ++i) pp[i] = (const float*)d_in[i];
    p.out = (float*)d_out; p.ws = (unsigned char*)d_ws;
    if (hipMemsetAsync((char*)d_ws + O_BAR, 0, 16384, stream) != hipSuccess) { fprintf(stderr, "memset of barrier words failed\n"); return; }
    if (hipMemsetAsync((char*)d_ws + O_B1I, 0, 4096, stream) != hipSuccess) { fprintf(stderr, "memset of bias accumulators failed\n"); return; }
    void* args[] = {&p};
    hipError_t e = hipLaunchKernel((const void*)fwd_mega, dim3(grid_blocks), dim3(NTHREADS), args, LDS_BYTES, stream);
    if (e != hipSuccess) fprintf(stderr, "launch failed: %s (grid %d)\n", hipGetErrorString(e), grid_blocks);
}
```
